# Optimizing an MI355X kernel written in HIP

```python
import math
import jax, jax.numpy as jnp
from jax import lax
import numpy as np


D_MODEL = 1024
BATCH = 8
SEQ = 2048
DEPTH = 4

N_MEM = 256
EPS = 1e-6

A_WIDTH = 512
CONV_WIDTH = 3
POOL_WINDOWS = (2, 4, 8, 16)
POOL_GROUP = 128
B_WIDTH = 512
C_HEADS = 8
C_LATENT = 128
C_HEAD_DIM = 64
IDX_HEADS = 8
IDX_DIM = 64
DSA_TOPK_MAX = 256
Q_BLOCK = 128
REL_BUCKETS = 32
REL_MAX_DIST = 128
D_HEADS = 4
D_KEY = 128
D_VAL = 128
CHUNK = 64
X_HEADS = 4
X_HEAD_DIM = 256
N_KEYS = 128
N_EXPERTS = 16384
PEER_HEADS = 8
PEER_QDIM = 256
PEER_HALF = 128
PEER_TOPK = 16
PEER_BLOCK = 128

EVEN_SPLITS = (512, 512, 512, 512)
ODD_SPLITS = (1024, 128, 512, 64, 8, 512, 512, 512, 512)
EVEN_IN = 2048
ODD_IN = 3784
MIX_WIDTH = 1024

kernel_name = 'hybrid_conv_pool_dsa_hgrn2_peer_trunk'


def _split(a, sizes):
    offs = np.cumsum(sizes)[:-1].tolist()
    return jnp.split(a, offs, axis=-1)


def rmsnorm(x, g):
    xf = x.astype(jnp.float32)
    y = xf * lax.rsqrt(jnp.mean(xf * xf, axis=-1, keepdims=True) + EPS)
    return (y * g.astype(jnp.float32)).astype(x.dtype)


def softmax32(logits, dtype):
    return jax.nn.softmax(logits.astype(jnp.float32), axis=-1).astype(dtype)


def t5_bucket(dist):
    max_exact = REL_BUCKETS // 2
    d = jnp.maximum(dist, 0)
    log_ratio = jnp.log(jnp.maximum(d, 1).astype(jnp.float32) / max_exact) / math.log(REL_MAX_DIST / max_exact)
    large = max_exact + (log_ratio * (REL_BUCKETS - max_exact)).astype(jnp.int32)
    large = jnp.minimum(large, REL_BUCKETS - 1)
    return jnp.where(d < max_exact, d, large)


def short_conv_pool_mixer(h, w_in, conv_w, pool_w, pool_scale, w_out):
    B_, S_, _ = h.shape
    u, gate_c, gate_b, pv = _split(h @ w_in, EVEN_SPLITS)
    z = lax.conv_general_dilated(gate_c * u, conv_w, window_strides=(1,), padding=[(CONV_WIDTH - 1, 0)],
                                 dimension_numbers=('NWC', 'WIO', 'NWC'), feature_group_count=A_WIDTH)
    y_a = gate_b * z
    cs = jnp.cumsum(pv.astype(jnp.float32), axis=1)
    cs = jnp.concatenate([jnp.zeros((B_, 1, B_WIDTH), jnp.float32), cs], axis=1)
    pos = jnp.arange(S_)
    groups = []
    for gi, w in enumerate(POOL_WINDOWS):
        sl = slice(gi * POOL_GROUP, (gi + 1) * POOL_GROUP)
        lo = jnp.maximum(pos + 1 - w, 0)
        cnt = jnp.minimum(pos + 1, w).astype(jnp.float32)
        mean = (cs[:, 1:, sl] - cs[:, lo, sl]) / cnt[None, :, None]
        groups.append(mean.astype(h.dtype) - pv[..., sl])
    pooled = jnp.stack(groups, axis=2)
    y_b = jnp.einsum('bsgc,gcd->bsgd', pooled, pool_w).reshape(B_, S_, B_WIDTH) * pool_scale
    return jnp.concatenate([y_a, y_b], axis=-1) @ w_out


def dsa_attention(q_lat, c_kv, iq, ik, iw, rel_bias):
    B_, S_ = c_kv.shape[:2]
    topk = min(DSA_TOPK_MAX, S_ // 4)
    n_blocks = S_ // Q_BLOCK
    scale = C_LATENT ** -0.5
    idx_scale = IDX_DIM ** -0.5
    key_pos = jnp.arange(S_)

    def block(start):
        qb = lax.dynamic_slice_in_dim(q_lat, start, Q_BLOCK, axis=1)
        iqb = lax.dynamic_slice_in_dim(iq, start, Q_BLOCK, axis=1)
        iwb = lax.dynamic_slice_in_dim(iw, start, Q_BLOCK, axis=1)
        t = start + jnp.arange(Q_BLOCK)
        rel = jax.nn.relu(jnp.einsum('bthd,bsd->bths', iqb, ik) * idx_scale)
        score = jnp.einsum('bths,bth->bts', rel, iwb).astype(jnp.float32)
        causal = key_pos[None, :] <= t[:, None]
        score = jnp.where(causal[None], score, -jnp.inf)
        _, sel = lax.top_k(score, topk)
        c_sel = jax.vmap(lambda c, i: c[i])(c_kv, sel)
        valid = sel <= t[None, :, None]
        bias = rel_bias[t5_bucket(t[None, :, None] - sel)]
        logits = (jnp.einsum('bthr,btkr->bhtk', qb, c_sel).astype(jnp.float32) * scale
                  + jnp.moveaxis(bias, -1, 1).astype(jnp.float32))
        logits = jnp.where(valid[:, None], logits, -jnp.inf)
        p = softmax32(logits, c_kv.dtype)
        return jnp.einsum('bhtk,btkr->bthr', p, c_sel)

    out = lax.map(block, jnp.arange(n_blocks) * Q_BLOCK)
    return jnp.moveaxis(out, 0, 1).reshape(B_, S_, C_HEADS, C_LATENT)


def hgrn2(q, f_logit, inp, gate, lb, norm_g):
    B_, S_, _ = q.shape
    nc = S_ // CHUNK
    f = lb + (1.0 - lb) * jax.nn.sigmoid(f_logit.astype(jnp.float32))
    log_f = jnp.log(f)
    k = 1.0 - f

    def to_chunks(a, d):
        return a.astype(jnp.float32).reshape(B_, nc, CHUNK, D_HEADS, d).transpose(1, 0, 3, 2, 4)

    qc, kc, lfc = to_chunks(q, D_KEY), to_chunks(k, D_KEY), to_chunks(log_f, D_KEY)
    ic = to_chunks(inp, D_VAL)
    causal = jnp.tril(jnp.ones((CHUNK, CHUNK), bool))

    def step(state, xs):
        qj, kj, ij, lfj = xs
        A = jnp.cumsum(lfj, axis=2)
        o_inter = jnp.einsum('bhtk,bhkv->bhtv', qj * jnp.exp(A), state)
        diff = A[:, :, :, None, :] - A[:, :, None, :, :]
        decay = jnp.exp(jnp.where(causal[:, :, None], diff, -jnp.inf))
        scores = jnp.einsum('bhtk,bhsk,bhtsk->bhts', qj, kj, decay)
        o_intra = jnp.einsum('bhts,bhsv->bhtv', scores, ij)
        A_end = A[:, :, -1]
        new_state = (jnp.exp(A_end)[..., None] * state
                     + jnp.einsum('bhsk,bhsv->bhkv', kj * jnp.exp(A_end[:, :, None] - A), ij))
        return new_state, o_inter + o_intra

    state0 = jnp.zeros((B_, D_HEADS, D_KEY, D_VAL), jnp.float32)
    _, o = lax.scan(step, state0, (qc, kc, ic, lfc))
    o = o.transpose(1, 0, 3, 2, 4).reshape(B_, S_, D_HEADS, D_VAL)
    o = o * lax.rsqrt(jnp.mean(o * o, axis=-1, keepdims=True) + EPS) * norm_g.astype(jnp.float32).reshape(D_HEADS, D_VAL)
    return (o.reshape(B_, S_, D_HEADS * D_VAL) * jax.nn.silu(gate.astype(jnp.float32))).astype(q.dtype)


def sparse_attn_hgrn_mixer(h, w_in, kv_norm, w_uv, hg_norm, w_out, rel_bias, lb):
    B_, S_, _ = h.shape
    q_lat, c_kv, iq, ik, iw, hq, hf, hi, hg = _split(h @ w_in, ODD_SPLITS)
    c_kv = rmsnorm(c_kv, kv_norm)
    lat = dsa_attention(q_lat.reshape(B_, S_, C_HEADS, C_LATENT), c_kv,
                        iq.reshape(B_, S_, IDX_HEADS, IDX_DIM), ik, iw * IDX_HEADS ** -0.5, rel_bias)
    y_c = jnp.einsum('bshr,hrd->bshd', lat, w_uv).reshape(B_, S_, C_HEADS * C_HEAD_DIM)
    y_d = hgrn2(hq, hf, hi, hg, lb, hg_norm)
    return jnp.concatenate([y_c, y_d], axis=-1) @ w_out


def memory_cross_attn(h, mem_n, wq, wkv, wo):
    B_, S_, _ = h.shape
    q = (h @ wq).reshape(B_, S_, X_HEADS, X_HEAD_DIM)
    k, v = jnp.split(mem_n @ wkv, 2, axis=-1)
    k = k.reshape(B_, -1, X_HEADS, X_HEAD_DIM)
    v = v.reshape(B_, -1, X_HEADS, X_HEAD_DIM)
    logits = jnp.einsum('bshd,bmhd->bhsm', q, k).astype(jnp.float32) * X_HEAD_DIM ** -0.5
    p = softmax32(logits, h.dtype)
    o = jnp.einsum('bhsm,bmhd->bshd', p, v).reshape(B_, S_, D_MODEL)
    return o @ wo


def peer_ffn(h, wq, sub_keys, u, v):
    B_, S_, D_ = h.shape
    T = B_ * S_
    ht = h.reshape(T, D_)

    def block(start):
        xb = lax.dynamic_slice_in_dim(ht, start, PEER_BLOCK, axis=0)
        q = (xb @ wq).reshape(PEER_BLOCK, PEER_HEADS, 2, PEER_HALF)
        s = jnp.einsum('thpd,hpnd->thpn', q, sub_keys).astype(jnp.float32)
        s1, i1 = lax.top_k(s[:, :, 0], PEER_TOPK)
        s2, i2 = lax.top_k(s[:, :, 1], PEER_TOPK)
        cand = (s1[..., :, None] + s2[..., None, :]).reshape(PEER_BLOCK, PEER_HEADS, PEER_TOPK * PEER_TOPK)
        cand_id = (i1[..., :, None] * N_KEYS + i2[..., None, :]).reshape(PEER_BLOCK, PEER_HEADS, PEER_TOPK * PEER_TOPK)
        top, pos = lax.top_k(cand, PEER_TOPK)
        eid = jnp.take_along_axis(cand_id, pos, axis=-1).reshape(PEER_BLOCK, PEER_HEADS * PEER_TOPK)
        g = jax.nn.softmax(top, axis=-1).reshape(PEER_BLOCK, PEER_HEADS * PEER_TOPK).astype(xb.dtype)
        act = jax.nn.gelu(jnp.einsum('td,ted->te', xb, u[eid]))
        return jnp.einsum('te,ted->td', g * act, v[eid])

    out = lax.map(block, jnp.arange(T // PEER_BLOCK) * PEER_BLOCK)
    return out.reshape(B_, S_, D_)


def setup_inputs(seed: int = 0) -> dict:
    key = jax.random.key(seed)
    ks = iter(jax.random.split(key, 32))
    n_even = (DEPTH + 1) // 2
    n_odd = DEPTH // 2

    def nrm(shape, scale):
        return jax.random.normal(next(ks), shape, jnp.float32) * scale

    def gain(shape):
        return 1.0 + 0.02 * jax.random.normal(next(ks), shape, jnp.float32)

    return {
        'x': nrm((BATCH, SEQ, D_MODEL), 1.0),
        'mem': nrm((BATCH, N_MEM, D_MODEL), 1.0),
        'mix_norm': gain((DEPTH, D_MODEL)),
        'even_w_in': nrm((n_even, D_MODEL, EVEN_IN), D_MODEL ** -0.5),
        'even_conv_w': nrm((n_even, CONV_WIDTH, 1, A_WIDTH), CONV_WIDTH ** -0.5),
        'even_pool_w': nrm((n_even, len(POOL_WINDOWS), POOL_GROUP, POOL_GROUP), POOL_GROUP ** -0.5),
        'even_pool_scale': gain((n_even, B_WIDTH)),
        'even_w_out': nrm((n_even, MIX_WIDTH, D_MODEL), MIX_WIDTH ** -0.5),
        'odd_w_in': nrm((n_odd, D_MODEL, ODD_IN), D_MODEL ** -0.5),
        'odd_kv_norm': gain((n_odd, C_LATENT)),
        'odd_w_uv': nrm((n_odd, C_HEADS, C_LATENT, C_HEAD_DIM), C_LATENT ** -0.5),
        'odd_hg_norm': gain((n_odd, D_HEADS * D_VAL)),
        'odd_w_out': nrm((n_odd, MIX_WIDTH, D_MODEL), MIX_WIDTH ** -0.5),
        'hgrn_gamma': nrm((DEPTH, D_HEADS * D_KEY), 0.5),
        'rel_bias': nrm((REL_BUCKETS, C_HEADS), 0.5),
        'mem_norm': gain((D_MODEL,)),
        'xattn_norm': gain((DEPTH, D_MODEL)),
        'xattn_wq': nrm((DEPTH, D_MODEL, D_MODEL), D_MODEL ** -0.5),
        'xattn_wkv': nrm((DEPTH, D_MODEL, 2 * D_MODEL), D_MODEL ** -0.5),
        'xattn_wo': nrm((DEPTH, D_MODEL, D_MODEL), D_MODEL ** -0.5),
        'peer_norm': gain((DEPTH, D_MODEL)),
        'peer_wq': nrm((DEPTH, D_MODEL, PEER_HEADS * PEER_QDIM), D_MODEL ** -0.5),
        'peer_keys': nrm((DEPTH, PEER_HEADS, 2, N_KEYS, PEER_HALF), PEER_HALF ** -0.5),
        'peer_u': nrm((DEPTH, N_EXPERTS, D_MODEL), D_MODEL ** -0.5),
        'peer_v': nrm((DEPTH, N_EXPERTS, D_MODEL), (PEER_HEADS * PEER_TOPK) ** -0.5),
        'final_norm': gain((D_MODEL,)),
    }


def reference(x, mem, mix_norm, even_w_in, even_conv_w, even_pool_w, even_pool_scale, even_w_out,
              odd_w_in, odd_kv_norm, odd_w_uv, odd_hg_norm, odd_w_out, hgrn_gamma, rel_bias, mem_norm,
              xattn_norm, xattn_wq, xattn_wkv, xattn_wo, peer_norm, peer_wq, peer_keys, peer_u, peer_v,
              final_norm):
    mem_n = rmsnorm(mem, mem_norm)
    p = jax.nn.softmax(hgrn_gamma.astype(jnp.float32), axis=0)
    lower_bounds = jnp.cumsum(p, axis=0) - p
    h = x
    for l in range(DEPTH):
        j = l // 2
        hn = rmsnorm(h, mix_norm[l])
        if l % 2 == 0:
            h = h + short_conv_pool_mixer(hn, even_w_in[j], even_conv_w[j], even_pool_w[j],
                                          even_pool_scale[j], even_w_out[j])
        else:
            h = h + sparse_attn_hgrn_mixer(hn, odd_w_in[j], odd_kv_norm[j], odd_w_uv[j], odd_hg_norm[j],
                                           odd_w_out[j], rel_bias, lower_bounds[l])
        h = h + memory_cross_attn(rmsnorm(h, xattn_norm[l]), mem_n, xattn_wq[l], xattn_wkv[l], xattn_wo[l])
        h = h + peer_ffn(rmsnorm(h, peer_norm[l]), peer_wq[l], peer_keys[l], peer_u[l], peer_v[l])
    return rmsnorm(h, final_norm)
```

```cpp
#include <hip/hip_runtime.h>
#include <hip/hip_bf16.h>
#include <stdint.h>
#include <math.h>
#include <string.h>

#define DI __device__ __forceinline__

constexpr int D = 1024, NB = 8, S = 2048, T = NB * S, DEPTH = 4, NMEM = 256;
constexpr int EVEN_IN = 2048, ODD_IN = 3784;
constexpr int NT = 256;

struct Params {
  const float *x, *mem, *mix_norm, *even_w_in, *even_conv_w, *even_pool_w, *even_pool_scale, *even_w_out;
  const float *odd_w_in, *odd_kv_norm, *odd_w_uv, *odd_hg_norm, *odd_w_out, *hgrn_gamma, *rel_bias, *mem_norm;
  const float *xattn_norm, *xattn_wq, *xattn_wkv, *xattn_wo, *peer_norm, *peer_wq, *peer_keys, *peer_u, *peer_v, *final_norm;
  float* out;
  float *h, *hn, *P, *Y, *pool, *memn, *kv, *ckv, *lat, *oraw, *lb;
};

DI float wave_sum(float v) {
#pragma unroll
  for (int o = 32; o > 0; o >>= 1) v += __shfl_xor(v, o);
  return v;
}
DI float wave_max(float v) {
#pragma unroll
  for (int o = 32; o > 0; o >>= 1) v = fmaxf(v, __shfl_xor(v, o));
  return v;
}
DI float gelu_tanh(float x) {
  const float k0 = 0.7978845608028654f, k1 = 0.044715f;
  return 0.5f * x * (1.f + tanhf(k0 * (x + k1 * x * x * x)));
}
DI float sigmoidf(float x) { return 1.f / (1.f + expf(-x)); }

DI void phase_copy(const float* __restrict__ src, float* __restrict__ dst, size_t n4) {
  const float4* s4 = (const float4*)src; float4* d4 = (float4*)dst;
  for (size_t i = (size_t)blockIdx.x * NT + threadIdx.x; i < n4; i += (size_t)gridDim.x * NT) d4[i] = s4[i];
}

DI void phase_rmsnorm(const float* __restrict__ in, int ldi, const float* __restrict__ g, float* __restrict__ out, int ldo, int rows, int W) {
  const int lane = threadIdx.x & 63, wv = threadIdx.x >> 6;
  for (int r = blockIdx.x * 4 + wv; r < rows; r += gridDim.x * 4) {
    const float* p = in + (size_t)r * ldi;
    float ss = 0.f;
    for (int c = lane; c < W; c += 64) { float v = p[c]; ss += v * v; }
    ss = wave_sum(ss);
    const float rs = rsqrtf(ss / (float)W + 1e-6f);
    float* o = out + (size_t)r * ldo;
    for (int c = lane; c < W; c += 64) o[c] = p[c] * rs * g[c];
  }
}

DI void phase_gemm_f32(const float* __restrict__ A, int lda, const float* __restrict__ W, int ldb, float* __restrict__ C, int ldc,
                       int M, int N, int K, int mode, const float* __restrict__ colscale, float* smem) {
  float (*As)[128] = (float (*)[128])smem;
  float (*Bs)[128] = (float (*)[128])(smem + 16 * 128);
  const int tid = threadIdx.x, ty = tid >> 4, tx = tid & 15;
  const int tm = M / 128, tn = (N + 127) / 128;
  for (int tile = blockIdx.x; tile < tm * tn; tile += gridDim.x) {
    const int m0 = (tile / tn) * 128, n0 = (tile % tn) * 128;
    float acc[8][8];
#pragma unroll
    for (int i = 0; i < 8; ++i)
#pragma unroll
      for (int j = 0; j < 8; ++j) acc[i][j] = 0.f;
    for (int k0 = 0; k0 < K; k0 += 16) {
      {
        const int row = tid >> 1, kq = (tid & 1) * 8;
        const float* ap = A + (size_t)(m0 + row) * lda + k0 + kq;
        float4 a0 = *(const float4*)ap, a1 = *(const float4*)(ap + 4);
        As[kq + 0][row] = a0.x; As[kq + 1][row] = a0.y; As[kq + 2][row] = a0.z; As[kq + 3][row] = a0.w;
        As[kq + 4][row] = a1.x; As[kq + 5][row] = a1.y; As[kq + 6][row] = a1.z; As[kq + 7][row] = a1.w;
        const int kr = tid >> 4, nc = (tid & 15) * 8;
        const float* wp = W + (size_t)(k0 + kr) * ldb + n0 + nc;
        float4 b0 = make_float4(0, 0, 0, 0), b1 = make_float4(0, 0, 0, 0);
        if (n0 + nc < N) b0 = *(const float4*)wp;
        if (n0 + nc + 4 < N) b1 = *(const float4*)(wp + 4);
        *(float4*)&Bs[kr][nc] = b0; *(float4*)&Bs[kr][nc + 4] = b1;
      }
      __syncthreads();
#pragma unroll
      for (int k = 0; k < 16; ++k) {
        float a[8], b[8];
        *(float4*)&a[0] = *(const float4*)&As[k][ty * 8]; *(float4*)&a[4] = *(const float4*)&As[k][ty * 8 + 4];
        *(float4*)&b[0] = *(const float4*)&Bs[k][tx * 8]; *(float4*)&b[4] = *(const float4*)&Bs[k][tx * 8 + 4];
#pragma unroll
        for (int i = 0; i < 8; ++i)
#pragma unroll
          for (int j = 0; j < 8; ++j) acc[i][j] = fmaf(a[i], b[j], acc[i][j]);
      }
      __syncthreads();
    }
#pragma unroll
    for (int i = 0; i < 8; ++i) {
      float* cp = C + (size_t)(m0 + ty * 8 + i) * ldc + n0 + tx * 8;
#pragma unroll
      for (int j = 0; j < 8; ++j) {
        const int n = n0 + tx * 8 + j;
        if (n < N) {
          float v = acc[i][j];
          if (mode == 1) v += cp[j];
          else if (mode == 2) v *= colscale[n];
          cp[j] = v;
        }
      }
    }
  }
}

DI void phase_evenmix(const Params& p, int j) {
  const float* __restrict__ P = p.P;
  const float* cw = p.even_conv_w + (size_t)j * 3 * 512;
  for (size_t idx = (size_t)blockIdx.x * NT + threadIdx.x; idx < (size_t)T * 512; idx += (size_t)gridDim.x * NT) {
    const int t = (int)(idx >> 9), c = (int)(idx & 511);
    const int s = t & (S - 1);
    float z = 0.f;
#pragma unroll
    for (int jj = 0; jj < 3; ++jj) {
      const int ds = 2 - jj;
      if (s - ds >= 0) {
        const float* r = P + (size_t)(t - ds) * EVEN_IN;
        z += cw[jj * 512 + c] * (r[512 + c] * r[c]);
      }
    }
    const float* r = P + (size_t)t * EVEN_IN;
    p.Y[(size_t)t * D + c] = r[1024 + c] * z;
    const int g = c >> 7, w = 2 << g;
    const int cnt = (s + 1 < w) ? (s + 1) : w;
    float sum = 0.f;
    for (int i = 0; i < cnt; ++i) sum += P[(size_t)(t - i) * EVEN_IN + 1536 + c];
    p.pool[(size_t)t * 512 + c] = sum / (float)cnt - r[1536 + c];
  }
}

DI void phase_lb(const Params& p) {
  for (int c = blockIdx.x * NT + threadIdx.x; c < 512; c += gridDim.x * NT) {
    float g[DEPTH], m = -INFINITY;
#pragma unroll
    for (int l = 0; l < DEPTH; ++l) { g[l] = p.hgrn_gamma[l * 512 + c]; m = fmaxf(m, g[l]); }
    float sum = 0.f;
#pragma unroll
    for (int l = 0; l < DEPTH; ++l) { g[l] = expf(g[l] - m); sum += g[l]; }
    float cum = 0.f;
#pragma unroll
    for (int l = 0; l < DEPTH; ++l) { p.lb[l * 512 + c] = cum; cum += g[l] / sum; }
  }
}

DI int t5_bucket(int dist) {
  const int d = dist < 0 ? 0 : dist;
  if (d < 16) return d;
  const float lr = logf((float)d / 16.f) / 2.0794415416798357f;
  int large = 16 + (int)(lr * 16.f);
  return large < 31 ? large : 31;
}

DI unsigned fkey(float f) { unsigned u = __float_as_uint(f); return (u & 0x80000000u) ? ~u : (u | 0x80000000u); }

DI int block_sum_int(int v, int* red) {
  const int lane = threadIdx.x & 63, wv = threadIdx.x >> 6;
#pragma unroll
  for (int o = 32; o > 0; o >>= 1) v += __shfl_xor(v, o);
  __syncthreads();
  if (lane == 0) red[wv] = v;
  __syncthreads();
  return red[0] + red[1] + red[2] + red[3];
}

DI void phase_dsa(const Params& p, int j, float* smem) {
  const float* __restrict__ P = p.P;
  float* sc = smem;
  float* qi = sc + 2048;
  float* ql = qi + 512;
  float* pl = ql + 1024;
  float* wh = pl + 2048;
  int* sel = (int*)(wh + 8);
  int* scan_gt = sel + 256;
  int* scan_eq = scan_gt + 256;
  int* red = scan_eq + 256;
  const int tid = threadIdx.x, lane = tid & 63, wv = tid >> 6;
  for (int q = blockIdx.x; q < T; q += gridDim.x) {
    const int b = q / S, t = q % S;
    const float* row = P + (size_t)q * ODD_IN;
    __syncthreads();
    for (int i = tid; i < 512; i += NT) qi[i] = row[1152 + i];
    for (int i = tid; i < 1024; i += NT) ql[i] = row[i];
    if (tid < 8) wh[tid] = row[1728 + tid] * 0.35355339059327373f;
    __syncthreads();
    for (int s = tid; s < S; s += NT) {
      float score = -INFINITY;
      if (s <= t) {
        const float* kr = P + (size_t)(b * S + s) * ODD_IN + 1664;
        score = 0.f;
        for (int hh = 0; hh < 8; ++hh) {
          float d = 0.f;
          for (int e = 0; e < 64; ++e) d = fmaf(qi[hh * 64 + e], kr[e], d);
          d *= 0.125f;
          score += wh[hh] * fmaxf(d, 0.f);
        }
      }
      sc[s] = score;
    }
    __syncthreads();
    int nsel;
    if (t + 1 <= 256) {
      nsel = t + 1;
      sel[tid] = tid <= t ? tid : 0;
      __syncthreads();
    } else {
      nsel = 256;
      unsigned keys[8];
#pragma unroll
      for (int i = 0; i < 8; ++i) keys[i] = fkey(sc[tid * 8 + i]);
      unsigned thr = 0;
      for (int bit = 31; bit >= 0; --bit) {
        const unsigned cand = thr | (1u << bit);
        int c = 0;
#pragma unroll
        for (int i = 0; i < 8; ++i) c += keys[i] >= cand;
        c = block_sum_int(c, red);
        if (c >= 256) thr = cand;
      }
      int cg = 0, ce = 0;
#pragma unroll
      for (int i = 0; i < 8; ++i) { cg += keys[i] > thr; ce += keys[i] == thr; }
      scan_gt[tid] = cg; scan_eq[tid] = ce;
      __syncthreads();
      for (int o = 1; o < 256; o <<= 1) {
        int a = 0, e = 0;
        if (tid >= o) { a = scan_gt[tid - o]; e = scan_eq[tid - o]; }
        __syncthreads();
        scan_gt[tid] += a; scan_eq[tid] += e;
        __syncthreads();
      }
      const int ngt = scan_gt[255];
      int pg = scan_gt[tid] - cg, pe = scan_eq[tid] - ce;
      const int need = 256 - ngt;
#pragma unroll
      for (int i = 0; i < 8; ++i) {
        if (keys[i] > thr) sel[pg++] = tid * 8 + i;
        else if (keys[i] == thr) { if (pe < need) sel[ngt + pe] = tid * 8 + i; ++pe; }
      }
      __syncthreads();
    }
    {
      const int k = tid;
      float acc[8];
#pragma unroll
      for (int hh = 0; hh < 8; ++hh) acc[hh] = 0.f;
      const bool valid = k < nsel;
      const int sk = valid ? sel[k] : 0;
      const float* cr = p.ckv + (size_t)(b * S + sk) * 128;
      for (int r = 0; r < 128; ++r) {
        const float c = cr[r];
#pragma unroll
        for (int hh = 0; hh < 8; ++hh) acc[hh] = fmaf(ql[hh * 128 + r], c, acc[hh]);
      }
      const int bk = t5_bucket(t - sk);
#pragma unroll
      for (int hh = 0; hh < 8; ++hh)
        pl[hh * 256 + k] = valid ? acc[hh] * 0.08838834764831845f + p.rel_bias[bk * 8 + hh] : -INFINITY;
    }
    __syncthreads();
    for (int hh = 2 * wv; hh < 2 * wv + 2; ++hh) {
      float v[4], m = -INFINITY;
#pragma unroll
      for (int i = 0; i < 4; ++i) { v[i] = pl[hh * 256 + lane + 64 * i]; m = fmaxf(m, v[i]); }
      m = wave_max(m);
      float sum = 0.f;
#pragma unroll
      for (int i = 0; i < 4; ++i) { v[i] = expf(v[i] - m); sum += v[i]; }
      sum = wave_sum(sum);
      const float inv = 1.f / sum;
#pragma unroll
      for (int i = 0; i < 4; ++i) pl[hh * 256 + lane + 64 * i] = v[i] * inv;
    }
    __syncthreads();
    {
      const int r = tid & 127, h0 = tid >> 7;
      float acc[4] = {0.f, 0.f, 0.f, 0.f};
      for (int k = 0; k < nsel; ++k) {
        const float c = p.ckv[(size_t)(b * S + sel[k]) * 128 + r];
#pragma unroll
        for (int i = 0; i < 4; ++i) acc[i] = fmaf(pl[(h0 + 2 * i) * 256 + k], c, acc[i]);
      }
#pragma unroll
      for (int i = 0; i < 4; ++i) p.lat[(size_t)q * D + (h0 + 2 * i) * 128 + r] = acc[i];
    }
  }
}

DI void phase_hgrn(const Params& p, int l, float* smem) {
  const float* __restrict__ P = p.P;
  float* sq = smem;
  float* sf = sq + 16 * 128;
  float* si = sf + 16 * 128;
  float* so = si + 16 * 128;
  const int tid = threadIdx.x, v = tid & 127, kh = tid >> 7;
  for (int u = blockIdx.x; u < NB * 4; u += gridDim.x) {
    const int b = u >> 2, hd = u & 3;
    float st[64];
#pragma unroll
    for (int i = 0; i < 64; ++i) st[i] = 0.f;
    for (int t0 = 0; t0 < S; t0 += 16) {
      __syncthreads();
      for (int i = tid; i < 16 * 128; i += NT) {
        const int tt = i >> 7, c = i & 127;
        const float* row = P + (size_t)(b * S + t0 + tt) * ODD_IN;
        sq[i] = row[1736 + hd * 128 + c];
        const float lbv = p.lb[l * 512 + hd * 128 + c];
        sf[i] = lbv + (1.f - lbv) * sigmoidf(row[2248 + hd * 128 + c]);
        si[i] = row[2760 + hd * 128 + c];
      }
      __syncthreads();
      for (int tt = 0; tt < 16; ++tt) {
        const float iv = si[tt * 128 + v];
        float o = 0.f;
#pragma unroll
        for (int i = 0; i < 64; ++i) {
          const float f = sf[tt * 128 + kh * 64 + i];
          st[i] = fmaf(f, st[i], (1.f - f) * iv);
          o = fmaf(sq[tt * 128 + kh * 64 + i], st[i], o);
        }
        so[(tt * 2 + kh) * 128 + v] = o;
      }
      __syncthreads();
      for (int i = tid; i < 16 * 128; i += NT) {
        const int tt = i >> 7, c = i & 127;
        p.oraw[(size_t)(b * S + t0 + tt) * 512 + hd * 128 + c] = so[(tt * 2) * 128 + c] + so[(tt * 2 + 1) * 128 + c];
      }
    }
  }
}

DI void phase_hgrn_post(const Params& p, int j) {
  const int lane = threadIdx.x & 63, wv = threadIdx.x >> 6;
  for (int r = blockIdx.x * 4 + wv; r < T * 4; r += gridDim.x * 4) {
    const int t = r >> 2, hd = r & 3;
    const float* o = p.oraw + (size_t)t * 512 + hd * 128;
    const float a = o[lane], bq = o[lane + 64];
    const float ss = wave_sum(a * a + bq * bq);
    const float rs = rsqrtf(ss / 128.f + 1e-6f);
    const float* gate = p.P + (size_t)t * ODD_IN + 3272 + hd * 128;
    const float* gn = p.odd_hg_norm + j * 512 + hd * 128;
    const float g0 = gate[lane], g1 = gate[lane + 64];
    p.Y[(size_t)t * D + 512 + hd * 128 + lane] = a * rs * gn[lane] * (g0 * sigmoidf(g0));
    p.Y[(size_t)t * D + 512 + hd * 128 + lane + 64] = bq * rs * gn[lane + 64] * (g1 * sigmoidf(g1));
  }
}

DI void phase_xattn(const Params& p, float* smem) {
  float* sq = smem;
  float* sp = sq + 256;
  float* red = sp + 256;
  const int tid = threadIdx.x, lane = tid & 63, wv = tid >> 6;
  for (int t = blockIdx.x; t < T; t += gridDim.x) {
    const int b = t / S;
    for (int hd = 0; hd < 4; ++hd) {
      __syncthreads();
      sq[tid] = p.P[(size_t)t * D + hd * 256 + tid];
      __syncthreads();
      const float* kr = p.kv + (size_t)(b * NMEM + tid) * 2048 + hd * 256;
      float d = 0.f;
      for (int e = 0; e < 256; e += 4) {
        const float4 k4 = *(const float4*)(kr + e);
        d = fmaf(sq[e], k4.x, d); d = fmaf(sq[e + 1], k4.y, d); d = fmaf(sq[e + 2], k4.z, d); d = fmaf(sq[e + 3], k4.w, d);
      }
      d *= 0.0625f;
      float m = wave_max(d);
      if (lane == 0) red[wv] = m;
      __syncthreads();
      m = fmaxf(fmaxf(red[0], red[1]), fmaxf(red[2], red[3]));
      const float e = expf(d - m);
      float sum = wave_sum(e);
      if (lane == 0) red[4 + wv] = sum;
      __syncthreads();
      sum = red[4] + red[5] + red[6] + red[7];
      sp[tid] = e / sum;
      __syncthreads();
      float o = 0.f;
      const float* vr = p.kv + (size_t)(b * NMEM) * 2048 + 1024 + hd * 256 + tid;
      for (int mm = 0; mm < NMEM; ++mm) o = fmaf(sp[mm], vr[(size_t)mm * 2048], o);
      p.Y[(size_t)t * D + hd * 256 + tid] = o;
    }
  }
}

DI void phase_peer(const Params& p, int l, float* smem) {
  float* sx = smem;
  float* sqv = sx + 1024;
  float* ss = sqv + 2048;
  float* stop = ss + 2048;
  int* itop = (int*)(stop + 256);
  float* cv = (float*)(itop + 256);
  float* gsel = cv + 256;
  int* esel = (int*)(gsel + 128);
  float* wts = (float*)(esel + 128);
  const int tid = threadIdx.x, lane = tid & 63, wv = tid >> 6;
  const float* keys = p.peer_keys + (size_t)l * 8 * 2 * 128 * 128;
  const float* U = p.peer_u + (size_t)l * 16384 * 1024;
  const float* V = p.peer_v + (size_t)l * 16384 * 1024;
  for (int t = blockIdx.x; t < T; t += gridDim.x) {
    __syncthreads();
    for (int i = tid; i < 1024; i += NT) sx[i] = p.hn[(size_t)t * D + i];
    for (int i = tid; i < 2048; i += NT) sqv[i] = p.P[(size_t)t * 2048 + i];
    __syncthreads();
    for (int i = 0; i < 8; ++i) {
      const int idx = tid + NT * i, hp = idx >> 7, n = idx & 127;
      const float* kr = keys + ((size_t)hp * 128 + n) * 128;
      const float* qq = sqv + hp * 128;
      float d = 0.f;
      for (int e = 0; e < 128; e += 4) {
        const float4 k4 = *(const float4*)(kr + e);
        d = fmaf(qq[e], k4.x, d); d = fmaf(qq[e + 1], k4.y, d); d = fmaf(qq[e + 2], k4.z, d); d = fmaf(qq[e + 3], k4.w, d);
      }
      ss[idx] = d;
    }
    __syncthreads();
    for (int g = 4 * wv; g < 4 * wv + 4; ++g) {
      float v0 = ss[g * 128 + lane], v1 = ss[g * 128 + 64 + lane];
      for (int r = 0; r < 16; ++r) {
        float bv; int bi;
        if (v0 >= v1) { bv = v0; bi = lane; } else { bv = v1; bi = lane + 64; }
#pragma unroll
        for (int o = 32; o > 0; o >>= 1) {
          const float ov = __shfl_xor(bv, o); const int oi = __shfl_xor(bi, o);
          if (ov > bv || (ov == bv && oi < bi)) { bv = ov; bi = oi; }
        }
        if (lane == 0) { stop[g * 16 + r] = bv; itop[g * 16 + r] = bi; }
        if (bi == lane) v0 = -INFINITY;
        if (bi == lane + 64) v1 = -INFINITY;
      }
    }
    __syncthreads();
    for (int hd = 0; hd < 8; ++hd) {
      const int i = tid >> 4, jx = tid & 15;
      const float val = stop[(hd * 2) * 16 + i] + stop[(hd * 2 + 1) * 16 + jx];
      const int id = itop[(hd * 2) * 16 + i] * 128 + itop[(hd * 2 + 1) * 16 + jx];
      cv[tid] = val;
      __syncthreads();
      int rank = 0;
      for (int c = 0; c < 256; ++c) { const float o = cv[c]; rank += (o > val) || (o == val && c < tid); }
      if (rank < 16) { gsel[hd * 16 + rank] = val; esel[hd * 16 + rank] = id; }
      __syncthreads();
    }
    if (tid < 128) {
      const int hd = tid >> 4;
      float m = -INFINITY;
      for (int r = 0; r < 16; ++r) m = fmaxf(m, gsel[hd * 16 + r]);
      float sum = 0.f;
      for (int r = 0; r < 16; ++r) sum += expf(gsel[hd * 16 + r] - m);
      wts[tid] = expf(gsel[tid] - m) / sum;
    }
    __syncthreads();
    if (tid < 128) gsel[tid] = wts[tid];
    __syncthreads();
    for (int e = wv; e < 128; e += 4) {
      const float* ur = U + (size_t)esel[e] * 1024;
      float d = 0.f;
#pragma unroll
      for (int i = 0; i < 4; ++i) {
        const float4 u4 = *(const float4*)(ur + i * 256 + lane * 4);
        const float* xx = sx + i * 256 + lane * 4;
        d = fmaf(xx[0], u4.x, d); d = fmaf(xx[1], u4.y, d); d = fmaf(xx[2], u4.z, d); d = fmaf(xx[3], u4.w, d);
      }
      d = wave_sum(d);
      if (lane == 0) wts[e] = gsel[e] * gelu_tanh(d);
    }
    __syncthreads();
    float4 acc = make_float4(0, 0, 0, 0);
    for (int e = 0; e < 128; ++e) {
      const float4 v4 = *(const float4*)(V + (size_t)esel[e] * 1024 + tid * 4);
      const float w = wts[e];
      acc.x = fmaf(w, v4.x, acc.x); acc.y = fmaf(w, v4.y, acc.y); acc.z = fmaf(w, v4.z, acc.z); acc.w = fmaf(w, v4.w, acc.w);
    }
    float4* hp4 = (float4*)(p.h + (size_t)t * D + tid * 4);
    float4 hv = *hp4;
    hv.x += acc.x; hv.y += acc.y; hv.z += acc.z; hv.w += acc.w;
    *hp4 = hv;
  }
}

enum { PH_COPY, PH_NORM, PH_GEMM, PH_EVENMIX, PH_LB, PH_DSA, PH_HGRN, PH_HGRN_POST, PH_XATTN, PH_PEER };

struct GemmArgs { const float* A; const float* W; float* C; const float* cs; int lda, ldb, ldc, M, N, K, mode, pad; };
struct NormArgs { const float* in; const float* g; float* out; int ldi, ldo, rows, W; };

__global__ void __launch_bounds__(NT) k_copy(Params p) { phase_copy(p.x, p.h, (size_t)T * D / 4); }
__global__ void __launch_bounds__(NT) k_norm(NormArgs a) { phase_rmsnorm(a.in, a.ldi, a.g, a.out, a.ldo, a.rows, a.W); }
__global__ void __launch_bounds__(NT) k_gemm(GemmArgs a) {
  __shared__ float smem[2 * 16 * 128];
  phase_gemm_f32(a.A, a.lda, a.W, a.ldb, a.C, a.ldc, a.M, a.N, a.K, a.mode, a.cs, smem);
}
__global__ void __launch_bounds__(NT) k_evenmix(Params p, int j) { phase_evenmix(p, j); }
__global__ void __launch_bounds__(NT) k_lb(Params p) { phase_lb(p); }
__global__ void __launch_bounds__(NT) k_dsa(Params p, int j) {
  __shared__ float smem[2048 + 512 + 1024 + 2048 + 8 + 256 * 3 + 8];
  phase_dsa(p, j, smem);
}
__global__ void __launch_bounds__(NT) k_hgrn(Params p, int l) {
  __shared__ float smem[16 * 128 * 5];
  phase_hgrn(p, l, smem);
}
__global__ void __launch_bounds__(NT) k_hgrn_post(Params p, int j) { phase_hgrn_post(p, j); }
__global__ void __launch_bounds__(NT) k_xattn(Params p) {
  __shared__ float smem[256 * 2 + 8];
  phase_xattn(p, smem);
}
__global__ void __launch_bounds__(NT) k_peer(Params p, int l) {
  __shared__ float smem[1024 + 2048 + 2048 + 256 * 3 + 128 * 3];
  phase_peer(p, l, smem);
}

static void gemm(hipStream_t st, const float* A, int lda, const float* W, int ldb, float* C, int ldc, int M, int N, int K, int mode, const float* cs = nullptr) {
  GemmArgs a; memset(&a, 0, sizeof(a));
  a.A = A; a.W = W; a.C = C; a.cs = cs; a.lda = lda; a.ldb = ldb; a.ldc = ldc; a.M = M; a.N = N; a.K = K; a.mode = mode;
  const int tiles = (M / 128) * ((N + 127) / 128);
  k_gemm<<<tiles < 4096 ? tiles : 4096, NT, 0, st>>>(a);
}
static void norm(hipStream_t st, const float* in, int ldi, const float* g, float* out, int ldo, int rows, int W) {
  NormArgs a; memset(&a, 0, sizeof(a));
  a.in = in; a.g = g; a.out = out; a.ldi = ldi; a.ldo = ldo; a.rows = rows; a.W = W;
  k_norm<<<2048, NT, 0, st>>>(a);
}

extern "C" void kernel_launch(void* const* d_in, const int* in_sizes, int n_in, void* d_out, int out_size, void* d_ws, size_t ws_size,
                              hipStream_t stream) {
  Params p; memset(&p, 0, sizeof(p));
  const float* const* in = (const float* const*)d_in;
  p.x = in[0]; p.mem = in[1]; p.mix_norm = in[2]; p.even_w_in = in[3]; p.even_conv_w = in[4]; p.even_pool_w = in[5];
  p.even_pool_scale = in[6]; p.even_w_out = in[7]; p.odd_w_in = in[8]; p.odd_kv_norm = in[9]; p.odd_w_uv = in[10];
  p.odd_hg_norm = in[11]; p.odd_w_out = in[12]; p.hgrn_gamma = in[13]; p.rel_bias = in[14]; p.mem_norm = in[15];
  p.xattn_norm = in[16]; p.xattn_wq = in[17]; p.xattn_wkv = in[18]; p.xattn_wo = in[19]; p.peer_norm = in[20];
  p.peer_wq = in[21]; p.peer_keys = in[22]; p.peer_u = in[23]; p.peer_v = in[24]; p.final_norm = in[25];
  p.out = (float*)d_out;
  float* w = (float*)d_ws;
  auto take = [&](size_t n) { float* r = w; w += (n + 63) / 64 * 64; return r; };
  p.h = take((size_t)T * D); p.hn = take((size_t)T * D); p.P = take((size_t)T * ODD_IN); p.Y = take((size_t)T * D);
  p.pool = take((size_t)T * 512); p.memn = take((size_t)NB * NMEM * D); p.kv = take((size_t)NB * NMEM * 2048);
  p.ckv = take((size_t)T * 128); p.lat = take((size_t)T * D); p.oraw = take((size_t)T * 512); p.lb = take(DEPTH * 512);

  const int G = 2048;
  k_copy<<<G, NT, 0, stream>>>(p);
  k_lb<<<2, NT, 0, stream>>>(p);
  norm(stream, p.mem, D, p.mem_norm, p.memn, D, NB * NMEM, D);
  for (int l = 0; l < DEPTH; ++l) {
    const int j = l / 2;
    norm(stream, p.h, D, p.mix_norm + l * D, p.hn, D, T, D);
    if ((l & 1) == 0) {
      gemm(stream, p.hn, D, p.even_w_in + (size_t)j * D * EVEN_IN, EVEN_IN, p.P, EVEN_IN, T, EVEN_IN, D, 0);
      k_evenmix<<<G, NT, 0, stream>>>(p, j);
      for (int g = 0; g < 4; ++g)
        gemm(stream, p.pool + g * 128, 512, p.even_pool_w + ((size_t)j * 4 + g) * 128 * 128, 128, p.Y + 512 + g * 128, D, T, 128, 128, 2,
             p.even_pool_scale + j * 512 + g * 128 - 0);
      gemm(stream, p.Y, D, p.even_w_out + (size_t)j * D * D, D, p.h, D, T, D, D, 1);
    } else {
      gemm(stream, p.hn, D, p.odd_w_in + (size_t)j * D * ODD_IN, ODD_IN, p.P, ODD_IN, T, ODD_IN, D, 0);
      norm(stream, p.P + 1024, ODD_IN, p.odd_kv_norm + j * 128, p.ckv, 128, T, 128);
      k_dsa<<<G, NT, 0, stream>>>(p, j);
      for (int hd = 0; hd < 8; ++hd)
        gemm(stream, p.lat + hd * 128, D, p.odd_w_uv + ((size_t)j * 8 + hd) * 128 * 64, 64, p.Y + hd * 64, D, T, 64, 128, 0);
      k_hgrn<<<32, NT, 0, stream>>>(p, l);
      k_hgrn_post<<<G, NT, 0, stream>>>(p, j);
      gemm(stream, p.Y, D, p.odd_w_out + (size_t)j * D * D, D, p.h, D, T, D, D, 1);
    }
    norm(stream, p.h, D, p.xattn_norm + l * D, p.hn, D, T, D);
    gemm(stream, p.hn, D, p.xattn_wq + (size_t)l * D * D, D, p.P, D, T, D, D, 0);
    gemm(stream, p.memn, D, p.xattn_wkv + (size_t)l * D * 2048, 2048, p.kv, 2048, NB * NMEM, 2048, D, 0);
    k_xattn<<<G, NT, 0, stream>>>(p);
    gemm(stream, p.Y, D, p.xattn_wo + (size_t)l * D * D, D, p.h, D, T, D, D, 1);
    norm(stream, p.h, D, p.peer_norm + l * D, p.hn, D, T, D);
    gemm(stream, p.hn, D, p.peer_wq + (size_t)l * D * 2048, 2048, p.P, 2048, T, 2048, D, 0);
    k_peer<<<G, NT, 0, stream>>>(p, l);
  }
  norm(stream, p.h, D, p.final_norm, p.out, D, T, D);
}
```

```cpp
#include <hip/hip_runtime.h>
#include <hip/hip_bf16.h>
#include <stdint.h>
#include <math.h>
#include <string.h>

#define DI __device__ __forceinline__

constexpr int D = 1024, NB = 8, S = 2048, T = NB * S, DEPTH = 4, NMEM = 256;
constexpr int EVEN_IN = 2048, ODD_IN = 3784;
constexpr int NT = 256;

typedef unsigned short bf16_t;
struct Params {
  const float *x, *mem, *mix_norm, *even_w_in, *even_conv_w, *even_pool_w, *even_pool_scale, *even_w_out;
  const float *odd_w_in, *odd_kv_norm, *odd_w_uv, *odd_hg_norm, *odd_w_out, *hgrn_gamma, *rel_bias, *mem_norm;
  const float *xattn_norm, *xattn_wq, *xattn_wkv, *xattn_wo, *peer_norm, *peer_wq, *peer_keys, *peer_u, *peer_v, *final_norm;
  float* out;
  float *h, *P, *kv, *ckv, *oraw, *lb; bf16_t* P16;
  bf16_t *hn, *Y, *pool, *memn, *lat;
  bf16_t *u16, *v16, *keys16; int* tops; signed char *u8, *v8, *x8; float *su, *sxq, *sel_su;
  float* rss;
  bf16_t *q16, *kvh, *p16; float* sx; int* sel_id; float* sel_g; float* pbuf;
  bf16_t *qlat16, *ckv16, *iq16, *ik16; float* sc; unsigned* qctr;
  bf16_t *w_even_in, *w_even_pool, *w_even_out, *w_odd_in, *w_odd_uv, *w_odd_out, *w_xq, *w_xkv, *w_xo, *w_pq;
  unsigned* bar;
  int probe, pad_;
};

#define XB_TMO      128
#define XB_XCNT(j)  (256  + 64 * (j))
#define XB_XSUB(j)  (1280 + 64 * (j))
#define XB_XGEN(j)  (2304 + 64 * (j))
#define XB_TOP      3328
#define XB_TOPGEN   3392
#define XCD_BAR_WORDS 3456
#define XB_SPIN_CAP (1u << 18)
#define LAS __attribute__((address_space(3)))

__device__ __forceinline__ unsigned xb_ld(unsigned* p)              { return __hip_atomic_load(p, __ATOMIC_RELAXED, __HIP_MEMORY_SCOPE_AGENT); }
__device__ __forceinline__ unsigned xb_add(unsigned* p, unsigned v) { return __hip_atomic_fetch_add(p, v, __ATOMIC_RELAXED, __HIP_MEMORY_SCOPE_AGENT); }
__device__ __forceinline__ unsigned xb_xcc_id() { return (unsigned)__builtin_amdgcn_s_getreg((3 << 11) | 20) & 0xFu; }
#define XB_SPIN(cond, bar) do { unsigned _sp = 0; while (cond) { __builtin_amdgcn_s_sleep(1); \
    if ((++_sp & 255u) == 0u) { if (xb_ld(&(bar)[XB_TMO])) break; if (_sp > XB_SPIN_CAP) { atomicAdd(&(bar)[XB_TMO], 1u); break; } } } } while (0)

typedef const __attribute__((address_space(3))) Params& PRef;
DI const __attribute__((address_space(3))) Params* lp(const __attribute__((address_space(3))) Params* q) { asm volatile("" : "+v"(q)); return q; }
struct XcdBarrier {
    unsigned* bar; unsigned x;
    volatile LAS unsigned* st;
};

__device__ __forceinline__ XcdBarrier xcd_barrier_post(unsigned* bar, volatile LAS unsigned* st) {
    XcdBarrier b; b.bar = bar; b.x = xb_xcc_id(); b.st = st;
    if (threadIdx.x == 0) (void)xb_add(&bar[XB_XCNT(b.x)], 1u);
    return b;
}
__device__ __forceinline__ void xcd_barrier_complete(unsigned* bar, unsigned x, unsigned& nloc, unsigned& nx) {
    const unsigned G = gridDim.x * gridDim.y * gridDim.z;
    unsigned sum, cnt, mine, sp = 0u;
    for (;;) {
        sum = 0u; cnt = 0u; mine = 0u;
#pragma unroll
        for (unsigned j = 0; j < 16; ++j) { const unsigned c = xb_ld(&bar[XB_XCNT(j)]); sum += c; cnt += (c > 0u) ? 1u : 0u; mine = (j == x) ? c : mine; }
        if (sum == G) break;
        __builtin_amdgcn_s_sleep(1);
        if ((++sp & 255u) == 0u) { if (xb_ld(&bar[XB_TMO])) break; if (sp > XB_SPIN_CAP) { atomicAdd(&bar[XB_TMO], 1u); break; } }
    }
    nloc = mine > 0u ? mine : 1u; nx = cnt > 0u ? cnt : 1u;
}

__device__ __forceinline__ void xcd_barrier(const XcdBarrier& b) {
    asm volatile("s_waitcnt vmcnt(0)" ::: "memory");
    __syncthreads();
    if (threadIdx.x == 0) {
        unsigned* bar = b.bar;
        __builtin_amdgcn_s_waitcnt(0);
        unsigned nloc = b.st[0], nx = b.st[1];
        if (nloc == 0u) { xcd_barrier_complete(bar, b.x, nloc, nx); b.st[0] = nloc; b.st[1] = nx; }
        const unsigned old = xb_add(&bar[XB_XSUB(b.x)], 1u);
        const unsigned gen = old / nloc;
        if (old + 1u == (gen + 1u) * nloc) {
            __builtin_amdgcn_fence(__ATOMIC_RELEASE, "agent");
            asm volatile("s_waitcnt vmcnt(0)" ::: "memory");
            const unsigned og = xb_add(&bar[XB_TOP], 1u);
            const unsigned tg = og / nx;
            if (og + 1u == (tg + 1u) * nx) xb_add(&bar[XB_TOPGEN], 1u);
            else XB_SPIN(xb_ld(&bar[XB_TOPGEN]) == tg, bar);
            __builtin_amdgcn_fence(__ATOMIC_ACQUIRE, "agent");
            xb_add(&bar[XB_XGEN(b.x)], 1u);
            asm volatile("s_waitcnt vmcnt(0)" ::: "memory");
        } else {
            XB_SPIN(xb_ld(&bar[XB_XGEN(b.x)]) == gen, bar);
            __builtin_amdgcn_fence(__ATOMIC_ACQUIRE, "agent");
            asm volatile("s_waitcnt vmcnt(0)" ::: "memory");
        }
    }
    __syncthreads();
}


typedef __bf16 bf16x2_t __attribute__((ext_vector_type(2)));
typedef float f32x2_t __attribute__((ext_vector_type(2)));
using bf16x8 = __attribute__((ext_vector_type(8))) short;
using f32x16 = __attribute__((ext_vector_type(16))) float;
using u32x4 = __attribute__((ext_vector_type(4))) unsigned;
using u32x2 = __attribute__((ext_vector_type(2))) unsigned;
using f32x4v = __attribute__((ext_vector_type(4))) float;
using f32x2v = __attribute__((ext_vector_type(2))) float;
#define GAS __attribute__((address_space(1)))
typedef const GAS u32x4* gp_u32x4;
DI u32x4 gload16(const void* p) { return *(gp_u32x4)(p); }
DI bf16_t f2bf(float f) { __bf16 b = (__bf16)f; return __builtin_bit_cast(unsigned short, b); }
DI unsigned pack2(float a, float b) { f32x2_t v = {a, b}; bf16x2_t r = __builtin_convertvector(v, bf16x2_t); return __builtin_bit_cast(unsigned, r); }
DI float bf2f(bf16_t u) { return __uint_as_float(((unsigned)u) << 16); }
DI float bflo(unsigned u) { return __uint_as_float(u << 16); }
DI float bfhi(unsigned u) { return __uint_as_float(u & 0xffff0000u); }
DI f32x4v bf4_to_f(const u32x2 v) { const unsigned a = v[0], b = v[1]; f32x4v r; r[0] = bflo(a); r[1] = bfhi(a); r[2] = bflo(b); r[3] = bfhi(b); return r; }
DI int ltid(int wq) { int t; asm volatile("v_mbcnt_lo_u32_b32 %0, -1, 0\n\tv_mbcnt_hi_u32_b32 %0, -1, %0" : "=v"(t)); return (wq << 6) | t; }
DI int lbid() { int b = blockIdx.x; asm volatile("" : "+s"(b)); return b; }
#define DPP_F(v, ctrl, rmask, bctl) __int_as_float(__builtin_amdgcn_update_dpp(0, __float_as_int(v), (ctrl), (rmask), 0xF, (bctl)))
DI float wave_sum(float v) {
  v += DPP_F(v, 0xB1, 0xF, true);
  v += DPP_F(v, 0x4E, 0xF, true);
  v += DPP_F(v, 0x141, 0xF, true);
  v += DPP_F(v, 0x140, 0xF, true);
  v += DPP_F(v, 0x142, 0xA, false);
  v += DPP_F(v, 0x143, 0xC, false);
  return __int_as_float(__builtin_amdgcn_readlane(__float_as_int(v), 63));
}
#define DPP_I(v, ctrl, rmask, bctl) __builtin_amdgcn_update_dpp(0, (v), (ctrl), (rmask), 0xF, (bctl))
DI int wave_sum_i(int v) {
  v += DPP_I(v, 0xB1, 0xF, true); v += DPP_I(v, 0x4E, 0xF, true); v += DPP_I(v, 0x141, 0xF, true); v += DPP_I(v, 0x140, 0xF, true);
  v += DPP_I(v, 0x142, 0xA, false); v += DPP_I(v, 0x143, 0xC, false);
  return __builtin_amdgcn_readlane(v, 63);
}
DI float wave_max(float v) {
  v = fmaxf(v, DPP_F(v, 0xB1, 0xF, true));
  v = fmaxf(v, DPP_F(v, 0x4E, 0xF, true));
  v = fmaxf(v, DPP_F(v, 0x141, 0xF, true));
  v = fmaxf(v, DPP_F(v, 0x140, 0xF, true));
  { const float t = __int_as_float(__builtin_amdgcn_update_dpp(__float_as_int(v), __float_as_int(v), 0x142, 0xA, 0xF, false)); v = fmaxf(v, t); }
  { const float t = __int_as_float(__builtin_amdgcn_update_dpp(__float_as_int(v), __float_as_int(v), 0x143, 0xC, 0xF, false)); v = fmaxf(v, t); }
  return __int_as_float(__builtin_amdgcn_readlane(__float_as_int(v), 63));
}
DI float rowsum16(float v) { v += DPP_F(v, 0x128, 0xF, true); v += DPP_F(v, 0x124, 0xF, true); v += DPP_F(v, 0x122, 0xF, true); v += DPP_F(v, 0x121, 0xF, true); return v; }
DI float rowmax16(float v) { v = fmaxf(v, DPP_F(v, 0x128, 0xF, true)); v = fmaxf(v, DPP_F(v, 0x124, 0xF, true)); v = fmaxf(v, DPP_F(v, 0x122, 0xF, true)); v = fmaxf(v, DPP_F(v, 0x121, 0xF, true)); return v; }
DI float shx(float v, int mask, int lane) { return __int_as_float(__builtin_amdgcn_ds_bpermute((lane ^ mask) << 2, __float_as_int(v))); }
DI int shxi(int v, int mask, int lane) { return __builtin_amdgcn_ds_bpermute((lane ^ mask) << 2, v); }
DI float gelu_tanh(float x) {
  const float k0 = 0.7978845608028654f, k1 = 0.044715f;
  return 0.5f * x * (1.f + tanhf(k0 * (x + k1 * x * x * x)));
}
DI float sigmoidf(float x) { return 1.f / (1.f + expf(-x)); }

DI void phase_copy(const int wq, const float* __restrict__ src, float* __restrict__ dst, size_t n4) {
  const int tid_ = ltid(wq); const int bid_ = lbid(); (void)tid_; (void)bid_;
  const float4* s4 = (const float4*)src; float4* d4 = (float4*)dst;
  for (size_t i = (size_t)bid_ * NT + tid_; i < n4; i += (size_t)gridDim.x * NT) d4[i] = s4[i];
}

DI float rstd_of(const float* __restrict__ rss, int row) {
  const float* q = rss + (size_t)row * 16;
  const f32x4v a = *(const f32x4v*)q, b = *(const f32x4v*)(q + 4), c = *(const f32x4v*)(q + 8), d = *(const f32x4v*)(q + 12);
  const float s0 = (a[0] + a[1]) + (a[2] + a[3]), s1 = (b[0] + b[1]) + (b[2] + b[3]), s2 = (c[0] + c[1]) + (c[2] + c[3]), s3 = (d[0] + d[1]) + (d[2] + d[3]);
  return rsqrtf(((s0 + s1) + (s2 + s3)) * (1.f / 1024.f) + 1e-6f);
}
DI void phase_init_h(const int wq, const float* __restrict__ x, float* __restrict__ h, bf16_t* __restrict__ hb, float* __restrict__ rss) {
  const int tid = ltid(wq); const int bid = lbid();
  const int lane = tid & 63, wv = tid >> 6;
  for (int r = bid * 4 + wv; r < T; r += gridDim.x * 4) {
    float ss = 0.f;
#pragma unroll
    for (int i = 0; i < 4; ++i) {
      const u32x4 v = gload16(x + (size_t)r * D + i * 256 + lane * 4);
      const unsigned v0 = v[0], v1 = v[1], v2 = v[2], v3 = v[3];
      const float a = __uint_as_float(v0), b = __uint_as_float(v1), c = __uint_as_float(v2), d = __uint_as_float(v3);
      ss += a * a + b * b + c * c + d * d;
      *(GAS u32x4*)(h + (size_t)r * D + i * 256 + lane * 4) = v;
      u32x2 o; o[0] = pack2(a, b); o[1] = pack2(c, d);
      *(GAS u32x2*)(hb + (size_t)r * D + i * 256 + lane * 4) = o;
    }
    ss = wave_sum(ss);
    if (lane < 16) rss[(size_t)r * 16 + lane] = lane == 0 ? ss : 0.f;
  }
}

DI void phase_rmsnorm(const int wq, const float* __restrict__ in, int ldi, const float* __restrict__ g, float* __restrict__ out, int ldo, int rows, int W) {
  const int tid_ = ltid(wq); const int bid_ = lbid(); (void)tid_; (void)bid_;
  const int lane = tid_ & 63, wv = tid_ >> 6;
  for (int r = bid_ * 4 + wv; r < rows; r += gridDim.x * 4) {
    const float* p = in + (size_t)r * ldi;
    float ss = 0.f;
    for (int c = lane; c < W; c += 64) { float v = p[c]; ss += v * v; }
    ss = wave_sum(ss);
    const float rs = rsqrtf(ss / (float)W + 1e-6f);
    float* o = out + (size_t)r * ldo;
    for (int c = lane; c < W; c += 64) o[c] = p[c] * rs * g[c];
  }
}

DI void phase_rmsnorm_bf(const int wq, const float* __restrict__ in, int ldi, const float* __restrict__ g, bf16_t* __restrict__ out, int ldo, int rows, int W) {
  const int tid_ = ltid(wq); const int bid_ = lbid();
  const int lane = tid_ & 63, wv = tid_ >> 6;
  f32x4v gv[4];
#pragma unroll
  for (int i = 0; i < 4; ++i) gv[i] = *(const f32x4v*)(g + i * 256 + lane * 4);
  for (int r = bid_ * 4 + wv; r < rows; r += gridDim.x * 4) {
    const float* p = in + (size_t)r * ldi;
    u32x4 v[4];
#pragma unroll
    for (int i = 0; i < 4; ++i) v[i] = gload16(p + i * 256 + lane * 4);
    float ss = 0.f;
#pragma unroll
    for (int i = 0; i < 4; ++i) {
      const float a = __uint_as_float(v[i][0]), b = __uint_as_float(v[i][1]), c = __uint_as_float(v[i][2]), d = __uint_as_float(v[i][3]);
      ss += a * a + b * b + c * c + d * d;
    }
    ss = wave_sum(ss);
    const float rs = rsqrtf(ss / (float)W + 1e-6f);
    bf16_t* o = out + (size_t)r * ldo;
#pragma unroll
    for (int i = 0; i < 4; ++i) {
      u32x2 ov;
      ov[0] = pack2(__uint_as_float(v[i][0]) * rs * gv[i][0], __uint_as_float(v[i][1]) * rs * gv[i][1]);
      ov[1] = pack2(__uint_as_float(v[i][2]) * rs * gv[i][2], __uint_as_float(v[i][3]) * rs * gv[i][3]);
      *(GAS u32x2*)(o + i * 256 + lane * 4) = ov;
    }
  }
}

DI void phase_convert(const int wq, const float* __restrict__ W0, int K, int N, int ldw, bf16_t* __restrict__ Bt0, int Npad, const float* __restrict__ cs0,
                      int nbatch, size_t sW, size_t sBt, size_t sCS, float* smem, const float* __restrict__ rs0 = nullptr, size_t sRS = 0) {
  const int tid = ltid(wq); const int bid = lbid();
  float (*tl)[65] = (float (*)[65])smem;
  const int tk = K / 64, tn = Npad / 64;
  for (int tile0 = bid; tile0 < tk * tn * nbatch; tile0 += gridDim.x) {
    const int bt = tile0 / (tk * tn), tile = tile0 % (tk * tn);
    const int k0 = (tile / tn) * 64, n0 = (tile % tn) * 64;
    const float* W = W0 + (size_t)bt * sW;
    bf16_t* Bt = Bt0 + (size_t)bt * sBt;
    __syncthreads();
#pragma unroll 4
    for (int i = 0; i < 16; ++i) {
      const int k = i * 4 + (tid >> 6), n = tid & 63;
      float v = 0.f;
      if (n0 + n < N) { v = W[(size_t)(k0 + k) * ldw + n0 + n]; if (cs0) v *= cs0[(size_t)bt * sCS + n0 + n]; if (rs0) v *= rs0[(size_t)bt * sRS + k0 + k]; }
      tl[k][n] = v;
    }
    __syncthreads();
#pragma unroll 4
    for (int i = 0; i < 16; ++i) {
      const int n = i * 4 + (tid >> 6), k = tid & 63;
      Bt[(size_t)(n0 + n) * K + k0 + k] = f2bf(tl[k][n]);
    }
  }
}

constexpr int G_LDS_ROW = 144;
constexpr int G_TILE_B = 128 * G_LDS_ROW;
template <int MODE, int RS = 0>
DI void phase_gemm_bf16(const int wq, const bf16_t* __restrict__ A0, int lda, const bf16_t* __restrict__ B0, void* __restrict__ C0, int ldc,
                        int M, int N, int K, char* smem, int dry, int nbatch = 1, size_t sA = 0, size_t sB = 0, size_t sC = 0,
                        int inner = 1, size_t sA2 = 0, size_t sC2 = 0, const float* __restrict__ rss_in = nullptr, bf16_t* __restrict__ hb_out = nullptr, float* __restrict__ rss_out = nullptr) {
  const int tid = ltid(wq); const int bid = lbid();
  const int lane = tid & 63, wv = tid >> 6, wm = wv >> 1, wn = wv & 1;
  const int r = lane & 31, hh = lane >> 5;
  const int tm = M / 128, tn = (N + 127) / 128;
  const int nk = K / 64;
  const int srow = tid >> 3, skc = tid & 7;
  const int ntile_all = tm * tn * nbatch;
  const int per_x = (ntile_all + 7) >> 3;
  const int t_beg = (bid & 7) * per_x, t_end = (t_beg + per_x < ntile_all) ? t_beg + per_x : ntile_all;
  for (int tile0 = t_beg + (bid >> 3); tile0 < t_end; tile0 += (int)(gridDim.x >> 3)) {
    const int bt = tile0 / (tm * tn), tile = tile0 % (tm * tn);
    const int m0 = (tile / tn) * 128, n0 = (tile % tn) * 128;
    const int bhi = bt / inner, blo = bt % inner;
    const bf16_t* Ag = A0 + (size_t)bhi * sA + (size_t)blo * sA2 + (size_t)(m0 + srow) * lda + skc * 8;
    const bf16_t* Bg = B0 + (size_t)bt * sB + (size_t)(n0 + srow) * K + skc * 8;
    f32x16 acc[2][2];
#pragma unroll
    for (int i = 0; i < 2; ++i)
#pragma unroll
      for (int j = 0; j < 2; ++j)
#pragma unroll
        for (int e = 0; e < 16; ++e) acc[i][j][e] = 0.f;
    u32x4 ra[4], rb[4];
#pragma unroll
    for (int i = 0; i < 4; ++i) {
      ra[i] = gload16(Ag + (size_t)(32 * i) * lda);
      rb[i] = gload16(Bg + (size_t)(32 * i) * K);
    }
    __syncthreads();
#pragma unroll
    for (int i = 0; i < 4; ++i) {
      *(u32x4*)(smem + (srow + 32 * i) * G_LDS_ROW + skc * 16) = ra[i];
      *(u32x4*)(smem + 2 * G_TILE_B + (srow + 32 * i) * G_LDS_ROW + skc * 16) = rb[i];
    }
    __syncthreads();
#pragma unroll 1
    for (int kt = 0; kt < nk; ++kt) {
      const int cur = kt & 1;
      if (kt + 1 < nk) {
#pragma unroll
        for (int i = 0; i < 4; ++i) {
          ra[i] = gload16(Ag + (size_t)(32 * i) * lda + (kt + 1) * 64);
          rb[i] = gload16(Bg + (size_t)(32 * i) * K + (kt + 1) * 64);
        }
      }
      const char* As = smem + cur * G_TILE_B + (wm * 64 + r) * G_LDS_ROW + hh * 16;
      const char* Bs = smem + 2 * G_TILE_B + cur * G_TILE_B + (wn * 64 + r) * G_LDS_ROW + hh * 16;
#pragma unroll
      for (int ks = 0; ks < 4; ++ks) {
        bf16x8 a0 = *(const bf16x8*)(As + ks * 32);
        bf16x8 a1 = *(const bf16x8*)(As + 32 * G_LDS_ROW + ks * 32);
        bf16x8 b0 = *(const bf16x8*)(Bs + ks * 32);
        bf16x8 b1 = *(const bf16x8*)(Bs + 32 * G_LDS_ROW + ks * 32);
        acc[0][0] = __builtin_amdgcn_mfma_f32_32x32x16_bf16(a0, b0, acc[0][0], 0, 0, 0);
        acc[0][1] = __builtin_amdgcn_mfma_f32_32x32x16_bf16(a0, b1, acc[0][1], 0, 0, 0);
        acc[1][0] = __builtin_amdgcn_mfma_f32_32x32x16_bf16(a1, b0, acc[1][0], 0, 0, 0);
        acc[1][1] = __builtin_amdgcn_mfma_f32_32x32x16_bf16(a1, b1, acc[1][1], 0, 0, 0);
      }
      if (kt + 1 < nk) {
        const int nxt = cur ^ 1;
#pragma unroll
        for (int i = 0; i < 4; ++i) {
          *(u32x4*)(smem + nxt * G_TILE_B + (srow + 32 * i) * G_LDS_ROW + skc * 16) = ra[i];
          *(u32x4*)(smem + 2 * G_TILE_B + nxt * G_TILE_B + (srow + 32 * i) * G_LDS_ROW + skc * 16) = rb[i];
        }
      }
      __syncthreads();
    }
    if (RS) {
      if (tid < 128) ((float*)smem)[tid] = rstd_of(rss_in, m0 + tid);
      __syncthreads();
    }
#pragma unroll
    for (int i = 0; i < 2; ++i)
#pragma unroll
      for (int j = 0; j < 2; ++j) {
        const int col = n0 + wn * 64 + j * 32 + r;
        if (col < N && !dry) {
          const size_t base = (size_t)bhi * sC + (size_t)blo * sC2 + (size_t)(m0 + wm * 64 + i * 32 + 4 * hh) * ldc + col;
          if (RS) {
            const float* rp = (const float*)smem + wm * 64 + i * 32 + 4 * hh;
#pragma unroll
            for (int e = 0; e < 16; ++e) acc[i][j][e] *= rp[(e & 3) + 8 * (e >> 2)];
          }
          if (MODE == 1) {
            GAS float* cp = (GAS float*)C0 + base;
            float old[16];
#pragma unroll
            for (int e = 0; e < 16; ++e) old[e] = cp[(size_t)((e & 3) + 8 * (e >> 2)) * ldc];
#pragma unroll
            for (int e = 0; e < 16; ++e) { old[e] += acc[i][j][e]; acc[i][j][e] = old[e]; cp[(size_t)((e & 3) + 8 * (e >> 2)) * ldc] = old[e]; }
            if (hb_out) {
              GAS bf16_t* hp = (GAS bf16_t*)hb_out + base;
#pragma unroll
              for (int e = 0; e < 16; ++e) hp[(size_t)((e & 3) + 8 * (e >> 2)) * ldc] = f2bf(old[e]);
            }
          } else if (MODE == 0) {
            GAS float* cp = (GAS float*)C0 + base;
#pragma unroll
            for (int e = 0; e < 16; ++e) cp[(size_t)((e & 3) + 8 * (e >> 2)) * ldc] = acc[i][j][e];
          } else if (MODE == 2) {
            GAS bf16_t* cp = (GAS bf16_t*)C0 + base;
#pragma unroll
            for (int e = 0; e < 16; ++e) cp[(size_t)((e & 3) + 8 * (e >> 2)) * ldc] = f2bf(acc[i][j][e]);
          } else if (MODE == 4) {
            GAS bf16_t* cp = (GAS bf16_t*)C0 + base;
#pragma unroll
            for (int e = 0; e < 16; ++e) cp[(size_t)((e & 3) + 8 * (e >> 2)) * ldc] = f2bf(acc[i][j][e] * 0.0625f);
          } else {
            const int rowb = m0 + wm * 64 + i * 32 + 4 * hh;
            const int b_ = rowb >> 8, mm = rowb & 255;
            const int cc = col & 1023, hd_ = cc >> 8, dd = cc & 255;
            GAS bf16_t* kb = (GAS bf16_t*)C0;
            if (col < 1024) {
#pragma unroll
              for (int e = 0; e < 16; ++e) kb[((size_t)(b_ * 4 + hd_) * 256 + mm + (e & 3) + 8 * (e >> 2)) * 256 + dd] = f2bf(acc[i][j][e]);
            } else {
#pragma unroll
              for (int e = 0; e < 16; ++e) kb[(size_t)2048 * 1024 + ((size_t)(b_ * 4 + hd_) * 256 + dd) * 256 + mm + (e & 3) + 8 * (e >> 2)] = f2bf(acc[i][j][e]);
            }
          }
        }
      }
    if (MODE == 1 && rss_out && !dry) {
#pragma unroll
      for (int i = 0; i < 2; ++i) {
        float myv = 0.f;
#pragma unroll
        for (int e = 0; e < 16; ++e) {
          float v = acc[i][0][e] * acc[i][0][e] + acc[i][1][e] * acc[i][1][e];
          v = rowsum16(v);
          v += shx(v, 16, lane);
          if ((lane & 15) == e) myv = v;
        }
        if ((lane & 16) == 0) rss_out[(size_t)(m0 + wm * 64 + i * 32 + (lane & 3) + 8 * ((lane & 15) >> 2) + 4 * hh) * 16 + (n0 >> 7) * 2 + wn] = myv;
      }
    }
  }
}

template <int W>
DI void evenmix_run(const bf16_t* __restrict__ P, const float* __restrict__ cw, bf16_t* __restrict__ Y, bf16_t* __restrict__ pool, int t0, int c) {
  const int s0 = t0 & (S - 1);
  f32x4v w0 = *(const f32x4v*)(cw + c), w1 = *(const f32x4v*)(cw + 512 + c), w2 = *(const f32x4v*)(cw + 1024 + c);
  const f32x4v zero = {0.f, 0.f, 0.f, 0.f};
  auto ld = [&](int t, int off) { const u32x2 v = *(const GAS u32x2*)(P + (size_t)t * EVEN_IN + off + c); return bf4_to_f(v); };
  f32x4v xm2 = zero, xm1 = zero;
  if (s0 >= 2) xm2 = ld(t0 - 2, 512) * ld(t0 - 2, 0);
  if (s0 >= 1) xm1 = ld(t0 - 1, 512) * ld(t0 - 1, 0);
  f32x4v ring[W];
  f32x4v sum = zero;
#pragma unroll
  for (int i = 0; i < W; ++i) { ring[i] = (s0 + i - W >= 0) ? ld(t0 + i - W, 1536) : zero; sum += ring[i]; }
#pragma unroll
  for (int tt = 0; tt < 32; ++tt) {
    const int t = t0 + tt;
    const f32x4v x0 = ld(t, 512) * ld(t, 0);
    const f32x4v z = w0 * xm2 + w1 * xm1 + w2 * x0;
    xm2 = xm1; xm1 = x0;
    const f32x4v ya = ld(t, 1024) * z;
    const f32x4v pv = ld(t, 1536);
    sum += pv - ring[tt % W]; ring[tt % W] = pv;
    const int cnt = (s0 + tt + 1 < W) ? (s0 + tt + 1) : W;
    const float ic = 1.f / (float)cnt;
    const f32x4v pl = sum * ic - pv;
    u32x2 oa, ob;
    oa[0] = pack2(ya[0], ya[1]); oa[1] = pack2(ya[2], ya[3]);
    ob[0] = pack2(pl[0], pl[1]); ob[1] = pack2(pl[2], pl[3]);
    *(GAS u32x2*)(Y + (size_t)t * D + c) = oa;
    *(GAS u32x2*)(pool + (size_t)t * 512 + c) = ob;
  }
}
DI void phase_evenmix(const int wq, PRef p, int j) {
  const int tid = ltid(wq); const int bid = lbid();
  const int lane = tid & 63, wv = tid >> 6;
  const float* cw = p.even_conv_w + (size_t)j * 3 * 512;
  for (int Wg = bid * 4 + wv; Wg < 1024; Wg += gridDim.x * 4) {
    const int g = Wg & 3, cp = Wg >> 2;
    const int t0 = (cp * 2 + (lane >> 5)) * 32;
    const int c = g * 128 + (lane & 31) * 4;
    if (g == 0) evenmix_run<2>(p.P16, cw, p.Y, p.pool, t0, c);
    else if (g == 1) evenmix_run<4>(p.P16, cw, p.Y, p.pool, t0, c);
    else if (g == 2) evenmix_run<8>(p.P16, cw, p.Y, p.pool, t0, c);
    else evenmix_run<16>(p.P16, cw, p.Y, p.pool, t0, c);
  }
}

DI void phase_lb(const int wq, PRef p) {
  const int tid_ = ltid(wq); const int bid_ = lbid(); (void)tid_; (void)bid_;
  for (int c = bid_ * NT + tid_; c < 512; c += gridDim.x * NT) {
    float g[DEPTH], m = -INFINITY;
#pragma unroll
    for (int l = 0; l < DEPTH; ++l) { g[l] = p.hgrn_gamma[l * 512 + c]; m = fmaxf(m, g[l]); }
    float sum = 0.f;
#pragma unroll
    for (int l = 0; l < DEPTH; ++l) { g[l] = expf(g[l] - m); sum += g[l]; }
    float cum = 0.f;
#pragma unroll
    for (int l = 0; l < DEPTH; ++l) { p.lb[l * 512 + c] = cum; cum += g[l] / sum; }
  }
}

DI int t5_bucket(int dist) {
  const int d = dist < 0 ? 0 : dist;
  if (d < 16) return d;
  const float lr = logf((float)d / 16.f) / 2.0794415416798357f;
  int large = 16 + (int)(lr * 16.f);
  return large < 31 ? large : 31;
}

DI unsigned fkey(float f) { unsigned u = __float_as_uint(f); return (u & 0x80000000u) ? ~u : (u | 0x80000000u); }

DI int block_sum_int(int v, int* red) {
  const int lane = threadIdx.x & 63, wv = threadIdx.x >> 6;
#pragma unroll
  for (int o = 32; o > 0; o >>= 1) v += __shfl_xor(v, o);
  __syncthreads();
  if (lane == 0) red[wv] = v;
  __syncthreads();
  return red[0] + red[1] + red[2] + red[3];
}

DI void phase_dsa(const int wq, PRef p, int j, float* smem) {
  const int tid_ = ltid(wq); const int bid_ = lbid(); (void)tid_; (void)bid_;
  const float* __restrict__ P = p.P;
  float* sc = smem;
  float* qi = sc + 2048;
  float* ql = qi + 512;
  float* pl = ql + 1024;
  float* wh = pl + 2048;
  int* sel = (int*)(wh + 8);
  int* scan_gt = sel + 256;
  int* scan_eq = scan_gt + 256;
  int* red = scan_eq + 256;
  const int tid = tid_, lane = tid & 63, wv = tid >> 6;
  for (int q = bid_; q < T; q += gridDim.x) {
    const int b = q / S, t = q % S;
    const float* row = P + (size_t)q * ODD_IN;
    __syncthreads();
    for (int i = tid; i < 512; i += NT) qi[i] = row[1152 + i];
    for (int i = tid; i < 1024; i += NT) ql[i] = row[i];
    if (tid < 8) wh[tid] = row[1728 + tid] * 0.35355339059327373f;
    __syncthreads();
    for (int s = tid; s < S; s += NT) {
      float score = -INFINITY;
      if (s <= t) {
        const float* kr = P + (size_t)(b * S + s) * ODD_IN + 1664;
        score = 0.f;
        for (int hh = 0; hh < 8; ++hh) {
          float d = 0.f;
          for (int e = 0; e < 64; ++e) d = fmaf(qi[hh * 64 + e], kr[e], d);
          d *= 0.125f;
          score += wh[hh] * fmaxf(d, 0.f);
        }
      }
      sc[s] = score;
    }
    __syncthreads();
    int nsel;
    if (t + 1 <= 256) {
      nsel = t + 1;
      sel[tid] = tid <= t ? tid : 0;
      __syncthreads();
    } else {
      nsel = 256;
      unsigned keys[8];
#pragma unroll
      for (int i = 0; i < 8; ++i) keys[i] = fkey(sc[tid * 8 + i]);
      unsigned thr = 0;
      for (int bit = 31; bit >= 0; --bit) {
        const unsigned cand = thr | (1u << bit);
        int c = 0;
#pragma unroll
        for (int i = 0; i < 8; ++i) c += keys[i] >= cand;
        c = block_sum_int(c, red);
        if (c >= 256) thr = cand;
      }
      int cg = 0, ce = 0;
#pragma unroll
      for (int i = 0; i < 8; ++i) { cg += keys[i] > thr; ce += keys[i] == thr; }
      scan_gt[tid] = cg; scan_eq[tid] = ce;
      __syncthreads();
      for (int o = 1; o < 256; o <<= 1) {
        int a = 0, e = 0;
        if (tid >= o) { a = scan_gt[tid - o]; e = scan_eq[tid - o]; }
        __syncthreads();
        scan_gt[tid] += a; scan_eq[tid] += e;
        __syncthreads();
      }
      const int ngt = scan_gt[255];
      int pg = scan_gt[tid] - cg, pe = scan_eq[tid] - ce;
      const int need = 256 - ngt;
#pragma unroll
      for (int i = 0; i < 8; ++i) {
        if (keys[i] > thr) sel[pg++] = tid * 8 + i;
        else if (keys[i] == thr) { if (pe < need) sel[ngt + pe] = tid * 8 + i; ++pe; }
      }
      __syncthreads();
    }
    {
      const int k = tid;
      float acc[8];
#pragma unroll
      for (int hh = 0; hh < 8; ++hh) acc[hh] = 0.f;
      const bool valid = k < nsel;
      const int sk = valid ? sel[k] : 0;
      const float* cr = p.ckv + (size_t)(b * S + sk) * 128;
      for (int r = 0; r < 128; ++r) {
        const float c = cr[r];
#pragma unroll
        for (int hh = 0; hh < 8; ++hh) acc[hh] = fmaf(ql[hh * 128 + r], c, acc[hh]);
      }
      const int bk = t5_bucket(t - sk);
#pragma unroll
      for (int hh = 0; hh < 8; ++hh)
        pl[hh * 256 + k] = valid ? acc[hh] * 0.08838834764831845f + p.rel_bias[bk * 8 + hh] : -INFINITY;
    }
    __syncthreads();
    for (int hh = 2 * wv; hh < 2 * wv + 2; ++hh) {
      float v[4], m = -INFINITY;
#pragma unroll
      for (int i = 0; i < 4; ++i) { v[i] = pl[hh * 256 + lane + 64 * i]; m = fmaxf(m, v[i]); }
      m = wave_max(m);
      float sum = 0.f;
#pragma unroll
      for (int i = 0; i < 4; ++i) { v[i] = expf(v[i] - m); sum += v[i]; }
      sum = wave_sum(sum);
      const float inv = 1.f / sum;
#pragma unroll
      for (int i = 0; i < 4; ++i) pl[hh * 256 + lane + 64 * i] = v[i] * inv;
    }
    __syncthreads();
    {
      const int r = tid & 127, h0 = tid >> 7;
      float acc[4] = {0.f, 0.f, 0.f, 0.f};
      for (int k = 0; k < nsel; ++k) {
        const float c = p.ckv[(size_t)(b * S + sel[k]) * 128 + r];
#pragma unroll
        for (int i = 0; i < 4; ++i) acc[i] = fmaf(pl[(h0 + 2 * i) * 256 + k], c, acc[i]);
      }
#pragma unroll
      for (int i = 0; i < 4; ++i) p.lat[(size_t)q * D + (h0 + 2 * i) * 128 + r] = f2bf(acc[i]);
    }
  }
}

DI void phase_hgrn(const int wq, PRef p, int l, float* smem) {
  const int tid_ = ltid(wq); const int bid_ = lbid(); (void)tid_; (void)bid_;
  const float* __restrict__ P = p.P;
  float* sq = smem;
  float* sf = sq + 16 * 128;
  float* si = sf + 16 * 128;
  float* so = si + 16 * 128;
  const int tid = tid_, v = tid & 127, kh = tid >> 7;
  for (int u = bid_; u < NB * 4; u += gridDim.x) {
    const int b = u >> 2, hd = u & 3;
    float st[64];
#pragma unroll
    for (int i = 0; i < 64; ++i) st[i] = 0.f;
    for (int t0 = 0; t0 < S; t0 += 16) {
      __syncthreads();
      for (int i = tid; i < 16 * 128; i += NT) {
        const int tt = i >> 7, c = i & 127;
        const float* row = P + (size_t)(b * S + t0 + tt) * ODD_IN;
        sq[i] = row[1736 + hd * 128 + c];
        const float lbv = p.lb[l * 512 + hd * 128 + c];
        sf[i] = lbv + (1.f - lbv) * sigmoidf(row[2248 + hd * 128 + c]);
        si[i] = row[2760 + hd * 128 + c];
      }
      __syncthreads();
      for (int tt = 0; tt < 16; ++tt) {
        const float iv = si[tt * 128 + v];
        float o = 0.f;
#pragma unroll
        for (int i = 0; i < 64; ++i) {
          const float f = sf[tt * 128 + kh * 64 + i];
          st[i] = fmaf(f, st[i], (1.f - f) * iv);
          o = fmaf(sq[tt * 128 + kh * 64 + i], st[i], o);
        }
        so[(tt * 2 + kh) * 128 + v] = o;
      }
      __syncthreads();
      for (int i = tid; i < 16 * 128; i += NT) {
        const int tt = i >> 7, c = i & 127;
        p.oraw[(size_t)(b * S + t0 + tt) * 512 + hd * 128 + c] = so[(tt * 2) * 128 + c] + so[(tt * 2 + 1) * 128 + c];
      }
    }
  }
}

DI void phase_hgrn_post(const int wq, PRef p, int j) {
  const int tid_ = ltid(wq); const int bid_ = lbid(); (void)tid_; (void)bid_;
  const int lane = tid_ & 63, wv = tid_ >> 6;
  for (int r = bid_ * 4 + wv; r < T * 4; r += gridDim.x * 4) {
    const int t = r >> 2, hd = r & 3;
    const float* o = p.oraw + (size_t)t * 512 + hd * 128;
    const float a = o[lane], bq = o[lane + 64];
    const float ss = wave_sum(a * a + bq * bq);
    const float rs = rsqrtf(ss / 128.f + 1e-6f);
    const bf16_t* gate = p.P16 + (size_t)t * ODD_IN + 3272 + hd * 128;
    const float* gn = p.odd_hg_norm + j * 512 + hd * 128;
    const float g0 = bf2f(gate[lane]), g1 = bf2f(gate[lane + 64]);
    p.Y[(size_t)t * D + 512 + hd * 128 + lane] = f2bf(a * rs * gn[lane] * (g0 * sigmoidf(g0)));
    p.Y[(size_t)t * D + 512 + hd * 128 + lane + 64] = f2bf(bq * rs * gn[lane + 64] * (g1 * sigmoidf(g1)));
  }
}

DI void phase_xattn(const int wq, PRef p, float* smem) {
  const int tid_ = ltid(wq); const int bid_ = lbid(); (void)tid_; (void)bid_;
  float* sq = smem;
  float* sp = sq + 256;
  float* red = sp + 256;
  const int tid = tid_, lane = tid & 63, wv = tid >> 6;
  for (int t = bid_; t < T; t += gridDim.x) {
    const int b = t / S;
    for (int hd = 0; hd < 4; ++hd) {
      __syncthreads();
      sq[tid] = p.P[(size_t)t * D + hd * 256 + tid];
      __syncthreads();
      const float* kr = p.kv + (size_t)(b * NMEM + tid) * 2048 + hd * 256;
      float d = 0.f;
      for (int e = 0; e < 256; e += 4) {
        const float4 k4 = *(const float4*)(kr + e);
        d = fmaf(sq[e], k4.x, d); d = fmaf(sq[e + 1], k4.y, d); d = fmaf(sq[e + 2], k4.z, d); d = fmaf(sq[e + 3], k4.w, d);
      }
      d *= 0.0625f;
      float m = wave_max(d);
      if (lane == 0) red[wv] = m;
      __syncthreads();
      m = fmaxf(fmaxf(red[0], red[1]), fmaxf(red[2], red[3]));
      const float e = expf(d - m);
      float sum = wave_sum(e);
      if (lane == 0) red[4 + wv] = sum;
      __syncthreads();
      sum = red[4] + red[5] + red[6] + red[7];
      sp[tid] = e / sum;
      __syncthreads();
      float o = 0.f;
      const float* vr = p.kv + (size_t)(b * NMEM) * 2048 + 1024 + hd * 256 + tid;
      for (int mm = 0; mm < NMEM; ++mm) o = fmaf(sp[mm], vr[(size_t)mm * 2048], o);
      p.Y[(size_t)t * D + hd * 256 + tid] = f2bf(o);
    }
  }
}


DI void phase_dsa_prep(const int wq, PRef p, int j) {
  const int tid = ltid(wq); const int bid = lbid();
  const int lane = tid & 63, wv = tid >> 6;
  for (int t = bid * 4 + wv; t < T; t += gridDim.x * 4) {
    const bf16_t* row = p.P16 + (size_t)t * ODD_IN;
#pragma unroll
    for (int c = 0; c < 2; ++c) *(GAS u32x4*)(p.qlat16 + (size_t)t * 1024 + c * 512 + lane * 8) = gload16(row + c * 512 + lane * 8);
    {
      const unsigned cv = *(const GAS unsigned*)(row + 1024 + 2 * lane);
      const float c0 = bflo(cv), c1 = bfhi(cv);
      const float ss = wave_sum(c0 * c0 + c1 * c1);
      const float rs = rsqrtf(ss / 128.f + 1e-6f);
      const float* g = p.odd_kv_norm + j * 128;
      *(GAS unsigned*)(p.ckv16 + (size_t)t * 128 + 2 * lane) = pack2(c0 * rs * g[2 * lane], c1 * rs * g[2 * lane + 1]);
    }
    *(GAS u32x4*)(p.iq16 + (size_t)t * 512 + lane * 8) = gload16(row + 1152 + lane * 8);
    p.ik16[(size_t)t * 64 + lane] = row[1664 + lane];
  }
}

DI void phase_dsa_scores(const int wq, PRef p, char* smem) {
  const int tid = ltid(wq); const int bid = lbid();
  const int lane = tid & 63, wv = tid >> 6, wm = wv >> 1, wn = wv & 1;
  const int r = lane & 31, hh = lane >> 5;
  const int srow = tid >> 3, skc = tid & 7;
  char* Ks = smem;
  char* Qs = smem + G_TILE_B;
  float* Ws = (float*)(smem + 3 * G_TILE_B);
  for (int tile = bid; tile < NB * 136; tile += gridDim.x) {
    const int b = tile / 136, u = tile % 136;
    int qb = 0;
    while ((qb + 1) * (qb + 2) / 2 <= u) ++qb;
    const int kb = u - qb * (qb + 1) / 2;
    const int q0 = b * S + qb * 128, k0 = b * S + kb * 128;
    const bf16_t* Kg = p.ik16 + (size_t)(k0 + srow) * 64 + skc * 8;
    const bf16_t* Qg = p.iq16 + (size_t)(q0 + srow) * 512 + skc * 8;
    u32x4 rk[4], rq[4];
#pragma unroll
    for (int i = 0; i < 4; ++i) { rk[i] = gload16(Kg + (size_t)(32 * i) * 64); rq[i] = gload16(Qg + (size_t)(32 * i) * 512); }
    u32x4 wv4 = {0u, 0u, 0u, 0u};
    if (tid < 128) wv4 = gload16(p.P16 + (size_t)(q0 + tid) * ODD_IN + 1728);
    __syncthreads();
#pragma unroll
    for (int i = 0; i < 4; ++i) {
      *(u32x4*)(Ks + (srow + 32 * i) * G_LDS_ROW + skc * 16) = rk[i];
      *(u32x4*)(Qs + (srow + 32 * i) * G_LDS_ROW + skc * 16) = rq[i];
    }
    if (tid < 128) {
      const unsigned w0 = wv4[0], w1 = wv4[1], w2 = wv4[2], w3 = wv4[3];
      f32x4v a4, b4;
      a4[0] = bflo(w0) * 0.35355339059327373f; a4[1] = bfhi(w0) * 0.35355339059327373f; a4[2] = bflo(w1) * 0.35355339059327373f; a4[3] = bfhi(w1) * 0.35355339059327373f;
      b4[0] = bflo(w2) * 0.35355339059327373f; b4[1] = bfhi(w2) * 0.35355339059327373f; b4[2] = bflo(w3) * 0.35355339059327373f; b4[3] = bfhi(w3) * 0.35355339059327373f;
      *(f32x4v*)(Ws + tid * 8) = a4; *(f32x4v*)(Ws + tid * 8 + 4) = b4;
    }
    __syncthreads();
    f32x16 sc[2][2];
#pragma unroll
    for (int i = 0; i < 2; ++i)
#pragma unroll
      for (int jx = 0; jx < 2; ++jx)
#pragma unroll
        for (int e = 0; e < 16; ++e) sc[i][jx][e] = 0.f;
#pragma unroll 1
    for (int hd = 0; hd < 8; ++hd) {
      const int cur = hd & 1;
      if (hd + 1 < 8) {
#pragma unroll
        for (int i = 0; i < 4; ++i) rq[i] = gload16(Qg + (size_t)(32 * i) * 512 + (hd + 1) * 64);
      }
      f32x16 acc[2][2];
#pragma unroll
      for (int i = 0; i < 2; ++i)
#pragma unroll
        for (int jx = 0; jx < 2; ++jx)
#pragma unroll
          for (int e = 0; e < 16; ++e) acc[i][jx][e] = 0.f;
      const char* As = Qs + cur * G_TILE_B + (wm * 64 + r) * G_LDS_ROW + hh * 16;
      const char* Bs = Ks + (wn * 64 + r) * G_LDS_ROW + hh * 16;
#pragma unroll
      for (int ks = 0; ks < 4; ++ks) {
        const bf16x8 a0 = *(const bf16x8*)(As + ks * 32), a1 = *(const bf16x8*)(As + 32 * G_LDS_ROW + ks * 32);
        const bf16x8 b0 = *(const bf16x8*)(Bs + ks * 32), b1 = *(const bf16x8*)(Bs + 32 * G_LDS_ROW + ks * 32);
        acc[0][0] = __builtin_amdgcn_mfma_f32_32x32x16_bf16(a0, b0, acc[0][0], 0, 0, 0);
        acc[0][1] = __builtin_amdgcn_mfma_f32_32x32x16_bf16(a0, b1, acc[0][1], 0, 0, 0);
        acc[1][0] = __builtin_amdgcn_mfma_f32_32x32x16_bf16(a1, b0, acc[1][0], 0, 0, 0);
        acc[1][1] = __builtin_amdgcn_mfma_f32_32x32x16_bf16(a1, b1, acc[1][1], 0, 0, 0);
      }
#pragma unroll
      for (int i = 0; i < 2; ++i)
#pragma unroll
        for (int e = 0; e < 16; ++e) {
          const float w = Ws[(wm * 64 + i * 32 + (e & 3) + 8 * (e >> 2) + 4 * hh) * 8 + hd];
          sc[i][0][e] = fmaf(w, fmaxf(acc[i][0][e] * 0.125f, 0.f), sc[i][0][e]);
          sc[i][1][e] = fmaf(w, fmaxf(acc[i][1][e] * 0.125f, 0.f), sc[i][1][e]);
        }
      if (hd + 1 < 8) {
#pragma unroll
        for (int i = 0; i < 4; ++i) *(u32x4*)(Qs + (cur ^ 1) * G_TILE_B + (srow + 32 * i) * G_LDS_ROW + skc * 16) = rq[i];
      }
      __syncthreads();
    }
#pragma unroll
    for (int i = 0; i < 2; ++i)
#pragma unroll
      for (int jx = 0; jx < 2; ++jx) {
        GAS float* cp = (GAS float*)p.sc + (size_t)(q0 + wm * 64 + i * 32 + 4 * hh) * 2048 + kb * 128 + wn * 64 + jx * 32 + r;
#pragma unroll
        for (int e = 0; e < 16; ++e) cp[(size_t)((e & 3) + 8 * (e >> 2)) * 2048] = sc[i][jx][e];
      }
  }
}

DI void phase_hgrn_scan(const int wq, PRef p, int l, char* smem) {
  const int tid = ltid(wq); const int bid = lbid();
  const int lane = tid & 63, wv = tid >> 6;
  const int kq = wv * 4 + (lane & 3), v = lane >> 2;
  constexpr int BUF = (2048 + 2048 + 256);
  float* bufs = (float*)smem;
  float* opart = bufs + 2 * BUF;
  for (int unit = bid; unit < 256; unit += gridDim.x) {
    const int b = unit >> 5, hd = (unit >> 3) & 3, vs = unit & 7;
    const int ltok = tid >> 4, lc = (tid & 15) * 8;
    const bf16_t* Pb = p.P16 + (size_t)(b * S) * ODD_IN;
    f32x4v lbv0, lbv1;
    { const float* lbp = p.lb + l * 512 + hd * 128 + lc; lbv0 = *(const f32x4v*)lbp; lbv1 = *(const f32x4v*)(lbp + 4); }
    float st[8];
#pragma unroll
    for (int i = 0; i < 8; ++i) st[i] = 0.f;
    u32x4 rq, rf; float riv;
    auto gl = [&](int bt) {
      const bf16_t* row = Pb + (size_t)(bt * 16 + ltok) * ODD_IN;
      rq = gload16(row + 1736 + hd * 128 + lc);
      rf = gload16(row + 2248 + hd * 128 + lc);
      riv = bf2f(row[2760 + hd * 128 + vs * 16 + (tid & 15)]);
    };
    auto st_lds = [&](int which) {
      float* bq = bufs + which * BUF; float* bf = bq + 2048; float* bi = bf + 2048;
      const unsigned q0_ = rq[0], q1_ = rq[1], q2_ = rq[2], q3_ = rq[3], f0_ = rf[0], f1_ = rf[1], f2_ = rf[2], f3_ = rf[3];
      f32x4v qa, qb, fa, fb;
      qa[0] = bflo(q0_); qa[1] = bfhi(q0_); qa[2] = bflo(q1_); qa[3] = bfhi(q1_); qb[0] = bflo(q2_); qb[1] = bfhi(q2_); qb[2] = bflo(q3_); qb[3] = bfhi(q3_);
      fa[0] = bflo(f0_); fa[1] = bfhi(f0_); fa[2] = bflo(f1_); fa[3] = bfhi(f1_); fb[0] = bflo(f2_); fb[1] = bfhi(f2_); fb[2] = bflo(f3_); fb[3] = bfhi(f3_);
      *(f32x4v*)(bq + ltok * 128 + lc) = qa; *(f32x4v*)(bq + ltok * 128 + lc + 4) = qb;
      f32x4v f0, f1;
#pragma unroll
      for (int i = 0; i < 4; ++i) {
        f0[i] = lbv0[i] + (1.f - lbv0[i]) * sigmoidf(fa[i]);
        f1[i] = lbv1[i] + (1.f - lbv1[i]) * sigmoidf(fb[i]);
      }
      *(f32x4v*)(bf + ltok * 128 + lc) = f0; *(f32x4v*)(bf + ltok * 128 + lc + 4) = f1;
      bi[ltok * 16 + (tid & 15)] = riv;
    };
    gl(0);
    __syncthreads();
    st_lds(0);
    __syncthreads();
#pragma unroll 1
    for (int bt = 0; bt < S / 16; ++bt) {
      const int cur = bt & 1;
      if (bt + 1 < S / 16) gl(bt + 1);
      const float* bq = bufs + cur * BUF; const float* bf = bq + 2048; const float* bi = bf + 2048;
#pragma unroll 4
      for (int tt = 0; tt < 16; ++tt) {
        const float iv = bi[tt * 16 + v];
        const f32x4v f0 = *(const f32x4v*)(bf + tt * 128 + kq * 8), f1 = *(const f32x4v*)(bf + tt * 128 + kq * 8 + 4);
        const f32x4v q0 = *(const f32x4v*)(bq + tt * 128 + kq * 8), q1 = *(const f32x4v*)(bq + tt * 128 + kq * 8 + 4);
        float o = 0.f;
#pragma unroll
        for (int i = 0; i < 4; ++i) {
          st[i] = fmaf(f0[i], st[i], (1.f - f0[i]) * iv); o = fmaf(q0[i], st[i], o);
          st[4 + i] = fmaf(f1[i], st[4 + i], (1.f - f1[i]) * iv); o = fmaf(q1[i], st[4 + i], o);
        }
        o += __int_as_float(__builtin_amdgcn_update_dpp(0, __float_as_int(o), 0xB1, 0xF, 0xF, true));
        o += __int_as_float(__builtin_amdgcn_update_dpp(0, __float_as_int(o), 0x4E, 0xF, 0xF, true));
        if ((lane & 3) == 0) opart[(tt * 4 + wv) * 16 + v] = o;
      }
      __syncthreads();
      {
        const int tt = tid >> 4, vo = tid & 15;
        const float o = opart[(tt * 4 + 0) * 16 + vo] + opart[(tt * 4 + 1) * 16 + vo] + opart[(tt * 4 + 2) * 16 + vo] + opart[(tt * 4 + 3) * 16 + vo];
        p.oraw[(size_t)(b * S + bt * 16 + tt) * 512 + hd * 128 + vs * 16 + vo] = o;
      }
      if (bt + 1 < S / 16) st_lds(cur ^ 1);
      __syncthreads();
    }
  }
}

DI float dot2bf(unsigned a, unsigned b, float acc) { return __builtin_amdgcn_fdot2_f32_bf16(__builtin_bit_cast(bf16x2_t, a), __builtin_bit_cast(bf16x2_t, b), acc, false); }
DI unsigned fkey_u(float f) { const unsigned u = __float_as_uint(f); return (u & 0x80000000u) ? ~u : (u | 0x80000000u); }
DI void phase_dsa_attend(const int wq, PRef p, int j, char* smem, int qoff) {
  const int tid = ltid(wq); const int bid = lbid(); (void)bid;
  const int lane = tid & 63, wv = tid >> 6;
  int* selL = (int*)smem;
  int* nselL = selL + 1024;
  float* bias = (float*)(smem + 4096 + 64);
  float* part = (float*)(smem + 4096 + 64 + 1024);
  float* msb = part + 2 * 4 * 8 * 128;
  float* plw = msb + 2 * 4 * 16 + wv * 64 * 8;
  int* sel = selL + wv * 256;
  __syncthreads();
  bias[tid] = p.rel_bias[tid];
  const int n16 = lane & 15, kg = lane >> 4;
  const unsigned long long ltmask = (1ull << lane) - 1ull;
  for (;;) {
    __syncthreads();
    if (tid == 0) nselL[4] = (int)atomicAdd(p.qctr + qoff, 4u);
    __syncthreads();
    const int base = nselL[4];
    if (base >= T) break;
    {
      const int q = base + wv;
      const int t = q % S;
      const float* row = p.sc + (size_t)q * 2048;
      int nsel;
      if (t < 256) {
        nsel = t + 1;
#pragma unroll
        for (int i = 0; i < 4; ++i) sel[i * 64 + lane] = i * 64 + lane;
      } else {
        nsel = 256;
        const int ni = (t >> 6) + 1;
        unsigned keys[32];
#pragma unroll
        for (int i = 0; i < 32; ++i) {
          keys[i] = 0u;
          if (i < ni) { const int s_ = i * 64 + lane; if (s_ <= t) keys[i] = fkey_u(row[s_]); }
        }
        unsigned thr = 0u;
#pragma unroll 1
        for (int bit = 31; bit >= 0; --bit) {
          const unsigned cand = thr | (1u << bit);
          int cl = 0;
#pragma unroll
          for (int g = 0; g < 4; ++g) if (g * 8 < ni) {
#pragma unroll
            for (int i = g * 8; i < g * 8 + 8; ++i) cl += (keys[i] >= cand) ? 1 : 0;
          }
          const int cnt = wave_sum_i(cl);
          if (cnt >= 256) thr = cand;
        }
        int ngt = 0;
#pragma unroll
        for (int i = 0; i < 32; ++i) if (i < ni) ngt += __builtin_popcountll(__ballot(keys[i] > thr));
        const int need = 256 - ngt;
        int pg = 0, pe = 0;
#pragma unroll
        for (int i = 0; i < 32; ++i) if (i < ni) {
          const unsigned long long mg = __ballot(keys[i] > thr), me = __ballot(keys[i] == thr);
          const int myg = pg + __builtin_popcountll(mg & ltmask), mye = pe + __builtin_popcountll(me & ltmask);
          if (keys[i] > thr) sel[myg] = i * 64 + lane;
          else if (keys[i] == thr && mye < need) sel[ngt + mye] = i * 64 + lane;
          pg += __builtin_popcountll(mg); pe += __builtin_popcountll(me);
        }
      }
      if (lane == 0) nselL[wv] = nsel;
    }
    __syncthreads();
#pragma unroll 1
    for (int qi = 0; qi < 4; ++qi) {
      const int tid = ltid(wq);
      const int lane = tid & 63;
      const int n16 = lane & 15, kg = lane >> 4;
      const int q = base + qi;
      const int b = q / S, t = q % S;
      const int nsel = nselL[qi];
      const int* qsel = selL + qi * 256 + wv * 64;
      const int slot0 = wv * 64;
      float* pw = part + ((qi & 1) * 4 + wv) * 8 * 128;
      float* mw = msb + ((qi & 1) * 4 + wv) * 16;
      bf16x8 aq[4];
#pragma unroll
      for (int ks = 0; ks < 4; ++ks) {
        u32x4 z = {0u, 0u, 0u, 0u};
        if (n16 < 8) z = gload16(p.qlat16 + (size_t)q * 1024 + n16 * 128 + ks * 32 + kg * 8);
        aq[ks] = __builtin_bit_cast(bf16x8, z);
      }
      u32x4 bv[4][4];
#pragma unroll
      for (int bb = 0; bb < 4; ++bb) {
        const int sl = bb * 16 + n16;
        const int sxv = (slot0 + sl < nsel) ? qsel[sl] : 0;
        const bf16_t* crow = p.ckv16 + (size_t)(b * S + sxv) * 128 + kg * 8;
#pragma unroll
        for (int ks = 0; ks < 4; ++ks) bv[bb][ks] = gload16(crow + ks * 32);
      }
      const bf16_t* cb = p.ckv16 + (size_t)(b * S) * 128 + 2 * lane;
      unsigned cbuf[64];
#pragma unroll
      for (int i4 = 0; i4 < 8; ++i4) {
        const u32x4 s4 = *(const u32x4*)(qsel + i4 * 4);
#pragma unroll
        for (int e = 0; e < 4; ++e) {
          const int k = i4 * 4 + e;
          const int sk = (slot0 + k < nsel) ? __builtin_amdgcn_readfirstlane((int)s4[e]) : 0;
          cbuf[k] = *(const GAS unsigned*)(cb + (size_t)sk * 128);
        }
      }
      asm volatile("" ::: "memory");
      f32x4v lg[4];
#pragma unroll
      for (int bb = 0; bb < 4; ++bb) {
        f32x4v acc = {0.f, 0.f, 0.f, 0.f};
#pragma unroll
        for (int ks = 0; ks < 4; ++ks) acc = __builtin_amdgcn_mfma_f32_16x16x32_bf16(aq[ks], __builtin_bit_cast(bf16x8, bv[bb][ks]), acc, 0, 0, 0);
        lg[bb] = acc;
      }
      asm volatile("" ::: "memory");
#pragma unroll
      for (int i4 = 8; i4 < 16; ++i4) {
        const u32x4 s4 = *(const u32x4*)(qsel + i4 * 4);
#pragma unroll
        for (int e = 0; e < 4; ++e) {
          const int k = i4 * 4 + e;
          const int sk = (slot0 + k < nsel) ? __builtin_amdgcn_readfirstlane((int)s4[e]) : 0;
          cbuf[k] = *(const GAS unsigned*)(cb + (size_t)sk * 128);
        }
      }
      float mx[4] = {-INFINITY, -INFINITY, -INFINITY, -INFINITY};
#pragma unroll
      for (int bb = 0; bb < 4; ++bb) {
        const bool ok = slot0 + bb * 16 + n16 < nsel;
        const int bk = t5_bucket(t - (ok ? qsel[bb * 16 + n16] : 0));
#pragma unroll
        for (int i = 0; i < 4; ++i) {
          const float lv = ok ? lg[bb][i] * 0.08838834764831845f + bias[bk * 8 + ((4 * kg + i) & 7)] : -INFINITY;
          lg[bb][i] = lv; mx[i] = fmaxf(mx[i], lv);
        }
      }
#pragma unroll
      for (int i = 0; i < 4; ++i) mx[i] = rowmax16(mx[i]);
      float sm[4] = {0.f, 0.f, 0.f, 0.f};
#pragma unroll
      for (int bb = 0; bb < 4; ++bb)
#pragma unroll
        for (int i = 0; i < 4; ++i) {
          const float e_ = (mx[i] == -INFINITY) ? 0.f : __expf(lg[bb][i] - mx[i]);
          lg[bb][i] = e_; sm[i] += e_;
        }
#pragma unroll
      for (int i = 0; i < 4; ++i) sm[i] = rowsum16(sm[i]);
#pragma unroll
      for (int bb = 0; bb < 4; ++bb) {
        u32x4 pr;
#pragma unroll
        for (int i = 0; i < 4; ++i) {
          const float other = DPP_F(lg[bb][i], 0xB1, 0xF, true);
          pr[i] = pack2(lg[bb][i], other);
        }
        if (kg < 2 && (n16 & 1) == 0) *(u32x4*)((unsigned*)plw + ((bb * 16 + n16) >> 1) * 8 + 4 * kg) = pr;
      }
      if (kg < 2) {
        if (n16 == 0) {
#pragma unroll
          for (int i = 0; i < 4; ++i) { mw[4 * kg + i] = mx[i]; mw[8 + 4 * kg + i] = sm[i]; }
        }
      }
      asm volatile("s_waitcnt lgkmcnt(0)" ::: "memory");
      float o[16];
#pragma unroll
      for (int i = 0; i < 16; ++i) o[i] = 0.f;
#pragma unroll
      for (int kp = 0; kp < 32; ++kp) {
        if ((kp & 1) == 0) asm volatile("" ::: "memory");
        const unsigned ca = cbuf[2 * kp], cbx = cbuf[2 * kp + 1];
        const unsigned x0 = __builtin_amdgcn_perm(cbx, ca, 0x05040100u);
        const unsigned x1 = __builtin_amdgcn_perm(cbx, ca, 0x07060302u);
        const u32x4 pa4 = *(const u32x4*)((const unsigned*)plw + kp * 8), pb4 = *(const u32x4*)((const unsigned*)plw + kp * 8 + 4);
        const unsigned q0 = pa4[0], q1 = pa4[1], q2 = pa4[2], q3 = pa4[3], q4 = pb4[0], q5 = pb4[1], q6 = pb4[2], q7 = pb4[3];
        o[0] = dot2bf(q0, x0, o[0]); o[1] = dot2bf(q0, x1, o[1]); o[2] = dot2bf(q1, x0, o[2]); o[3] = dot2bf(q1, x1, o[3]);
        o[4] = dot2bf(q2, x0, o[4]); o[5] = dot2bf(q2, x1, o[5]); o[6] = dot2bf(q3, x0, o[6]); o[7] = dot2bf(q3, x1, o[7]);
        o[8] = dot2bf(q4, x0, o[8]); o[9] = dot2bf(q4, x1, o[9]); o[10] = dot2bf(q5, x0, o[10]); o[11] = dot2bf(q5, x1, o[11]);
        o[12] = dot2bf(q6, x0, o[12]); o[13] = dot2bf(q6, x1, o[13]); o[14] = dot2bf(q7, x0, o[14]); o[15] = dot2bf(q7, x1, o[15]);
      }
#pragma unroll
      for (int hd = 0; hd < 8; ++hd) { float2 ov; ov.x = o[2 * hd]; ov.y = o[2 * hd + 1]; *(float2*)(pw + hd * 128 + 2 * lane) = ov; }
      __syncthreads();
      {
        const int hd = tid >> 5, ch = (tid & 31) * 4;
        const float* pq = part + (qi & 1) * 4 * 8 * 128;
        const float* mq = msb + (qi & 1) * 4 * 16;
        float m0 = mq[hd], m1 = mq[16 + hd], m2 = mq[32 + hd], m3 = mq[48 + hd];
        const float M = fmaxf(fmaxf(m0, m1), fmaxf(m2, m3));
        const float f0 = __expf(m0 - M), f1 = __expf(m1 - M), f2 = __expf(m2 - M), f3 = __expf(m3 - M);
        const float den = f0 * mq[8 + hd] + f1 * mq[24 + hd] + f2 * mq[40 + hd] + f3 * mq[56 + hd];
        const f32x4v a0 = *(const f32x4v*)(pq + (0 * 8 + hd) * 128 + ch), a1 = *(const f32x4v*)(pq + (1 * 8 + hd) * 128 + ch);
        const f32x4v a2 = *(const f32x4v*)(pq + (2 * 8 + hd) * 128 + ch), a3 = *(const f32x4v*)(pq + (3 * 8 + hd) * 128 + ch);
        const float inv = 1.f / den;
        const f32x4v r = (a0 * f0 + a1 * f1 + a2 * f2 + a3 * f3) * inv;
        u32x2 ov; ov[0] = pack2(r[0], r[1]); ov[1] = pack2(r[2], r[3]);
        *(GAS u32x2*)(p.lat + (size_t)q * D + hd * 128 + ch) = ov;
      }
    }
  }
}

DI void phase_softmax256(const int wq, const bf16_t* __restrict__ S, bf16_t* __restrict__ Pm, int rows) {
  const int tid = ltid(wq); const int bid = lbid();
  const int lane = tid & 63, wv = tid >> 6;
  for (int r = bid * 4 + wv; r < rows; r += gridDim.x * 4) {
    const f32x4v v = bf4_to_f(*(const GAS u32x2*)(S + (size_t)r * 256 + lane * 4));
    const float a = v[0], b = v[1], c = v[2], d = v[3];
    const float m = wave_max(fmaxf(fmaxf(a, b), fmaxf(c, d)));
    const float ea = __expf(a - m), eb = __expf(b - m), ec = __expf(c - m), ed = __expf(d - m);
    const float inv = 1.f / wave_sum(ea + eb + ec + ed);
    u32x2 o; o[0] = pack2(ea * inv, eb * inv); o[1] = pack2(ec * inv, ed * inv);
    *(GAS u32x2*)(Pm + (size_t)r * 256 + lane * 4) = o;
  }
}

DI int fkey_s(int b) { return b ^ ((b >> 31) & 0x7fffffff); }

template <int N, int KMAX>
DI void bitonic_blocks(int (&v)[N]) {
#pragma unroll
  for (int k = 2; k <= KMAX; k <<= 1)
#pragma unroll
    for (int j = k >> 1; j > 0; j >>= 1)
#pragma unroll
      for (int i = 0; i < N; ++i) {
        const int l = i ^ j;
        if (l > i) {
          const bool desc = ((i & k) == 0);
          const int a = v[i], b = v[l];
          const int hi = a > b ? a : b, lo = a > b ? b : a;
          v[i] = desc ? hi : lo;
          v[l] = desc ? lo : hi;
        }
      }
}
template <bool DESC>
DI void bitonic_merge16(int (&v)[16]) {
#pragma unroll
  for (int j = 8; j > 0; j >>= 1)
#pragma unroll
    for (int i = 0; i < 16; ++i) {
      const int l = i ^ j;
      if (l > i) {
        const int a = v[i], b = v[l];
        const int hi = a > b ? a : b, lo = a > b ? b : a;
        v[i] = DESC ? hi : lo;
        v[l] = DESC ? lo : hi;
      }
    }
}

DI void phase_cvt_rows(const int wq, const float* __restrict__ src, bf16_t* __restrict__ dst, size_t n8) {
  const int tid = ltid(wq); const int bid = lbid();
  for (size_t i = (size_t)bid * NT + tid; i < n8; i += (size_t)gridDim.x * NT) {
    const u32x4 a = gload16(src + i * 8), b = gload16(src + i * 8 + 4);
    u32x4 o;
    o[0] = pack2(__uint_as_float(a[0]), __uint_as_float(a[1])); o[1] = pack2(__uint_as_float(a[2]), __uint_as_float(a[3]));
    o[2] = pack2(__uint_as_float(b[0]), __uint_as_float(b[1])); o[3] = pack2(__uint_as_float(b[2]), __uint_as_float(b[3]));
    *(GAS u32x4*)(dst + i * 8) = o;
  }
}

DI void phase_cvt_sliced(const int wq, const float* __restrict__ src, bf16_t* __restrict__ dst, size_t n8) {
  const int tid = ltid(wq); const int bid = lbid();
  for (size_t i = (size_t)bid * NT + tid; i < n8; i += (size_t)gridDim.x * NT) {
    const u32x4 a = gload16(src + i * 8), b = gload16(src + i * 8 + 4);
    u32x4 o;
    o[0] = pack2(__uint_as_float(a[0]), __uint_as_float(a[1])); o[1] = pack2(__uint_as_float(a[2]), __uint_as_float(a[3]));
    o[2] = pack2(__uint_as_float(b[0]), __uint_as_float(b[1])); o[3] = pack2(__uint_as_float(b[2]), __uint_as_float(b[3]));
    const size_t row = i >> 7;
    const int j = (int)(i & 127), c = j >> 4, w = j & 15;
    const size_t lyr = row >> 14, e = row & 16383;
    *(GAS u32x4*)(dst + (((lyr * 8 + c) * 16384 + e) * 128 + w * 8)) = o;
  }
}

constexpr int KEY_ROW = 264;
DI void phase_peer_qs(const int wq, const bf16_t* __restrict__ X0, const bf16_t* __restrict__ W0, const bf16_t* __restrict__ keys0, int* __restrict__ tops, char* smem, const float* __restrict__ rss_in) {
  const int tid = ltid(wq); const int bid = lbid();
  const int lane = tid & 63, wv = tid >> 6;
  const int r = lane & 31, hh = lane >> 5;
  const int srow = tid >> 3, skc = tid & 7;
  constexpr int nk = D / 64;
  for (int tile = bid; tile < (T / 128) * 16; tile += gridDim.x) {
    const int mt = tile >> 4, hp = tile & 15;
    const bf16_t* Wg = W0 + (size_t)(hp * 128 + srow) * D + skc * 8;
    const bf16_t* Xg = X0 + (size_t)(mt * 128 + srow) * D + skc * 8;
    f32x16 acc[4];
#pragma unroll
    for (int i = 0; i < 4; ++i)
#pragma unroll
      for (int e = 0; e < 16; ++e) acc[i][e] = 0.f;
    u32x4 ra[4], rb[4];
#pragma unroll
    for (int i = 0; i < 4; ++i) { ra[i] = gload16(Wg + (size_t)(32 * i) * D); rb[i] = gload16(Xg + (size_t)(32 * i) * D); }
    __syncthreads();
#pragma unroll
    for (int i = 0; i < 4; ++i) {
      *(u32x4*)(smem + (srow + 32 * i) * G_LDS_ROW + skc * 16) = ra[i];
      *(u32x4*)(smem + 2 * G_TILE_B + (srow + 32 * i) * G_LDS_ROW + skc * 16) = rb[i];
    }
    __syncthreads();
#pragma unroll 1
    for (int kt = 0; kt < nk; ++kt) {
      const int cur = kt & 1;
      if (kt + 1 < nk) {
#pragma unroll
        for (int i = 0; i < 4; ++i) { ra[i] = gload16(Wg + (size_t)(32 * i) * D + (kt + 1) * 64); rb[i] = gload16(Xg + (size_t)(32 * i) * D + (kt + 1) * 64); }
      }
      const char* As = smem + cur * G_TILE_B + r * G_LDS_ROW + hh * 16;
      const char* Bs = smem + 2 * G_TILE_B + cur * G_TILE_B + (wv * 32 + r) * G_LDS_ROW + hh * 16;
#pragma unroll
      for (int ks = 0; ks < 4; ++ks) {
        const bf16x8 b = *(const bf16x8*)(Bs + ks * 32);
#pragma unroll
        for (int mb = 0; mb < 4; ++mb) {
          const bf16x8 a = *(const bf16x8*)(As + mb * 32 * G_LDS_ROW + ks * 32);
          acc[mb] = __builtin_amdgcn_mfma_f32_32x32x16_bf16(a, b, acc[mb], 0, 0, 0);
        }
      }
      if (kt + 1 < nk) {
        const int nxt = cur ^ 1;
#pragma unroll
        for (int i = 0; i < 4; ++i) {
          *(u32x4*)(smem + nxt * G_TILE_B + (srow + 32 * i) * G_LDS_ROW + skc * 16) = ra[i];
          *(u32x4*)(smem + 2 * G_TILE_B + nxt * G_TILE_B + (srow + 32 * i) * G_LDS_ROW + skc * 16) = rb[i];
        }
      }
      __syncthreads();
    }
    {
      const bf16_t* kg = keys0 + (size_t)hp * 128 * 128;
#pragma unroll
      for (int i = 0; i < 8; ++i) {
        const int c = tid + NT * i, row = c >> 4, c16 = c & 15;
        const u32x4 v = gload16(kg + row * 128 + c16 * 8);
        uint2 lo, hi2; lo.x = v[0]; lo.y = v[1]; hi2.x = v[2]; hi2.y = v[3];
        *(uint2*)(smem + row * KEY_ROW + c16 * 16) = lo;
        *(uint2*)(smem + row * KEY_ROW + c16 * 16 + 8) = hi2;
      }
    }
    __syncthreads();
    u32x4 qf[8];
    const float rstd_t = rstd_of(rss_in, mt * 128 + wv * 32 + r);
#pragma unroll
    for (int mb = 0; mb < 4; ++mb)
#pragma unroll
      for (int s2 = 0; s2 < 2; ++s2) {
        u32x4 f;
#pragma unroll
        for (int jj = 0; jj < 4; ++jj) f[jj] = pack2(acc[mb][8 * s2 + 2 * jj] * rstd_t, acc[mb][8 * s2 + 2 * jj + 1] * rstd_t);
        qf[mb * 2 + s2] = f;
      }
    int v[64];
#pragma unroll
    for (int kb = 0; kb < 4; ++kb) {
      f32x16 sa;
#pragma unroll
      for (int e = 0; e < 16; ++e) sa[e] = 0.f;
      const char* kr = smem + (kb * 32 + r) * KEY_ROW + hh * 8;
#pragma unroll
      for (int ksi = 0; ksi < 8; ++ksi) {
        const uint2 lo = *(const uint2*)(kr + ksi * 32);
        const uint2 hi2 = *(const uint2*)(kr + ksi * 32 + 16);
        u32x4 a; a[0] = lo.x; a[1] = lo.y; a[2] = hi2.x; a[3] = hi2.y;
        sa = __builtin_amdgcn_mfma_f32_32x32x16_bf16(__builtin_bit_cast(bf16x8, a), __builtin_bit_cast(bf16x8, qf[ksi]), sa, 0, 0, 0);
      }
#pragma unroll
      for (int e = 0; e < 16; ++e) {
        const int kidx = kb * 32 + (e & 3) + 8 * (e >> 2) + 4 * hh;
        v[kb * 16 + e] = (fkey_s(__float_as_int(sa[e])) & ~127) | kidx;
      }
    }
    bitonic_blocks<64, 16>(v);
    int c01[16], c23[16];
#pragma unroll
    for (int i = 0; i < 16; ++i) { c01[i] = v[i] > v[16 + i] ? v[i] : v[16 + i]; c23[i] = v[32 + i] > v[48 + i] ? v[32 + i] : v[48 + i]; }
    bitonic_merge16<true>(c01);
    bitonic_merge16<false>(c23);
    int d[16];
#pragma unroll
    for (int i = 0; i < 16; ++i) d[i] = c01[i] > c23[i] ? c01[i] : c23[i];
    bitonic_merge16<true>(d);
    int f[16];
#pragma unroll
    for (int i = 0; i < 16; ++i) { const int o = shxi(d[15 - i], 32, lane); f[i] = d[i] > o ? d[i] : o; }
    bitonic_merge16<true>(f);
    {
      const int token = mt * 128 + wv * 32 + r;
      GAS int* op = (GAS int*)tops + ((size_t)token * 16 + hp) * 16 + hh * 8;
      u32x4 o0, o1;
      if (hh) {
#pragma unroll
        for (int i = 0; i < 4; ++i) { o0[i] = f[8 + i]; o1[i] = f[12 + i]; }
        asm volatile("" : "+v"(o0), "+v"(o1));
      } else {
#pragma unroll
        for (int i = 0; i < 4; ++i) { o0[i] = f[i]; o1[i] = f[4 + i]; }
        asm volatile("" : "+v"(o0), "+v"(o1));
      }
      *(GAS u32x4*)op = o0; *(GAS u32x4*)(op + 4) = o1;
    }
  }
}

DI float dot8(const u32x4 a, const u32x4 b, float acc) {
  const unsigned a0 = a[0], a1 = a[1], a2 = a[2], a3 = a[3], b0 = b[0], b1 = b[1], b2 = b[2], b3 = b[3];
  acc = dot2bf(a0, b0, acc); acc = dot2bf(a1, b1, acc); acc = dot2bf(a2, b2, acc); acc = dot2bf(a3, b3, acc);
  return acc;
}
DI void phase_peer_gather(const int wq, PRef p, int l, char* smem, int fin, int dry) {
  const int tid = ltid(wq); const int bid = lbid();
  const int lane = tid & 63, wv = tid >> 6;
  int* wtops = (int*)(smem + wv * 2048);
  int* wsel_id = wtops + 256;
  float* wsel_g = (float*)(wsel_id + 128);
  int ci, cj;
  if (lane < 16) { ci = 0; cj = lane; } else if (lane < 24) { ci = 1; cj = lane - 16; } else if (lane < 29) { ci = 2; cj = lane - 24; }
  else if (lane < 33) { ci = 3; cj = lane - 29; } else if (lane < 36) { ci = 4; cj = lane - 33; } else if (lane < 38) { ci = 5; cj = lane - 36; }
  else if (lane < 40) { ci = 6; cj = lane - 38; } else if (lane < 42) { ci = 7; cj = lane - 40; } else { ci = lane - 42 + 8; cj = 0; }
  const bool cvalid = lane < 50;
  if (!cvalid) { ci = 0; cj = 0; }
  const int myslot = (lane & 7) * 8 + (lane >> 3);
  const bf16_t* U16 = p.u16 + (size_t)l * 16384 * 1024;
  const bf16_t* V16 = p.v16 + (size_t)l * 16384 * 1024;
  for (int token = bid * 4 + wv; token < T; token += gridDim.x * 4) {
    const u32x4 x0 = gload16(p.hn + (size_t)token * D + lane * 8);
    const u32x4 x1 = gload16(p.hn + (size_t)token * D + 512 + lane * 8);
    {
      const u32x4 tv = gload16(p.tops + (size_t)token * 256 + lane * 4);
      *(u32x4*)(wtops + lane * 4) = tv;
    }
    asm volatile("s_waitcnt lgkmcnt(0)" ::: "memory");
    for (int hd = 0; hd < 8; ++hd) {
      const int k1 = wtops[(2 * hd) * 16 + ci], k2 = wtops[(2 * hd + 1) * 16 + cj];
      const float s1 = __int_as_float(fkey_s(k1 & ~127)), s2 = __int_as_float(fkey_s(k2 & ~127));
      const float val = s1 + s2;
      const int vk = cvalid ? ((fkey_s(__float_as_int(val)) & ~63) | (63 - lane)) : (int)0x80000000;
      int rank = 0;
#pragma unroll
      for (int c = 0; c < 50; ++c) rank += (__builtin_amdgcn_readlane(vk, c) > vk) ? 1 : 0;
      const float m = __int_as_float(__builtin_amdgcn_readlane(__float_as_int(val), 0));
      const bool sel = cvalid && rank < 16;
      const float ev = sel ? __expf(val - m) : 0.f;
      const float sum = wave_sum(ev);
      if (sel) { wsel_id[hd * 16 + rank] = (k1 & 127) * 128 + (k2 & 127); wsel_g[hd * 16 + rank] = ev / sum; }
    }
    asm volatile("s_waitcnt lgkmcnt(0)" ::: "memory");
    float wgt[2]; int eids[2];
#pragma unroll
    for (int half = 0; half < 2; ++half) {
      const int E = wsel_id[half * 64 + myslot];
      const float G = wsel_g[half * 64 + myslot];
      float res = 0.f;
#pragma unroll 1
      for (int gi = 0; gi < 8; ++gi) {
        float pp[8];
#pragma unroll
        for (int k = 0; k < 8; ++k) {
          const int eid = __builtin_amdgcn_readlane(E, k * 8 + gi);
          const bf16_t* ur = U16 + (size_t)eid * 1024;
          const u32x4 a = gload16(ur + lane * 8), b = gload16(ur + 512 + lane * 8);
          pp[k] = dot8(x1, b, dot8(x0, a, 0.f));
        }
        float q4[4], q2[2], q1;
        const bool b5 = lane & 32, b4 = lane & 16, b3 = lane & 8;
#pragma unroll
        for (int i = 0; i < 4; ++i) { const float mine = b5 ? pp[i + 4] : pp[i], oth = b5 ? pp[i] : pp[i + 4]; q4[i] = mine + shx(oth, 32, lane); }
#pragma unroll
        for (int i = 0; i < 2; ++i) { const float mine = b4 ? q4[i + 2] : q4[i], oth = b4 ? q4[i] : q4[i + 2]; q2[i] = mine + shx(oth, 16, lane); }
        { const float mine = b3 ? q2[1] : q2[0], oth = b3 ? q2[0] : q2[1]; q1 = mine + shx(oth, 8, lane); }
        q1 += shx(q1, 4, lane); q1 += shx(q1, 2, lane); q1 += shx(q1, 1, lane);
        if ((lane & 7) == gi) res = q1;
      }
      wgt[half] = G * gelu_tanh(res);
      eids[half] = E;
    }
    float o[16];
#pragma unroll
    for (int i = 0; i < 16; ++i) o[i] = 0.f;
#pragma unroll
    for (int half = 0; half < 2; ++half) {
#pragma unroll 4
      for (int sidx = 0; sidx < 64; ++sidx) {
        const int holder = (sidx & 7) * 8 + (sidx >> 3);
        const int eid = __builtin_amdgcn_readlane(eids[half], holder);
        const float w = __int_as_float(__builtin_amdgcn_readlane(__float_as_int(wgt[half]), holder));
        const bf16_t* vr = V16 + (size_t)eid * 1024;
        const u32x4 a = gload16(vr + lane * 8), b = gload16(vr + 512 + lane * 8);
#pragma unroll
        for (int i = 0; i < 4; ++i) {
          o[2 * i] = fmaf(w, bflo(a[i]), o[2 * i]); o[2 * i + 1] = fmaf(w, bfhi(a[i]), o[2 * i + 1]);
          o[8 + 2 * i] = fmaf(w, bflo(b[i]), o[8 + 2 * i]); o[8 + 2 * i + 1] = fmaf(w, bfhi(b[i]), o[8 + 2 * i + 1]);
        }
      }
    }
    GAS float* hp0 = (GAS float*)p.h + (size_t)token * D + lane * 8;
    GAS float* hp1 = hp0 + 512;
    float hv[16];
    {
      const u32x4 h0 = *(GAS u32x4*)hp0, h1 = *(GAS u32x4*)(hp0 + 4), h2 = *(GAS u32x4*)hp1, h3 = *(GAS u32x4*)(hp1 + 4);
#pragma unroll
      for (int i = 0; i < 4; ++i) {
        hv[i] = __uint_as_float(h0[i]) + o[i]; hv[4 + i] = __uint_as_float(h1[i]) + o[4 + i];
        hv[8 + i] = __uint_as_float(h2[i]) + o[8 + i]; hv[12 + i] = __uint_as_float(h3[i]) + o[12 + i];
      }
    }
    if (!fin) {
      if (!dry) {
        u32x4 s0, s1, s2, s3;
#pragma unroll
        for (int i = 0; i < 4; ++i) {
          s0[i] = __float_as_uint(hv[i]); s1[i] = __float_as_uint(hv[4 + i]); s2[i] = __float_as_uint(hv[8 + i]); s3[i] = __float_as_uint(hv[12 + i]);
        }
        *(GAS u32x4*)hp0 = s0; *(GAS u32x4*)(hp0 + 4) = s1; *(GAS u32x4*)hp1 = s2; *(GAS u32x4*)(hp1 + 4) = s3;
      }
    } else {
      float ss = 0.f;
#pragma unroll
      for (int i = 0; i < 16; ++i) ss += hv[i] * hv[i];
      ss = wave_sum(ss);
      const float rs = rsqrtf(ss / (float)D + 1e-6f);
      const float* g0 = p.final_norm + lane * 8; const float* g1 = g0 + 512;
      GAS float* op0 = (GAS float*)p.out + (size_t)token * D + lane * 8; GAS float* op1 = op0 + 512;
      if (!dry) {
#pragma unroll
        for (int i = 0; i < 8; ++i) { op0[i] = hv[i] * rs * g0[i]; op1[i] = hv[8 + i] * rs * g1[i]; }
      }
    }
  }
}


DI void phase_peer_combine(const int wq, PRef p, char* smem) {
  const int tid = ltid(wq); const int bid = lbid();
  const int lane = tid & 63, wv = tid >> 6;
  int* wtops = (int*)(smem + wv * 1024);
  int ci, cj;
  if (lane < 16) { ci = 0; cj = lane; } else if (lane < 24) { ci = 1; cj = lane - 16; } else if (lane < 29) { ci = 2; cj = lane - 24; }
  else if (lane < 33) { ci = 3; cj = lane - 29; } else if (lane < 36) { ci = 4; cj = lane - 33; } else if (lane < 38) { ci = 5; cj = lane - 36; }
  else if (lane < 40) { ci = 6; cj = lane - 38; } else if (lane < 42) { ci = 7; cj = lane - 40; } else { ci = lane - 42 + 8; cj = 0; }
  const bool cvalid = lane < 50;
  if (!cvalid) { ci = 0; cj = 0; }
  for (int token = bid * 4 + wv; token < T; token += gridDim.x * 4) {
    {
      const u32x4 tv = gload16(p.tops + (size_t)token * 256 + lane * 4);
      *(u32x4*)(wtops + lane * 4) = tv;
    }
    asm volatile("s_waitcnt lgkmcnt(0)" ::: "memory");
#pragma unroll 1
    for (int hd = 0; hd < 8; ++hd) {
      const int k1 = wtops[(2 * hd) * 16 + ci], k2 = wtops[(2 * hd + 1) * 16 + cj];
      const float s1 = __int_as_float(fkey_s(k1 & ~127)), s2 = __int_as_float(fkey_s(k2 & ~127));
      const float val = s1 + s2;
      const int vk = cvalid ? ((fkey_s(__float_as_int(val)) & ~63) | (63 - lane)) : (int)0x80000000;
      int rank = 0;
#pragma unroll
      for (int c = 0; c < 50; ++c) rank += (__builtin_amdgcn_readlane(vk, c) > vk) ? 1 : 0;
      const float m = __int_as_float(__builtin_amdgcn_readlane(__float_as_int(val), 0));
      const bool sel = cvalid && rank < 16;
      const float ev = sel ? __expf(val - m) : 0.f;
      const float sum = wave_sum(ev);
      if (sel) {
        p.sel_id[(size_t)token * 128 + hd * 16 + rank] = (k1 & 127) * 128 + (k2 & 127);
        p.sel_g[(size_t)token * 128 + hd * 16 + rank] = ev / sum;
      }
    }
    asm volatile("s_waitcnt lgkmcnt(0)" ::: "memory");
  }
}

DI void phase_peer_udot(const int wq, PRef p, int l, char* smem, int coff) {
  const int tid = ltid(wq); const int bid = lbid(); (void)bid;
  const int lane = tid & 63, wv = tid >> 6;
  const int grp = lane >> 4, li = lane & 15;
  int* wid = (int*)(smem + wv * 512);
  const bool b3 = li & 8, b2 = li & 4, b1 = li & 2, b0 = li & 1;
  const int myx = (int)(xb_xcc_id() & 7u);
  for (int cs = 0; cs < 8; ++cs) {
    const int c = (myx + cs) & 7;
    const bf16_t* U16 = p.u16 + ((size_t)l * 8 + c) * 16384 * 128 + li * 8;
    float* pb = p.pbuf + (size_t)c * T * 128;
    for (;;) {
      unsigned tb = 0;
      if (lane == 0) tb = atomicAdd(p.qctr + coff + c * 16, 8u);
      tb = __builtin_amdgcn_readfirstlane(tb);
      if (tb >= (unsigned)T) break;
      int ci0 = __builtin_nontemporal_load((const GAS int*)p.sel_id + (size_t)tb * 128 + lane), ci1 = __builtin_nontemporal_load((const GAS int*)p.sel_id + (size_t)tb * 128 + 64 + lane);
      u32x4 cx = __builtin_nontemporal_load((gp_u32x4)(p.hn + (size_t)tb * D + c * 128 + li * 8));
#pragma unroll 1
      for (int k = 0; k < 8; ++k) {
        const int token = (int)tb + k;
        const int tn = token + (k < 7 ? 1 : 0);
        const int ni0 = __builtin_nontemporal_load((const GAS int*)p.sel_id + (size_t)tn * 128 + lane), ni1 = __builtin_nontemporal_load((const GAS int*)p.sel_id + (size_t)tn * 128 + 64 + lane);
        const u32x4 nx = __builtin_nontemporal_load((gp_u32x4)(p.hn + (size_t)tn * D + c * 128 + li * 8));
        wid[lane] = ci0; wid[64 + lane] = ci1;
        asm volatile("s_waitcnt lgkmcnt(0)" ::: "memory");
        int ids[32];
#pragma unroll
        for (int i = 0; i < 8; ++i) {
          const u32x4 t4 = *(const u32x4*)(wid + grp * 32 + i * 4);
          ids[4 * i] = t4[0]; ids[4 * i + 1] = t4[1]; ids[4 * i + 2] = t4[2]; ids[4 * i + 3] = t4[3];
        }
        float pp[32];
#pragma unroll
        for (int i = 0; i < 32; ++i) {
          const u32x4 u8 = gload16(U16 + (size_t)ids[i] * 128);
          pp[i] = dot8(cx, u8, 0.f);
        }
        float q16[16], q8[8], q4[4], q2[2];
#pragma unroll
        for (int i = 0; i < 16; ++i) { const float mine = b3 ? pp[i + 16] : pp[i], oth = b3 ? pp[i] : pp[i + 16]; q16[i] = mine + shx(oth, 8, lane); }
#pragma unroll
        for (int i = 0; i < 8; ++i) { const float mine = b2 ? q16[i + 8] : q16[i], oth = b2 ? q16[i] : q16[i + 8]; q8[i] = mine + shx(oth, 4, lane); }
#pragma unroll
        for (int i = 0; i < 4; ++i) { const float mine = b1 ? q8[i + 4] : q8[i], oth = b1 ? q8[i] : q8[i + 4]; q4[i] = mine + shx(oth, 2, lane); }
#pragma unroll
        for (int i = 0; i < 2; ++i) { const float mine = b0 ? q4[i + 2] : q4[i], oth = b0 ? q4[i] : q4[i + 2]; q2[i] = mine + shx(oth, 1, lane); }
        u32x2 ov; ov[0] = __float_as_uint(q2[0]); ov[1] = __float_as_uint(q2[1]);
        __builtin_nontemporal_store(ov, (GAS u32x2*)(pb + (size_t)token * 128 + 2 * lane));
        asm volatile("s_waitcnt lgkmcnt(0)" ::: "memory");
        ci0 = ni0; ci1 = ni1; cx = nx;
      }
    }
  }
}

DI void phase_peer_vacc(const int wq, PRef p, int l, char* smem, int coff, int dry) {
  const int tid = ltid(wq); const int bid = lbid(); (void)bid;
  const int lane = tid & 63, wv = tid >> 6;
  const int grp = lane >> 4, li = lane & 15;
  int* wid = (int*)(smem + wv * 1024);
  float* ww = (float*)(smem + wv * 1024 + 512);
  const int myx = (int)(xb_xcc_id() & 7u);
  for (int cs = 0; cs < 8; ++cs) {
    const int c = (myx + cs) & 7;
    const bf16_t* V16 = p.v16 + ((size_t)l * 8 + c) * 16384 * 128 + li * 8;
    for (;;) {
      unsigned tb = 0;
      if (lane == 0) tb = atomicAdd(p.qctr + coff + c * 16, 8u);
      tb = __builtin_amdgcn_readfirstlane(tb);
      if (tb >= (unsigned)T) break;
      int ci0, ci1; u32x2 cg; u32x2 cp[8]; u32x4 ch0, ch1;
      {
        const int token = (int)tb;
        ci0 = __builtin_nontemporal_load((const GAS int*)p.sel_id + (size_t)token * 128 + lane); ci1 = __builtin_nontemporal_load((const GAS int*)p.sel_id + (size_t)token * 128 + 64 + lane);
        cg = __builtin_nontemporal_load((const GAS u32x2*)(p.sel_g + (size_t)token * 128 + 2 * lane));
#pragma unroll
        for (int cc = 0; cc < 8; ++cc) cp[cc] = __builtin_nontemporal_load((const GAS u32x2*)(p.pbuf + ((size_t)cc * T + token) * 128 + 2 * lane));
        GAS float* hp = (GAS float*)p.h + (size_t)token * D + c * 128 + li * 8;
        ch0 = __builtin_nontemporal_load((GAS u32x4*)hp); ch1 = __builtin_nontemporal_load((GAS u32x4*)(hp + 4));
      }
#pragma unroll 1
      for (int k = 0; k < 8; ++k) {
        const int token = (int)tb + k;
        const int tn = token + (k < 7 ? 1 : 0);
        const int ni0 = __builtin_nontemporal_load((const GAS int*)p.sel_id + (size_t)tn * 128 + lane), ni1 = __builtin_nontemporal_load((const GAS int*)p.sel_id + (size_t)tn * 128 + 64 + lane);
        const u32x2 ng = __builtin_nontemporal_load((const GAS u32x2*)(p.sel_g + (size_t)tn * 128 + 2 * lane));
        u32x2 np[8];
#pragma unroll
        for (int cc = 0; cc < 8; ++cc) np[cc] = __builtin_nontemporal_load((const GAS u32x2*)(p.pbuf + ((size_t)cc * T + tn) * 128 + 2 * lane));
        GAS float* hpn = (GAS float*)p.h + (size_t)tn * D + c * 128 + li * 8;
        const u32x4 nh0 = __builtin_nontemporal_load((GAS u32x4*)hpn), nh1 = __builtin_nontemporal_load((GAS u32x4*)(hpn + 4));
        {
          wid[lane] = ci0; wid[64 + lane] = ci1;
          float d0 = 0.f, d1 = 0.f;
#pragma unroll
          for (int cc = 0; cc < 8; ++cc) { d0 += __uint_as_float(cp[cc][0]); d1 += __uint_as_float(cp[cc][1]); }
          ww[2 * lane] = __uint_as_float(cg[0]) * gelu_tanh(d0);
          ww[2 * lane + 1] = __uint_as_float(cg[1]) * gelu_tanh(d1);
        }
        asm volatile("s_waitcnt lgkmcnt(0)" ::: "memory");
        int ids[32]; float wts[32];
#pragma unroll
        for (int i = 0; i < 8; ++i) {
          const u32x4 t4 = *(const u32x4*)(wid + grp * 32 + i * 4);
          ids[4 * i] = t4[0]; ids[4 * i + 1] = t4[1]; ids[4 * i + 2] = t4[2]; ids[4 * i + 3] = t4[3];
          const f32x4v w4 = *(const f32x4v*)(ww + grp * 32 + i * 4);
          wts[4 * i] = w4[0]; wts[4 * i + 1] = w4[1]; wts[4 * i + 2] = w4[2]; wts[4 * i + 3] = w4[3];
        }
        float o[8];
#pragma unroll
        for (int i = 0; i < 8; ++i) o[i] = 0.f;
#pragma unroll
        for (int i = 0; i < 32; ++i) {
          const u32x4 v8 = gload16(V16 + (size_t)ids[i] * 128);
          const float w = wts[i];
          const unsigned v0 = v8[0], v1 = v8[1], v2 = v8[2], v3 = v8[3];
          o[0] = fmaf(w, bflo(v0), o[0]); o[1] = fmaf(w, bfhi(v0), o[1]); o[2] = fmaf(w, bflo(v1), o[2]); o[3] = fmaf(w, bfhi(v1), o[3]);
          o[4] = fmaf(w, bflo(v2), o[4]); o[5] = fmaf(w, bfhi(v2), o[5]); o[6] = fmaf(w, bflo(v3), o[6]); o[7] = fmaf(w, bfhi(v3), o[7]);
        }
#pragma unroll
        for (int i = 0; i < 8; ++i) { o[i] += shx(o[i], 16, lane); o[i] += shx(o[i], 32, lane); }
        if (lane < 16 && !dry) {
          GAS float* hp = (GAS float*)p.h + (size_t)token * D + c * 128 + li * 8;
          u32x4 s0, s1;
#pragma unroll
          for (int i = 0; i < 4; ++i) { s0[i] = __float_as_uint(__uint_as_float(ch0[i]) + o[i]); s1[i] = __float_as_uint(__uint_as_float(ch1[i]) + o[4 + i]); }
          __builtin_nontemporal_store(s0, (GAS u32x4*)hp); __builtin_nontemporal_store(s1, (GAS u32x4*)(hp + 4));
        }
        asm volatile("s_waitcnt lgkmcnt(0)" ::: "memory");
        ci0 = ni0; ci1 = ni1; cg = ng; ch0 = nh0; ch1 = nh1;
#pragma unroll
        for (int cc = 0; cc < 8; ++cc) cp[cc] = np[cc];
      }
    }
  }
}


typedef signed char i8_t;
using i32x2 = __attribute__((ext_vector_type(2))) int;
DI void phase_quant_u(const int wq, const float* __restrict__ src, i8_t* __restrict__ dst, float* __restrict__ su, int nrows, const float* __restrict__ gain) {
  const int tid = ltid(wq); const int bid = lbid();
  const int lane = tid & 63, wv = tid >> 6;
  for (int row = bid * 4 + wv; row < nrows; row += gridDim.x * 4) {
    const float* r = src + (size_t)row * 1024 + 16 * lane;
    u32x4 a[4];
    {
      const float* gp = gain + (size_t)(row >> 14) * 1024 + 16 * lane;
#pragma unroll
      for (int i = 0; i < 4; ++i) {
        const u32x4 t = gload16(r + 4 * i);
        const f32x4v g4 = *(const f32x4v*)(gp + 4 * i);
        const unsigned t0 = t[0], t1 = t[1], t2 = t[2], t3 = t[3];
        a[i][0] = __float_as_uint(__uint_as_float(t0) * g4[0]); a[i][1] = __float_as_uint(__uint_as_float(t1) * g4[1]);
        a[i][2] = __float_as_uint(__uint_as_float(t2) * g4[2]); a[i][3] = __float_as_uint(__uint_as_float(t3) * g4[3]);
      }
    }
    float am = 0.f;
#pragma unroll
    for (int i = 0; i < 4; ++i) {
      const unsigned x0 = a[i][0], x1 = a[i][1], x2 = a[i][2], x3 = a[i][3];
      am = fmaxf(am, fmaxf(fmaxf(fabsf(__uint_as_float(x0)), fabsf(__uint_as_float(x1))), fmaxf(fabsf(__uint_as_float(x2)), fabsf(__uint_as_float(x3)))));
    }
    am = wave_max(am);
    const float inv = am > 0.f ? 127.f / am : 0.f;
    u32x4 o;
#pragma unroll
    for (int i = 0; i < 4; ++i) {
      const unsigned x0 = a[i][0], x1 = a[i][1], x2 = a[i][2], x3 = a[i][3];
      const int q0 = (int)rintf(__uint_as_float(x0) * inv), q1 = (int)rintf(__uint_as_float(x1) * inv);
      const int q2 = (int)rintf(__uint_as_float(x2) * inv), q3 = (int)rintf(__uint_as_float(x3) * inv);
      o[i] = (unsigned)(q0 & 255) | ((unsigned)(q1 & 255) << 8) | ((unsigned)(q2 & 255) << 16) | ((unsigned)(q3 & 255) << 24);
    }
    const size_t lyr = (size_t)row >> 14, e = (size_t)row & 16383;
    *(GAS u32x4*)(dst + (((lyr * 8 + (lane >> 3)) * 16384 + e) * 128 + (lane & 7) * 16)) = o;
    if (lane == 0) su[row] = am * (1.f / 127.f);
  }
}
DI void phase_cvt_v8(const int wq, const float* __restrict__ src, i8_t* __restrict__ dst, size_t n16) {
  const int tid = ltid(wq); const int bid = lbid();
  for (size_t i = (size_t)bid * NT + tid; i < n16; i += (size_t)gridDim.x * NT) {
    u32x4 o;
#pragma unroll
    for (int k = 0; k < 4; ++k) {
      const u32x4 a = gload16(src + i * 16 + 4 * k);
      const unsigned x0 = a[0], x1 = a[1], x2 = a[2], x3 = a[3];
      int pk = 0;
      pk = __builtin_amdgcn_cvt_pk_fp8_f32(__uint_as_float(x0) * 16.f, __uint_as_float(x1) * 16.f, pk, false);
      pk = __builtin_amdgcn_cvt_pk_fp8_f32(__uint_as_float(x2) * 16.f, __uint_as_float(x3) * 16.f, pk, true);
      o[k] = (unsigned)pk;
    }
    const size_t row = i >> 6; const int j = (int)(i & 63);
    const size_t lyr = row >> 14, e = row & 16383;
    *(GAS u32x4*)(dst + (((lyr * 8 + (j >> 3)) * 16384 + e) * 128 + (j & 7) * 16)) = o;
  }
}

DI void phase_peer_combine8(const int wq, PRef p, int l, char* smem, const float* __restrict__ rss_in) {
  const int tid = ltid(wq); const int bid = lbid();
  const int lane = tid & 63, wv = tid >> 6;
  int* wtops = (int*)(smem + wv * 1024);
  int ci, cj;
  if (lane < 16) { ci = 0; cj = lane; } else if (lane < 24) { ci = 1; cj = lane - 16; } else if (lane < 29) { ci = 2; cj = lane - 24; }
  else if (lane < 33) { ci = 3; cj = lane - 29; } else if (lane < 36) { ci = 4; cj = lane - 33; } else if (lane < 38) { ci = 5; cj = lane - 36; }
  else if (lane < 40) { ci = 6; cj = lane - 38; } else if (lane < 42) { ci = 7; cj = lane - 40; } else { ci = lane - 42 + 8; cj = 0; }
  const bool cvalid = lane < 50;
  if (!cvalid) { ci = 0; cj = 0; }
  const float* sul = p.su + (size_t)l * 16384;
  for (int token = bid * 4 + wv; token < T; token += gridDim.x * 4) {
    {
      const u32x4 tv = gload16(p.tops + (size_t)token * 256 + lane * 4);
      *(u32x4*)(wtops + lane * 4) = tv;
    }
    {
      const u32x4 a = gload16(p.hn + (size_t)token * D + 16 * lane), b2 = gload16(p.hn + (size_t)token * D + 16 * lane + 8);
      float xv[16];
      { const unsigned a0 = a[0], a1 = a[1], a2 = a[2], a3 = a[3], c0 = b2[0], c1 = b2[1], c2 = b2[2], c3 = b2[3];
        xv[0] = bflo(a0); xv[1] = bfhi(a0); xv[2] = bflo(a1); xv[3] = bfhi(a1); xv[4] = bflo(a2); xv[5] = bfhi(a2); xv[6] = bflo(a3); xv[7] = bfhi(a3);
        xv[8] = bflo(c0); xv[9] = bfhi(c0); xv[10] = bflo(c1); xv[11] = bfhi(c1); xv[12] = bflo(c2); xv[13] = bfhi(c2); xv[14] = bflo(c3); xv[15] = bfhi(c3); }
      float am = 0.f;
#pragma unroll
      for (int i = 0; i < 16; ++i) am = fmaxf(am, fabsf(xv[i]));
      am = wave_max(am);
      const float inv = am > 0.f ? 127.f / am : 0.f;
      u32x4 o;
#pragma unroll
      for (int i = 0; i < 4; ++i) {
        const int q0 = (int)rintf(xv[4 * i] * inv), q1 = (int)rintf(xv[4 * i + 1] * inv), q2 = (int)rintf(xv[4 * i + 2] * inv), q3 = (int)rintf(xv[4 * i + 3] * inv);
        o[i] = (unsigned)(q0 & 255) | ((unsigned)(q1 & 255) << 8) | ((unsigned)(q2 & 255) << 16) | ((unsigned)(q3 & 255) << 24);
      }
      *(GAS u32x4*)(p.x8 + (size_t)token * 1024 + 16 * lane) = o;
      if (lane == 0) p.sxq[token] = am * (1.f / 127.f) * rstd_of(rss_in, token);
    }
    asm volatile("s_waitcnt lgkmcnt(0)" ::: "memory");
#pragma unroll 1
    for (int hd = 0; hd < 8; ++hd) {
      const int k1 = wtops[(2 * hd) * 16 + ci], k2 = wtops[(2 * hd + 1) * 16 + cj];
      const float s1 = __int_as_float(fkey_s(k1 & ~127)), s2 = __int_as_float(fkey_s(k2 & ~127));
      const float val = s1 + s2;
      const int vk = cvalid ? ((fkey_s(__float_as_int(val)) & ~63) | (63 - lane)) : (int)0x80000000;
      int rank = 0;
#pragma unroll
      for (int c = 0; c < 50; ++c) rank += (__builtin_amdgcn_readlane(vk, c) > vk) ? 1 : 0;
      const float m = __int_as_float(__builtin_amdgcn_readlane(__float_as_int(val), 0));
      const bool sel = cvalid && rank < 16;
      const float ev = sel ? __expf(val - m) : 0.f;
      const float sum = wave_sum(ev);
      if (sel) {
        const int eid = (k1 & 127) * 128 + (k2 & 127);
        p.sel_id[(size_t)token * 128 + hd * 16 + rank] = eid;
        p.sel_g[(size_t)token * 128 + hd * 16 + rank] = ev / sum;
        p.sel_su[(size_t)token * 128 + hd * 16 + rank] = sul[eid];
      }
    }
    asm volatile("s_waitcnt lgkmcnt(0)" ::: "memory");
  }
}

DI void phase_peer_udot8(const int wq, PRef p, int l, char* smem, int coff) {
  const int tid = ltid(wq);
  const int lane = tid & 63, wv = tid >> 6;
  const int grp = lane >> 3, li = lane & 7;
  int* wid = (int*)(smem + wv * 4096);
  const bool b2 = li & 4, b1 = li & 2, b0 = li & 1;
  const int myx = (int)(xb_xcc_id() & 7u);
  for (int cs = 0; cs < 8; ++cs) {
    const int c = (myx + cs) & 7;
    const i8_t* U8 = p.u8 + ((size_t)l * 8 + c) * 16384 * 128 + li * 16;
    int* pb = (int*)p.pbuf + (size_t)c * T * 128;
    for (;;) {
      unsigned tb = 0;
      if (lane == 0) tb = atomicAdd(p.qctr + coff + c * 16, 8u);
      tb = __builtin_amdgcn_readfirstlane(tb);
      if (tb >= (unsigned)T) break;
      u32x4 xs[8];
      {
        int idl[16];
#pragma unroll
        for (int k = 0; k < 8; ++k) {
          idl[2 * k] = __builtin_nontemporal_load((const GAS int*)p.sel_id + (size_t)(tb + k) * 128 + lane);
          idl[2 * k + 1] = __builtin_nontemporal_load((const GAS int*)p.sel_id + (size_t)(tb + k) * 128 + 64 + lane);
          xs[k] = __builtin_nontemporal_load((gp_u32x4)(p.x8 + (size_t)(tb + k) * 1024 + c * 128 + li * 16));
        }
#pragma unroll
        for (int k = 0; k < 8; ++k) { wid[k * 128 + lane] = idl[2 * k]; wid[k * 128 + 64 + lane] = idl[2 * k + 1]; }
      }
      asm volatile("s_waitcnt lgkmcnt(0)" ::: "memory");
      auto issue = [&](int k, u32x4 (&g)[16]) {
        int ids[16];
#pragma unroll
        for (int i = 0; i < 4; ++i) {
          const u32x4 t4 = *(const u32x4*)(wid + k * 128 + grp * 16 + i * 4);
          ids[4 * i] = t4[0]; ids[4 * i + 1] = t4[1]; ids[4 * i + 2] = t4[2]; ids[4 * i + 3] = t4[3];
        }
#pragma unroll
        for (int i = 0; i < 16; ++i) g[i] = gload16(U8 + (size_t)ids[i] * 128);
      };
      auto consume = [&](int k, const u32x4 (&g)[16], const u32x4 cx) {
        const int x0 = (int)cx[0], x1 = (int)cx[1], x2 = (int)cx[2], x3 = (int)cx[3];
        int pp[16];
#pragma unroll
        for (int i = 0; i < 16; ++i) {
          const u32x4 u8 = g[i];
          const int u0 = (int)u8[0], u1 = (int)u8[1], u2 = (int)u8[2], u3 = (int)u8[3];
          int acc = __builtin_amdgcn_sdot4(x0, u0, 0, false);
          acc = __builtin_amdgcn_sdot4(x1, u1, acc, false);
          acc = __builtin_amdgcn_sdot4(x2, u2, acc, false);
          pp[i] = __builtin_amdgcn_sdot4(x3, u3, acc, false);
        }
        int q8[8], q4[4], q2[2];
#pragma unroll
        for (int i = 0; i < 8; ++i) { const int mine = b2 ? pp[i + 8] : pp[i], oth = b2 ? pp[i] : pp[i + 8]; q8[i] = mine + shxi(oth, 4, lane); }
#pragma unroll
        for (int i = 0; i < 4; ++i) { const int mine = b1 ? q8[i + 4] : q8[i], oth = b1 ? q8[i] : q8[i + 4]; q4[i] = mine + shxi(oth, 2, lane); }
#pragma unroll
        for (int i = 0; i < 2; ++i) { const int mine = b0 ? q4[i + 2] : q4[i], oth = b0 ? q4[i] : q4[i + 2]; q2[i] = mine + shxi(oth, 1, lane); }
        i32x2 ov; ov[0] = q2[0]; ov[1] = q2[1];
        __builtin_nontemporal_store(ov, (GAS i32x2*)(pb + (size_t)(tb + k) * 128 + 2 * lane));
      };
      u32x4 ga[16], gb[16];
      issue(0, ga);
#pragma unroll
      for (int k2 = 0; k2 < 4; ++k2) {
        issue(2 * k2 + 1, gb);
        consume(2 * k2, ga, xs[2 * k2]);
        if (k2 < 3) issue(2 * k2 + 2, ga);
        consume(2 * k2 + 1, gb, xs[2 * k2 + 1]);
      }
      asm volatile("s_waitcnt lgkmcnt(0)" ::: "memory");
    }
  }
}

DI void phase_peer_vacc8(const int wq, PRef p, int l, char* smem, int coff, int dry, int rss_idx) {
  const int myx = (int)(xb_xcc_id() & 7u);
  for (int cs = 0; cs < 8; ++cs) {
    const int c = (myx + cs) & 7;
    for (;;) {
      const int tid = ltid(wq);
      const int lane = tid & 63, wv = tid >> 6;
      int* wid = (int*)(smem + wv * 8192);
      float* ww = (float*)(smem + wv * 8192 + 4096);
      const int grp = lane >> 3, li = lane & 7;
      const bool g2 = grp & 4, g1 = grp & 2, g0 = grp & 1;
      const i8_t* V8 = p.v8 + ((size_t)l * 8 + c) * 16384 * 128 + li * 16;
      const int chan = c * 128 + li * 16 + 2 * grp;
      unsigned tb = 0;
      if (lane == 0) tb = atomicAdd(p.qctr + coff + c * 16, 8u);
      tb = __builtin_amdgcn_readfirstlane(tb);
      if (tb >= (unsigned)T) break;
#pragma unroll
      for (int kb = 0; kb < 8; kb += 2) {
        int i0[2], i1[2]; u32x2 gg[2], su2[2]; float sxv[2]; i32x2 pp8[2][8];
#pragma unroll
        for (int u = 0; u < 2; ++u) {
          const size_t token = (size_t)tb + kb + u;
          i0[u] = __builtin_nontemporal_load((const GAS int*)p.sel_id + token * 128 + lane);
          i1[u] = __builtin_nontemporal_load((const GAS int*)p.sel_id + token * 128 + 64 + lane);
          gg[u] = __builtin_nontemporal_load((const GAS u32x2*)(p.sel_g + token * 128 + 2 * lane));
          su2[u] = __builtin_nontemporal_load((const GAS u32x2*)(p.sel_su + token * 128 + 2 * lane));
          sxv[u] = p.sxq[token];
#pragma unroll
          for (int cc = 0; cc < 8; ++cc) pp8[u][cc] = __builtin_nontemporal_load((const GAS i32x2*)((const int*)p.pbuf + ((size_t)cc * T + token) * 128 + 2 * lane));
        }
#pragma unroll
        for (int u = 0; u < 2; ++u) {
          const int k = kb + u;
          wid[k * 128 + lane] = i0[u]; wid[k * 128 + 64 + lane] = i1[u];
          int d0 = 0, d1 = 0;
#pragma unroll
          for (int cc = 0; cc < 8; ++cc) { d0 += pp8[u][cc][0]; d1 += pp8[u][cc][1]; }
          const float f0 = (float)d0 * (sxv[u] * __uint_as_float(su2[u][0])), f1 = (float)d1 * (sxv[u] * __uint_as_float(su2[u][1]));
          f32x2v w2; w2[0] = __uint_as_float(gg[u][0]) * gelu_tanh(f0) * 0.0625f; w2[1] = __uint_as_float(gg[u][1]) * gelu_tanh(f1) * 0.0625f;
          *(f32x2v*)(ww + k * 128 + 2 * lane) = w2;
        }
      }
      asm volatile("s_waitcnt lgkmcnt(0)" ::: "memory");
      auto issue = [&](int hh_, u32x4 (&g)[8]) {
        const int k = hh_ >> 1, hf = hh_ & 1;
        int ids[8];
#pragma unroll
        for (int i = 0; i < 2; ++i) {
          const u32x4 t4 = *(const u32x4*)(wid + k * 128 + grp * 16 + hf * 8 + i * 4);
          ids[4 * i] = t4[0]; ids[4 * i + 1] = t4[1]; ids[4 * i + 2] = t4[2]; ids[4 * i + 3] = t4[3];
        }
#pragma unroll
        for (int i = 0; i < 8; ++i) g[i] = gload16(V8 + (size_t)ids[i] * 128);
      };
      float o[16];
      u32x2 hcur;
      auto accum = [&](int hh_, const u32x4 (&g)[8]) {
        const int k = hh_ >> 1, hf = hh_ & 1;
        if (hf == 0) {
#pragma unroll
          for (int i = 0; i < 16; ++i) o[i] = 0.f;
          hcur = __builtin_nontemporal_load((GAS u32x2*)((GAS float*)p.h + ((size_t)tb + k) * D + chan));
        }
#pragma unroll
        for (int i = 0; i < 8; ++i) {
          const u32x4 v8 = g[i];
          const float w = ww[k * 128 + grp * 16 + hf * 8 + i];
          const int v0 = (int)v8[0], v1 = (int)v8[1], v2 = (int)v8[2], v3 = (int)v8[3];
          f32x2v t2;
          t2 = __builtin_amdgcn_cvt_pk_f32_fp8(v0, false); o[0] = fmaf(w, t2[0], o[0]); o[1] = fmaf(w, t2[1], o[1]);
          t2 = __builtin_amdgcn_cvt_pk_f32_fp8(v0, true);  o[2] = fmaf(w, t2[0], o[2]); o[3] = fmaf(w, t2[1], o[3]);
          t2 = __builtin_amdgcn_cvt_pk_f32_fp8(v1, false); o[4] = fmaf(w, t2[0], o[4]); o[5] = fmaf(w, t2[1], o[5]);
          t2 = __builtin_amdgcn_cvt_pk_f32_fp8(v1, true);  o[6] = fmaf(w, t2[0], o[6]); o[7] = fmaf(w, t2[1], o[7]);
          t2 = __builtin_amdgcn_cvt_pk_f32_fp8(v2, false); o[8] = fmaf(w, t2[0], o[8]); o[9] = fmaf(w, t2[1], o[9]);
          t2 = __builtin_amdgcn_cvt_pk_f32_fp8(v2, true);  o[10] = fmaf(w, t2[0], o[10]); o[11] = fmaf(w, t2[1], o[11]);
          t2 = __builtin_amdgcn_cvt_pk_f32_fp8(v3, false); o[12] = fmaf(w, t2[0], o[12]); o[13] = fmaf(w, t2[1], o[13]);
          t2 = __builtin_amdgcn_cvt_pk_f32_fp8(v3, true);  o[14] = fmaf(w, t2[0], o[14]); o[15] = fmaf(w, t2[1], o[15]);
        }
        if (hf == 1) {
          float r8[8], r4[4], r2[2];
#pragma unroll
          for (int i = 0; i < 8; ++i) { const float mine = g2 ? o[i + 8] : o[i], oth = g2 ? o[i] : o[i + 8]; r8[i] = mine + shx(oth, 32, lane); }
#pragma unroll
          for (int i = 0; i < 4; ++i) { const float mine = g1 ? r8[i + 4] : r8[i], oth = g1 ? r8[i] : r8[i + 4]; r4[i] = mine + shx(oth, 16, lane); }
#pragma unroll
          for (int i = 0; i < 2; ++i) { const float mine = g0 ? r4[i + 2] : r4[i], oth = g0 ? r4[i] : r4[i + 2]; r2[i] = mine + shx(oth, 8, lane); }
          if (!dry) {
            const size_t token = (size_t)tb + k;
            GAS float* hp = (GAS float*)p.h + token * D + chan;
            const u32x2 ch = hcur;
            const float h0 = __uint_as_float(ch[0]) + r2[0], h1 = __uint_as_float(ch[1]) + r2[1];
            u32x2 sv; sv[0] = __float_as_uint(h0); sv[1] = __float_as_uint(h1);
            __builtin_nontemporal_store(sv, (GAS u32x2*)hp);
            *(GAS unsigned*)(p.hn + token * D + chan) = pack2(h0, h1);
            if (rss_idx >= 0) {
              const float ss = wave_sum(h0 * h0 + h1 * h1);
              if (lane < 2) p.rss[((size_t)rss_idx * T + token) * 16 + 2 * c + lane] = lane == 0 ? ss : 0.f;
            }
          }
        }
      };
      u32x4 gA[8], gB[8], gC[8];
      issue(0, gA); issue(1, gB);
#pragma unroll
      for (int h3 = 0; h3 < 15; h3 += 3) {
        asm volatile("" ::: "memory");
        issue(h3 + 2, gC); accum(h3, gA);
        asm volatile("" ::: "memory");
        issue(h3 + 3, gA); accum(h3 + 1, gB);
        asm volatile("" ::: "memory");
        if (h3 + 4 < 16) issue(h3 + 4, gB);
        accum(h3 + 2, gC);
      }
      accum(15, gA);
      asm volatile("s_waitcnt lgkmcnt(0)" ::: "memory");
    }
  }
}

DI void phase_final_norm(const int wq, const float* __restrict__ in, const float* __restrict__ g, float* __restrict__ out, int rows) {
  const int tid = ltid(wq); const int bid = lbid();
  const int lane = tid & 63, wv = tid >> 6;
  f32x4v gv[4];
#pragma unroll
  for (int i = 0; i < 4; ++i) gv[i] = *(const f32x4v*)(g + i * 256 + lane * 4);
  for (int r = bid * 4 + wv; r < rows; r += gridDim.x * 4) {
    const float* pr = in + (size_t)r * D;
    u32x4 v[4];
#pragma unroll
    for (int i = 0; i < 4; ++i) v[i] = gload16(pr + i * 256 + lane * 4);
    float ss = 0.f;
#pragma unroll
    for (int i = 0; i < 4; ++i) {
      const float a = __uint_as_float(v[i][0]), b = __uint_as_float(v[i][1]), c = __uint_as_float(v[i][2]), d = __uint_as_float(v[i][3]);
      ss += a * a + b * b + c * c + d * d;
    }
    ss = wave_sum(ss);
    const float rs = rsqrtf(ss / (float)D + 1e-6f);
#pragma unroll
    for (int i = 0; i < 4; ++i) {
      u32x4 ov;
#pragma unroll
      for (int e = 0; e < 4; ++e) ov[e] = __float_as_uint(__uint_as_float(v[i][e]) * rs * gv[i][e]);
      *(GAS u32x4*)(out + (size_t)r * D + i * 256 + lane * 4) = ov;
    }
  }
}

#define PROBE 0
constexpr int SMEM_BYTES = 73728;
__global__ void __launch_bounds__(NT, 2) mega(Params pk) {
  __shared__ __attribute__((aligned(16))) char smem_c[SMEM_BYTES];
  __shared__ uint4 xb_words;
  __shared__ Params sp;
  {
    const unsigned long long* src = (const unsigned long long*)&pk;
    unsigned long long* dst = (unsigned long long*)&sp;
    if (threadIdx.x < sizeof(Params) / 8) dst[threadIdx.x] = src[threadIdx.x];
  }
  if (threadIdx.x == 0) xb_words = make_uint4(0u, 0u, 0u, 0u);
  __syncthreads();
#define p (*lp((const __attribute__((address_space(3))) Params*)&sp))
  float* smem = (float*)smem_c;
  const int wq = __builtin_amdgcn_readfirstlane((int)(threadIdx.x >> 6));
  (void)xcd_barrier_post(p.bar, (volatile LAS unsigned*)&xb_words);
#define GRID_BARRIER() do { XcdBarrier bb_; bb_.bar = p.bar; bb_.x = xb_xcc_id(); bb_.st = (volatile LAS unsigned*)&xb_words; xcd_barrier(bb_); } while (0)

  phase_convert(wq, p.even_w_in, D, EVEN_IN, EVEN_IN, p.w_even_in, EVEN_IN, nullptr, 2, (size_t)D * EVEN_IN, (size_t)EVEN_IN * D, 0, smem, p.mix_norm, 2 * D);
  phase_convert(wq, p.even_pool_w, 128, 128, 128, p.w_even_pool, 128, p.even_pool_scale, 8, 128 * 128, 128 * 128, 128, smem);
  phase_convert(wq, p.even_w_out, D, D, D, p.w_even_out, D, nullptr, 2, (size_t)D * D, (size_t)D * D, 0, smem);
  phase_convert(wq, p.odd_w_in, D, ODD_IN, ODD_IN, p.w_odd_in, 3840, nullptr, 2, (size_t)D * ODD_IN, (size_t)3840 * D, 0, smem, p.mix_norm + D, 2 * D);
  phase_convert(wq, p.odd_w_uv, 128, 64, 64, p.w_odd_uv, 128, nullptr, 16, 128 * 64, 128 * 128, 0, smem);
  phase_convert(wq, p.odd_w_out, D, D, D, p.w_odd_out, D, nullptr, 2, (size_t)D * D, (size_t)D * D, 0, smem);
  phase_convert(wq, p.xattn_wq, D, D, D, p.w_xq, D, nullptr, 4, (size_t)D * D, (size_t)D * D, 0, smem, p.xattn_norm, D);
  phase_convert(wq, p.xattn_wkv, D, 2048, 2048, p.w_xkv, 2048, nullptr, 4, (size_t)D * 2048, (size_t)2048 * D, 0, smem);
  phase_convert(wq, p.xattn_wo, D, D, D, p.w_xo, D, nullptr, 4, (size_t)D * D, (size_t)D * D, 0, smem);
  phase_convert(wq, p.peer_wq, D, 2048, 2048, p.w_pq, 2048, nullptr, 4, (size_t)D * 2048, (size_t)2048 * D, 0, smem, p.peer_norm, D);
  phase_quant_u(wq, p.peer_u, p.u8, p.su, DEPTH * 16384, p.peer_norm);
  phase_cvt_v8(wq, p.peer_v, p.v8, (size_t)DEPTH * 16384 * 1024 / 16);
  phase_cvt_rows(wq, p.peer_keys, p.keys16, (size_t)DEPTH * 16 * 128 * 128 / 8);
  phase_init_h(wq, p.x, p.h, p.hn, p.rss);
  phase_lb(wq, p);
  phase_rmsnorm_bf(wq, p.mem, D, p.mem_norm, p.memn, D, NB * NMEM, D);
  GRID_BARRIER();
  for (int l = 0; l < DEPTH; ++l)
    phase_gemm_bf16<3>(wq, p.memn, D, p.w_xkv + (size_t)l * 2048 * D, p.kvh + (size_t)l * 2 * 2048 * 1024, 2048, NB * NMEM, 2048, D, smem_c, 0);
  GRID_BARRIER();
  for (int l = 0; l < DEPTH; ++l) {
    const int j = l >> 1;
    if ((l & 1) == 0) {
      phase_gemm_bf16<2, 1>(wq, p.hn, D, p.w_even_in + (size_t)j * EVEN_IN * D, p.P16, EVEN_IN, T, EVEN_IN, D, smem_c, 0, 1, 0, 0, 0, 1, 0, 0, p.rss + (size_t)(3 * l) * T * 16);
      GRID_BARRIER();
      phase_evenmix(wq, p, j);
      GRID_BARRIER();
      phase_gemm_bf16<2>(wq, p.pool, 512, p.w_even_pool + (size_t)j * 4 * 128 * 128, p.Y + 512, D, T, 128, 128, smem_c, 0, 4, 128, 128 * 128, 128);
      GRID_BARRIER();
      phase_gemm_bf16<1>(wq, p.Y, D, p.w_even_out + (size_t)j * D * D, p.h, D, T, D, D, smem_c, 0, 1, 0, 0, 0, 1, 0, 0, nullptr, p.hn, p.rss + (size_t)(3 * l + 1) * T * 16);
      GRID_BARRIER();
    } else {
      phase_gemm_bf16<2, 1>(wq, p.hn, D, p.w_odd_in + (size_t)j * 3840 * D, p.P16, ODD_IN, T, ODD_IN, D, smem_c, 0, 1, 0, 0, 0, 1, 0, 0, p.rss + (size_t)(3 * l) * T * 16);
      GRID_BARRIER();
      phase_dsa_prep(wq, p, j);
      GRID_BARRIER();
      phase_dsa_scores(wq, p, smem_c);
      GRID_BARRIER();
      phase_hgrn_scan(wq, p, l, smem_c);
      phase_dsa_attend(wq, p, j, smem_c, 64 * j);
      GRID_BARRIER();
      phase_gemm_bf16<2>(wq, p.lat, D, p.w_odd_uv + (size_t)j * 8 * 128 * 128, p.Y, D, T, 64, 128, smem_c, 0, 8, 128, 128 * 128, 64);
      phase_hgrn_post(wq, p, j);
      GRID_BARRIER();
      phase_gemm_bf16<1>(wq, p.Y, D, p.w_odd_out + (size_t)j * D * D, p.h, D, T, D, D, smem_c, 0, 1, 0, 0, 0, 1, 0, 0, nullptr, p.hn, p.rss + (size_t)(3 * l + 1) * T * 16);
      GRID_BARRIER();
    }
    phase_gemm_bf16<2, 1>(wq, p.hn, D, p.w_xq + (size_t)l * D * D, p.q16, D, T, D, D, smem_c, 0, 1, 0, 0, 0, 1, 0, 0, p.rss + (size_t)(3 * l + 1) * T * 16);
    GRID_BARRIER();
    phase_gemm_bf16<4>(wq, p.q16, D, p.kvh + (size_t)l * 2 * 2048 * 1024, p.sx, 256, S, 256, 256, smem_c, 0, 32, (size_t)S * D, 256 * 256, (size_t)S * 1024, 4, 256, (size_t)S * 256);
    GRID_BARRIER();
    phase_softmax256(wq, (const bf16_t*)p.sx, p.p16, T * 4);
    GRID_BARRIER();
    phase_gemm_bf16<2>(wq, p.p16, 256, p.kvh + (size_t)l * 2 * 2048 * 1024 + (size_t)2048 * 1024, p.Y, D, S, 256, 256, smem_c, 0, 32, (size_t)S * 1024, 256 * 256, (size_t)S * D, 4, (size_t)S * 256, 256);
    GRID_BARRIER();
    phase_gemm_bf16<1>(wq, p.Y, D, p.w_xo + (size_t)l * D * D, p.h, D, T, D, D, smem_c, 0, 1, 0, 0, 0, 1, 0, 0, nullptr, p.hn, p.rss + (size_t)(3 * l + 2) * T * 16);
    GRID_BARRIER();
    phase_peer_qs(wq, p.hn, p.w_pq + (size_t)l * 2048 * D, p.keys16 + (size_t)l * 16 * 128 * 128, p.tops, smem_c, p.rss + (size_t)(3 * l + 2) * T * 16);
    GRID_BARRIER();
    phase_peer_combine8(wq, p, l, smem_c, p.rss + (size_t)(3 * l + 2) * T * 16);
    GRID_BARRIER();
    phase_peer_udot8(wq, p, l, smem_c, 256 + (l * 2 + 0) * 128);
    GRID_BARRIER();
    phase_peer_vacc8(wq, p, l, smem_c, 256 + (l * 2 + 1) * 128, 0, l + 1 < DEPTH ? 3 * l + 3 : -1);
    GRID_BARRIER();
  }
  phase_final_norm(wq, p.h, p.final_norm, p.out, T);
}

#undef p
extern "C" void kernel_launch(void* const* d_in, const int* in_sizes, int n_in, void* d_out, int out_size, void* d_ws, size_t ws_size,
                              hipStream_t stream) {
  Params p; memset(&p, 0, sizeof(p));
  const float* const* in = (const float* const*)d_in;
  p.x = in[0]; p.mem = in[1]; p.mix_norm = in[2]; p.even_w_in = in[3]; p.even_conv_w = in[4]; p.even_pool_w = in[5];
  p.even_pool_scale = in[6]; p.even_w_out = in[7]; p.odd_w_in = in[8]; p.odd_kv_norm = in[9]; p.odd_w_uv = in[10];
  p.odd_hg_norm = in[11]; p.odd_w_out = in[12]; p.hgrn_gamma = in[13]; p.rel_bias = in[14]; p.mem_norm = in[15];
  p.xattn_norm = in[16]; p.xattn_wq = in[17]; p.xattn_wkv = in[18]; p.xattn_wo = in[19]; p.peer_norm = in[20];
  p.peer_wq = in[21]; p.peer_keys = in[22]; p.peer_u = in[23]; p.peer_v = in[24]; p.final_norm = in[25];
  p.out = (float*)d_out;
  char* w = (char*)d_ws;
  auto take = [&](size_t bytes) { char* r = w; w += (bytes + 255) / 256 * 256; return r; };
  p.bar = (unsigned*)take((XCD_BAR_WORDS + 2048) * 4); p.qctr = p.bar + XCD_BAR_WORDS;
  p.h = (float*)take((size_t)T * D * 4); p.P = (float*)take((size_t)T * ODD_IN * 4); p.P16 = (bf16_t*)p.P;
  p.oraw = (float*)take((size_t)T * 512 * 4); p.lb = (float*)take(DEPTH * 512 * 4);
  p.hn = (bf16_t*)take((size_t)T * D * 2); p.Y = (bf16_t*)take((size_t)T * D * 2); p.pool = (bf16_t*)take((size_t)T * 512 * 2);
  p.memn = (bf16_t*)take((size_t)NB * NMEM * D * 2); p.lat = (bf16_t*)take((size_t)T * D * 2);
  p.w_even_in = (bf16_t*)take((size_t)2 * EVEN_IN * D * 2); p.w_even_pool = (bf16_t*)take((size_t)8 * 128 * 128 * 2);
  p.w_even_out = (bf16_t*)take((size_t)2 * D * D * 2); p.w_odd_in = (bf16_t*)take((size_t)2 * 3840 * D * 2);
  p.w_odd_uv = (bf16_t*)take((size_t)16 * 128 * 128 * 2); p.w_odd_out = (bf16_t*)take((size_t)2 * D * D * 2);
  p.w_xq = (bf16_t*)take((size_t)4 * D * D * 2); p.w_xkv = (bf16_t*)take((size_t)4 * 2048 * D * 2); p.w_xo = (bf16_t*)take((size_t)4 * D * D * 2);
  p.w_pq = (bf16_t*)take((size_t)4 * 2048 * D * 2);
  p.u8 = (signed char*)take((size_t)DEPTH * 16384 * 1024); p.v8 = (signed char*)take((size_t)DEPTH * 16384 * 1024); p.x8 = (signed char*)take((size_t)T * 1024);
  p.su = (float*)take((size_t)DEPTH * 16384 * 4); p.sxq = (float*)take((size_t)T * 4); p.sel_su = (float*)take((size_t)T * 128 * 4);
  p.keys16 = (bf16_t*)take((size_t)DEPTH * 16 * 128 * 128 * 2); p.kvh = (bf16_t*)take((size_t)DEPTH * 2 * 2048 * 1024 * 2); p.rss = (float*)take((size_t)12 * T * 16 * 4);
  {
    char* a = (char*)p.P;
    p.sx = (float*)a; a += (size_t)T * 4 * 256 * 4;
    p.p16 = (bf16_t*)a; a += (size_t)T * 4 * 256 * 2;
    p.q16 = (bf16_t*)a; a += (size_t)T * D * 2;
    p.tops = (int*)a; a += (size_t)T * 256 * 4;
    p.sel_id = (int*)a; a += (size_t)T * 128 * 4;
    p.sel_g = (float*)a; a += (size_t)T * 128 * 4;
    p.pbuf = (float*)a;
  }
  p.qlat16 = (bf16_t*)take((size_t)T * 1024 * 2); p.ckv16 = (bf16_t*)take((size_t)T * 128 * 2); p.iq16 = (bf16_t*)take((size_t)T * 512 * 2);
  p.ik16 = (bf16_t*)take((size_t)T * 64 * 2); p.sc = (float*)take((size_t)T * 2048 * 4);

  p.probe = 1;
  static int grid = 0;
  if (!grid) {
    int dev = 0, cus = 0, per_cu = 0;
    (void)hipGetDevice(&dev);
    (void)hipDeviceGetAttribute(&cus, hipDeviceAttributeMultiprocessorCount, dev);
    (void)hipOccupancyMaxActiveBlocksPerMultiprocessor(&per_cu, mega, NT, 0);
    if (per_cu > 2) per_cu = 2;
    if (per_cu < 1) per_cu = 1;
    grid = cus * per_cu;
  }
  (void)hipMemsetAsync(p.bar, 0, (XCD_BAR_WORDS + 2048) * sizeof(unsigned), stream);
  mega<<<grid, NT, 0, stream>>>(p);
}
```

```cpp
#include <hip/hip_runtime.h>
#include <hip/hip_bf16.h>
#include <stdint.h>
#include <math.h>
#include <string.h>

#define DI __device__ __forceinline__

constexpr int D = 1024, NB = 8, S = 2048, T = NB * S, DEPTH = 4, NMEM = 256;
constexpr int EVEN_IN = 2048, ODD_IN = 3784;
constexpr int NT = 256;

typedef unsigned short bf16_t;
struct Params {
  const float *x, *mem, *mix_norm, *even_w_in, *even_conv_w, *even_pool_w, *even_pool_scale, *even_w_out;
  const float *odd_w_in, *odd_kv_norm, *odd_w_uv, *odd_hg_norm, *odd_w_out, *hgrn_gamma, *rel_bias, *mem_norm;
  const float *xattn_norm, *xattn_wq, *xattn_wkv, *xattn_wo, *peer_norm, *peer_wq, *peer_keys, *peer_u, *peer_v, *final_norm;
  float* out;
  float *h, *P, *kv, *ckv, *oraw, *lb; bf16_t* P16;
  bf16_t *hn, *Y, *pool, *memn, *lat;
  bf16_t *u16, *v16, *keys16; int* tops; signed char *u8, *v8, *x8; float *su, *sxq, *sel_su;
  float* rss;
  bf16_t *q16, *kvh, *p16; float* sx; int* sel_id; float* sel_g; float* pbuf;
  bf16_t *qlat16, *ckv16, *iq16, *ik16; float* sc; unsigned* qctr;
  bf16_t *w_even_in, *w_even_pool, *w_even_out, *w_odd_in, *w_odd_uv, *w_odd_out, *w_xq, *w_xkv, *w_xo, *w_pq;
  unsigned* bar;
  int probe, pad_;
};

#define XB_TMO      128
#define XB_XCNT(j)  (256  + 64 * (j))
#define XB_XSUB(j)  (1280 + 64 * (j))
#define XB_XGEN(j)  (2304 + 64 * (j))
#define XB_TOP      3328
#define XB_TOPGEN   3392
#define XCD_BAR_WORDS 3456
#define XB_SPIN_CAP (1u << 18)
#define LAS __attribute__((address_space(3)))

__device__ __forceinline__ unsigned xb_ld(unsigned* p)              { return __hip_atomic_load(p, __ATOMIC_RELAXED, __HIP_MEMORY_SCOPE_AGENT); }
__device__ __forceinline__ unsigned xb_add(unsigned* p, unsigned v) { return __hip_atomic_fetch_add(p, v, __ATOMIC_RELAXED, __HIP_MEMORY_SCOPE_AGENT); }
__device__ __forceinline__ unsigned xb_xcc_id() { return (unsigned)__builtin_amdgcn_s_getreg((3 << 11) | 20) & 0xFu; }
#define XB_SPIN(cond, bar) do { unsigned _sp = 0; while (cond) { __builtin_amdgcn_s_sleep(1); \
    if ((++_sp & 255u) == 0u) { if (xb_ld(&(bar)[XB_TMO])) break; if (_sp > XB_SPIN_CAP) { atomicAdd(&(bar)[XB_TMO], 1u); break; } } } } while (0)

typedef const __attribute__((address_space(3))) Params& PRef;
DI const __attribute__((address_space(3))) Params* lp(const __attribute__((address_space(3))) Params* q) { asm volatile("" : "+v"(q)); return q; }
struct XcdBarrier {
    unsigned* bar; unsigned x;
    volatile LAS unsigned* st;
};

__device__ __forceinline__ XcdBarrier xcd_barrier_post(unsigned* bar, volatile LAS unsigned* st) {
    XcdBarrier b; b.bar = bar; b.x = xb_xcc_id(); b.st = st;
    if (threadIdx.x == 0) (void)xb_add(&bar[XB_XCNT(b.x)], 1u);
    return b;
}
__device__ __forceinline__ void xcd_barrier_complete(unsigned* bar, unsigned x, unsigned& nloc, unsigned& nx) {
    const unsigned G = gridDim.x * gridDim.y * gridDim.z;
    unsigned sum, cnt, mine, sp = 0u;
    for (;;) {
        sum = 0u; cnt = 0u; mine = 0u;
#pragma unroll
        for (unsigned j = 0; j < 16; ++j) { const unsigned c = xb_ld(&bar[XB_XCNT(j)]); sum += c; cnt += (c > 0u) ? 1u : 0u; mine = (j == x) ? c : mine; }
        if (sum == G) break;
        __builtin_amdgcn_s_sleep(1);
        if ((++sp & 255u) == 0u) { if (xb_ld(&bar[XB_TMO])) break; if (sp > XB_SPIN_CAP) { atomicAdd(&bar[XB_TMO], 1u); break; } }
    }
    nloc = mine > 0u ? mine : 1u; nx = cnt > 0u ? cnt : 1u;
}

__device__ __forceinline__ void xcd_barrier(const XcdBarrier& b) {
    asm volatile("s_waitcnt vmcnt(0)" ::: "memory");
    __syncthreads();
    if (threadIdx.x == 0) {
        unsigned* bar = b.bar;
        __builtin_amdgcn_s_waitcnt(0);
        unsigned nloc = b.st[0], nx = b.st[1];
        if (nloc == 0u) { xcd_barrier_complete(bar, b.x, nloc, nx); b.st[0] = nloc; b.st[1] = nx; }
        const unsigned old = xb_add(&bar[XB_XSUB(b.x)], 1u);
        const unsigned gen = old / nloc;
        if (old + 1u == (gen + 1u) * nloc) {
            __builtin_amdgcn_fence(__ATOMIC_RELEASE, "agent");
            asm volatile("s_waitcnt vmcnt(0)" ::: "memory");
            const unsigned og = xb_add(&bar[XB_TOP], 1u);
            const unsigned tg = og / nx;
            if (og + 1u == (tg + 1u) * nx) xb_add(&bar[XB_TOPGEN], 1u);
            else XB_SPIN(xb_ld(&bar[XB_TOPGEN]) == tg, bar);
            __builtin_amdgcn_fence(__ATOMIC_ACQUIRE, "agent");
            xb_add(&bar[XB_XGEN(b.x)], 1u);
            asm volatile("s_waitcnt vmcnt(0)" ::: "memory");
        } else {
            XB_SPIN(xb_ld(&bar[XB_XGEN(b.x)]) == gen, bar);
            __builtin_amdgcn_fence(__ATOMIC_ACQUIRE, "agent");
            asm volatile("s_waitcnt vmcnt(0)" ::: "memory");
        }
    }
    __syncthreads();
}


typedef __bf16 bf16x2_t __attribute__((ext_vector_type(2)));
typedef float f32x2_t __attribute__((ext_vector_type(2)));
using bf16x8 = __attribute__((ext_vector_type(8))) short;
using f32x16 = __attribute__((ext_vector_type(16))) float;
using u32x4 = __attribute__((ext_vector_type(4))) unsigned;
using u32x2 = __attribute__((ext_vector_type(2))) unsigned;
using f32x4v = __attribute__((ext_vector_type(4))) float;
using f32x2v = __attribute__((ext_vector_type(2))) float;
#define GAS __attribute__((address_space(1)))
typedef const GAS u32x4* gp_u32x4;
DI u32x4 gload16(const void* p) { return *(gp_u32x4)(p); }
DI bf16_t f2bf(float f) { __bf16 b = (__bf16)f; return __builtin_bit_cast(unsigned short, b); }
DI unsigned pack2(float a, float b) { f32x2_t v = {a, b}; bf16x2_t r = __builtin_convertvector(v, bf16x2_t); return __builtin_bit_cast(unsigned, r); }
DI float bf2f(bf16_t u) { return __uint_as_float(((unsigned)u) << 16); }
DI float bflo(unsigned u) { return __uint_as_float(u << 16); }
DI float bfhi(unsigned u) { return __uint_as_float(u & 0xffff0000u); }
DI f32x4v bf4_to_f(const u32x2 v) { const unsigned a = v[0], b = v[1]; f32x4v r; r[0] = bflo(a); r[1] = bfhi(a); r[2] = bflo(b); r[3] = bfhi(b); return r; }
DI int ltid(int wq) { int t; asm volatile("v_mbcnt_lo_u32_b32 %0, -1, 0\n\tv_mbcnt_hi_u32_b32 %0, -1, %0" : "=v"(t)); return (wq << 6) | t; }
DI int lbid() { int b = blockIdx.x; asm volatile("" : "+s"(b)); return b; }
#define DPP_F(v, ctrl, rmask, bctl) __int_as_float(__builtin_amdgcn_update_dpp(0, __float_as_int(v), (ctrl), (rmask), 0xF, (bctl)))
DI float wave_sum(float v) {
  v += DPP_F(v, 0xB1, 0xF, true);
  v += DPP_F(v, 0x4E, 0xF, true);
  v += DPP_F(v, 0x141, 0xF, true);
  v += DPP_F(v, 0x140, 0xF, true);
  v += DPP_F(v, 0x142, 0xA, false);
  v += DPP_F(v, 0x143, 0xC, false);
  return __int_as_float(__builtin_amdgcn_readlane(__float_as_int(v), 63));
}
#define DPP_I(v, ctrl, rmask, bctl) __builtin_amdgcn_update_dpp(0, (v), (ctrl), (rmask), 0xF, (bctl))
DI int wave_sum_i(int v) {
  v += DPP_I(v, 0xB1, 0xF, true); v += DPP_I(v, 0x4E, 0xF, true); v += DPP_I(v, 0x141, 0xF, true); v += DPP_I(v, 0x140, 0xF, true);
  v += DPP_I(v, 0x142, 0xA, false); v += DPP_I(v, 0x143, 0xC, false);
  return __builtin_amdgcn_readlane(v, 63);
}
DI float wave_max(float v) {
  v = fmaxf(v, DPP_F(v, 0xB1, 0xF, true));
  v = fmaxf(v, DPP_F(v, 0x4E, 0xF, true));
  v = fmaxf(v, DPP_F(v, 0x141, 0xF, true));
  v = fmaxf(v, DPP_F(v, 0x140, 0xF, true));
  { const float t = __int_as_float(__builtin_amdgcn_update_dpp(__float_as_int(v), __float_as_int(v), 0x142, 0xA, 0xF, false)); v = fmaxf(v, t); }
  { const float t = __int_as_float(__builtin_amdgcn_update_dpp(__float_as_int(v), __float_as_int(v), 0x143, 0xC, 0xF, false)); v = fmaxf(v, t); }
  return __int_as_float(__builtin_amdgcn_readlane(__float_as_int(v), 63));
}
DI float rowsum16(float v) { v += DPP_F(v, 0x128, 0xF, true); v += DPP_F(v, 0x124, 0xF, true); v += DPP_F(v, 0x122, 0xF, true); v += DPP_F(v, 0x121, 0xF, true); return v; }
DI float rowmax16(float v) { v = fmaxf(v, DPP_F(v, 0x128, 0xF, true)); v = fmaxf(v, DPP_F(v, 0x124, 0xF, true)); v = fmaxf(v, DPP_F(v, 0x122, 0xF, true)); v = fmaxf(v, DPP_F(v, 0x121, 0xF, true)); return v; }
DI float shx(float v, int mask, int lane) { return __int_as_float(__builtin_amdgcn_ds_bpermute((lane ^ mask) << 2, __float_as_int(v))); }
DI int shxi(int v, int mask, int lane) { return __builtin_amdgcn_ds_bpermute((lane ^ mask) << 2, v); }
DI float gelu_tanh(float x) {
  const float k0 = 0.7978845608028654f, k1 = 0.044715f;
  return 0.5f * x * (1.f + tanhf(k0 * (x + k1 * x * x * x)));
}
DI float sigmoidf(float x) { return 1.f / (1.f + expf(-x)); }

DI float rstd_of(const float* __restrict__ rss, int row) {
  const float* q = rss + (size_t)row * 16;
  const f32x4v a = *(const f32x4v*)q, b = *(const f32x4v*)(q + 4), c = *(const f32x4v*)(q + 8), d = *(const f32x4v*)(q + 12);
  const float s0 = (a[0] + a[1]) + (a[2] + a[3]), s1 = (b[0] + b[1]) + (b[2] + b[3]), s2 = (c[0] + c[1]) + (c[2] + c[3]), s3 = (d[0] + d[1]) + (d[2] + d[3]);
  return rsqrtf(((s0 + s1) + (s2 + s3)) * (1.f / 1024.f) + 1e-6f);
}
DI void phase_init_h(const int wq, const float* __restrict__ x, float* __restrict__ h, bf16_t* __restrict__ hb, float* __restrict__ rss) {
  const int tid = ltid(wq); const int bid = lbid();
  const int lane = tid & 63, wv = tid >> 6;
  for (int r = bid * 4 + wv; r < T; r += gridDim.x * 4) {
    float ss = 0.f;
#pragma unroll
    for (int i = 0; i < 4; ++i) {
      const u32x4 v = gload16(x + (size_t)r * D + i * 256 + lane * 4);
      const unsigned v0 = v[0], v1 = v[1], v2 = v[2], v3 = v[3];
      const float a = __uint_as_float(v0), b = __uint_as_float(v1), c = __uint_as_float(v2), d = __uint_as_float(v3);
      ss += a * a + b * b + c * c + d * d;
      *(GAS u32x4*)(h + (size_t)r * D + i * 256 + lane * 4) = v;
      u32x2 o; o[0] = pack2(a, b); o[1] = pack2(c, d);
      *(GAS u32x2*)(hb + (size_t)r * D + i * 256 + lane * 4) = o;
    }
    ss = wave_sum(ss);
    if (lane < 16) rss[(size_t)r * 16 + lane] = lane == 0 ? ss : 0.f;
  }
}

DI void phase_rmsnorm_bf(const int wq, const float* __restrict__ in, int ldi, const float* __restrict__ g, bf16_t* __restrict__ out, int ldo, int rows, int W) {
  const int tid_ = ltid(wq); const int bid_ = lbid();
  const int lane = tid_ & 63, wv = tid_ >> 6;
  f32x4v gv[4];
#pragma unroll
  for (int i = 0; i < 4; ++i) gv[i] = *(const f32x4v*)(g + i * 256 + lane * 4);
  for (int r = bid_ * 4 + wv; r < rows; r += gridDim.x * 4) {
    const float* p = in + (size_t)r * ldi;
    u32x4 v[4];
#pragma unroll
    for (int i = 0; i < 4; ++i) v[i] = gload16(p + i * 256 + lane * 4);
    float ss = 0.f;
#pragma unroll
    for (int i = 0; i < 4; ++i) {
      const float a = __uint_as_float(v[i][0]), b = __uint_as_float(v[i][1]), c = __uint_as_float(v[i][2]), d = __uint_as_float(v[i][3]);
      ss += a * a + b * b + c * c + d * d;
    }
    ss = wave_sum(ss);
    const float rs = rsqrtf(ss / (float)W + 1e-6f);
    bf16_t* o = out + (size_t)r * ldo;
#pragma unroll
    for (int i = 0; i < 4; ++i) {
      u32x2 ov;
      ov[0] = pack2(__uint_as_float(v[i][0]) * rs * gv[i][0], __uint_as_float(v[i][1]) * rs * gv[i][1]);
      ov[1] = pack2(__uint_as_float(v[i][2]) * rs * gv[i][2], __uint_as_float(v[i][3]) * rs * gv[i][3]);
      *(GAS u32x2*)(o + i * 256 + lane * 4) = ov;
    }
  }
}

DI void phase_convert(const int wq, const float* __restrict__ W0, int K, int N, int ldw, bf16_t* __restrict__ Bt0, int Npad, const float* __restrict__ cs0,
                      int nbatch, size_t sW, size_t sBt, size_t sCS, float* smem, const float* __restrict__ rs0 = nullptr, size_t sRS = 0) {
  const int tid = ltid(wq); const int bid = lbid();
  float (*tl)[65] = (float (*)[65])smem;
  const int tk = K / 64, tn = Npad / 64;
  for (int tile0 = bid; tile0 < tk * tn * nbatch; tile0 += gridDim.x) {
    const int bt = tile0 / (tk * tn), tile = tile0 % (tk * tn);
    const int k0 = (tile / tn) * 64, n0 = (tile % tn) * 64;
    const float* W = W0 + (size_t)bt * sW;
    bf16_t* Bt = Bt0 + (size_t)bt * sBt;
    __syncthreads();
#pragma unroll 4
    for (int i = 0; i < 16; ++i) {
      const int k = i * 4 + (tid >> 6), n = tid & 63;
      float v = 0.f;
      if (n0 + n < N) { v = W[(size_t)(k0 + k) * ldw + n0 + n]; if (cs0) v *= cs0[(size_t)bt * sCS + n0 + n]; if (rs0) v *= rs0[(size_t)bt * sRS + k0 + k]; }
      tl[k][n] = v;
    }
    __syncthreads();
#pragma unroll 4
    for (int i = 0; i < 16; ++i) {
      const int n = i * 4 + (tid >> 6), k = tid & 63;
      Bt[(size_t)(n0 + n) * K + k0 + k] = f2bf(tl[k][n]);
    }
  }
}

constexpr int G_LDS_ROW = 144;
constexpr int G_TILE_B = 128 * G_LDS_ROW;
template <int MODE, int RS = 0>
DI void phase_gemm_bf16(const int wq, const bf16_t* __restrict__ A0, int lda, const bf16_t* __restrict__ B0, void* __restrict__ C0, int ldc,
                        int M, int N, int K, char* smem, int dry, int nbatch = 1, size_t sA = 0, size_t sB = 0, size_t sC = 0,
                        int inner = 1, size_t sA2 = 0, size_t sC2 = 0, const float* __restrict__ rss_in = nullptr, bf16_t* __restrict__ hb_out = nullptr, float* __restrict__ rss_out = nullptr) {
  const int tid = ltid(wq); const int bid = lbid();
  const int lane = tid & 63, wv = tid >> 6, wm = wv >> 1, wn = wv & 1;
  const int r = lane & 31, hh = lane >> 5;
  const int tm = M / 128, tn = (N + 127) / 128;
  const int nk = K / 64;
  const int srow = tid >> 3, skc = tid & 7;
  const int ntile_all = tm * tn * nbatch;
  const int per_x = (ntile_all + 7) >> 3;
  const int t_beg = (bid & 7) * per_x, t_end = (t_beg + per_x < ntile_all) ? t_beg + per_x : ntile_all;
  for (int tile0 = t_beg + (bid >> 3); tile0 < t_end; tile0 += (int)(gridDim.x >> 3)) {
    const int bt = tile0 / (tm * tn), tile = tile0 % (tm * tn);
    const int m0 = (tile / tn) * 128, n0 = (tile % tn) * 128;
    const int bhi = bt / inner, blo = bt % inner;
    const bf16_t* Ag = A0 + (size_t)bhi * sA + (size_t)blo * sA2 + (size_t)(m0 + srow) * lda + skc * 8;
    const bf16_t* Bg = B0 + (size_t)bt * sB + (size_t)(n0 + srow) * K + skc * 8;
    f32x16 acc[2][2];
#pragma unroll
    for (int i = 0; i < 2; ++i)
#pragma unroll
      for (int j = 0; j < 2; ++j)
#pragma unroll
        for (int e = 0; e < 16; ++e) acc[i][j][e] = 0.f;
    u32x4 ra[4], rb[4];
#pragma unroll
    for (int i = 0; i < 4; ++i) {
      ra[i] = gload16(Ag + (size_t)(32 * i) * lda);
      rb[i] = gload16(Bg + (size_t)(32 * i) * K);
    }
    __syncthreads();
#pragma unroll
    for (int i = 0; i < 4; ++i) {
      *(u32x4*)(smem + (srow + 32 * i) * G_LDS_ROW + skc * 16) = ra[i];
      *(u32x4*)(smem + 2 * G_TILE_B + (srow + 32 * i) * G_LDS_ROW + skc * 16) = rb[i];
    }
    __syncthreads();
#pragma unroll 1
    for (int kt = 0; kt < nk; ++kt) {
      const int cur = kt & 1;
      if (kt + 1 < nk) {
#pragma unroll
        for (int i = 0; i < 4; ++i) {
          ra[i] = gload16(Ag + (size_t)(32 * i) * lda + (kt + 1) * 64);
          rb[i] = gload16(Bg + (size_t)(32 * i) * K + (kt + 1) * 64);
        }
      }
      const char* As = smem + cur * G_TILE_B + (wm * 64 + r) * G_LDS_ROW + hh * 16;
      const char* Bs = smem + 2 * G_TILE_B + cur * G_TILE_B + (wn * 64 + r) * G_LDS_ROW + hh * 16;
#pragma unroll
      for (int ks = 0; ks < 4; ++ks) {
        bf16x8 a0 = *(const bf16x8*)(As + ks * 32);
        bf16x8 a1 = *(const bf16x8*)(As + 32 * G_LDS_ROW + ks * 32);
        bf16x8 b0 = *(const bf16x8*)(Bs + ks * 32);
        bf16x8 b1 = *(const bf16x8*)(Bs + 32 * G_LDS_ROW + ks * 32);
        acc[0][0] = __builtin_amdgcn_mfma_f32_32x32x16_bf16(a0, b0, acc[0][0], 0, 0, 0);
        acc[0][1] = __builtin_amdgcn_mfma_f32_32x32x16_bf16(a0, b1, acc[0][1], 0, 0, 0);
        acc[1][0] = __builtin_amdgcn_mfma_f32_32x32x16_bf16(a1, b0, acc[1][0], 0, 0, 0);
        acc[1][1] = __builtin_amdgcn_mfma_f32_32x32x16_bf16(a1, b1, acc[1][1], 0, 0, 0);
      }
      if (kt + 1 < nk) {
        const int nxt = cur ^ 1;
#pragma unroll
        for (int i = 0; i < 4; ++i) {
          *(u32x4*)(smem + nxt * G_TILE_B + (srow + 32 * i) * G_LDS_ROW + skc * 16) = ra[i];
          *(u32x4*)(smem + 2 * G_TILE_B + nxt * G_TILE_B + (srow + 32 * i) * G_LDS_ROW + skc * 16) = rb[i];
        }
      }
      __syncthreads();
    }
    if (RS) {
      if (tid < 128) ((float*)smem)[tid] = rstd_of(rss_in, m0 + tid);
      __syncthreads();
    }
#pragma unroll
    for (int i = 0; i < 2; ++i)
#pragma unroll
      for (int j = 0; j < 2; ++j) {
        const int col = n0 + wn * 64 + j * 32 + r;
        if (col < N && !dry) {
          const size_t base = (size_t)bhi * sC + (size_t)blo * sC2 + (size_t)(m0 + wm * 64 + i * 32 + 4 * hh) * ldc + col;
          if (RS) {
            const float* rp = (const float*)smem + wm * 64 + i * 32 + 4 * hh;
#pragma unroll
            for (int e = 0; e < 16; ++e) acc[i][j][e] *= rp[(e & 3) + 8 * (e >> 2)];
          }
          if (MODE == 1) {
            GAS float* cp = (GAS float*)C0 + base;
            float old[16];
#pragma unroll
            for (int e = 0; e < 16; ++e) old[e] = cp[(size_t)((e & 3) + 8 * (e >> 2)) * ldc];
#pragma unroll
            for (int e = 0; e < 16; ++e) { old[e] += acc[i][j][e]; acc[i][j][e] = old[e]; cp[(size_t)((e & 3) + 8 * (e >> 2)) * ldc] = old[e]; }
            if (hb_out) {
              GAS bf16_t* hp = (GAS bf16_t*)hb_out + base;
#pragma unroll
              for (int e = 0; e < 16; ++e) hp[(size_t)((e & 3) + 8 * (e >> 2)) * ldc] = f2bf(old[e]);
            }
          } else if (MODE == 0) {
            GAS float* cp = (GAS float*)C0 + base;
#pragma unroll
            for (int e = 0; e < 16; ++e) cp[(size_t)((e & 3) + 8 * (e >> 2)) * ldc] = acc[i][j][e];
          } else if (MODE == 2) {
            GAS bf16_t* cp = (GAS bf16_t*)C0 + base;
#pragma unroll
            for (int e = 0; e < 16; ++e) cp[(size_t)((e & 3) + 8 * (e >> 2)) * ldc] = f2bf(acc[i][j][e]);
          } else if (MODE == 4) {
            GAS bf16_t* cp = (GAS bf16_t*)C0 + base;
#pragma unroll
            for (int e = 0; e < 16; ++e) cp[(size_t)((e & 3) + 8 * (e >> 2)) * ldc] = f2bf(acc[i][j][e] * 0.0625f);
          } else {
            const int rowb = m0 + wm * 64 + i * 32 + 4 * hh;
            const int b_ = rowb >> 8, mm = rowb & 255;
            const int cc = col & 1023, hd_ = cc >> 8, dd = cc & 255;
            GAS bf16_t* kb = (GAS bf16_t*)C0;
            if (col < 1024) {
#pragma unroll
              for (int e = 0; e < 16; ++e) kb[((size_t)(b_ * 4 + hd_) * 256 + mm + (e & 3) + 8 * (e >> 2)) * 256 + dd] = f2bf(acc[i][j][e]);
            } else {
#pragma unroll
              for (int e = 0; e < 16; ++e) kb[(size_t)2048 * 1024 + ((size_t)(b_ * 4 + hd_) * 256 + dd) * 256 + mm + (e & 3) + 8 * (e >> 2)] = f2bf(acc[i][j][e]);
            }
          }
        }
      }
    if (MODE == 1 && rss_out && !dry) {
#pragma unroll
      for (int i = 0; i < 2; ++i) {
        float myv = 0.f;
#pragma unroll
        for (int e = 0; e < 16; ++e) {
          float v = acc[i][0][e] * acc[i][0][e] + acc[i][1][e] * acc[i][1][e];
          v = rowsum16(v);
          v += shx(v, 16, lane);
          if ((lane & 15) == e) myv = v;
        }
        if ((lane & 16) == 0) rss_out[(size_t)(m0 + wm * 64 + i * 32 + (lane & 3) + 8 * ((lane & 15) >> 2) + 4 * hh) * 16 + (n0 >> 7) * 2 + wn] = myv;
      }
    }
  }
}

template <int W>
DI void evenmix_run(const bf16_t* __restrict__ P, const float* __restrict__ cw, bf16_t* __restrict__ Y, bf16_t* __restrict__ pool, int t0, int c) {
  const int s0 = t0 & (S - 1);
  f32x4v w0 = *(const f32x4v*)(cw + c), w1 = *(const f32x4v*)(cw + 512 + c), w2 = *(const f32x4v*)(cw + 1024 + c);
  const f32x4v zero = {0.f, 0.f, 0.f, 0.f};
  auto ld = [&](int t, int off) { const u32x2 v = *(const GAS u32x2*)(P + (size_t)t * EVEN_IN + off + c); return bf4_to_f(v); };
  f32x4v xm2 = zero, xm1 = zero;
  if (s0 >= 2) xm2 = ld(t0 - 2, 512) * ld(t0 - 2, 0);
  if (s0 >= 1) xm1 = ld(t0 - 1, 512) * ld(t0 - 1, 0);
  f32x4v ring[W];
  f32x4v sum = zero;
#pragma unroll
  for (int i = 0; i < W; ++i) { ring[i] = (s0 + i - W >= 0) ? ld(t0 + i - W, 1536) : zero; sum += ring[i]; }
#pragma unroll
  for (int tt = 0; tt < 32; ++tt) {
    const int t = t0 + tt;
    const f32x4v x0 = ld(t, 512) * ld(t, 0);
    const f32x4v z = w0 * xm2 + w1 * xm1 + w2 * x0;
    xm2 = xm1; xm1 = x0;
    const f32x4v ya = ld(t, 1024) * z;
    const f32x4v pv = ld(t, 1536);
    sum += pv - ring[tt % W]; ring[tt % W] = pv;
    const int cnt = (s0 + tt + 1 < W) ? (s0 + tt + 1) : W;
    const float ic = 1.f / (float)cnt;
    const f32x4v pl = sum * ic - pv;
    u32x2 oa, ob;
    oa[0] = pack2(ya[0], ya[1]); oa[1] = pack2(ya[2], ya[3]);
    ob[0] = pack2(pl[0], pl[1]); ob[1] = pack2(pl[2], pl[3]);
    *(GAS u32x2*)(Y + (size_t)t * D + c) = oa;
    *(GAS u32x2*)(pool + (size_t)t * 512 + c) = ob;
  }
}
DI void phase_evenmix(const int wq, PRef p, int j) {
  const int tid = ltid(wq); const int bid = lbid();
  const int lane = tid & 63, wv = tid >> 6;
  const float* cw = p.even_conv_w + (size_t)j * 3 * 512;
  for (int Wg = bid * 4 + wv; Wg < 1024; Wg += gridDim.x * 4) {
    const int g = Wg & 3, cp = Wg >> 2;
    const int t0 = (cp * 2 + (lane >> 5)) * 32;
    const int c = g * 128 + (lane & 31) * 4;
    if (g == 0) evenmix_run<2>(p.P16, cw, p.Y, p.pool, t0, c);
    else if (g == 1) evenmix_run<4>(p.P16, cw, p.Y, p.pool, t0, c);
    else if (g == 2) evenmix_run<8>(p.P16, cw, p.Y, p.pool, t0, c);
    else evenmix_run<16>(p.P16, cw, p.Y, p.pool, t0, c);
  }
}

DI void phase_lb(const int wq, PRef p) {
  const int tid_ = ltid(wq); const int bid_ = lbid(); (void)tid_; (void)bid_;
  for (int c = bid_ * NT + tid_; c < 512; c += gridDim.x * NT) {
    float g[DEPTH], m = -INFINITY;
#pragma unroll
    for (int l = 0; l < DEPTH; ++l) { g[l] = p.hgrn_gamma[l * 512 + c]; m = fmaxf(m, g[l]); }
    float sum = 0.f;
#pragma unroll
    for (int l = 0; l < DEPTH; ++l) { g[l] = expf(g[l] - m); sum += g[l]; }
    float cum = 0.f;
#pragma unroll
    for (int l = 0; l < DEPTH; ++l) { p.lb[l * 512 + c] = cum; cum += g[l] / sum; }
  }
}

DI int t5_bucket(int dist) {
  const int d = dist < 0 ? 0 : dist;
  if (d < 16) return d;
  const float lr = logf((float)d / 16.f) / 2.0794415416798357f;
  int large = 16 + (int)(lr * 16.f);
  return large < 31 ? large : 31;
}

DI unsigned fkey(float f) { unsigned u = __float_as_uint(f); return (u & 0x80000000u) ? ~u : (u | 0x80000000u); }

DI void phase_hgrn_post(const int wq, PRef p, int j) {
  const int tid_ = ltid(wq); const int bid_ = lbid(); (void)tid_; (void)bid_;
  const int lane = tid_ & 63, wv = tid_ >> 6;
  for (int r = bid_ * 4 + wv; r < T * 4; r += gridDim.x * 4) {
    const int t = r >> 2, hd = r & 3;
    const float* o = p.oraw + (size_t)t * 512 + hd * 128;
    const float a = o[lane], bq = o[lane + 64];
    const float ss = wave_sum(a * a + bq * bq);
    const float rs = rsqrtf(ss / 128.f + 1e-6f);
    const bf16_t* gate = p.P16 + (size_t)t * ODD_IN + 3272 + hd * 128;
    const float* gn = p.odd_hg_norm + j * 512 + hd * 128;
    const float g0 = bf2f(gate[lane]), g1 = bf2f(gate[lane + 64]);
    p.Y[(size_t)t * D + 512 + hd * 128 + lane] = f2bf(a * rs * gn[lane] * (g0 * sigmoidf(g0)));
    p.Y[(size_t)t * D + 512 + hd * 128 + lane + 64] = f2bf(bq * rs * gn[lane + 64] * (g1 * sigmoidf(g1)));
  }
}

DI void phase_dsa_prep(const int wq, PRef p, int j) {
  const int tid = ltid(wq); const int bid = lbid();
  const int lane = tid & 63, wv = tid >> 6;
  for (int t = bid * 4 + wv; t < T; t += gridDim.x * 4) {
    const bf16_t* row = p.P16 + (size_t)t * ODD_IN;
#pragma unroll
    for (int c = 0; c < 2; ++c) *(GAS u32x4*)(p.qlat16 + (size_t)t * 1024 + c * 512 + lane * 8) = gload16(row + c * 512 + lane * 8);
    {
      const unsigned cv = *(const GAS unsigned*)(row + 1024 + 2 * lane);
      const float c0 = bflo(cv), c1 = bfhi(cv);
      const float ss = wave_sum(c0 * c0 + c1 * c1);
      const float rs = rsqrtf(ss / 128.f + 1e-6f);
      const float* g = p.odd_kv_norm + j * 128;
      *(GAS unsigned*)(p.ckv16 + (size_t)t * 128 + 2 * lane) = pack2(c0 * rs * g[2 * lane], c1 * rs * g[2 * lane + 1]);
    }
    *(GAS u32x4*)(p.iq16 + (size_t)t * 512 + lane * 8) = gload16(row + 1152 + lane * 8);
    p.ik16[(size_t)t * 64 + lane] = row[1664 + lane];
  }
}

DI void phase_dsa_scores(const int wq, PRef p, char* smem) {
  const int tid = ltid(wq); const int bid = lbid();
  const int lane = tid & 63, wv = tid >> 6, wm = wv >> 1, wn = wv & 1;
  const int r = lane & 31, hh = lane >> 5;
  const int srow = tid >> 3, skc = tid & 7;
  char* Ks = smem;
  char* Qs = smem + G_TILE_B;
  float* Ws = (float*)(smem + 3 * G_TILE_B);
  for (int tile = bid; tile < NB * 136; tile += gridDim.x) {
    const int b = tile / 136, u = tile % 136;
    int qb = 0;
    while ((qb + 1) * (qb + 2) / 2 <= u) ++qb;
    const int kb = u - qb * (qb + 1) / 2;
    const int q0 = b * S + qb * 128, k0 = b * S + kb * 128;
    const bf16_t* Kg = p.ik16 + (size_t)(k0 + srow) * 64 + skc * 8;
    const bf16_t* Qg = p.iq16 + (size_t)(q0 + srow) * 512 + skc * 8;
    u32x4 rk[4], rq[4];
#pragma unroll
    for (int i = 0; i < 4; ++i) { rk[i] = gload16(Kg + (size_t)(32 * i) * 64); rq[i] = gload16(Qg + (size_t)(32 * i) * 512); }
    u32x4 wv4 = {0u, 0u, 0u, 0u};
    if (tid < 128) wv4 = gload16(p.P16 + (size_t)(q0 + tid) * ODD_IN + 1728);
    __syncthreads();
#pragma unroll
    for (int i = 0; i < 4; ++i) {
      *(u32x4*)(Ks + (srow + 32 * i) * G_LDS_ROW + skc * 16) = rk[i];
      *(u32x4*)(Qs + (srow + 32 * i) * G_LDS_ROW + skc * 16) = rq[i];
    }
    if (tid < 128) {
      const unsigned w0 = wv4[0], w1 = wv4[1], w2 = wv4[2], w3 = wv4[3];
      f32x4v a4, b4;
      a4[0] = bflo(w0) * 0.35355339059327373f; a4[1] = bfhi(w0) * 0.35355339059327373f; a4[2] = bflo(w1) * 0.35355339059327373f; a4[3] = bfhi(w1) * 0.35355339059327373f;
      b4[0] = bflo(w2) * 0.35355339059327373f; b4[1] = bfhi(w2) * 0.35355339059327373f; b4[2] = bflo(w3) * 0.35355339059327373f; b4[3] = bfhi(w3) * 0.35355339059327373f;
      *(f32x4v*)(Ws + tid * 8) = a4; *(f32x4v*)(Ws + tid * 8 + 4) = b4;
    }
    __syncthreads();
    f32x16 sc[2][2];
#pragma unroll
    for (int i = 0; i < 2; ++i)
#pragma unroll
      for (int jx = 0; jx < 2; ++jx)
#pragma unroll
        for (int e = 0; e < 16; ++e) sc[i][jx][e] = 0.f;
#pragma unroll 1
    for (int hd = 0; hd < 8; ++hd) {
      const int cur = hd & 1;
      if (hd + 1 < 8) {
#pragma unroll
        for (int i = 0; i < 4; ++i) rq[i] = gload16(Qg + (size_t)(32 * i) * 512 + (hd + 1) * 64);
      }
      f32x16 acc[2][2];
#pragma unroll
      for (int i = 0; i < 2; ++i)
#pragma unroll
        for (int jx = 0; jx < 2; ++jx)
#pragma unroll
          for (int e = 0; e < 16; ++e) acc[i][jx][e] = 0.f;
      const char* As = Qs + cur * G_TILE_B + (wm * 64 + r) * G_LDS_ROW + hh * 16;
      const char* Bs = Ks + (wn * 64 + r) * G_LDS_ROW + hh * 16;
#pragma unroll
      for (int ks = 0; ks < 4; ++ks) {
        const bf16x8 a0 = *(const bf16x8*)(As + ks * 32), a1 = *(const bf16x8*)(As + 32 * G_LDS_ROW + ks * 32);
        const bf16x8 b0 = *(const bf16x8*)(Bs + ks * 32), b1 = *(const bf16x8*)(Bs + 32 * G_LDS_ROW + ks * 32);
        acc[0][0] = __builtin_amdgcn_mfma_f32_32x32x16_bf16(a0, b0, acc[0][0], 0, 0, 0);
        acc[0][1] = __builtin_amdgcn_mfma_f32_32x32x16_bf16(a0, b1, acc[0][1], 0, 0, 0);
        acc[1][0] = __builtin_amdgcn_mfma_f32_32x32x16_bf16(a1, b0, acc[1][0], 0, 0, 0);
        acc[1][1] = __builtin_amdgcn_mfma_f32_32x32x16_bf16(a1, b1, acc[1][1], 0, 0, 0);
      }
#pragma unroll
      for (int i = 0; i < 2; ++i)
#pragma unroll
        for (int e = 0; e < 16; ++e) {
          const float w = Ws[(wm * 64 + i * 32 + (e & 3) + 8 * (e >> 2) + 4 * hh) * 8 + hd];
          sc[i][0][e] = fmaf(w, fmaxf(acc[i][0][e] * 0.125f, 0.f), sc[i][0][e]);
          sc[i][1][e] = fmaf(w, fmaxf(acc[i][1][e] * 0.125f, 0.f), sc[i][1][e]);
        }
      if (hd + 1 < 8) {
#pragma unroll
        for (int i = 0; i < 4; ++i) *(u32x4*)(Qs + (cur ^ 1) * G_TILE_B + (srow + 32 * i) * G_LDS_ROW + skc * 16) = rq[i];
      }
      __syncthreads();
    }
#pragma unroll
    for (int i = 0; i < 2; ++i)
#pragma unroll
      for (int jx = 0; jx < 2; ++jx) {
        GAS float* cp = (GAS float*)p.sc + (size_t)(q0 + wm * 64 + i * 32 + 4 * hh) * 2048 + kb * 128 + wn * 64 + jx * 32 + r;
#pragma unroll
        for (int e = 0; e < 16; ++e) cp[(size_t)((e & 3) + 8 * (e >> 2)) * 2048] = sc[i][jx][e];
      }
  }
}

DI void phase_hgrn_scan(const int wq, PRef p, int l, char* smem) {
  const int tid = ltid(wq); const int bid = lbid();
  const int lane = tid & 63, wv = tid >> 6;
  const int kq = wv * 4 + (lane & 3), v = lane >> 2;
  constexpr int BUF = (2048 + 2048 + 256);
  float* bufs = (float*)smem;
  float* opart = bufs + 2 * BUF;
  for (int unit = bid; unit < 256; unit += gridDim.x) {
    const int b = unit >> 5, hd = (unit >> 3) & 3, vs = unit & 7;
    const int ltok = tid >> 4, lc = (tid & 15) * 8;
    const bf16_t* Pb = p.P16 + (size_t)(b * S) * ODD_IN;
    f32x4v lbv0, lbv1;
    { const float* lbp = p.lb + l * 512 + hd * 128 + lc; lbv0 = *(const f32x4v*)lbp; lbv1 = *(const f32x4v*)(lbp + 4); }
    float st[8];
#pragma unroll
    for (int i = 0; i < 8; ++i) st[i] = 0.f;
    u32x4 rq, rf; float riv;
    auto gl = [&](int bt) {
      const bf16_t* row = Pb + (size_t)(bt * 16 + ltok) * ODD_IN;
      rq = gload16(row + 1736 + hd * 128 + lc);
      rf = gload16(row + 2248 + hd * 128 + lc);
      riv = bf2f(row[2760 + hd * 128 + vs * 16 + (tid & 15)]);
    };
    auto st_lds = [&](int which) {
      float* bq = bufs + which * BUF; float* bf = bq + 2048; float* bi = bf + 2048;
      const unsigned q0_ = rq[0], q1_ = rq[1], q2_ = rq[2], q3_ = rq[3], f0_ = rf[0], f1_ = rf[1], f2_ = rf[2], f3_ = rf[3];
      f32x4v qa, qb, fa, fb;
      qa[0] = bflo(q0_); qa[1] = bfhi(q0_); qa[2] = bflo(q1_); qa[3] = bfhi(q1_); qb[0] = bflo(q2_); qb[1] = bfhi(q2_); qb[2] = bflo(q3_); qb[3] = bfhi(q3_);
      fa[0] = bflo(f0_); fa[1] = bfhi(f0_); fa[2] = bflo(f1_); fa[3] = bfhi(f1_); fb[0] = bflo(f2_); fb[1] = bfhi(f2_); fb[2] = bflo(f3_); fb[3] = bfhi(f3_);
      *(f32x4v*)(bq + ltok * 128 + lc) = qa; *(f32x4v*)(bq + ltok * 128 + lc + 4) = qb;
      f32x4v f0, f1;
#pragma unroll
      for (int i = 0; i < 4; ++i) {
        f0[i] = lbv0[i] + (1.f - lbv0[i]) * sigmoidf(fa[i]);
        f1[i] = lbv1[i] + (1.f - lbv1[i]) * sigmoidf(fb[i]);
      }
      *(f32x4v*)(bf + ltok * 128 + lc) = f0; *(f32x4v*)(bf + ltok * 128 + lc + 4) = f1;
      bi[ltok * 16 + (tid & 15)] = riv;
    };
    gl(0);
    __syncthreads();
    st_lds(0);
    __syncthreads();
#pragma unroll 1
    for (int bt = 0; bt < S / 16; ++bt) {
      const int cur = bt & 1;
      if (bt + 1 < S / 16) gl(bt + 1);
      const float* bq = bufs + cur * BUF; const float* bf = bq + 2048; const float* bi = bf + 2048;
#pragma unroll 4
      for (int tt = 0; tt < 16; ++tt) {
        const float iv = bi[tt * 16 + v];
        const f32x4v f0 = *(const f32x4v*)(bf + tt * 128 + kq * 8), f1 = *(const f32x4v*)(bf + tt * 128 + kq * 8 + 4);
        const f32x4v q0 = *(const f32x4v*)(bq + tt * 128 + kq * 8), q1 = *(const f32x4v*)(bq + tt * 128 + kq * 8 + 4);
        float o = 0.f;
#pragma unroll
        for (int i = 0; i < 4; ++i) {
          st[i] = fmaf(f0[i], st[i], (1.f - f0[i]) * iv); o = fmaf(q0[i], st[i], o);
          st[4 + i] = fmaf(f1[i], st[4 + i], (1.f - f1[i]) * iv); o = fmaf(q1[i], st[4 + i], o);
        }
        o += __int_as_float(__builtin_amdgcn_update_dpp(0, __float_as_int(o), 0xB1, 0xF, 0xF, true));
        o += __int_as_float(__builtin_amdgcn_update_dpp(0, __float_as_int(o), 0x4E, 0xF, 0xF, true));
        if ((lane & 3) == 0) opart[(tt * 4 + wv) * 16 + v] = o;
      }
      __syncthreads();
      {
        const int tt = tid >> 4, vo = tid & 15;
        const float o = opart[(tt * 4 + 0) * 16 + vo] + opart[(tt * 4 + 1) * 16 + vo] + opart[(tt * 4 + 2) * 16 + vo] + opart[(tt * 4 + 3) * 16 + vo];
        p.oraw[(size_t)(b * S + bt * 16 + tt) * 512 + hd * 128 + vs * 16 + vo] = o;
      }
      if (bt + 1 < S / 16) st_lds(cur ^ 1);
      __syncthreads();
    }
  }
}

DI float dot2bf(unsigned a, unsigned b, float acc) { return __builtin_amdgcn_fdot2_f32_bf16(__builtin_bit_cast(bf16x2_t, a), __builtin_bit_cast(bf16x2_t, b), acc, false); }
DI unsigned fkey_u(float f) { const unsigned u = __float_as_uint(f); return (u & 0x80000000u) ? ~u : (u | 0x80000000u); }
DI void phase_dsa_attend(const int wq, PRef p, int j, char* smem, int qoff) {
  const int tid = ltid(wq); const int bid = lbid(); (void)bid;
  const int lane = tid & 63, wv = tid >> 6;
  int* selL = (int*)smem;
  int* nselL = selL + 1024;
  float* bias = (float*)(smem + 4096 + 64);
  float* part = (float*)(smem + 4096 + 64 + 1024);
  float* msb = part + 2 * 4 * 8 * 128;
  float* plw = msb + 2 * 4 * 16 + wv * 64 * 8;
  int* sel = selL + wv * 256;
  __syncthreads();
  bias[tid] = p.rel_bias[tid];
  const int n16 = lane & 15, kg = lane >> 4;
  const unsigned long long ltmask = (1ull << lane) - 1ull;
  for (;;) {
    __syncthreads();
    if (tid == 0) nselL[4] = (int)atomicAdd(p.qctr + qoff, 4u);
    __syncthreads();
    const int base = nselL[4];
    if (base >= T) break;
    {
      const int q = base + wv;
      const int t = q % S;
      const float* row = p.sc + (size_t)q * 2048;
      int nsel;
      if (t < 256) {
        nsel = t + 1;
#pragma unroll
        for (int i = 0; i < 4; ++i) sel[i * 64 + lane] = i * 64 + lane;
      } else {
        nsel = 256;
        const int ni = (t >> 6) + 1;
        unsigned keys[32];
#pragma unroll
        for (int i = 0; i < 32; ++i) {
          keys[i] = 0u;
          if (i < ni) { const int s_ = i * 64 + lane; if (s_ <= t) keys[i] = fkey_u(row[s_]); }
        }
        unsigned thr = 0u;
#pragma unroll 1
        for (int bit = 31; bit >= 0; --bit) {
          const unsigned cand = thr | (1u << bit);
          int cl = 0;
#pragma unroll
          for (int g = 0; g < 4; ++g) if (g * 8 < ni) {
#pragma unroll
            for (int i = g * 8; i < g * 8 + 8; ++i) cl += (keys[i] >= cand) ? 1 : 0;
          }
          const int cnt = wave_sum_i(cl);
          if (cnt >= 256) thr = cand;
        }
        int ngt = 0;
#pragma unroll
        for (int i = 0; i < 32; ++i) if (i < ni) ngt += __builtin_popcountll(__ballot(keys[i] > thr));
        const int need = 256 - ngt;
        int pg = 0, pe = 0;
#pragma unroll
        for (int i = 0; i < 32; ++i) if (i < ni) {
          const unsigned long long mg = __ballot(keys[i] > thr), me = __ballot(keys[i] == thr);
          const int myg = pg + __builtin_popcountll(mg & ltmask), mye = pe + __builtin_popcountll(me & ltmask);
          if (keys[i] > thr) sel[myg] = i * 64 + lane;
          else if (keys[i] == thr && mye < need) sel[ngt + mye] = i * 64 + lane;
          pg += __builtin_popcountll(mg); pe += __builtin_popcountll(me);
        }
      }
      if (lane == 0) nselL[wv] = nsel;
    }
    __syncthreads();
#pragma unroll 1
    for (int qi = 0; qi < 4; ++qi) {
      const int tid = ltid(wq);
      const int lane = tid & 63;
      const int n16 = lane & 15, kg = lane >> 4;
      const int q = base + qi;
      const int b = q / S, t = q % S;
      const int nsel = nselL[qi];
      const int* qsel = selL + qi * 256 + wv * 64;
      const int slot0 = wv * 64;
      float* pw = part + ((qi & 1) * 4 + wv) * 8 * 128;
      float* mw = msb + ((qi & 1) * 4 + wv) * 16;
      bf16x8 aq[4];
#pragma unroll
      for (int ks = 0; ks < 4; ++ks) {
        u32x4 z = {0u, 0u, 0u, 0u};
        if (n16 < 8) z = gload16(p.qlat16 + (size_t)q * 1024 + n16 * 128 + ks * 32 + kg * 8);
        aq[ks] = __builtin_bit_cast(bf16x8, z);
      }
      u32x4 bv[4][4];
#pragma unroll
      for (int bb = 0; bb < 4; ++bb) {
        const int sl = bb * 16 + n16;
        const int sxv = (slot0 + sl < nsel) ? qsel[sl] : 0;
        const bf16_t* crow = p.ckv16 + (size_t)(b * S + sxv) * 128 + kg * 8;
#pragma unroll
        for (int ks = 0; ks < 4; ++ks) bv[bb][ks] = gload16(crow + ks * 32);
      }
      const bf16_t* cb = p.ckv16 + (size_t)(b * S) * 128 + 2 * lane;
      unsigned cbuf[64];
#pragma unroll
      for (int i4 = 0; i4 < 8; ++i4) {
        const u32x4 s4 = *(const u32x4*)(qsel + i4 * 4);
#pragma unroll
        for (int e = 0; e < 4; ++e) {
          const int k = i4 * 4 + e;
          const int sk = (slot0 + k < nsel) ? __builtin_amdgcn_readfirstlane((int)s4[e]) : 0;
          cbuf[k] = *(const GAS unsigned*)(cb + (size_t)sk * 128);
        }
      }
      asm volatile("" ::: "memory");
      f32x4v lg[4];
#pragma unroll
      for (int bb = 0; bb < 4; ++bb) {
        f32x4v acc = {0.f, 0.f, 0.f, 0.f};
#pragma unroll
        for (int ks = 0; ks < 4; ++ks) acc = __builtin_amdgcn_mfma_f32_16x16x32_bf16(aq[ks], __builtin_bit_cast(bf16x8, bv[bb][ks]), acc, 0, 0, 0);
        lg[bb] = acc;
      }
      asm volatile("" ::: "memory");
#pragma unroll
      for (int i4 = 8; i4 < 16; ++i4) {
        const u32x4 s4 = *(const u32x4*)(qsel + i4 * 4);
#pragma unroll
        for (int e = 0; e < 4; ++e) {
          const int k = i4 * 4 + e;
          const int sk = (slot0 + k < nsel) ? __builtin_amdgcn_readfirstlane((int)s4[e]) : 0;
          cbuf[k] = *(const GAS unsigned*)(cb + (size_t)sk * 128);
        }
      }
      float mx[4] = {-INFINITY, -INFINITY, -INFINITY, -INFINITY};
#pragma unroll
      for (int bb = 0; bb < 4; ++bb) {
        const bool ok = slot0 + bb * 16 + n16 < nsel;
        const int bk = t5_bucket(t - (ok ? qsel[bb * 16 + n16] : 0));
#pragma unroll
        for (int i = 0; i < 4; ++i) {
          const float lv = ok ? lg[bb][i] * 0.08838834764831845f + bias[bk * 8 + ((4 * kg + i) & 7)] : -INFINITY;
          lg[bb][i] = lv; mx[i] = fmaxf(mx[i], lv);
        }
      }
#pragma unroll
      for (int i = 0; i < 4; ++i) mx[i] = rowmax16(mx[i]);
      float sm[4] = {0.f, 0.f, 0.f, 0.f};
#pragma unroll
      for (int bb = 0; bb < 4; ++bb)
#pragma unroll
        for (int i = 0; i < 4; ++i) {
          const float e_ = (mx[i] == -INFINITY) ? 0.f : __expf(lg[bb][i] - mx[i]);
          lg[bb][i] = e_; sm[i] += e_;
        }
#pragma unroll
      for (int i = 0; i < 4; ++i) sm[i] = rowsum16(sm[i]);
#pragma unroll
      for (int bb = 0; bb < 4; ++bb) {
        u32x4 pr;
#pragma unroll
        for (int i = 0; i < 4; ++i) {
          const float other = DPP_F(lg[bb][i], 0xB1, 0xF, true);
          pr[i] = pack2(lg[bb][i], other);
        }
        if (kg < 2 && (n16 & 1) == 0) *(u32x4*)((unsigned*)plw + ((bb * 16 + n16) >> 1) * 8 + 4 * kg) = pr;
      }
      if (kg < 2) {
        if (n16 == 0) {
#pragma unroll
          for (int i = 0; i < 4; ++i) { mw[4 * kg + i] = mx[i]; mw[8 + 4 * kg + i] = sm[i]; }
        }
      }
      asm volatile("s_waitcnt lgkmcnt(0)" ::: "memory");
      float o[16];
#pragma unroll
      for (int i = 0; i < 16; ++i) o[i] = 0.f;
#pragma unroll
      for (int kp = 0; kp < 32; ++kp) {
        if ((kp & 1) == 0) asm volatile("" ::: "memory");
        const unsigned ca = cbuf[2 * kp], cbx = cbuf[2 * kp + 1];
        const unsigned x0 = __builtin_amdgcn_perm(cbx, ca, 0x05040100u);
        const unsigned x1 = __builtin_amdgcn_perm(cbx, ca, 0x07060302u);
        const u32x4 pa4 = *(const u32x4*)((const unsigned*)plw + kp * 8), pb4 = *(const u32x4*)((const unsigned*)plw + kp * 8 + 4);
        const unsigned q0 = pa4[0], q1 = pa4[1], q2 = pa4[2], q3 = pa4[3], q4 = pb4[0], q5 = pb4[1], q6 = pb4[2], q7 = pb4[3];
        o[0] = dot2bf(q0, x0, o[0]); o[1] = dot2bf(q0, x1, o[1]); o[2] = dot2bf(q1, x0, o[2]); o[3] = dot2bf(q1, x1, o[3]);
        o[4] = dot2bf(q2, x0, o[4]); o[5] = dot2bf(q2, x1, o[5]); o[6] = dot2bf(q3, x0, o[6]); o[7] = dot2bf(q3, x1, o[7]);
        o[8] = dot2bf(q4, x0, o[8]); o[9] = dot2bf(q4, x1, o[9]); o[10] = dot2bf(q5, x0, o[10]); o[11] = dot2bf(q5, x1, o[11]);
        o[12] = dot2bf(q6, x0, o[12]); o[13] = dot2bf(q6, x1, o[13]); o[14] = dot2bf(q7, x0, o[14]); o[15] = dot2bf(q7, x1, o[15]);
      }
#pragma unroll
      for (int hd = 0; hd < 8; ++hd) { float2 ov; ov.x = o[2 * hd]; ov.y = o[2 * hd + 1]; *(float2*)(pw + hd * 128 + 2 * lane) = ov; }
      __syncthreads();
      {
        const int hd = tid >> 5, ch = (tid & 31) * 4;
        const float* pq = part + (qi & 1) * 4 * 8 * 128;
        const float* mq = msb + (qi & 1) * 4 * 16;
        float m0 = mq[hd], m1 = mq[16 + hd], m2 = mq[32 + hd], m3 = mq[48 + hd];
        const float M = fmaxf(fmaxf(m0, m1), fmaxf(m2, m3));
        const float f0 = __expf(m0 - M), f1 = __expf(m1 - M), f2 = __expf(m2 - M), f3 = __expf(m3 - M);
        const float den = f0 * mq[8 + hd] + f1 * mq[24 + hd] + f2 * mq[40 + hd] + f3 * mq[56 + hd];
        const f32x4v a0 = *(const f32x4v*)(pq + (0 * 8 + hd) * 128 + ch), a1 = *(const f32x4v*)(pq + (1 * 8 + hd) * 128 + ch);
        const f32x4v a2 = *(const f32x4v*)(pq + (2 * 8 + hd) * 128 + ch), a3 = *(const f32x4v*)(pq + (3 * 8 + hd) * 128 + ch);
        const float inv = 1.f / den;
        const f32x4v r = (a0 * f0 + a1 * f1 + a2 * f2 + a3 * f3) * inv;
        u32x2 ov; ov[0] = pack2(r[0], r[1]); ov[1] = pack2(r[2], r[3]);
        *(GAS u32x2*)(p.lat + (size_t)q * D + hd * 128 + ch) = ov;
      }
    }
  }
}

DI void phase_softmax256(const int wq, const bf16_t* __restrict__ S, bf16_t* __restrict__ Pm, int rows) {
  const int tid = ltid(wq); const int bid = lbid();
  const int lane = tid & 63, wv = tid >> 6;
  for (int r = bid * 4 + wv; r < rows; r += gridDim.x * 4) {
    const f32x4v v = bf4_to_f(*(const GAS u32x2*)(S + (size_t)r * 256 + lane * 4));
    const float a = v[0], b = v[1], c = v[2], d = v[3];
    const float m = wave_max(fmaxf(fmaxf(a, b), fmaxf(c, d)));
    const float ea = __expf(a - m), eb = __expf(b - m), ec = __expf(c - m), ed = __expf(d - m);
    const float inv = 1.f / wave_sum(ea + eb + ec + ed);
    u32x2 o; o[0] = pack2(ea * inv, eb * inv); o[1] = pack2(ec * inv, ed * inv);
    *(GAS u32x2*)(Pm + (size_t)r * 256 + lane * 4) = o;
  }
}

DI int fkey_s(int b) { return b ^ ((b >> 31) & 0x7fffffff); }

template <int N, int KMAX>
DI void bitonic_blocks(int (&v)[N]) {
#pragma unroll
  for (int k = 2; k <= KMAX; k <<= 1)
#pragma unroll
    for (int j = k >> 1; j > 0; j >>= 1)
#pragma unroll
      for (int i = 0; i < N; ++i) {
        const int l = i ^ j;
        if (l > i) {
          const bool desc = ((i & k) == 0);
          const int a = v[i], b = v[l];
          const int hi = a > b ? a : b, lo = a > b ? b : a;
          v[i] = desc ? hi : lo;
          v[l] = desc ? lo : hi;
        }
      }
}
template <bool DESC>
DI void bitonic_merge16(int (&v)[16]) {
#pragma unroll
  for (int j = 8; j > 0; j >>= 1)
#pragma unroll
    for (int i = 0; i < 16; ++i) {
      const int l = i ^ j;
      if (l > i) {
        const int a = v[i], b = v[l];
        const int hi = a > b ? a : b, lo = a > b ? b : a;
        v[i] = DESC ? hi : lo;
        v[l] = DESC ? lo : hi;
      }
    }
}

DI void phase_cvt_rows(const int wq, const float* __restrict__ src, bf16_t* __restrict__ dst, size_t n8) {
  const int tid = ltid(wq); const int bid = lbid();
  for (size_t i = (size_t)bid * NT + tid; i < n8; i += (size_t)gridDim.x * NT) {
    const u32x4 a = gload16(src + i * 8), b = gload16(src + i * 8 + 4);
    u32x4 o;
    o[0] = pack2(__uint_as_float(a[0]), __uint_as_float(a[1])); o[1] = pack2(__uint_as_float(a[2]), __uint_as_float(a[3]));
    o[2] = pack2(__uint_as_float(b[0]), __uint_as_float(b[1])); o[3] = pack2(__uint_as_float(b[2]), __uint_as_float(b[3]));
    *(GAS u32x4*)(dst + i * 8) = o;
  }
}

constexpr int KEY_ROW = 264;
DI void phase_peer_qs(const int wq, const bf16_t* __restrict__ X0, const bf16_t* __restrict__ W0, const bf16_t* __restrict__ keys0, int* __restrict__ tops, char* smem, const float* __restrict__ rss_in) {
  const int tid = ltid(wq); const int bid = lbid();
  const int lane = tid & 63, wv = tid >> 6;
  const int r = lane & 31, hh = lane >> 5;
  const int srow = tid >> 3, skc = tid & 7;
  constexpr int nk = D / 64;
  for (int tile = bid; tile < (T / 128) * 16; tile += gridDim.x) {
    const int mt = tile >> 4, hp = tile & 15;
    const bf16_t* Wg = W0 + (size_t)(hp * 128 + srow) * D + skc * 8;
    const bf16_t* Xg = X0 + (size_t)(mt * 128 + srow) * D + skc * 8;
    f32x16 acc[4];
#pragma unroll
    for (int i = 0; i < 4; ++i)
#pragma unroll
      for (int e = 0; e < 16; ++e) acc[i][e] = 0.f;
    u32x4 ra[4], rb[4];
#pragma unroll
    for (int i = 0; i < 4; ++i) { ra[i] = gload16(Wg + (size_t)(32 * i) * D); rb[i] = gload16(Xg + (size_t)(32 * i) * D); }
    __syncthreads();
#pragma unroll
    for (int i = 0; i < 4; ++i) {
      *(u32x4*)(smem + (srow + 32 * i) * G_LDS_ROW + skc * 16) = ra[i];
      *(u32x4*)(smem + 2 * G_TILE_B + (srow + 32 * i) * G_LDS_ROW + skc * 16) = rb[i];
    }
    __syncthreads();
#pragma unroll 1
    for (int kt = 0; kt < nk; ++kt) {
      const int cur = kt & 1;
      if (kt + 1 < nk) {
#pragma unroll
        for (int i = 0; i < 4; ++i) { ra[i] = gload16(Wg + (size_t)(32 * i) * D + (kt + 1) * 64); rb[i] = gload16(Xg + (size_t)(32 * i) * D + (kt + 1) * 64); }
      }
      const char* As = smem + cur * G_TILE_B + r * G_LDS_ROW + hh * 16;
      const char* Bs = smem + 2 * G_TILE_B + cur * G_TILE_B + (wv * 32 + r) * G_LDS_ROW + hh * 16;
#pragma unroll
      for (int ks = 0; ks < 4; ++ks) {
        const bf16x8 b = *(const bf16x8*)(Bs + ks * 32);
#pragma unroll
        for (int mb = 0; mb < 4; ++mb) {
          const bf16x8 a = *(const bf16x8*)(As + mb * 32 * G_LDS_ROW + ks * 32);
          acc[mb] = __builtin_amdgcn_mfma_f32_32x32x16_bf16(a, b, acc[mb], 0, 0, 0);
        }
      }
      if (kt + 1 < nk) {
        const int nxt = cur ^ 1;
#pragma unroll
        for (int i = 0; i < 4; ++i) {
          *(u32x4*)(smem + nxt * G_TILE_B + (srow + 32 * i) * G_LDS_ROW + skc * 16) = ra[i];
          *(u32x4*)(smem + 2 * G_TILE_B + nxt * G_TILE_B + (srow + 32 * i) * G_LDS_ROW + skc * 16) = rb[i];
        }
      }
      __syncthreads();
    }
    {
      const bf16_t* kg = keys0 + (size_t)hp * 128 * 128;
#pragma unroll
      for (int i = 0; i < 8; ++i) {
        const int c = tid + NT * i, row = c >> 4, c16 = c & 15;
        const u32x4 v = gload16(kg + row * 128 + c16 * 8);
        uint2 lo, hi2; lo.x = v[0]; lo.y = v[1]; hi2.x = v[2]; hi2.y = v[3];
        *(uint2*)(smem + row * KEY_ROW + c16 * 16) = lo;
        *(uint2*)(smem + row * KEY_ROW + c16 * 16 + 8) = hi2;
      }
    }
    __syncthreads();
    u32x4 qf[8];
    const float rstd_t = rstd_of(rss_in, mt * 128 + wv * 32 + r);
#pragma unroll
    for (int mb = 0; mb < 4; ++mb)
#pragma unroll
      for (int s2 = 0; s2 < 2; ++s2) {
        u32x4 f;
#pragma unroll
        for (int jj = 0; jj < 4; ++jj) f[jj] = pack2(acc[mb][8 * s2 + 2 * jj] * rstd_t, acc[mb][8 * s2 + 2 * jj + 1] * rstd_t);
        qf[mb * 2 + s2] = f;
      }
    int v[64];
#pragma unroll
    for (int kb = 0; kb < 4; ++kb) {
      f32x16 sa;
#pragma unroll
      for (int e = 0; e < 16; ++e) sa[e] = 0.f;
      const char* kr = smem + (kb * 32 + r) * KEY_ROW + hh * 8;
#pragma unroll
      for (int ksi = 0; ksi < 8; ++ksi) {
        const uint2 lo = *(const uint2*)(kr + ksi * 32);
        const uint2 hi2 = *(const uint2*)(kr + ksi * 32 + 16);
        u32x4 a; a[0] = lo.x; a[1] = lo.y; a[2] = hi2.x; a[3] = hi2.y;
        sa = __builtin_amdgcn_mfma_f32_32x32x16_bf16(__builtin_bit_cast(bf16x8, a), __builtin_bit_cast(bf16x8, qf[ksi]), sa, 0, 0, 0);
      }
#pragma unroll
      for (int e = 0; e < 16; ++e) {
        const int kidx = kb * 32 + (e & 3) + 8 * (e >> 2) + 4 * hh;
        v[kb * 16 + e] = (fkey_s(__float_as_int(sa[e])) & ~127) | kidx;
      }
    }
    bitonic_blocks<64, 16>(v);
    int c01[16], c23[16];
#pragma unroll
    for (int i = 0; i < 16; ++i) { c01[i] = v[i] > v[16 + i] ? v[i] : v[16 + i]; c23[i] = v[32 + i] > v[48 + i] ? v[32 + i] : v[48 + i]; }
    bitonic_merge16<true>(c01);
    bitonic_merge16<false>(c23);
    int d[16];
#pragma unroll
    for (int i = 0; i < 16; ++i) d[i] = c01[i] > c23[i] ? c01[i] : c23[i];
    bitonic_merge16<true>(d);
    int f[16];
#pragma unroll
    for (int i = 0; i < 16; ++i) { const int o = shxi(d[15 - i], 32, lane); f[i] = d[i] > o ? d[i] : o; }
    bitonic_merge16<true>(f);
    {
      const int token = mt * 128 + wv * 32 + r;
      GAS int* op = (GAS int*)tops + ((size_t)token * 16 + hp) * 16 + hh * 8;
      u32x4 o0, o1;
      if (hh) {
#pragma unroll
        for (int i = 0; i < 4; ++i) { o0[i] = f[8 + i]; o1[i] = f[12 + i]; }
        asm volatile("" : "+v"(o0), "+v"(o1));
      } else {
#pragma unroll
        for (int i = 0; i < 4; ++i) { o0[i] = f[i]; o1[i] = f[4 + i]; }
        asm volatile("" : "+v"(o0), "+v"(o1));
      }
      *(GAS u32x4*)op = o0; *(GAS u32x4*)(op + 4) = o1;
    }
  }
}

DI float dot8(const u32x4 a, const u32x4 b, float acc) {
  const unsigned a0 = a[0], a1 = a[1], a2 = a[2], a3 = a[3], b0 = b[0], b1 = b[1], b2 = b[2], b3 = b[3];
  acc = dot2bf(a0, b0, acc); acc = dot2bf(a1, b1, acc); acc = dot2bf(a2, b2, acc); acc = dot2bf(a3, b3, acc);
  return acc;
}
typedef signed char i8_t;
using i32x2 = __attribute__((ext_vector_type(2))) int;
DI void phase_quant_u(const int wq, const float* __restrict__ src, i8_t* __restrict__ dst, float* __restrict__ su, int nrows, const float* __restrict__ gain) {
  const int tid = ltid(wq); const int bid = lbid();
  const int lane = tid & 63, wv = tid >> 6;
  for (int row = bid * 4 + wv; row < nrows; row += gridDim.x * 4) {
    const float* r = src + (size_t)row * 1024 + 16 * lane;
    u32x4 a[4];
    {
      const float* gp = gain + (size_t)(row >> 14) * 1024 + 16 * lane;
#pragma unroll
      for (int i = 0; i < 4; ++i) {
        const u32x4 t = gload16(r + 4 * i);
        const f32x4v g4 = *(const f32x4v*)(gp + 4 * i);
        const unsigned t0 = t[0], t1 = t[1], t2 = t[2], t3 = t[3];
        a[i][0] = __float_as_uint(__uint_as_float(t0) * g4[0]); a[i][1] = __float_as_uint(__uint_as_float(t1) * g4[1]);
        a[i][2] = __float_as_uint(__uint_as_float(t2) * g4[2]); a[i][3] = __float_as_uint(__uint_as_float(t3) * g4[3]);
      }
    }
    float am = 0.f;
#pragma unroll
    for (int i = 0; i < 4; ++i) {
      const unsigned x0 = a[i][0], x1 = a[i][1], x2 = a[i][2], x3 = a[i][3];
      am = fmaxf(am, fmaxf(fmaxf(fabsf(__uint_as_float(x0)), fabsf(__uint_as_float(x1))), fmaxf(fabsf(__uint_as_float(x2)), fabsf(__uint_as_float(x3)))));
    }
    am = wave_max(am);
    const float inv = am > 0.f ? 127.f / am : 0.f;
    u32x4 o;
#pragma unroll
    for (int i = 0; i < 4; ++i) {
      const unsigned x0 = a[i][0], x1 = a[i][1], x2 = a[i][2], x3 = a[i][3];
      const int q0 = (int)rintf(__uint_as_float(x0) * inv), q1 = (int)rintf(__uint_as_float(x1) * inv);
      const int q2 = (int)rintf(__uint_as_float(x2) * inv), q3 = (int)rintf(__uint_as_float(x3) * inv);
      o[i] = (unsigned)(q0 & 255) | ((unsigned)(q1 & 255) << 8) | ((unsigned)(q2 & 255) << 16) | ((unsigned)(q3 & 255) << 24);
    }
    const size_t lyr = (size_t)row >> 14, e = (size_t)row & 16383;
    *(GAS u32x4*)(dst + (((lyr * 8 + (lane >> 3)) * 16384 + e) * 128 + (lane & 7) * 16)) = o;
    if (lane == 0) su[row] = am * (1.f / 127.f);
  }
}
DI void phase_cvt_v8(const int wq, const float* __restrict__ src, i8_t* __restrict__ dst, size_t n16) {
  const int tid = ltid(wq); const int bid = lbid();
  for (size_t i = (size_t)bid * NT + tid; i < n16; i += (size_t)gridDim.x * NT) {
    u32x4 o;
#pragma unroll
    for (int k = 0; k < 4; ++k) {
      const u32x4 a = gload16(src + i * 16 + 4 * k);
      const unsigned x0 = a[0], x1 = a[1], x2 = a[2], x3 = a[3];
      int pk = 0;
      pk = __builtin_amdgcn_cvt_pk_fp8_f32(__uint_as_float(x0) * 16.f, __uint_as_float(x1) * 16.f, pk, false);
      pk = __builtin_amdgcn_cvt_pk_fp8_f32(__uint_as_float(x2) * 16.f, __uint_as_float(x3) * 16.f, pk, true);
      o[k] = (unsigned)pk;
    }
    const size_t row = i >> 6; const int j = (int)(i & 63);
    const size_t lyr = row >> 14, e = row & 16383;
    *(GAS u32x4*)(dst + (((lyr * 8 + (j >> 3)) * 16384 + e) * 128 + (j & 7) * 16)) = o;
  }
}

DI void phase_peer_combine8(const int wq, PRef p, int l, char* smem, const float* __restrict__ rss_in) {
  const int tid = ltid(wq); const int bid = lbid();
  const int lane = tid & 63, wv = tid >> 6;
  int* wtops = (int*)(smem + wv * 1024);
  int ci, cj;
  if (lane < 16) { ci = 0; cj = lane; } else if (lane < 24) { ci = 1; cj = lane - 16; } else if (lane < 29) { ci = 2; cj = lane - 24; }
  else if (lane < 33) { ci = 3; cj = lane - 29; } else if (lane < 36) { ci = 4; cj = lane - 33; } else if (lane < 38) { ci = 5; cj = lane - 36; }
  else if (lane < 40) { ci = 6; cj = lane - 38; } else if (lane < 42) { ci = 7; cj = lane - 40; } else { ci = lane - 42 + 8; cj = 0; }
  const bool cvalid = lane < 50;
  if (!cvalid) { ci = 0; cj = 0; }
  const float* sul = p.su + (size_t)l * 16384;
  for (int token = bid * 4 + wv; token < T; token += gridDim.x * 4) {
    {
      const u32x4 tv = gload16(p.tops + (size_t)token * 256 + lane * 4);
      *(u32x4*)(wtops + lane * 4) = tv;
    }
    {
      const u32x4 a = gload16(p.hn + (size_t)token * D + 16 * lane), b2 = gload16(p.hn + (size_t)token * D + 16 * lane + 8);
      float xv[16];
      { const unsigned a0 = a[0], a1 = a[1], a2 = a[2], a3 = a[3], c0 = b2[0], c1 = b2[1], c2 = b2[2], c3 = b2[3];
        xv[0] = bflo(a0); xv[1] = bfhi(a0); xv[2] = bflo(a1); xv[3] = bfhi(a1); xv[4] = bflo(a2); xv[5] = bfhi(a2); xv[6] = bflo(a3); xv[7] = bfhi(a3);
        xv[8] = bflo(c0); xv[9] = bfhi(c0); xv[10] = bflo(c1); xv[11] = bfhi(c1); xv[12] = bflo(c2); xv[13] = bfhi(c2); xv[14] = bflo(c3); xv[15] = bfhi(c3); }
      float am = 0.f;
#pragma unroll
      for (int i = 0; i < 16; ++i) am = fmaxf(am, fabsf(xv[i]));
      am = wave_max(am);
      const float inv = am > 0.f ? 127.f / am : 0.f;
      u32x4 o;
#pragma unroll
      for (int i = 0; i < 4; ++i) {
        const int q0 = (int)rintf(xv[4 * i] * inv), q1 = (int)rintf(xv[4 * i + 1] * inv), q2 = (int)rintf(xv[4 * i + 2] * inv), q3 = (int)rintf(xv[4 * i + 3] * inv);
        o[i] = (unsigned)(q0 & 255) | ((unsigned)(q1 & 255) << 8) | ((unsigned)(q2 & 255) << 16) | ((unsigned)(q3 & 255) << 24);
      }
      *(GAS u32x4*)(p.x8 + (size_t)token * 1024 + 16 * lane) = o;
      if (lane == 0) p.sxq[token] = am * (1.f / 127.f) * rstd_of(rss_in, token);
    }
    asm volatile("s_waitcnt lgkmcnt(0)" ::: "memory");
#pragma unroll 1
    for (int hd = 0; hd < 8; ++hd) {
      const int k1 = wtops[(2 * hd) * 16 + ci], k2 = wtops[(2 * hd + 1) * 16 + cj];
      const float s1 = __int_as_float(fkey_s(k1 & ~127)), s2 = __int_as_float(fkey_s(k2 & ~127));
      const float val = s1 + s2;
      const int vk = cvalid ? ((fkey_s(__float_as_int(val)) & ~63) | (63 - lane)) : (int)0x80000000;
      int rank = 0;
#pragma unroll
      for (int c = 0; c < 50; ++c) rank += (__builtin_amdgcn_readlane(vk, c) > vk) ? 1 : 0;
      const float m = __int_as_float(__builtin_amdgcn_readlane(__float_as_int(val), 0));
      const bool sel = cvalid && rank < 16;
      const float ev = sel ? __expf(val - m) : 0.f;
      const float sum = wave_sum(ev);
      if (sel) {
        const int eid = (k1 & 127) * 128 + (k2 & 127);
        p.sel_id[(size_t)token * 128 + hd * 16 + rank] = eid;
        p.sel_g[(size_t)token * 128 + hd * 16 + rank] = ev / sum;
        p.sel_su[(size_t)token * 128 + hd * 16 + rank] = sul[eid];
      }
    }
    asm volatile("s_waitcnt lgkmcnt(0)" ::: "memory");
  }
}

DI void phase_peer_udot8(const int wq, PRef p, int l, char* smem, int coff) {
  const int tid = ltid(wq);
  const int lane = tid & 63, wv = tid >> 6;
  const int grp = lane >> 3, li = lane & 7;
  int* wid = (int*)(smem + wv * 4096);
  const bool b2 = li & 4, b1 = li & 2, b0 = li & 1;
  const int myx = (int)(xb_xcc_id() & 7u);
  for (int cs = 0; cs < 8; ++cs) {
    const int c = (myx + cs) & 7;
    const i8_t* U8 = p.u8 + ((size_t)l * 8 + c) * 16384 * 128 + li * 16;
    int* pb = (int*)p.pbuf + (size_t)c * T * 128;
    for (;;) {
      unsigned tb = 0;
      if (lane == 0) tb = atomicAdd(p.qctr + coff + c * 16, 8u);
      tb = __builtin_amdgcn_readfirstlane(tb);
      if (tb >= (unsigned)T) break;
      u32x4 xs[8];
      {
        int idl[16];
#pragma unroll
        for (int k = 0; k < 8; ++k) {
          idl[2 * k] = __builtin_nontemporal_load((const GAS int*)p.sel_id + (size_t)(tb + k) * 128 + lane);
          idl[2 * k + 1] = __builtin_nontemporal_load((const GAS int*)p.sel_id + (size_t)(tb + k) * 128 + 64 + lane);
          xs[k] = __builtin_nontemporal_load((gp_u32x4)(p.x8 + (size_t)(tb + k) * 1024 + c * 128 + li * 16));
        }
#pragma unroll
        for (int k = 0; k < 8; ++k) { wid[k * 128 + lane] = idl[2 * k]; wid[k * 128 + 64 + lane] = idl[2 * k + 1]; }
      }
      asm volatile("s_waitcnt lgkmcnt(0)" ::: "memory");
      auto issue = [&](int k, u32x4 (&g)[16]) {
        int ids[16];
#pragma unroll
        for (int i = 0; i < 4; ++i) {
          const u32x4 t4 = *(const u32x4*)(wid + k * 128 + grp * 16 + i * 4);
          ids[4 * i] = t4[0]; ids[4 * i + 1] = t4[1]; ids[4 * i + 2] = t4[2]; ids[4 * i + 3] = t4[3];
        }
#pragma unroll
        for (int i = 0; i < 16; ++i) g[i] = gload16(U8 + (size_t)ids[i] * 128);
      };
      auto consume = [&](int k, const u32x4 (&g)[16], const u32x4 cx) {
        const int x0 = (int)cx[0], x1 = (int)cx[1], x2 = (int)cx[2], x3 = (int)cx[3];
        int pp[16];
#pragma unroll
        for (int i = 0; i < 16; ++i) {
          const u32x4 u8 = g[i];
          const int u0 = (int)u8[0], u1 = (int)u8[1], u2 = (int)u8[2], u3 = (int)u8[3];
          int acc = __builtin_amdgcn_sdot4(x0, u0, 0, false);
          acc = __builtin_amdgcn_sdot4(x1, u1, acc, false);
          acc = __builtin_amdgcn_sdot4(x2, u2, acc, false);
          pp[i] = __builtin_amdgcn_sdot4(x3, u3, acc, false);
        }
        int q8[8], q4[4], q2[2];
#pragma unroll
        for (int i = 0; i < 8; ++i) { const int mine = b2 ? pp[i + 8] : pp[i], oth = b2 ? pp[i] : pp[i + 8]; q8[i] = mine + shxi(oth, 4, lane); }
#pragma unroll
        for (int i = 0; i < 4; ++i) { const int mine = b1 ? q8[i + 4] : q8[i], oth = b1 ? q8[i] : q8[i + 4]; q4[i] = mine + shxi(oth, 2, lane); }
#pragma unroll
        for (int i = 0; i < 2; ++i) { const int mine = b0 ? q4[i + 2] : q4[i], oth = b0 ? q4[i] : q4[i + 2]; q2[i] = mine + shxi(oth, 1, lane); }
        i32x2 ov; ov[0] = q2[0]; ov[1] = q2[1];
        __builtin_nontemporal_store(ov, (GAS i32x2*)(pb + (size_t)(tb + k) * 128 + 2 * lane));
      };
      u32x4 ga[16], gb[16];
      issue(0, ga);
#pragma unroll
      for (int k2 = 0; k2 < 4; ++k2) {
        issue(2 * k2 + 1, gb);
        consume(2 * k2, ga, xs[2 * k2]);
        if (k2 < 3) issue(2 * k2 + 2, ga);
        consume(2 * k2 + 1, gb, xs[2 * k2 + 1]);
      }
      asm volatile("s_waitcnt lgkmcnt(0)" ::: "memory");
    }
  }
}

DI void phase_peer_vacc8(const int wq, PRef p, int l, char* smem, int coff, int dry, int rss_idx) {
  const int myx = (int)(xb_xcc_id() & 7u);
  for (int cs = 0; cs < 8; ++cs) {
    const int c = (myx + cs) & 7;
    for (;;) {
      const int tid = ltid(wq);
      const int lane = tid & 63, wv = tid >> 6;
      int* wid = (int*)(smem + wv * 8192);
      float* ww = (float*)(smem + wv * 8192 + 4096);
      const int grp = lane >> 3, li = lane & 7;
      const bool g2 = grp & 4, g1 = grp & 2, g0 = grp & 1;
      const i8_t* V8 = p.v8 + ((size_t)l * 8 + c) * 16384 * 128 + li * 16;
      const int chan = c * 128 + li * 16 + 2 * grp;
      unsigned tb = 0;
      if (lane == 0) tb = atomicAdd(p.qctr + coff + c * 16, 8u);
      tb = __builtin_amdgcn_readfirstlane(tb);
      if (tb >= (unsigned)T) break;
#pragma unroll
      for (int kb = 0; kb < 8; kb += 2) {
        int i0[2], i1[2]; u32x2 gg[2], su2[2]; float sxv[2]; i32x2 pp8[2][8];
#pragma unroll
        for (int u = 0; u < 2; ++u) {
          const size_t token = (size_t)tb + kb + u;
          i0[u] = __builtin_nontemporal_load((const GAS int*)p.sel_id + token * 128 + lane);
          i1[u] = __builtin_nontemporal_load((const GAS int*)p.sel_id + token * 128 + 64 + lane);
          gg[u] = __builtin_nontemporal_load((const GAS u32x2*)(p.sel_g + token * 128 + 2 * lane));
          su2[u] = __builtin_nontemporal_load((const GAS u32x2*)(p.sel_su + token * 128 + 2 * lane));
          sxv[u] = p.sxq[token];
#pragma unroll
          for (int cc = 0; cc < 8; ++cc) pp8[u][cc] = __builtin_nontemporal_load((const GAS i32x2*)((const int*)p.pbuf + ((size_t)cc * T + token) * 128 + 2 * lane));
        }
#pragma unroll
        for (int u = 0; u < 2; ++u) {
          const int k = kb + u;
          wid[k * 128 + lane] = i0[u]; wid[k * 128 + 64 + lane] = i1[u];
          int d0 = 0, d1 = 0;
#pragma unroll
          for (int cc = 0; cc < 8; ++cc) { d0 += pp8[u][cc][0]; d1 += pp8[u][cc][1]; }
          const float f0 = (float)d0 * (sxv[u] * __uint_as_float(su2[u][0])), f1 = (float)d1 * (sxv[u] * __uint_as_float(su2[u][1]));
          f32x2v w2; w2[0] = __uint_as_float(gg[u][0]) * gelu_tanh(f0) * 0.0625f; w2[1] = __uint_as_float(gg[u][1]) * gelu_tanh(f1) * 0.0625f;
          *(f32x2v*)(ww + k * 128 + 2 * lane) = w2;
        }
      }
      asm volatile("s_waitcnt lgkmcnt(0)" ::: "memory");
      auto issue = [&](int hh_, u32x4 (&g)[8]) {
        const int k = hh_ >> 1, hf = hh_ & 1;
        int ids[8];
#pragma unroll
        for (int i = 0; i < 2; ++i) {
          const u32x4 t4 = *(const u32x4*)(wid + k * 128 + grp * 16 + hf * 8 + i * 4);
          ids[4 * i] = t4[0]; ids[4 * i + 1] = t4[1]; ids[4 * i + 2] = t4[2]; ids[4 * i + 3] = t4[3];
        }
#pragma unroll
        for (int i = 0; i < 8; ++i) g[i] = gload16(V8 + (size_t)ids[i] * 128);
      };
      float o[16];
      u32x2 hcur;
      auto accum = [&](int hh_, const u32x4 (&g)[8]) {
        const int k = hh_ >> 1, hf = hh_ & 1;
        if (hf == 0) {
#pragma unroll
          for (int i = 0; i < 16; ++i) o[i] = 0.f;
          hcur = __builtin_nontemporal_load((GAS u32x2*)((GAS float*)p.h + ((size_t)tb + k) * D + chan));
        }
#pragma unroll
        for (int i = 0; i < 8; ++i) {
          const u32x4 v8 = g[i];
          const float w = ww[k * 128 + grp * 16 + hf * 8 + i];
          const int v0 = (int)v8[0], v1 = (int)v8[1], v2 = (int)v8[2], v3 = (int)v8[3];
          f32x2v t2;
          t2 = __builtin_amdgcn_cvt_pk_f32_fp8(v0, false); o[0] = fmaf(w, t2[0], o[0]); o[1] = fmaf(w, t2[1], o[1]);
          t2 = __builtin_amdgcn_cvt_pk_f32_fp8(v0, true);  o[2] = fmaf(w, t2[0], o[2]); o[3] = fmaf(w, t2[1], o[3]);
          t2 = __builtin_amdgcn_cvt_pk_f32_fp8(v1, false); o[4] = fmaf(w, t2[0], o[4]); o[5] = fmaf(w, t2[1], o[5]);
          t2 = __builtin_amdgcn_cvt_pk_f32_fp8(v1, true);  o[6] = fmaf(w, t2[0], o[6]); o[7] = fmaf(w, t2[1], o[7]);
          t2 = __builtin_amdgcn_cvt_pk_f32_fp8(v2, false); o[8] = fmaf(w, t2[0], o[8]); o[9] = fmaf(w, t2[1], o[9]);
          t2 = __builtin_amdgcn_cvt_pk_f32_fp8(v2, true);  o[10] = fmaf(w, t2[0], o[10]); o[11] = fmaf(w, t2[1], o[11]);
          t2 = __builtin_amdgcn_cvt_pk_f32_fp8(v3, false); o[12] = fmaf(w, t2[0], o[12]); o[13] = fmaf(w, t2[1], o[13]);
          t2 = __builtin_amdgcn_cvt_pk_f32_fp8(v3, true);  o[14] = fmaf(w, t2[0], o[14]); o[15] = fmaf(w, t2[1], o[15]);
        }
        if (hf == 1) {
          float r8[8], r4[4], r2[2];
#pragma unroll
          for (int i = 0; i < 8; ++i) { const float mine = g2 ? o[i + 8] : o[i], oth = g2 ? o[i] : o[i + 8]; r8[i] = mine + shx(oth, 32, lane); }
#pragma unroll
          for (int i = 0; i < 4; ++i) { const float mine = g1 ? r8[i + 4] : r8[i], oth = g1 ? r8[i] : r8[i + 4]; r4[i] = mine + shx(oth, 16, lane); }
#pragma unroll
          for (int i = 0; i < 2; ++i) { const float mine = g0 ? r4[i + 2] : r4[i], oth = g0 ? r4[i] : r4[i + 2]; r2[i] = mine + shx(oth, 8, lane); }
          if (!dry) {
            const size_t token = (size_t)tb + k;
            GAS float* hp = (GAS float*)p.h + token * D + chan;
            const u32x2 ch = hcur;
            const float h0 = __uint_as_float(ch[0]) + r2[0], h1 = __uint_as_float(ch[1]) + r2[1];
            u32x2 sv; sv[0] = __float_as_uint(h0); sv[1] = __float_as_uint(h1);
            __builtin_nontemporal_store(sv, (GAS u32x2*)hp);
            *(GAS unsigned*)(p.hn + token * D + chan) = pack2(h0, h1);
            if (rss_idx >= 0) {
              const float ss = wave_sum(h0 * h0 + h1 * h1);
              if (lane < 2) p.rss[((size_t)rss_idx * T + token) * 16 + 2 * c + lane] = lane == 0 ? ss : 0.f;
            }
          }
        }
      };
      u32x4 gA[8], gB[8], gC[8];
      issue(0, gA); issue(1, gB);
#pragma unroll
      for (int h3 = 0; h3 < 15; h3 += 3) {
        asm volatile("" ::: "memory");
        issue(h3 + 2, gC); accum(h3, gA);
        asm volatile("" ::: "memory");
        issue(h3 + 3, gA); accum(h3 + 1, gB);
        asm volatile("" ::: "memory");
        if (h3 + 4 < 16) issue(h3 + 4, gB);
        accum(h3 + 2, gC);
      }
      accum(15, gA);
      asm volatile("s_waitcnt lgkmcnt(0)" ::: "memory");
    }
  }
}

DI void phase_final_norm(const int wq, const float* __restrict__ in, const float* __restrict__ g, float* __restrict__ out, int rows) {
  const int tid = ltid(wq); const int bid = lbid();
  const int lane = tid & 63, wv = tid >> 6;
  f32x4v gv[4];
#pragma unroll
  for (int i = 0; i < 4; ++i) gv[i] = *(const f32x4v*)(g + i * 256 + lane * 4);
  for (int r = bid * 4 + wv; r < rows; r += gridDim.x * 4) {
    const float* pr = in + (size_t)r * D;
    u32x4 v[4];
#pragma unroll
    for (int i = 0; i < 4; ++i) v[i] = gload16(pr + i * 256 + lane * 4);
    float ss = 0.f;
#pragma unroll
    for (int i = 0; i < 4; ++i) {
      const float a = __uint_as_float(v[i][0]), b = __uint_as_float(v[i][1]), c = __uint_as_float(v[i][2]), d = __uint_as_float(v[i][3]);
      ss += a * a + b * b + c * c + d * d;
    }
    ss = wave_sum(ss);
    const float rs = rsqrtf(ss / (float)D + 1e-6f);
#pragma unroll
    for (int i = 0; i < 4; ++i) {
      u32x4 ov;
#pragma unroll
      for (int e = 0; e < 4; ++e) ov[e] = __float_as_uint(__uint_as_float(v[i][e]) * rs * gv[i][e]);
      *(GAS u32x4*)(out + (size_t)r * D + i * 256 + lane * 4) = ov;
    }
  }
}

#define PROBE 0
constexpr int SMEM_BYTES = 73728;
__global__ void __launch_bounds__(NT, 2) mega(Params pk) {
  __shared__ __attribute__((aligned(16))) char smem_c[SMEM_BYTES];
  __shared__ uint4 xb_words;
  __shared__ Params sp;
  {
    const unsigned long long* src = (const unsigned long long*)&pk;
    unsigned long long* dst = (unsigned long long*)&sp;
    if (threadIdx.x < sizeof(Params) / 8) dst[threadIdx.x] = src[threadIdx.x];
  }
  if (threadIdx.x == 0) xb_words = make_uint4(0u, 0u, 0u, 0u);
  __syncthreads();
#define p (*lp((const __attribute__((address_space(3))) Params*)&sp))
  float* smem = (float*)smem_c;
  const int wq = __builtin_amdgcn_readfirstlane((int)(threadIdx.x >> 6));
  (void)xcd_barrier_post(p.bar, (volatile LAS unsigned*)&xb_words);
#define GRID_BARRIER() do { XcdBarrier bb_; bb_.bar = p.bar; bb_.x = xb_xcc_id(); bb_.st = (volatile LAS unsigned*)&xb_words; xcd_barrier(bb_); } while (0)

  phase_convert(wq, p.even_w_in, D, EVEN_IN, EVEN_IN, p.w_even_in, EVEN_IN, nullptr, 2, (size_t)D * EVEN_IN, (size_t)EVEN_IN * D, 0, smem, p.mix_norm, 2 * D);
  phase_convert(wq, p.even_pool_w, 128, 128, 128, p.w_even_pool, 128, p.even_pool_scale, 8, 128 * 128, 128 * 128, 128, smem);
  phase_convert(wq, p.even_w_out, D, D, D, p.w_even_out, D, nullptr, 2, (size_t)D * D, (size_t)D * D, 0, smem);
  phase_convert(wq, p.odd_w_in, D, ODD_IN, ODD_IN, p.w_odd_in, 3840, nullptr, 2, (size_t)D * ODD_IN, (size_t)3840 * D, 0, smem, p.mix_norm + D, 2 * D);
  phase_convert(wq, p.odd_w_uv, 128, 64, 64, p.w_odd_uv, 128, nullptr, 16, 128 * 64, 128 * 128, 0, smem);
  phase_convert(wq, p.odd_w_out, D, D, D, p.w_odd_out, D, nullptr, 2, (size_t)D * D, (size_t)D * D, 0, smem);
  phase_convert(wq, p.xattn_wq, D, D, D, p.w_xq, D, nullptr, 4, (size_t)D * D, (size_t)D * D, 0, smem, p.xattn_norm, D);
  phase_convert(wq, p.xattn_wkv, D, 2048, 2048, p.w_xkv, 2048, nullptr, 4, (size_t)D * 2048, (size_t)2048 * D, 0, smem);
  phase_convert(wq, p.xattn_wo, D, D, D, p.w_xo, D, nullptr, 4, (size_t)D * D, (size_t)D * D, 0, smem);
  phase_convert(wq, p.peer_wq, D, 2048, 2048, p.w_pq, 2048, nullptr, 4, (size_t)D * 2048, (size_t)2048 * D, 0, smem, p.peer_norm, D);
  phase_quant_u(wq, p.peer_u, p.u8, p.su, DEPTH * 16384, p.peer_norm);
  phase_cvt_v8(wq, p.peer_v, p.v8, (size_t)DEPTH * 16384 * 1024 / 16);
  phase_cvt_rows(wq, p.peer_keys, p.keys16, (size_t)DEPTH * 16 * 128 * 128 / 8);
  phase_init_h(wq, p.x, p.h, p.hn, p.rss);
  phase_lb(wq, p);
  phase_rmsnorm_bf(wq, p.mem, D, p.mem_norm, p.memn, D, NB * NMEM, D);
  GRID_BARRIER();
  for (int l = 0; l < DEPTH; ++l)
    phase_gemm_bf16<3>(wq, p.memn, D, p.w_xkv + (size_t)l * 2048 * D, p.kvh + (size_t)l * 2 * 2048 * 1024, 2048, NB * NMEM, 2048, D, smem_c, 0);
  GRID_BARRIER();
  for (int l = 0; l < DEPTH; ++l) {
    const int j = l >> 1;
    if ((l & 1) == 0) {
      phase_gemm_bf16<2, 1>(wq, p.hn, D, p.w_even_in + (size_t)j * EVEN_IN * D, p.P16, EVEN_IN, T, EVEN_IN, D, smem_c, 0, 1, 0, 0, 0, 1, 0, 0, p.rss + (size_t)(3 * l) * T * 16);
      GRID_BARRIER();
      phase_evenmix(wq, p, j);
      GRID_BARRIER();
      phase_gemm_bf16<2>(wq, p.pool, 512, p.w_even_pool + (size_t)j * 4 * 128 * 128, p.Y + 512, D, T, 128, 128, smem_c, 0, 4, 128, 128 * 128, 128);
      GRID_BARRIER();
      phase_gemm_bf16<1>(wq, p.Y, D, p.w_even_out + (size_t)j * D * D, p.h, D, T, D, D, smem_c, 0, 1, 0, 0, 0, 1, 0, 0, nullptr, p.hn, p.rss + (size_t)(3 * l + 1) * T * 16);
      GRID_BARRIER();
    } else {
      phase_gemm_bf16<2, 1>(wq, p.hn, D, p.w_odd_in + (size_t)j * 3840 * D, p.P16, ODD_IN, T, ODD_IN, D, smem_c, 0, 1, 0, 0, 0, 1, 0, 0, p.rss + (size_t)(3 * l) * T * 16);
      GRID_BARRIER();
      phase_dsa_prep(wq, p, j);
      GRID_BARRIER();
      phase_dsa_scores(wq, p, smem_c);
      GRID_BARRIER();
      phase_hgrn_scan(wq, p, l, smem_c);
      phase_dsa_attend(wq, p, j, smem_c, 64 * j);
      GRID_BARRIER();
      phase_gemm_bf16<2>(wq, p.lat, D, p.w_odd_uv + (size_t)j * 8 * 128 * 128, p.Y, D, T, 64, 128, smem_c, 0, 8, 128, 128 * 128, 64);
      phase_hgrn_post(wq, p, j);
      GRID_BARRIER();
      phase_gemm_bf16<1>(wq, p.Y, D, p.w_odd_out + (size_t)j * D * D, p.h, D, T, D, D, smem_c, 0, 1, 0, 0, 0, 1, 0, 0, nullptr, p.hn, p.rss + (size_t)(3 * l + 1) * T * 16);
      GRID_BARRIER();
    }
    phase_gemm_bf16<2, 1>(wq, p.hn, D, p.w_xq + (size_t)l * D * D, p.q16, D, T, D, D, smem_c, 0, 1, 0, 0, 0, 1, 0, 0, p.rss + (size_t)(3 * l + 1) * T * 16);
    GRID_BARRIER();
    phase_gemm_bf16<4>(wq, p.q16, D, p.kvh + (size_t)l * 2 * 2048 * 1024, p.sx, 256, S, 256, 256, smem_c, 0, 32, (size_t)S * D, 256 * 256, (size_t)S * 1024, 4, 256, (size_t)S * 256);
    GRID_BARRIER();
    phase_softmax256(wq, (const bf16_t*)p.sx, p.p16, T * 4);
    GRID_BARRIER();
    phase_gemm_bf16<2>(wq, p.p16, 256, p.kvh + (size_t)l * 2 * 2048 * 1024 + (size_t)2048 * 1024, p.Y, D, S, 256, 256, smem_c, 0, 32, (size_t)S * 1024, 256 * 256, (size_t)S * D, 4, (size_t)S * 256, 256);
    GRID_BARRIER();
    phase_gemm_bf16<1>(wq, p.Y, D, p.w_xo + (size_t)l * D * D, p.h, D, T, D, D, smem_c, 0, 1, 0, 0, 0, 1, 0, 0, nullptr, p.hn, p.rss + (size_t)(3 * l + 2) * T * 16);
    GRID_BARRIER();
    phase_peer_qs(wq, p.hn, p.w_pq + (size_t)l * 2048 * D, p.keys16 + (size_t)l * 16 * 128 * 128, p.tops, smem_c, p.rss + (size_t)(3 * l + 2) * T * 16);
    GRID_BARRIER();
    phase_peer_combine8(wq, p, l, smem_c, p.rss + (size_t)(3 * l + 2) * T * 16);
    GRID_BARRIER();
    phase_peer_udot8(wq, p, l, smem_c, 256 + (l * 2 + 0) * 128);
    GRID_BARRIER();
    phase_peer_vacc8(wq, p, l, smem_c, 256 + (l * 2 + 1) * 128, 0, l + 1 < DEPTH ? 3 * l + 3 : -1);
    GRID_BARRIER();
  }
  phase_final_norm(wq, p.h, p.final_norm, p.out, T);
}

#undef p
extern "C" void kernel_launch(void* const* d_in, const int* in_sizes, int n_in, void* d_out, int out_size, void* d_ws, size_t ws_size,
                              hipStream_t stream) {
  Params p; memset(&p, 0, sizeof(p));
  const float* const* in = (const float* const*)d_in;
  p.x = in[0]; p.mem = in[1]; p.mix_norm = in[2]; p.even_w_in = in[3]; p.even_conv_w = in[4]; p.even_pool_w = in[5];
  p.even_pool_scale = in[6]; p.even_w_out = in[7]; p.odd_w_in = in[8]; p.odd_kv_norm = in[9]; p.odd_w_uv = in[10];
  p.odd_hg_norm = in[11]; p.odd_w_out = in[12]; p.hgrn_gamma = in[13]; p.rel_bias = in[14]; p.mem_norm = in[15];
  p.xattn_norm = in[16]; p.xattn_wq = in[17]; p.xattn_wkv = in[18]; p.xattn_wo = in[19]; p.peer_norm = in[20];
  p.peer_wq = in[21]; p.peer_keys = in[22]; p.peer_u = in[23]; p.peer_v = in[24]; p.final_norm = in[25];
  p.out = (float*)d_out;
  char* w = (char*)d_ws;
  auto take = [&](size_t bytes) { char* r = w; w += (bytes + 255) / 256 * 256; return r; };
  p.bar = (unsigned*)take((XCD_BAR_WORDS + 2048) * 4); p.qctr = p.bar + XCD_BAR_WORDS;
  p.h = (float*)take((size_t)T * D * 4); p.P = (float*)take((size_t)T * ODD_IN * 4); p.P16 = (bf16_t*)p.P;
  p.oraw = (float*)take((size_t)T * 512 * 4); p.lb = (float*)take(DEPTH * 512 * 4);
  p.hn = (bf16_t*)take((size_t)T * D * 2); p.Y = (bf16_t*)take((size_t)T * D * 2); p.pool = (bf16_t*)take((size_t)T * 512 * 2);
  p.memn = (bf16_t*)take((size_t)NB * NMEM * D * 2); p.lat = (bf16_t*)take((size_t)T * D * 2);
  p.w_even_in = (bf16_t*)take((size_t)2 * EVEN_IN * D * 2); p.w_even_pool = (bf16_t*)take((size_t)8 * 128 * 128 * 2);
  p.w_even_out = (bf16_t*)take((size_t)2 * D * D * 2); p.w_odd_in = (bf16_t*)take((size_t)2 * 3840 * D * 2);
  p.w_odd_uv = (bf16_t*)take((size_t)16 * 128 * 128 * 2); p.w_odd_out = (bf16_t*)take((size_t)2 * D * D * 2);
  p.w_xq = (bf16_t*)take((size_t)4 * D * D * 2); p.w_xkv = (bf16_t*)take((size_t)4 * 2048 * D * 2); p.w_xo = (bf16_t*)take((size_t)4 * D * D * 2);
  p.w_pq = (bf16_t*)take((size_t)4 * 2048 * D * 2);
  p.u8 = (signed char*)take((size_t)DEPTH * 16384 * 1024); p.v8 = (signed char*)take((size_t)DEPTH * 16384 * 1024); p.x8 = (signed char*)take((size_t)T * 1024);
  p.su = (float*)take((size_t)DEPTH * 16384 * 4); p.sxq = (float*)take((size_t)T * 4); p.sel_su = (float*)take((size_t)T * 128 * 4);
  p.keys16 = (bf16_t*)take((size_t)DEPTH * 16 * 128 * 128 * 2); p.kvh = (bf16_t*)take((size_t)DEPTH * 2 * 2048 * 1024 * 2); p.rss = (float*)take((size_t)12 * T * 16 * 4);
  {
    char* a = (char*)p.P;
    p.sx = (float*)a; a += (size_t)T * 4 * 256 * 4;
    p.p16 = (bf16_t*)a; a += (size_t)T * 4 * 256 * 2;
    p.q16 = (bf16_t*)a; a += (size_t)T * D * 2;
    p.tops = (int*)a; a += (size_t)T * 256 * 4;
    p.sel_id = (int*)a; a += (size_t)T * 128 * 4;
    p.sel_g = (float*)a; a += (size_t)T * 128 * 4;
    p.pbuf = (float*)a;
  }
  p.qlat16 = (bf16_t*)take((size_t)T * 1024 * 2); p.ckv16 = (bf16_t*)take((size_t)T * 128 * 2); p.iq16 = (bf16_t*)take((size_t)T * 512 * 2);
  p.ik16 = (bf16_t*)take((size_t)T * 64 * 2); p.sc = (float*)take((size_t)T * 2048 * 4);

  p.probe = 1;
  static int grid = 0;
  if (!grid) {
    int dev = 0, cus = 0, per_cu = 0;
    (void)hipGetDevice(&dev);
    (void)hipDeviceGetAttribute(&cus, hipDeviceAttributeMultiprocessorCount, dev);
    (void)hipOccupancyMaxActiveBlocksPerMultiprocessor(&per_cu, mega, NT, 0);
    if (per_cu > 2) per_cu = 2;
    if (per_cu < 1) per_cu = 1;
    grid = cus * per_cu;
  }
  (void)hipMemsetAsync(p.bar, 0, (XCD_BAR_WORDS + 2048) * sizeof(unsigned), stream);
  mega<<<grid, NT, 0, stream>>>(p);
}
```

```cpp
#include <hip/hip_runtime.h>
#include <hip/hip_bf16.h>
#include <stdint.h>
#include <math.h>
#include <string.h>

#define DI __device__ __forceinline__

constexpr int D = 1024, NB = 8, S = 2048, T = NB * S, DEPTH = 4, NMEM = 256;
constexpr int EVEN_IN = 2048, ODD_IN = 3784;
constexpr int NT = 256;

typedef unsigned short bf16_t;
struct Params {
  const float *x, *mem, *mix_norm, *even_w_in, *even_conv_w, *even_pool_w, *even_pool_scale, *even_w_out;
  const float *odd_w_in, *odd_kv_norm, *odd_w_uv, *odd_hg_norm, *odd_w_out, *hgrn_gamma, *rel_bias, *mem_norm;
  const float *xattn_norm, *xattn_wq, *xattn_wkv, *xattn_wo, *peer_norm, *peer_wq, *peer_keys, *peer_u, *peer_v, *final_norm;
  float* out;
  float *h, *P, *kv, *ckv, *oraw, *lb; bf16_t* P16;
  bf16_t *hn, *Y, *pool, *memn, *lat;
  bf16_t *u16, *v16, *keys16; int* tops; signed char *u8, *v8, *x8; float *su, *sxq, *sel_su;
  float* rss;
  bf16_t *q16, *kvh, *p16; float* sx; int* sel_id; float* sel_g; float* pbuf;
  bf16_t *qlat16, *ckv16, *iq16, *ik16; float* sc; unsigned* qctr;
  bf16_t *w_even_in, *w_even_pool, *w_even_out, *w_odd_in, *w_odd_uv, *w_odd_out, *w_xq, *w_xkv, *w_xo, *w_pq;
  unsigned* bar;
  int probe, pad_;
};

#define XB_TMO      128
#define XB_XCNT(j)  (256  + 64 * (j))
#define XB_XSUB(j)  (1280 + 64 * (j))
#define XB_XGEN(j)  (2304 + 64 * (j))
#define XB_TOP      3328
#define XB_TOPGEN   3392
#define XCD_BAR_WORDS 3456
#define XB_SPIN_CAP (1u << 18)
#define LAS __attribute__((address_space(3)))

__device__ __forceinline__ unsigned xb_ld(unsigned* p)              { return __hip_atomic_load(p, __ATOMIC_RELAXED, __HIP_MEMORY_SCOPE_AGENT); }
__device__ __forceinline__ unsigned xb_add(unsigned* p, unsigned v) { return __hip_atomic_fetch_add(p, v, __ATOMIC_RELAXED, __HIP_MEMORY_SCOPE_AGENT); }
__device__ __forceinline__ unsigned xb_xcc_id() { return (unsigned)__builtin_amdgcn_s_getreg((3 << 11) | 20) & 0xFu; }
#define XB_SPIN(cond, bar) do { unsigned _sp = 0; while (cond) { __builtin_amdgcn_s_sleep(1); \
    if ((++_sp & 255u) == 0u) { if (xb_ld(&(bar)[XB_TMO])) break; if (_sp > XB_SPIN_CAP) { atomicAdd(&(bar)[XB_TMO], 1u); break; } } } } while (0)

typedef const __attribute__((address_space(3))) Params& PRef;
DI const __attribute__((address_space(3))) Params* lp(const __attribute__((address_space(3))) Params* q) { asm volatile("" : "+v"(q)); return q; }
struct XcdBarrier {
    unsigned* bar; unsigned x;
    volatile LAS unsigned* st;
};

__device__ __forceinline__ XcdBarrier xcd_barrier_post(unsigned* bar, volatile LAS unsigned* st) {
    XcdBarrier b; b.bar = bar; b.x = xb_xcc_id(); b.st = st;
    if (threadIdx.x == 0) (void)xb_add(&bar[XB_XCNT(b.x)], 1u);
    return b;
}
__device__ __forceinline__ void xcd_barrier_complete(unsigned* bar, unsigned x, unsigned& nloc, unsigned& nx) {
    const unsigned G = gridDim.x * gridDim.y * gridDim.z;
    unsigned sum, cnt, mine, sp = 0u;
    for (;;) {
        sum = 0u; cnt = 0u; mine = 0u;
#pragma unroll
        for (unsigned j = 0; j < 16; ++j) { const unsigned c = xb_ld(&bar[XB_XCNT(j)]); sum += c; cnt += (c > 0u) ? 1u : 0u; mine = (j == x) ? c : mine; }
        if (sum == G) break;
        __builtin_amdgcn_s_sleep(1);
        if ((++sp & 255u) == 0u) { if (xb_ld(&bar[XB_TMO])) break; if (sp > XB_SPIN_CAP) { atomicAdd(&bar[XB_TMO], 1u); break; } }
    }
    nloc = mine > 0u ? mine : 1u; nx = cnt > 0u ? cnt : 1u;
}

__device__ __forceinline__ void xcd_barrier(const XcdBarrier& b) {
    asm volatile("s_waitcnt vmcnt(0)" ::: "memory");
    __syncthreads();
    if (threadIdx.x == 0) {
        unsigned* bar = b.bar;
        __builtin_amdgcn_s_waitcnt(0);
        unsigned nloc = b.st[0], nx = b.st[1];
        if (nloc == 0u) { xcd_barrier_complete(bar, b.x, nloc, nx); b.st[0] = nloc; b.st[1] = nx; }
        const unsigned old = xb_add(&bar[XB_XSUB(b.x)], 1u);
        const unsigned gen = old / nloc;
        if (old + 1u == (gen + 1u) * nloc) {
            __builtin_amdgcn_fence(__ATOMIC_RELEASE, "agent");
            asm volatile("s_waitcnt vmcnt(0)" ::: "memory");
            const unsigned og = xb_add(&bar[XB_TOP], 1u);
            const unsigned tg = og / nx;
            if (og + 1u == (tg + 1u) * nx) xb_add(&bar[XB_TOPGEN], 1u);
            else XB_SPIN(xb_ld(&bar[XB_TOPGEN]) == tg, bar);
            __builtin_amdgcn_fence(__ATOMIC_ACQUIRE, "agent");
            xb_add(&bar[XB_XGEN(b.x)], 1u);
            asm volatile("s_waitcnt vmcnt(0)" ::: "memory");
        } else {
            XB_SPIN(xb_ld(&bar[XB_XGEN(b.x)]) == gen, bar);
            __builtin_amdgcn_fence(__ATOMIC_ACQUIRE, "agent");
            asm volatile("s_waitcnt vmcnt(0)" ::: "memory");
        }
    }
    __syncthreads();
}


typedef __bf16 bf16x2_t __attribute__((ext_vector_type(2)));
typedef float f32x2_t __attribute__((ext_vector_type(2)));
using bf16x8 = __attribute__((ext_vector_type(8))) short;
using f32x16 = __attribute__((ext_vector_type(16))) float;
using u32x4 = __attribute__((ext_vector_type(4))) unsigned;
using u32x2 = __attribute__((ext_vector_type(2))) unsigned;
using f32x4v = __attribute__((ext_vector_type(4))) float;
using f32x2v = __attribute__((ext_vector_type(2))) float;
#define GAS __attribute__((address_space(1)))
typedef const GAS u32x4* gp_u32x4;
DI u32x4 gload16(const void* p) { return *(gp_u32x4)(p); }
DI bf16_t f2bf(float f) { __bf16 b = (__bf16)f; return __builtin_bit_cast(unsigned short, b); }
DI unsigned pack2(float a, float b) { f32x2_t v = {a, b}; bf16x2_t r = __builtin_convertvector(v, bf16x2_t); return __builtin_bit_cast(unsigned, r); }
DI float bf2f(bf16_t u) { return __uint_as_float(((unsigned)u) << 16); }
DI float bflo(unsigned u) { return __uint_as_float(u << 16); }
DI float bfhi(unsigned u) { return __uint_as_float(u & 0xffff0000u); }
DI f32x4v bf4_to_f(const u32x2 v) { const unsigned a = v[0], b = v[1]; f32x4v r; r[0] = bflo(a); r[1] = bfhi(a); r[2] = bflo(b); r[3] = bfhi(b); return r; }
DI int ltid(int wq) { int t; asm volatile("v_mbcnt_lo_u32_b32 %0, -1, 0\n\tv_mbcnt_hi_u32_b32 %0, -1, %0" : "=v"(t)); return (wq << 6) | t; }
DI int lbid() { int b = blockIdx.x; asm volatile("" : "+s"(b)); return b; }
#define DPP_F(v, ctrl, rmask, bctl) __int_as_float(__builtin_amdgcn_update_dpp(0, __float_as_int(v), (ctrl), (rmask), 0xF, (bctl)))
DI float wave_sum(float v) {
  v += DPP_F(v, 0xB1, 0xF, true);
  v += DPP_F(v, 0x4E, 0xF, true);
  v += DPP_F(v, 0x141, 0xF, true);
  v += DPP_F(v, 0x140, 0xF, true);
  v += DPP_F(v, 0x142, 0xA, false);
  v += DPP_F(v, 0x143, 0xC, false);
  return __int_as_float(__builtin_amdgcn_readlane(__float_as_int(v), 63));
}
#define DPP_I(v, ctrl, rmask, bctl) __builtin_amdgcn_update_dpp(0, (v), (ctrl), (rmask), 0xF, (bctl))
DI int wave_sum_i(int v) {
  v += DPP_I(v, 0xB1, 0xF, true); v += DPP_I(v, 0x4E, 0xF, true); v += DPP_I(v, 0x141, 0xF, true); v += DPP_I(v, 0x140, 0xF, true);
  v += DPP_I(v, 0x142, 0xA, false); v += DPP_I(v, 0x143, 0xC, false);
  return __builtin_amdgcn_readlane(v, 63);
}
DI float wave_max(float v) {
  v = fmaxf(v, DPP_F(v, 0xB1, 0xF, true));
  v = fmaxf(v, DPP_F(v, 0x4E, 0xF, true));
  v = fmaxf(v, DPP_F(v, 0x141, 0xF, true));
  v = fmaxf(v, DPP_F(v, 0x140, 0xF, true));
  { const float t = __int_as_float(__builtin_amdgcn_update_dpp(__float_as_int(v), __float_as_int(v), 0x142, 0xA, 0xF, false)); v = fmaxf(v, t); }
  { const float t = __int_as_float(__builtin_amdgcn_update_dpp(__float_as_int(v), __float_as_int(v), 0x143, 0xC, 0xF, false)); v = fmaxf(v, t); }
  return __int_as_float(__builtin_amdgcn_readlane(__float_as_int(v), 63));
}
DI float rowsum16(float v) { v += DPP_F(v, 0x128, 0xF, true); v += DPP_F(v, 0x124, 0xF, true); v += DPP_F(v, 0x122, 0xF, true); v += DPP_F(v, 0x121, 0xF, true); return v; }
DI float rowmax16(float v) { v = fmaxf(v, DPP_F(v, 0x128, 0xF, true)); v = fmaxf(v, DPP_F(v, 0x124, 0xF, true)); v = fmaxf(v, DPP_F(v, 0x122, 0xF, true)); v = fmaxf(v, DPP_F(v, 0x121, 0xF, true)); return v; }
DI float shx(float v, int mask, int lane) { return __int_as_float(__builtin_amdgcn_ds_bpermute((lane ^ mask) << 2, __float_as_int(v))); }
DI int shxi(int v, int mask, int lane) { return __builtin_amdgcn_ds_bpermute((lane ^ mask) << 2, v); }
DI float gelu_tanh(float x) {
  const float k0 = 0.7978845608028654f, k1 = 0.044715f;
  return 0.5f * x * (1.f + tanhf(k0 * (x + k1 * x * x * x)));
}
DI float sigmoidf(float x) { return 1.f / (1.f + expf(-x)); }

DI float rstd_of(const float* __restrict__ rss, int row) {
  const float* q = rss + (size_t)row * 16;
  const f32x4v a = *(const f32x4v*)q, b = *(const f32x4v*)(q + 4), c = *(const f32x4v*)(q + 8), d = *(const f32x4v*)(q + 12);
  const float s0 = (a[0] + a[1]) + (a[2] + a[3]), s1 = (b[0] + b[1]) + (b[2] + b[3]), s2 = (c[0] + c[1]) + (c[2] + c[3]), s3 = (d[0] + d[1]) + (d[2] + d[3]);
  return rsqrtf(((s0 + s1) + (s2 + s3)) * (1.f / 1024.f) + 1e-6f);
}
DI void phase_init_h(const int wq, const float* __restrict__ x, float* __restrict__ h, bf16_t* __restrict__ hb, float* __restrict__ rss) {
  const int tid = ltid(wq); const int bid = lbid();
  const int lane = tid & 63, wv = tid >> 6;
  for (int r = bid * 4 + wv; r < T; r += gridDim.x * 4) {
    float ss = 0.f;
#pragma unroll
    for (int i = 0; i < 4; ++i) {
      const u32x4 v = gload16(x + (size_t)r * D + i * 256 + lane * 4);
      const unsigned v0 = v[0], v1 = v[1], v2 = v[2], v3 = v[3];
      const float a = __uint_as_float(v0), b = __uint_as_float(v1), c = __uint_as_float(v2), d = __uint_as_float(v3);
      ss += a * a + b * b + c * c + d * d;
      *(GAS u32x4*)(h + (size_t)r * D + i * 256 + lane * 4) = v;
      u32x2 o; o[0] = pack2(a, b); o[1] = pack2(c, d);
      *(GAS u32x2*)(hb + (size_t)r * D + i * 256 + lane * 4) = o;
    }
    ss = wave_sum(ss);
    if (lane < 16) rss[(size_t)r * 16 + lane] = lane == 0 ? ss : 0.f;
  }
}

DI void phase_rmsnorm_bf(const int wq, const float* __restrict__ in, int ldi, const float* __restrict__ g, bf16_t* __restrict__ out, int ldo, int rows, int W) {
  const int tid_ = ltid(wq); const int bid_ = lbid();
  const int lane = tid_ & 63, wv = tid_ >> 6;
  f32x4v gv[4];
#pragma unroll
  for (int i = 0; i < 4; ++i) gv[i] = *(const f32x4v*)(g + i * 256 + lane * 4);
  for (int r = bid_ * 4 + wv; r < rows; r += gridDim.x * 4) {
    const float* p = in + (size_t)r * ldi;
    u32x4 v[4];
#pragma unroll
    for (int i = 0; i < 4; ++i) v[i] = gload16(p + i * 256 + lane * 4);
    float ss = 0.f;
#pragma unroll
    for (int i = 0; i < 4; ++i) {
      const float a = __uint_as_float(v[i][0]), b = __uint_as_float(v[i][1]), c = __uint_as_float(v[i][2]), d = __uint_as_float(v[i][3]);
      ss += a * a + b * b + c * c + d * d;
    }
    ss = wave_sum(ss);
    const float rs = rsqrtf(ss / (float)W + 1e-6f);
    bf16_t* o = out + (size_t)r * ldo;
#pragma unroll
    for (int i = 0; i < 4; ++i) {
      u32x2 ov;
      ov[0] = pack2(__uint_as_float(v[i][0]) * rs * gv[i][0], __uint_as_float(v[i][1]) * rs * gv[i][1]);
      ov[1] = pack2(__uint_as_float(v[i][2]) * rs * gv[i][2], __uint_as_float(v[i][3]) * rs * gv[i][3]);
      *(GAS u32x2*)(o + i * 256 + lane * 4) = ov;
    }
  }
}

DI void phase_convert(const int wq, const float* __restrict__ W0, int K, int N, int ldw, bf16_t* __restrict__ Bt0, int Npad, const float* __restrict__ cs0,
                      int nbatch, size_t sW, size_t sBt, size_t sCS, float* smem, const float* __restrict__ rs0 = nullptr, size_t sRS = 0) {
  const int tid = ltid(wq); const int bid = lbid();
  float (*tl)[65] = (float (*)[65])smem;
  const int tk = K / 64, tn = Npad / 64;
  for (int tile0 = bid; tile0 < tk * tn * nbatch; tile0 += gridDim.x) {
    const int bt = tile0 / (tk * tn), tile = tile0 % (tk * tn);
    const int k0 = (tile / tn) * 64, n0 = (tile % tn) * 64;
    const float* W = W0 + (size_t)bt * sW;
    bf16_t* Bt = Bt0 + (size_t)bt * sBt;
    __syncthreads();
#pragma unroll 4
    for (int i = 0; i < 16; ++i) {
      const int k = i * 4 + (tid >> 6), n = tid & 63;
      float v = 0.f;
      if (n0 + n < N) { v = W[(size_t)(k0 + k) * ldw + n0 + n]; if (cs0) v *= cs0[(size_t)bt * sCS + n0 + n]; if (rs0) v *= rs0[(size_t)bt * sRS + k0 + k]; }
      tl[k][n] = v;
    }
    __syncthreads();
#pragma unroll 4
    for (int i = 0; i < 16; ++i) {
      const int n = i * 4 + (tid >> 6), k = tid & 63;
      Bt[(size_t)(n0 + n) * K + k0 + k] = f2bf(tl[k][n]);
    }
  }
}

constexpr int G_LDS_ROW = 144;
constexpr int G_TILE_B = 128 * G_LDS_ROW;
template <int MODE, int RS = 0>
DI void phase_gemm_bf16(const int wq, const bf16_t* __restrict__ A0, int lda, const bf16_t* __restrict__ B0, void* __restrict__ C0, int ldc,
                        int M, int N, int K, char* smem, int dry, int nbatch = 1, size_t sA = 0, size_t sB = 0, size_t sC = 0,
                        int inner = 1, size_t sA2 = 0, size_t sC2 = 0, const float* __restrict__ rss_in = nullptr, bf16_t* __restrict__ hb_out = nullptr, float* __restrict__ rss_out = nullptr) {
  const int tid = ltid(wq); const int bid = lbid();
  const int lane = tid & 63, wv = tid >> 6, wm = wv >> 1, wn = wv & 1;
  const int r = lane & 31, hh = lane >> 5;
  const int tm = M / 128, tn = (N + 127) / 128;
  const int nk = K / 64;
  const int srow = tid >> 3, skc = tid & 7;
  const int ntile_all = tm * tn * nbatch;
  const int per_x = (ntile_all + 7) >> 3;
  const int t_beg = (bid & 7) * per_x, t_end = (t_beg + per_x < ntile_all) ? t_beg + per_x : ntile_all;
  for (int tile0 = t_beg + (bid >> 3); tile0 < t_end; tile0 += (int)(gridDim.x >> 3)) {
    const int bt = tile0 / (tm * tn), tile = tile0 % (tm * tn);
    const int m0 = (tile / tn) * 128, n0 = (tile % tn) * 128;
    const int bhi = bt / inner, blo = bt % inner;
    const bf16_t* Ag = A0 + (size_t)bhi * sA + (size_t)blo * sA2 + (size_t)(m0 + srow) * lda + skc * 8;
    const bf16_t* Bg = B0 + (size_t)bt * sB + (size_t)(n0 + srow) * K + skc * 8;
    f32x16 acc[2][2];
#pragma unroll
    for (int i = 0; i < 2; ++i)
#pragma unroll
      for (int j = 0; j < 2; ++j)
#pragma unroll
        for (int e = 0; e < 16; ++e) acc[i][j][e] = 0.f;
    u32x4 ra[4], rb[4];
#pragma unroll
    for (int i = 0; i < 4; ++i) {
      ra[i] = gload16(Ag + (size_t)(32 * i) * lda);
      rb[i] = gload16(Bg + (size_t)(32 * i) * K);
    }
    __syncthreads();
#pragma unroll
    for (int i = 0; i < 4; ++i) {
      *(u32x4*)(smem + (srow + 32 * i) * G_LDS_ROW + skc * 16) = ra[i];
      *(u32x4*)(smem + 2 * G_TILE_B + (srow + 32 * i) * G_LDS_ROW + skc * 16) = rb[i];
    }
    __syncthreads();
#pragma unroll 1
    for (int kt = 0; kt < nk; ++kt) {
      const int cur = kt & 1;
      if (kt + 1 < nk) {
#pragma unroll
        for (int i = 0; i < 4; ++i) {
          ra[i] = gload16(Ag + (size_t)(32 * i) * lda + (kt + 1) * 64);
          rb[i] = gload16(Bg + (size_t)(32 * i) * K + (kt + 1) * 64);
        }
      }
      const char* As = smem + cur * G_TILE_B + (wm * 64 + r) * G_LDS_ROW + hh * 16;
      const char* Bs = smem + 2 * G_TILE_B + cur * G_TILE_B + (wn * 64 + r) * G_LDS_ROW + hh * 16;
#pragma unroll
      for (int ks = 0; ks < 4; ++ks) {
        bf16x8 a0 = *(const bf16x8*)(As + ks * 32);
        bf16x8 a1 = *(const bf16x8*)(As + 32 * G_LDS_ROW + ks * 32);
        bf16x8 b0 = *(const bf16x8*)(Bs + ks * 32);
        bf16x8 b1 = *(const bf16x8*)(Bs + 32 * G_LDS_ROW + ks * 32);
        acc[0][0] = __builtin_amdgcn_mfma_f32_32x32x16_bf16(a0, b0, acc[0][0], 0, 0, 0);
        acc[0][1] = __builtin_amdgcn_mfma_f32_32x32x16_bf16(a0, b1, acc[0][1], 0, 0, 0);
        acc[1][0] = __builtin_amdgcn_mfma_f32_32x32x16_bf16(a1, b0, acc[1][0], 0, 0, 0);
        acc[1][1] = __builtin_amdgcn_mfma_f32_32x32x16_bf16(a1, b1, acc[1][1], 0, 0, 0);
      }
      if (kt + 1 < nk) {
        const int nxt = cur ^ 1;
#pragma unroll
        for (int i = 0; i < 4; ++i) {
          *(u32x4*)(smem + nxt * G_TILE_B + (srow + 32 * i) * G_LDS_ROW + skc * 16) = ra[i];
          *(u32x4*)(smem + 2 * G_TILE_B + nxt * G_TILE_B + (srow + 32 * i) * G_LDS_ROW + skc * 16) = rb[i];
        }
      }
      __syncthreads();
    }
    if (RS) {
      if (tid < 128) ((float*)smem)[tid] = rstd_of(rss_in, m0 + tid);
      __syncthreads();
    }
#pragma unroll
    for (int i = 0; i < 2; ++i)
#pragma unroll
      for (int j = 0; j < 2; ++j) {
        const int col = n0 + wn * 64 + j * 32 + r;
        if (col < N && !dry) {
          const size_t base = (size_t)bhi * sC + (size_t)blo * sC2 + (size_t)(m0 + wm * 64 + i * 32 + 4 * hh) * ldc + col;
          if (RS) {
            const float* rp = (const float*)smem + wm * 64 + i * 32 + 4 * hh;
#pragma unroll
            for (int e = 0; e < 16; ++e) acc[i][j][e] *= rp[(e & 3) + 8 * (e >> 2)];
          }
          if (MODE == 1) {
            GAS float* cp = (GAS float*)C0 + base;
            float old[16];
#pragma unroll
            for (int e = 0; e < 16; ++e) old[e] = cp[(size_t)((e & 3) + 8 * (e >> 2)) * ldc];
#pragma unroll
            for (int e = 0; e < 16; ++e) { old[e] += acc[i][j][e]; acc[i][j][e] = old[e]; cp[(size_t)((e & 3) + 8 * (e >> 2)) * ldc] = old[e]; }
            if (hb_out) {
              GAS bf16_t* hp = (GAS bf16_t*)hb_out + base;
#pragma unroll
              for (int e = 0; e < 16; ++e) hp[(size_t)((e & 3) + 8 * (e >> 2)) * ldc] = f2bf(old[e]);
            }
          } else if (MODE == 0) {
            GAS float* cp = (GAS float*)C0 + base;
#pragma unroll
            for (int e = 0; e < 16; ++e) cp[(size_t)((e & 3) + 8 * (e >> 2)) * ldc] = acc[i][j][e];
          } else if (MODE == 2) {
            GAS bf16_t* cp = (GAS bf16_t*)C0 + base;
#pragma unroll
            for (int e = 0; e < 16; ++e) cp[(size_t)((e & 3) + 8 * (e >> 2)) * ldc] = f2bf(acc[i][j][e]);
          } else if (MODE == 4) {
            GAS bf16_t* cp = (GAS bf16_t*)C0 + base;
#pragma unroll
            for (int e = 0; e < 16; ++e) cp[(size_t)((e & 3) + 8 * (e >> 2)) * ldc] = f2bf(acc[i][j][e] * 0.0625f);
          } else {
            const int rowb = m0 + wm * 64 + i * 32 + 4 * hh;
            const int b_ = rowb >> 8, mm = rowb & 255;
            const int cc = col & 1023, hd_ = cc >> 8, dd = cc & 255;
            GAS bf16_t* kb = (GAS bf16_t*)C0;
            if (col < 1024) {
#pragma unroll
              for (int e = 0; e < 16; ++e) kb[((size_t)(b_ * 4 + hd_) * 256 + mm + (e & 3) + 8 * (e >> 2)) * 256 + dd] = f2bf(acc[i][j][e]);
            } else {
#pragma unroll
              for (int e = 0; e < 16; ++e) kb[(size_t)2048 * 1024 + ((size_t)(b_ * 4 + hd_) * 256 + dd) * 256 + mm + (e & 3) + 8 * (e >> 2)] = f2bf(acc[i][j][e]);
            }
          }
        }
      }
    if (MODE == 1 && rss_out && !dry) {
#pragma unroll
      for (int i = 0; i < 2; ++i) {
        float myv = 0.f;
#pragma unroll
        for (int e = 0; e < 16; ++e) {
          float v = acc[i][0][e] * acc[i][0][e] + acc[i][1][e] * acc[i][1][e];
          v = rowsum16(v);
          v += shx(v, 16, lane);
          if ((lane & 15) == e) myv = v;
        }
        if ((lane & 16) == 0) rss_out[(size_t)(m0 + wm * 64 + i * 32 + (lane & 3) + 8 * ((lane & 15) >> 2) + 4 * hh) * 16 + (n0 >> 7) * 2 + wn] = myv;
      }
    }
  }
}

template <int W>
DI void evenmix_run(const bf16_t* __restrict__ P, const float* __restrict__ cw, bf16_t* __restrict__ Y, bf16_t* __restrict__ pool, int t0, int c) {
  const int s0 = t0 & (S - 1);
  f32x4v w0 = *(const f32x4v*)(cw + c), w1 = *(const f32x4v*)(cw + 512 + c), w2 = *(const f32x4v*)(cw + 1024 + c);
  const f32x4v zero = {0.f, 0.f, 0.f, 0.f};
  auto ld = [&](int t, int off) { const u32x2 v = *(const GAS u32x2*)(P + (size_t)t * EVEN_IN + off + c); return bf4_to_f(v); };
  f32x4v xm2 = zero, xm1 = zero;
  if (s0 >= 2) xm2 = ld(t0 - 2, 512) * ld(t0 - 2, 0);
  if (s0 >= 1) xm1 = ld(t0 - 1, 512) * ld(t0 - 1, 0);
  f32x4v ring[W];
  f32x4v sum = zero;
#pragma unroll
  for (int i = 0; i < W; ++i) { ring[i] = (s0 + i - W >= 0) ? ld(t0 + i - W, 1536) : zero; sum += ring[i]; }
#pragma unroll
  for (int tt = 0; tt < 32; ++tt) {
    const int t = t0 + tt;
    const f32x4v x0 = ld(t, 512) * ld(t, 0);
    const f32x4v z = w0 * xm2 + w1 * xm1 + w2 * x0;
    xm2 = xm1; xm1 = x0;
    const f32x4v ya = ld(t, 1024) * z;
    const f32x4v pv = ld(t, 1536);
    sum += pv - ring[tt % W]; ring[tt % W] = pv;
    const int cnt = (s0 + tt + 1 < W) ? (s0 + tt + 1) : W;
    const float ic = 1.f / (float)cnt;
    const f32x4v pl = sum * ic - pv;
    u32x2 oa, ob;
    oa[0] = pack2(ya[0], ya[1]); oa[1] = pack2(ya[2], ya[3]);
    ob[0] = pack2(pl[0], pl[1]); ob[1] = pack2(pl[2], pl[3]);
    *(GAS u32x2*)(Y + (size_t)t * D + c) = oa;
    *(GAS u32x2*)(pool + (size_t)t * 512 + c) = ob;
  }
}
DI void phase_evenmix(const int wq, PRef p, int j) {
  const int tid = ltid(wq); const int bid = lbid();
  const int lane = tid & 63, wv = tid >> 6;
  const float* cw = p.even_conv_w + (size_t)j * 3 * 512;
  for (int Wg = bid * 4 + wv; Wg < 1024; Wg += gridDim.x * 4) {
    const int g = Wg & 3, cp = Wg >> 2;
    const int t0 = (cp * 2 + (lane >> 5)) * 32;
    const int c = g * 128 + (lane & 31) * 4;
    if (g == 0) evenmix_run<2>(p.P16, cw, p.Y, p.pool, t0, c);
    else if (g == 1) evenmix_run<4>(p.P16, cw, p.Y, p.pool, t0, c);
    else if (g == 2) evenmix_run<8>(p.P16, cw, p.Y, p.pool, t0, c);
    else evenmix_run<16>(p.P16, cw, p.Y, p.pool, t0, c);
  }
}

DI void phase_lb(const int wq, PRef p) {
  const int tid_ = ltid(wq); const int bid_ = lbid(); (void)tid_; (void)bid_;
  for (int c = bid_ * NT + tid_; c < 512; c += gridDim.x * NT) {
    float g[DEPTH], m = -INFINITY;
#pragma unroll
    for (int l = 0; l < DEPTH; ++l) { g[l] = p.hgrn_gamma[l * 512 + c]; m = fmaxf(m, g[l]); }
    float sum = 0.f;
#pragma unroll
    for (int l = 0; l < DEPTH; ++l) { g[l] = expf(g[l] - m); sum += g[l]; }
    float cum = 0.f;
#pragma unroll
    for (int l = 0; l < DEPTH; ++l) { p.lb[l * 512 + c] = cum; cum += g[l] / sum; }
  }
}

DI int t5_bucket(int dist) {
  const int d = dist < 0 ? 0 : dist;
  if (d < 16) return d;
  const float lr = logf((float)d / 16.f) / 2.0794415416798357f;
  int large = 16 + (int)(lr * 16.f);
  return large < 31 ? large : 31;
}

DI unsigned fkey(float f) { unsigned u = __float_as_uint(f); return (u & 0x80000000u) ? ~u : (u | 0x80000000u); }

DI void phase_hgrn_post(const int wq, PRef p, int j) {
  const int tid_ = ltid(wq); const int bid_ = lbid(); (void)tid_; (void)bid_;
  const int lane = tid_ & 63, wv = tid_ >> 6;
  for (int r = bid_ * 4 + wv; r < T * 4; r += gridDim.x * 4) {
    const int t = r >> 2, hd = r & 3;
    const float* o = p.oraw + (size_t)t * 512 + hd * 128;
    const float a = o[lane], bq = o[lane + 64];
    const float ss = wave_sum(a * a + bq * bq);
    const float rs = rsqrtf(ss / 128.f + 1e-6f);
    const bf16_t* gate = p.P16 + (size_t)t * ODD_IN + 3272 + hd * 128;
    const float* gn = p.odd_hg_norm + j * 512 + hd * 128;
    const float g0 = bf2f(gate[lane]), g1 = bf2f(gate[lane + 64]);
    p.Y[(size_t)t * D + 512 + hd * 128 + lane] = f2bf(a * rs * gn[lane] * (g0 * sigmoidf(g0)));
    p.Y[(size_t)t * D + 512 + hd * 128 + lane + 64] = f2bf(bq * rs * gn[lane + 64] * (g1 * sigmoidf(g1)));
  }
}

DI void phase_dsa_prep(const int wq, PRef p, int j) {
  const int tid = ltid(wq); const int bid = lbid();
  const int lane = tid & 63, wv = tid >> 6;
  for (int t = bid * 4 + wv; t < T; t += gridDim.x * 4) {
    const bf16_t* row = p.P16 + (size_t)t * ODD_IN;
#pragma unroll
    for (int c = 0; c < 2; ++c) *(GAS u32x4*)(p.qlat16 + (size_t)t * 1024 + c * 512 + lane * 8) = gload16(row + c * 512 + lane * 8);
    {
      const unsigned cv = *(const GAS unsigned*)(row + 1024 + 2 * lane);
      const float c0 = bflo(cv), c1 = bfhi(cv);
      const float ss = wave_sum(c0 * c0 + c1 * c1);
      const float rs = rsqrtf(ss / 128.f + 1e-6f);
      const float* g = p.odd_kv_norm + j * 128;
      *(GAS unsigned*)(p.ckv16 + (size_t)t * 128 + 2 * lane) = pack2(c0 * rs * g[2 * lane], c1 * rs * g[2 * lane + 1]);
    }
    *(GAS u32x4*)(p.iq16 + (size_t)t * 512 + lane * 8) = gload16(row + 1152 + lane * 8);
    p.ik16[(size_t)t * 64 + lane] = row[1664 + lane];
  }
}

DI void phase_dsa_scores(const int wq, PRef p, char* smem) {
  const int tid = ltid(wq); const int bid = lbid();
  const int lane = tid & 63, wv = tid >> 6, wm = wv >> 1, wn = wv & 1;
  const int r = lane & 31, hh = lane >> 5;
  const int srow = tid >> 3, skc = tid & 7;
  char* Ks = smem;
  char* Qs = smem + G_TILE_B;
  float* Ws = (float*)(smem + 3 * G_TILE_B);
  for (int tile = bid; tile < NB * 136; tile += gridDim.x) {
    const int b = tile / 136, u = tile % 136;
    int qb = 0;
    while ((qb + 1) * (qb + 2) / 2 <= u) ++qb;
    const int kb = u - qb * (qb + 1) / 2;
    const int q0 = b * S + qb * 128, k0 = b * S + kb * 128;
    const bf16_t* Kg = p.ik16 + (size_t)(k0 + srow) * 64 + skc * 8;
    const bf16_t* Qg = p.iq16 + (size_t)(q0 + srow) * 512 + skc * 8;
    u32x4 rk[4], rq[4];
#pragma unroll
    for (int i = 0; i < 4; ++i) { rk[i] = gload16(Kg + (size_t)(32 * i) * 64); rq[i] = gload16(Qg + (size_t)(32 * i) * 512); }
    u32x4 wv4 = {0u, 0u, 0u, 0u};
    if (tid < 128) wv4 = gload16(p.P16 + (size_t)(q0 + tid) * ODD_IN + 1728);
    __syncthreads();
#pragma unroll
    for (int i = 0; i < 4; ++i) {
      *(u32x4*)(Ks + (srow + 32 * i) * G_LDS_ROW + skc * 16) = rk[i];
      *(u32x4*)(Qs + (srow + 32 * i) * G_LDS_ROW + skc * 16) = rq[i];
    }
    if (tid < 128) {
      const unsigned w0 = wv4[0], w1 = wv4[1], w2 = wv4[2], w3 = wv4[3];
      f32x4v a4, b4;
      a4[0] = bflo(w0) * 0.35355339059327373f; a4[1] = bfhi(w0) * 0.35355339059327373f; a4[2] = bflo(w1) * 0.35355339059327373f; a4[3] = bfhi(w1) * 0.35355339059327373f;
      b4[0] = bflo(w2) * 0.35355339059327373f; b4[1] = bfhi(w2) * 0.35355339059327373f; b4[2] = bflo(w3) * 0.35355339059327373f; b4[3] = bfhi(w3) * 0.35355339059327373f;
      *(f32x4v*)(Ws + tid * 8) = a4; *(f32x4v*)(Ws + tid * 8 + 4) = b4;
    }
    __syncthreads();
    f32x16 sc[2][2];
#pragma unroll
    for (int i = 0; i < 2; ++i)
#pragma unroll
      for (int jx = 0; jx < 2; ++jx)
#pragma unroll
        for (int e = 0; e < 16; ++e) sc[i][jx][e] = 0.f;
#pragma unroll 1
    for (int hd = 0; hd < 8; ++hd) {
      const int cur = hd & 1;
      if (hd + 1 < 8) {
#pragma unroll
        for (int i = 0; i < 4; ++i) rq[i] = gload16(Qg + (size_t)(32 * i) * 512 + (hd + 1) * 64);
      }
      f32x16 acc[2][2];
#pragma unroll
      for (int i = 0; i < 2; ++i)
#pragma unroll
        for (int jx = 0; jx < 2; ++jx)
#pragma unroll
          for (int e = 0; e < 16; ++e) acc[i][jx][e] = 0.f;
      const char* As = Qs + cur * G_TILE_B + (wm * 64 + r) * G_LDS_ROW + hh * 16;
      const char* Bs = Ks + (wn * 64 + r) * G_LDS_ROW + hh * 16;
#pragma unroll
      for (int ks = 0; ks < 4; ++ks) {
        const bf16x8 a0 = *(const bf16x8*)(As + ks * 32), a1 = *(const bf16x8*)(As + 32 * G_LDS_ROW + ks * 32);
        const bf16x8 b0 = *(const bf16x8*)(Bs + ks * 32), b1 = *(const bf16x8*)(Bs + 32 * G_LDS_ROW + ks * 32);
        acc[0][0] = __builtin_amdgcn_mfma_f32_32x32x16_bf16(a0, b0, acc[0][0], 0, 0, 0);
        acc[0][1] = __builtin_amdgcn_mfma_f32_32x32x16_bf16(a0, b1, acc[0][1], 0, 0, 0);
        acc[1][0] = __builtin_amdgcn_mfma_f32_32x32x16_bf16(a1, b0, acc[1][0], 0, 0, 0);
        acc[1][1] = __builtin_amdgcn_mfma_f32_32x32x16_bf16(a1, b1, acc[1][1], 0, 0, 0);
      }
#pragma unroll
      for (int i = 0; i < 2; ++i)
#pragma unroll
        for (int e = 0; e < 16; ++e) {
          const float w = Ws[(wm * 64 + i * 32 + (e & 3) + 8 * (e >> 2) + 4 * hh) * 8 + hd];
          sc[i][0][e] = fmaf(w, fmaxf(acc[i][0][e] * 0.125f, 0.f), sc[i][0][e]);
          sc[i][1][e] = fmaf(w, fmaxf(acc[i][1][e] * 0.125f, 0.f), sc[i][1][e]);
        }
      if (hd + 1 < 8) {
#pragma unroll
        for (int i = 0; i < 4; ++i) *(u32x4*)(Qs + (cur ^ 1) * G_TILE_B + (srow + 32 * i) * G_LDS_ROW + skc * 16) = rq[i];
      }
      __syncthreads();
    }
#pragma unroll
    for (int i = 0; i < 2; ++i)
#pragma unroll
      for (int jx = 0; jx < 2; ++jx) {
        GAS float* cp = (GAS float*)p.sc + (size_t)(q0 + wm * 64 + i * 32 + 4 * hh) * 2048 + kb * 128 + wn * 64 + jx * 32 + r;
#pragma unroll
        for (int e = 0; e < 16; ++e) cp[(size_t)((e & 3) + 8 * (e >> 2)) * 2048] = sc[i][jx][e];
      }
  }
}

DI void phase_hgrn_scan(const int wq, PRef p, int l, char* smem) {
  const int tid = ltid(wq); const int bid = lbid();
  const int lane = tid & 63, wv = tid >> 6;
  const int kq = wv * 4 + (lane & 3), v = lane >> 2;
  constexpr int BUF = (2048 + 2048 + 256);
  float* bufs = (float*)smem;
  float* opart = bufs + 2 * BUF;
  for (int unit = bid; unit < 256; unit += gridDim.x) {
    const int b = unit >> 5, hd = (unit >> 3) & 3, vs = unit & 7;
    const int ltok = tid >> 4, lc = (tid & 15) * 8;
    const bf16_t* Pb = p.P16 + (size_t)(b * S) * ODD_IN;
    f32x4v lbv0, lbv1;
    { const float* lbp = p.lb + l * 512 + hd * 128 + lc; lbv0 = *(const f32x4v*)lbp; lbv1 = *(const f32x4v*)(lbp + 4); }
    float st[8];
#pragma unroll
    for (int i = 0; i < 8; ++i) st[i] = 0.f;
    u32x4 rq, rf; float riv;
    auto gl = [&](int bt) {
      const bf16_t* row = Pb + (size_t)(bt * 16 + ltok) * ODD_IN;
      rq = gload16(row + 1736 + hd * 128 + lc);
      rf = gload16(row + 2248 + hd * 128 + lc);
      riv = bf2f(row[2760 + hd * 128 + vs * 16 + (tid & 15)]);
    };
    auto st_lds = [&](int which) {
      float* bq = bufs + which * BUF; float* bf = bq + 2048; float* bi = bf + 2048;
      const unsigned q0_ = rq[0], q1_ = rq[1], q2_ = rq[2], q3_ = rq[3], f0_ = rf[0], f1_ = rf[1], f2_ = rf[2], f3_ = rf[3];
      f32x4v qa, qb, fa, fb;
      qa[0] = bflo(q0_); qa[1] = bfhi(q0_); qa[2] = bflo(q1_); qa[3] = bfhi(q1_); qb[0] = bflo(q2_); qb[1] = bfhi(q2_); qb[2] = bflo(q3_); qb[3] = bfhi(q3_);
      fa[0] = bflo(f0_); fa[1] = bfhi(f0_); fa[2] = bflo(f1_); fa[3] = bfhi(f1_); fb[0] = bflo(f2_); fb[1] = bfhi(f2_); fb[2] = bflo(f3_); fb[3] = bfhi(f3_);
      *(f32x4v*)(bq + ltok * 128 + lc) = qa; *(f32x4v*)(bq + ltok * 128 + lc + 4) = qb;
      f32x4v f0, f1;
#pragma unroll
      for (int i = 0; i < 4; ++i) {
        f0[i] = lbv0[i] + (1.f - lbv0[i]) * sigmoidf(fa[i]);
        f1[i] = lbv1[i] + (1.f - lbv1[i]) * sigmoidf(fb[i]);
      }
      *(f32x4v*)(bf + ltok * 128 + lc) = f0; *(f32x4v*)(bf + ltok * 128 + lc + 4) = f1;
      bi[ltok * 16 + (tid & 15)] = riv;
    };
    gl(0);
    __syncthreads();
    st_lds(0);
    __syncthreads();
#pragma unroll 1
    for (int bt = 0; bt < S / 16; ++bt) {
      const int cur = bt & 1;
      if (bt + 1 < S / 16) gl(bt + 1);
      const float* bq = bufs + cur * BUF; const float* bf = bq + 2048; const float* bi = bf + 2048;
#pragma unroll 4
      for (int tt = 0; tt < 16; ++tt) {
        const float iv = bi[tt * 16 + v];
        const f32x4v f0 = *(const f32x4v*)(bf + tt * 128 + kq * 8), f1 = *(const f32x4v*)(bf + tt * 128 + kq * 8 + 4);
        const f32x4v q0 = *(const f32x4v*)(bq + tt * 128 + kq * 8), q1 = *(const f32x4v*)(bq + tt * 128 + kq * 8 + 4);
        float o = 0.f;
#pragma unroll
        for (int i = 0; i < 4; ++i) {
          st[i] = fmaf(f0[i], st[i], (1.f - f0[i]) * iv); o = fmaf(q0[i], st[i], o);
          st[4 + i] = fmaf(f1[i], st[4 + i], (1.f - f1[i]) * iv); o = fmaf(q1[i], st[4 + i], o);
        }
        o += __int_as_float(__builtin_amdgcn_update_dpp(0, __float_as_int(o), 0xB1, 0xF, 0xF, true));
        o += __int_as_float(__builtin_amdgcn_update_dpp(0, __float_as_int(o), 0x4E, 0xF, 0xF, true));
        if ((lane & 3) == 0) opart[(tt * 4 + wv) * 16 + v] = o;
      }
      __syncthreads();
      {
        const int tt = tid >> 4, vo = tid & 15;
        const float o = opart[(tt * 4 + 0) * 16 + vo] + opart[(tt * 4 + 1) * 16 + vo] + opart[(tt * 4 + 2) * 16 + vo] + opart[(tt * 4 + 3) * 16 + vo];
        p.oraw[(size_t)(b * S + bt * 16 + tt) * 512 + hd * 128 + vs * 16 + vo] = o;
      }
      if (bt + 1 < S / 16) st_lds(cur ^ 1);
      __syncthreads();
    }
  }
}

DI float dot2bf(unsigned a, unsigned b, float acc) { return __builtin_amdgcn_fdot2_f32_bf16(__builtin_bit_cast(bf16x2_t, a), __builtin_bit_cast(bf16x2_t, b), acc, false); }
DI unsigned fkey_u(float f) { const unsigned u = __float_as_uint(f); return (u & 0x80000000u) ? ~u : (u | 0x80000000u); }
DI void phase_dsa_attend(const int wq, PRef p, int j, char* smem, int qoff) {
  const int tid = ltid(wq); const int bid = lbid(); (void)bid;
  const int lane = tid & 63, wv = tid >> 6;
  int* selL = (int*)smem;
  int* nselL = selL + 1024;
  float* bias = (float*)(smem + 4096 + 64);
  float* part = (float*)(smem + 4096 + 64 + 1024);
  float* msb = part + 2 * 4 * 8 * 128;
  float* plw = msb + 2 * 4 * 16 + wv * 64 * 8;
  int* sel = selL + wv * 256;
  __syncthreads();
  bias[tid] = p.rel_bias[tid];
  const int n16 = lane & 15, kg = lane >> 4;
  const unsigned long long ltmask = (1ull << lane) - 1ull;
  for (;;) {
    __syncthreads();
    if (tid == 0) nselL[4] = (int)atomicAdd(p.qctr + qoff, 4u);
    __syncthreads();
    const int base = nselL[4];
    if (base >= T) break;
    {
      const int q = base + wv;
      const int t = q % S;
      const float* row = p.sc + (size_t)q * 2048;
      int nsel;
      if (t < 256) {
        nsel = t + 1;
#pragma unroll
        for (int i = 0; i < 4; ++i) sel[i * 64 + lane] = i * 64 + lane;
      } else {
        nsel = 256;
        const int ni = (t >> 6) + 1;
        unsigned keys[32];
#pragma unroll
        for (int i = 0; i < 32; ++i) {
          keys[i] = 0u;
          if (i < ni) { const int s_ = i * 64 + lane; if (s_ <= t) keys[i] = fkey_u(row[s_]); }
        }
        unsigned thr = 0u;
#pragma unroll 1
        for (int bit = 31; bit >= 0; --bit) {
          const unsigned cand = thr | (1u << bit);
          int cl = 0;
#pragma unroll
          for (int g = 0; g < 4; ++g) if (g * 8 < ni) {
#pragma unroll
            for (int i = g * 8; i < g * 8 + 8; ++i) cl += (keys[i] >= cand) ? 1 : 0;
          }
          const int cnt = wave_sum_i(cl);
          if (cnt >= 256) thr = cand;
        }
        int ngt = 0;
#pragma unroll
        for (int i = 0; i < 32; ++i) if (i < ni) ngt += __builtin_popcountll(__ballot(keys[i] > thr));
        const int need = 256 - ngt;
        int pg = 0, pe = 0;
#pragma unroll
        for (int i = 0; i < 32; ++i) if (i < ni) {
          const unsigned long long mg = __ballot(keys[i] > thr), me = __ballot(keys[i] == thr);
          const int myg = pg + __builtin_popcountll(mg & ltmask), mye = pe + __builtin_popcountll(me & ltmask);
          if (keys[i] > thr) sel[myg] = i * 64 + lane;
          else if (keys[i] == thr && mye < need) sel[ngt + mye] = i * 64 + lane;
          pg += __builtin_popcountll(mg); pe += __builtin_popcountll(me);
        }
      }
      if (lane == 0) nselL[wv] = nsel;
    }
    __syncthreads();
#pragma unroll 1
    for (int qi = 0; qi < 4; ++qi) {
      const int tid = ltid(wq);
      const int lane = tid & 63;
      const int n16 = lane & 15, kg = lane >> 4;
      const int q = base + qi;
      const int b = q / S, t = q % S;
      const int nsel = nselL[qi];
      const int* qsel = selL + qi * 256 + wv * 64;
      const int slot0 = wv * 64;
      float* pw = part + ((qi & 1) * 4 + wv) * 8 * 128;
      float* mw = msb + ((qi & 1) * 4 + wv) * 16;
      bf16x8 aq[4];
#pragma unroll
      for (int ks = 0; ks < 4; ++ks) {
        u32x4 z = {0u, 0u, 0u, 0u};
        if (n16 < 8) z = gload16(p.qlat16 + (size_t)q * 1024 + n16 * 128 + ks * 32 + kg * 8);
        aq[ks] = __builtin_bit_cast(bf16x8, z);
      }
      u32x4 bv[4][4];
#pragma unroll
      for (int bb = 0; bb < 4; ++bb) {
        const int sl = bb * 16 + n16;
        const int sxv = (slot0 + sl < nsel) ? qsel[sl] : 0;
        const bf16_t* crow = p.ckv16 + (size_t)(b * S + sxv) * 128 + kg * 8;
#pragma unroll
        for (int ks = 0; ks < 4; ++ks) bv[bb][ks] = gload16(crow + ks * 32);
      }
      const bf16_t* cb = p.ckv16 + (size_t)(b * S) * 128 + 2 * lane;
      unsigned cbuf[64];
#pragma unroll
      for (int i4 = 0; i4 < 8; ++i4) {
        const u32x4 s4 = *(const u32x4*)(qsel + i4 * 4);
#pragma unroll
        for (int e = 0; e < 4; ++e) {
          const int k = i4 * 4 + e;
          const int sk = (slot0 + k < nsel) ? __builtin_amdgcn_readfirstlane((int)s4[e]) : 0;
          cbuf[k] = *(const GAS unsigned*)(cb + (size_t)sk * 128);
        }
      }
      asm volatile("" ::: "memory");
      f32x4v lg[4];
#pragma unroll
      for (int bb = 0; bb < 4; ++bb) {
        f32x4v acc = {0.f, 0.f, 0.f, 0.f};
#pragma unroll
        for (int ks = 0; ks < 4; ++ks) acc = __builtin_amdgcn_mfma_f32_16x16x32_bf16(aq[ks], __builtin_bit_cast(bf16x8, bv[bb][ks]), acc, 0, 0, 0);
        lg[bb] = acc;
      }
      asm volatile("" ::: "memory");
#pragma unroll
      for (int i4 = 8; i4 < 16; ++i4) {
        const u32x4 s4 = *(const u32x4*)(qsel + i4 * 4);
#pragma unroll
        for (int e = 0; e < 4; ++e) {
          const int k = i4 * 4 + e;
          const int sk = (slot0 + k < nsel) ? __builtin_amdgcn_readfirstlane((int)s4[e]) : 0;
          cbuf[k] = *(const GAS unsigned*)(cb + (size_t)sk * 128);
        }
      }
      float mx[4] = {-INFINITY, -INFINITY, -INFINITY, -INFINITY};
#pragma unroll
      for (int bb = 0; bb < 4; ++bb) {
        const bool ok = slot0 + bb * 16 + n16 < nsel;
        const int bk = t5_bucket(t - (ok ? qsel[bb * 16 + n16] : 0));
#pragma unroll
        for (int i = 0; i < 4; ++i) {
          const float lv = ok ? lg[bb][i] * 0.08838834764831845f + bias[bk * 8 + ((4 * kg + i) & 7)] : -INFINITY;
          lg[bb][i] = lv; mx[i] = fmaxf(mx[i], lv);
        }
      }
#pragma unroll
      for (int i = 0; i < 4; ++i) mx[i] = rowmax16(mx[i]);
      float sm[4] = {0.f, 0.f, 0.f, 0.f};
#pragma unroll
      for (int bb = 0; bb < 4; ++bb)
#pragma unroll
        for (int i = 0; i < 4; ++i) {
          const float e_ = (mx[i] == -INFINITY) ? 0.f : __expf(lg[bb][i] - mx[i]);
          lg[bb][i] = e_; sm[i] += e_;
        }
#pragma unroll
      for (int i = 0; i < 4; ++i) sm[i] = rowsum16(sm[i]);
#pragma unroll
      for (int bb = 0; bb < 4; ++bb) {
        u32x4 pr;
#pragma unroll
        for (int i = 0; i < 4; ++i) {
          const float other = DPP_F(lg[bb][i], 0xB1, 0xF, true);
          pr[i] = pack2(lg[bb][i], other);
        }
        if (kg < 2 && (n16 & 1) == 0) *(u32x4*)((unsigned*)plw + ((bb * 16 + n16) >> 1) * 8 + 4 * kg) = pr;
      }
      if (kg < 2) {
        if (n16 == 0) {
#pragma unroll
          for (int i = 0; i < 4; ++i) { mw[4 * kg + i] = mx[i]; mw[8 + 4 * kg + i] = sm[i]; }
        }
      }
      asm volatile("s_waitcnt lgkmcnt(0)" ::: "memory");
      float o[16];
#pragma unroll
      for (int i = 0; i < 16; ++i) o[i] = 0.f;
#pragma unroll
      for (int kp = 0; kp < 32; ++kp) {
        if ((kp & 1) == 0) asm volatile("" ::: "memory");
        const unsigned ca = cbuf[2 * kp], cbx = cbuf[2 * kp + 1];
        const unsigned x0 = __builtin_amdgcn_perm(cbx, ca, 0x05040100u);
        const unsigned x1 = __builtin_amdgcn_perm(cbx, ca, 0x07060302u);
        const u32x4 pa4 = *(const u32x4*)((const unsigned*)plw + kp * 8), pb4 = *(const u32x4*)((const unsigned*)plw + kp * 8 + 4);
        const unsigned q0 = pa4[0], q1 = pa4[1], q2 = pa4[2], q3 = pa4[3], q4 = pb4[0], q5 = pb4[1], q6 = pb4[2], q7 = pb4[3];
        o[0] = dot2bf(q0, x0, o[0]); o[1] = dot2bf(q0, x1, o[1]); o[2] = dot2bf(q1, x0, o[2]); o[3] = dot2bf(q1, x1, o[3]);
        o[4] = dot2bf(q2, x0, o[4]); o[5] = dot2bf(q2, x1, o[5]); o[6] = dot2bf(q3, x0, o[6]); o[7] = dot2bf(q3, x1, o[7]);
        o[8] = dot2bf(q4, x0, o[8]); o[9] = dot2bf(q4, x1, o[9]); o[10] = dot2bf(q5, x0, o[10]); o[11] = dot2bf(q5, x1, o[11]);
        o[12] = dot2bf(q6, x0, o[12]); o[13] = dot2bf(q6, x1, o[13]); o[14] = dot2bf(q7, x0, o[14]); o[15] = dot2bf(q7, x1, o[15]);
      }
#pragma unroll
      for (int hd = 0; hd < 8; ++hd) { float2 ov; ov.x = o[2 * hd]; ov.y = o[2 * hd + 1]; *(float2*)(pw + hd * 128 + 2 * lane) = ov; }
      __syncthreads();
      {
        const int hd = tid >> 5, ch = (tid & 31) * 4;
        const float* pq = part + (qi & 1) * 4 * 8 * 128;
        const float* mq = msb + (qi & 1) * 4 * 16;
        float m0 = mq[hd], m1 = mq[16 + hd], m2 = mq[32 + hd], m3 = mq[48 + hd];
        const float M = fmaxf(fmaxf(m0, m1), fmaxf(m2, m3));
        const float f0 = __expf(m0 - M), f1 = __expf(m1 - M), f2 = __expf(m2 - M), f3 = __expf(m3 - M);
        const float den = f0 * mq[8 + hd] + f1 * mq[24 + hd] + f2 * mq[40 + hd] + f3 * mq[56 + hd];
        const f32x4v a0 = *(const f32x4v*)(pq + (0 * 8 + hd) * 128 + ch), a1 = *(const f32x4v*)(pq + (1 * 8 + hd) * 128 + ch);
        const f32x4v a2 = *(const f32x4v*)(pq + (2 * 8 + hd) * 128 + ch), a3 = *(const f32x4v*)(pq + (3 * 8 + hd) * 128 + ch);
        const float inv = 1.f / den;
        const f32x4v r = (a0 * f0 + a1 * f1 + a2 * f2 + a3 * f3) * inv;
        u32x2 ov; ov[0] = pack2(r[0], r[1]); ov[1] = pack2(r[2], r[3]);
        *(GAS u32x2*)(p.lat + (size_t)q * D + hd * 128 + ch) = ov;
      }
    }
  }
}

DI void phase_softmax256(const int wq, const bf16_t* __restrict__ S, bf16_t* __restrict__ Pm, int rows) {
  const int tid = ltid(wq); const int bid = lbid();
  const int lane = tid & 63, wv = tid >> 6;
  for (int r = bid * 4 + wv; r < rows; r += gridDim.x * 4) {
    const f32x4v v = bf4_to_f(*(const GAS u32x2*)(S + (size_t)r * 256 + lane * 4));
    const float a = v[0], b = v[1], c = v[2], d = v[3];
    const float m = wave_max(fmaxf(fmaxf(a, b), fmaxf(c, d)));
    const float ea = __expf(a - m), eb = __expf(b - m), ec = __expf(c - m), ed = __expf(d - m);
    const float inv = 1.f / wave_sum(ea + eb + ec + ed);
    u32x2 o; o[0] = pack2(ea * inv, eb * inv); o[1] = pack2(ec * inv, ed * inv);
    *(GAS u32x2*)(Pm + (size_t)r * 256 + lane * 4) = o;
  }
}

DI int fkey_s(int b) { return b ^ ((b >> 31) & 0x7fffffff); }

template <int N, int KMAX>
DI void bitonic_blocks(int (&v)[N]) {
#pragma unroll
  for (int k = 2; k <= KMAX; k <<= 1)
#pragma unroll
    for (int j = k >> 1; j > 0; j >>= 1)
#pragma unroll
      for (int i = 0; i < N; ++i) {
        const int l = i ^ j;
        if (l > i) {
          const bool desc = ((i & k) == 0);
          const int a = v[i], b = v[l];
          const int hi = a > b ? a : b, lo = a > b ? b : a;
          v[i] = desc ? hi : lo;
          v[l] = desc ? lo : hi;
        }
      }
}
template <bool DESC>
DI void bitonic_merge16(int (&v)[16]) {
#pragma unroll
  for (int j = 8; j > 0; j >>= 1)
#pragma unroll
    for (int i = 0; i < 16; ++i) {
      const int l = i ^ j;
      if (l > i) {
        const int a = v[i], b = v[l];
        const int hi = a > b ? a : b, lo = a > b ? b : a;
        v[i] = DESC ? hi : lo;
        v[l] = DESC ? lo : hi;
      }
    }
}

DI void phase_cvt_rows(const int wq, const float* __restrict__ src, bf16_t* __restrict__ dst, size_t n8) {
  const int tid = ltid(wq); const int bid = lbid();
  for (size_t i = (size_t)bid * NT + tid; i < n8; i += (size_t)gridDim.x * NT) {
    const u32x4 a = gload16(src + i * 8), b = gload16(src + i * 8 + 4);
    u32x4 o;
    o[0] = pack2(__uint_as_float(a[0]), __uint_as_float(a[1])); o[1] = pack2(__uint_as_float(a[2]), __uint_as_float(a[3]));
    o[2] = pack2(__uint_as_float(b[0]), __uint_as_float(b[1])); o[3] = pack2(__uint_as_float(b[2]), __uint_as_float(b[3]));
    *(GAS u32x4*)(dst + i * 8) = o;
  }
}

constexpr int KEY_ROW = 264;
DI void phase_peer_qs(const int wq, const bf16_t* __restrict__ X0, const bf16_t* __restrict__ W0, const bf16_t* __restrict__ keys0, int* __restrict__ tops, char* smem, const float* __restrict__ rss_in) {
  const int tid = ltid(wq); const int bid = lbid();
  const int lane = tid & 63, wv = tid >> 6;
  const int r = lane & 31, hh = lane >> 5;
  const int srow = tid >> 3, skc = tid & 7;
  constexpr int nk = D / 64;
  for (int tile = bid; tile < (T / 128) * 16; tile += gridDim.x) {
    const int mt = tile >> 4, hp = tile & 15;
    const bf16_t* Wg = W0 + (size_t)(hp * 128 + srow) * D + skc * 8;
    const bf16_t* Xg = X0 + (size_t)(mt * 128 + srow) * D + skc * 8;
    f32x16 acc[4];
#pragma unroll
    for (int i = 0; i < 4; ++i)
#pragma unroll
      for (int e = 0; e < 16; ++e) acc[i][e] = 0.f;
    u32x4 ra[4], rb[4];
#pragma unroll
    for (int i = 0; i < 4; ++i) { ra[i] = gload16(Wg + (size_t)(32 * i) * D); rb[i] = gload16(Xg + (size_t)(32 * i) * D); }
    __syncthreads();
#pragma unroll
    for (int i = 0; i < 4; ++i) {
      *(u32x4*)(smem + (srow + 32 * i) * G_LDS_ROW + skc * 16) = ra[i];
      *(u32x4*)(smem + 2 * G_TILE_B + (srow + 32 * i) * G_LDS_ROW + skc * 16) = rb[i];
    }
    __syncthreads();
#pragma unroll 1
    for (int kt = 0; kt < nk; ++kt) {
      const int cur = kt & 1;
      if (kt + 1 < nk) {
#pragma unroll
        for (int i = 0; i < 4; ++i) { ra[i] = gload16(Wg + (size_t)(32 * i) * D + (kt + 1) * 64); rb[i] = gload16(Xg + (size_t)(32 * i) * D + (kt + 1) * 64); }
      }
      const char* As = smem + cur * G_TILE_B + r * G_LDS_ROW + hh * 16;
      const char* Bs = smem + 2 * G_TILE_B + cur * G_TILE_B + (wv * 32 + r) * G_LDS_ROW + hh * 16;
#pragma unroll
      for (int ks = 0; ks < 4; ++ks) {
        const bf16x8 b = *(const bf16x8*)(Bs + ks * 32);
#pragma unroll
        for (int mb = 0; mb < 4; ++mb) {
          const bf16x8 a = *(const bf16x8*)(As + mb * 32 * G_LDS_ROW + ks * 32);
          acc[mb] = __builtin_amdgcn_mfma_f32_32x32x16_bf16(a, b, acc[mb], 0, 0, 0);
        }
      }
      if (kt + 1 < nk) {
        const int nxt = cur ^ 1;
#pragma unroll
        for (int i = 0; i < 4; ++i) {
          *(u32x4*)(smem + nxt * G_TILE_B + (srow + 32 * i) * G_LDS_ROW + skc * 16) = ra[i];
          *(u32x4*)(smem + 2 * G_TILE_B + nxt * G_TILE_B + (srow + 32 * i) * G_LDS_ROW + skc * 16) = rb[i];
        }
      }
      __syncthreads();
    }
    {
      const bf16_t* kg = keys0 + (size_t)hp * 128 * 128;
#pragma unroll
      for (int i = 0; i < 8; ++i) {
        const int c = tid + NT * i, row = c >> 4, c16 = c & 15;
        const u32x4 v = gload16(kg + row * 128 + c16 * 8);
        uint2 lo, hi2; lo.x = v[0]; lo.y = v[1]; hi2.x = v[2]; hi2.y = v[3];
        *(uint2*)(smem + row * KEY_ROW + c16 * 16) = lo;
        *(uint2*)(smem + row * KEY_ROW + c16 * 16 + 8) = hi2;
      }
    }
    __syncthreads();
    u32x4 qf[8];
    const float rstd_t = rstd_of(rss_in, mt * 128 + wv * 32 + r);
#pragma unroll
    for (int mb = 0; mb < 4; ++mb)
#pragma unroll
      for (int s2 = 0; s2 < 2; ++s2) {
        u32x4 f;
#pragma unroll
        for (int jj = 0; jj < 4; ++jj) f[jj] = pack2(acc[mb][8 * s2 + 2 * jj] * rstd_t, acc[mb][8 * s2 + 2 * jj + 1] * rstd_t);
        qf[mb * 2 + s2] = f;
      }
    int v[64];
#pragma unroll
    for (int kb = 0; kb < 4; ++kb) {
      f32x16 sa;
#pragma unroll
      for (int e = 0; e < 16; ++e) sa[e] = 0.f;
      const char* kr = smem + (kb * 32 + r) * KEY_ROW + hh * 8;
#pragma unroll
      for (int ksi = 0; ksi < 8; ++ksi) {
        const uint2 lo = *(const uint2*)(kr + ksi * 32);
        const uint2 hi2 = *(const uint2*)(kr + ksi * 32 + 16);
        u32x4 a; a[0] = lo.x; a[1] = lo.y; a[2] = hi2.x; a[3] = hi2.y;
        sa = __builtin_amdgcn_mfma_f32_32x32x16_bf16(__builtin_bit_cast(bf16x8, a), __builtin_bit_cast(bf16x8, qf[ksi]), sa, 0, 0, 0);
      }
#pragma unroll
      for (int e = 0; e < 16; ++e) {
        const int kidx = kb * 32 + (e & 3) + 8 * (e >> 2) + 4 * hh;
        v[kb * 16 + e] = (fkey_s(__float_as_int(sa[e])) & ~127) | kidx;
      }
    }
    bitonic_blocks<64, 16>(v);
    int c01[16], c23[16];
#pragma unroll
    for (int i = 0; i < 16; ++i) { c01[i] = v[i] > v[16 + i] ? v[i] : v[16 + i]; c23[i] = v[32 + i] > v[48 + i] ? v[32 + i] : v[48 + i]; }
    bitonic_merge16<true>(c01);
    bitonic_merge16<false>(c23);
    int d[16];
#pragma unroll
    for (int i = 0; i < 16; ++i) d[i] = c01[i] > c23[i] ? c01[i] : c23[i];
    bitonic_merge16<true>(d);
    int f[16];
#pragma unroll
    for (int i = 0; i < 16; ++i) { const int o = shxi(d[15 - i], 32, lane); f[i] = d[i] > o ? d[i] : o; }
    bitonic_merge16<true>(f);
    {
      const int token = mt * 128 + wv * 32 + r;
      GAS int* op = (GAS int*)tops + ((size_t)token * 16 + hp) * 16 + hh * 8;
      u32x4 o0, o1;
      if (hh) {
#pragma unroll
        for (int i = 0; i < 4; ++i) { o0[i] = f[8 + i]; o1[i] = f[12 + i]; }
        asm volatile("" : "+v"(o0), "+v"(o1));
      } else {
#pragma unroll
        for (int i = 0; i < 4; ++i) { o0[i] = f[i]; o1[i] = f[4 + i]; }
        asm volatile("" : "+v"(o0), "+v"(o1));
      }
      *(GAS u32x4*)op = o0; *(GAS u32x4*)(op + 4) = o1;
    }
  }
}

DI float dot8(const u32x4 a, const u32x4 b, float acc) {
  const unsigned a0 = a[0], a1 = a[1], a2 = a[2], a3 = a[3], b0 = b[0], b1 = b[1], b2 = b[2], b3 = b[3];
  acc = dot2bf(a0, b0, acc); acc = dot2bf(a1, b1, acc); acc = dot2bf(a2, b2, acc); acc = dot2bf(a3, b3, acc);
  return acc;
}
typedef signed char i8_t;
using i32x2 = __attribute__((ext_vector_type(2))) int;
DI void phase_quant_u(const int wq, const float* __restrict__ src, i8_t* __restrict__ dst, float* __restrict__ su, int nrows, const float* __restrict__ gain) {
  const int tid = ltid(wq); const int bid = lbid();
  const int lane = tid & 63, wv = tid >> 6;
  for (int row = bid * 4 + wv; row < nrows; row += gridDim.x * 4) {
    const float* r = src + (size_t)row * 1024 + 16 * lane;
    u32x4 a[4];
    {
      const float* gp = gain + (size_t)(row >> 14) * 1024 + 16 * lane;
#pragma unroll
      for (int i = 0; i < 4; ++i) {
        const u32x4 t = gload16(r + 4 * i);
        const f32x4v g4 = *(const f32x4v*)(gp + 4 * i);
        const unsigned t0 = t[0], t1 = t[1], t2 = t[2], t3 = t[3];
        a[i][0] = __float_as_uint(__uint_as_float(t0) * g4[0]); a[i][1] = __float_as_uint(__uint_as_float(t1) * g4[1]);
        a[i][2] = __float_as_uint(__uint_as_float(t2) * g4[2]); a[i][3] = __float_as_uint(__uint_as_float(t3) * g4[3]);
      }
    }
    float am = 0.f;
#pragma unroll
    for (int i = 0; i < 4; ++i) {
      const unsigned x0 = a[i][0], x1 = a[i][1], x2 = a[i][2], x3 = a[i][3];
      am = fmaxf(am, fmaxf(fmaxf(fabsf(__uint_as_float(x0)), fabsf(__uint_as_float(x1))), fmaxf(fabsf(__uint_as_float(x2)), fabsf(__uint_as_float(x3)))));
    }
    am = wave_max(am);
    const float inv = am > 0.f ? 127.f / am : 0.f;
    u32x4 o;
#pragma unroll
    for (int i = 0; i < 4; ++i) {
      const unsigned x0 = a[i][0], x1 = a[i][1], x2 = a[i][2], x3 = a[i][3];
      const int q0 = (int)rintf(__uint_as_float(x0) * inv), q1 = (int)rintf(__uint_as_float(x1) * inv);
      const int q2 = (int)rintf(__uint_as_float(x2) * inv), q3 = (int)rintf(__uint_as_float(x3) * inv);
      o[i] = (unsigned)(q0 & 255) | ((unsigned)(q1 & 255) << 8) | ((unsigned)(q2 & 255) << 16) | ((unsigned)(q3 & 255) << 24);
    }
    const size_t lyr = (size_t)row >> 14, e = (size_t)row & 16383;
    *(GAS u32x4*)(dst + (((lyr * 8 + (lane >> 3)) * 16384 + e) * 128 + (lane & 7) * 16)) = o;
    if (lane == 0) su[row] = am * (1.f / 127.f);
  }
}
DI void phase_cvt_v8(const int wq, const float* __restrict__ src, i8_t* __restrict__ dst, size_t n16) {
  const int tid = ltid(wq); const int bid = lbid();
  for (size_t i = (size_t)bid * NT + tid; i < n16; i += (size_t)gridDim.x * NT) {
    u32x4 o;
#pragma unroll
    for (int k = 0; k < 4; ++k) {
      const u32x4 a = gload16(src + i * 16 + 4 * k);
      const unsigned x0 = a[0], x1 = a[1], x2 = a[2], x3 = a[3];
      int pk = 0;
      pk = __builtin_amdgcn_cvt_pk_fp8_f32(__uint_as_float(x0) * 16.f, __uint_as_float(x1) * 16.f, pk, false);
      pk = __builtin_amdgcn_cvt_pk_fp8_f32(__uint_as_float(x2) * 16.f, __uint_as_float(x3) * 16.f, pk, true);
      o[k] = (unsigned)pk;
    }
    const size_t row = i >> 6; const int j = (int)(i & 63);
    const size_t lyr = row >> 14, e = row & 16383;
    *(GAS u32x4*)(dst + (((lyr * 8 + (j >> 3)) * 16384 + e) * 128 + (j & 7) * 16)) = o;
  }
}

DI void phase_peer_combine8(const int wq, PRef p, int l, char* smem, const float* __restrict__ rss_in) {
  const int tid = ltid(wq); const int bid = lbid();
  const int lane = tid & 63, wv = tid >> 6;
  int* wtops = (int*)(smem + wv * 1024);
  int ci, cj;
  if (lane < 16) { ci = 0; cj = lane; } else if (lane < 24) { ci = 1; cj = lane - 16; } else if (lane < 29) { ci = 2; cj = lane - 24; }
  else if (lane < 33) { ci = 3; cj = lane - 29; } else if (lane < 36) { ci = 4; cj = lane - 33; } else if (lane < 38) { ci = 5; cj = lane - 36; }
  else if (lane < 40) { ci = 6; cj = lane - 38; } else if (lane < 42) { ci = 7; cj = lane - 40; } else { ci = lane - 42 + 8; cj = 0; }
  const bool cvalid = lane < 50;
  if (!cvalid) { ci = 0; cj = 0; }
  const float* sul = p.su + (size_t)l * 16384;
  for (int token = bid * 4 + wv; token < T; token += gridDim.x * 4) {
    {
      const u32x4 tv = gload16(p.tops + (size_t)token * 256 + lane * 4);
      *(u32x4*)(wtops + lane * 4) = tv;
    }
    {
      const u32x4 a = gload16(p.hn + (size_t)token * D + 16 * lane), b2 = gload16(p.hn + (size_t)token * D + 16 * lane + 8);
      float xv[16];
      { const unsigned a0 = a[0], a1 = a[1], a2 = a[2], a3 = a[3], c0 = b2[0], c1 = b2[1], c2 = b2[2], c3 = b2[3];
        xv[0] = bflo(a0); xv[1] = bfhi(a0); xv[2] = bflo(a1); xv[3] = bfhi(a1); xv[4] = bflo(a2); xv[5] = bfhi(a2); xv[6] = bflo(a3); xv[7] = bfhi(a3);
        xv[8] = bflo(c0); xv[9] = bfhi(c0); xv[10] = bflo(c1); xv[11] = bfhi(c1); xv[12] = bflo(c2); xv[13] = bfhi(c2); xv[14] = bflo(c3); xv[15] = bfhi(c3); }
      float am = 0.f;
#pragma unroll
      for (int i = 0; i < 16; ++i) am = fmaxf(am, fabsf(xv[i]));
      am = wave_max(am);
      const float inv = am > 0.f ? 127.f / am : 0.f;
      u32x4 o;
#pragma unroll
      for (int i = 0; i < 4; ++i) {
        const int q0 = (int)rintf(xv[4 * i] * inv), q1 = (int)rintf(xv[4 * i + 1] * inv), q2 = (int)rintf(xv[4 * i + 2] * inv), q3 = (int)rintf(xv[4 * i + 3] * inv);
        o[i] = (unsigned)(q0 & 255) | ((unsigned)(q1 & 255) << 8) | ((unsigned)(q2 & 255) << 16) | ((unsigned)(q3 & 255) << 24);
      }
      *(GAS u32x4*)(p.x8 + (size_t)token * 1024 + 16 * lane) = o;
      if (lane == 0) p.sxq[token] = am * (1.f / 127.f) * rstd_of(rss_in, token);
    }
    asm volatile("s_waitcnt lgkmcnt(0)" ::: "memory");
#pragma unroll 1
    for (int hd = 0; hd < 8; ++hd) {
      const int k1 = wtops[(2 * hd) * 16 + ci], k2 = wtops[(2 * hd + 1) * 16 + cj];
      const float s1 = __int_as_float(fkey_s(k1 & ~127)), s2 = __int_as_float(fkey_s(k2 & ~127));
      const float val = s1 + s2;
      const int vk = cvalid ? ((fkey_s(__float_as_int(val)) & ~63) | (63 - lane)) : (int)0x80000000;
      int rank = 0;
#pragma unroll
      for (int c = 0; c < 50; ++c) rank += (__builtin_amdgcn_readlane(vk, c) > vk) ? 1 : 0;
      const float m = __int_as_float(__builtin_amdgcn_readlane(__float_as_int(val), 0));
      const bool sel = cvalid && rank < 16;
      const float ev = sel ? __expf(val - m) : 0.f;
      const float sum = wave_sum(ev);
      if (sel) {
        const int eid = (k1 & 127) * 128 + (k2 & 127);
        p.sel_id[(size_t)token * 128 + hd * 16 + rank] = eid;
        p.sel_g[(size_t)token * 128 + hd * 16 + rank] = ev / sum;
        p.sel_su[(size_t)token * 128 + hd * 16 + rank] = sul[eid];
      }
    }
    asm volatile("s_waitcnt lgkmcnt(0)" ::: "memory");
  }
}

DI void phase_peer_udot8(const int wq, PRef p, int l, char* smem, int coff) {
  const int tid = ltid(wq);
  const int lane = tid & 63, wv = tid >> 6;
  const int grp = lane >> 3, li = lane & 7;
  int* wid = (int*)(smem + wv * 4096);
  const bool b2 = li & 4, b1 = li & 2, b0 = li & 1;
  const int myx = (int)(xb_xcc_id() & 7u);
  for (int cs = 0; cs < 8; ++cs) {
    const int c = (myx + cs) & 7;
    const i8_t* U8 = p.u8 + ((size_t)l * 8 + c) * 16384 * 128 + li * 16;
    int* pb = (int*)p.pbuf + (size_t)c * T * 128;
    for (;;) {
      unsigned tb = 0;
      if (lane == 0) tb = atomicAdd(p.qctr + coff + c * 16, 8u);
      tb = __builtin_amdgcn_readfirstlane(tb);
      if (tb >= (unsigned)T) break;
      u32x4 xs[8];
      {
        int idl[16];
#pragma unroll
        for (int k = 0; k < 8; ++k) {
          idl[2 * k] = __builtin_nontemporal_load((const GAS int*)p.sel_id + (size_t)(tb + k) * 128 + lane);
          idl[2 * k + 1] = __builtin_nontemporal_load((const GAS int*)p.sel_id + (size_t)(tb + k) * 128 + 64 + lane);
          xs[k] = __builtin_nontemporal_load((gp_u32x4)(p.x8 + (size_t)(tb + k) * 1024 + c * 128 + li * 16));
        }
#pragma unroll
        for (int k = 0; k < 8; ++k) { wid[k * 128 + lane] = idl[2 * k]; wid[k * 128 + 64 + lane] = idl[2 * k + 1]; }
      }
      asm volatile("s_waitcnt lgkmcnt(0)" ::: "memory");
      auto issue = [&](int k, u32x4 (&g)[16]) {
        int ids[16];
#pragma unroll
        for (int i = 0; i < 4; ++i) {
          const u32x4 t4 = *(const u32x4*)(wid + k * 128 + grp * 16 + i * 4);
          ids[4 * i] = t4[0]; ids[4 * i + 1] = t4[1]; ids[4 * i + 2] = t4[2]; ids[4 * i + 3] = t4[3];
        }
#pragma unroll
        for (int i = 0; i < 16; ++i) g[i] = gload16(U8 + (size_t)ids[i] * 128);
      };
      auto consume = [&](int k, const u32x4 (&g)[16], const u32x4 cx) {
        const int x0 = (int)cx[0], x1 = (int)cx[1], x2 = (int)cx[2], x3 = (int)cx[3];
        int pp[16];
#pragma unroll
        for (int i = 0; i < 16; ++i) {
          const u32x4 u8 = g[i];
          const int u0 = (int)u8[0], u1 = (int)u8[1], u2 = (int)u8[2], u3 = (int)u8[3];
          int acc = __builtin_amdgcn_sdot4(x0, u0, 0, false);
          acc = __builtin_amdgcn_sdot4(x1, u1, acc, false);
          acc = __builtin_amdgcn_sdot4(x2, u2, acc, false);
          pp[i] = __builtin_amdgcn_sdot4(x3, u3, acc, false);
        }
        int q8[8], q4[4], q2[2];
#pragma unroll
        for (int i = 0; i < 8; ++i) { const int mine = b2 ? pp[i + 8] : pp[i], oth = b2 ? pp[i] : pp[i + 8]; q8[i] = mine + shxi(oth, 4, lane); }
#pragma unroll
        for (int i = 0; i < 4; ++i) { const int mine = b1 ? q8[i + 4] : q8[i], oth = b1 ? q8[i] : q8[i + 4]; q4[i] = mine + shxi(oth, 2, lane); }
#pragma unroll
        for (int i = 0; i < 2; ++i) { const int mine = b0 ? q4[i + 2] : q4[i], oth = b0 ? q4[i] : q4[i + 2]; q2[i] = mine + shxi(oth, 1, lane); }
        i32x2 ov; ov[0] = q2[0]; ov[1] = q2[1];
        __builtin_nontemporal_store(ov, (GAS i32x2*)(pb + (size_t)(tb + k) * 128 + 2 * lane));
      };
      u32x4 ga[16], gb[16];
      issue(0, ga);
#pragma unroll
      for (int k2 = 0; k2 < 4; ++k2) {
        issue(2 * k2 + 1, gb);
        consume(2 * k2, ga, xs[2 * k2]);
        if (k2 < 3) issue(2 * k2 + 2, ga);
        consume(2 * k2 + 1, gb, xs[2 * k2 + 1]);
      }
      asm volatile("s_waitcnt lgkmcnt(0)" ::: "memory");
    }
  }
}

DI void phase_peer_w(const int wq, PRef p) {
  const int tid = ltid(wq); const int bid = lbid();
  const int lane = tid & 63, wv = tid >> 6;
  for (int token = bid * 4 + wv; token < T; token += gridDim.x * 4) {
    i32x2 pp8[8];
#pragma unroll
    for (int cc = 0; cc < 8; ++cc) pp8[cc] = __builtin_nontemporal_load((const GAS i32x2*)((const int*)p.pbuf + ((size_t)cc * T + token) * 128 + 2 * lane));
    const u32x2 gg = __builtin_nontemporal_load((const GAS u32x2*)(p.sel_g + (size_t)token * 128 + 2 * lane));
    const u32x2 su2 = __builtin_nontemporal_load((const GAS u32x2*)(p.sel_su + (size_t)token * 128 + 2 * lane));
    const float sxv = p.sxq[token];
    int d0 = 0, d1 = 0;
#pragma unroll
    for (int cc = 0; cc < 8; ++cc) { d0 += pp8[cc][0]; d1 += pp8[cc][1]; }
    const float f0 = (float)d0 * (sxv * __uint_as_float(su2[0])), f1 = (float)d1 * (sxv * __uint_as_float(su2[1]));
    u32x2 w2; w2[0] = __float_as_uint(__uint_as_float(gg[0]) * gelu_tanh(f0) * 0.0625f); w2[1] = __float_as_uint(__uint_as_float(gg[1]) * gelu_tanh(f1) * 0.0625f);
    *(GAS u32x2*)(p.sel_g + (size_t)token * 128 + 2 * lane) = w2;
  }
}

DI void phase_peer_vacc8(const int wq, PRef p, int l, char* smem, int coff, int dry, int rss_idx) {
  const int myx = (int)(xb_xcc_id() & 7u);
  for (int cs = 0; cs < 8; ++cs) {
    const int c = (myx + cs) & 7;
    for (;;) {
      const int tid = ltid(wq);
      const int lane = tid & 63, wv = tid >> 6;
      int* wid = (int*)(smem + wv * 8192);
      float* ww = (float*)(smem + wv * 8192 + 4096);
      const int grp = lane >> 3, li = lane & 7;
      const bool g2 = grp & 4, g1 = grp & 2, g0 = grp & 1;
      const i8_t* V8 = p.v8 + ((size_t)l * 8 + c) * 16384 * 128 + li * 16;
      const int chan = c * 128 + li * 16 + 2 * grp;
      unsigned tb = 0;
      if (lane == 0) tb = atomicAdd(p.qctr + coff + c * 16, 8u);
      tb = __builtin_amdgcn_readfirstlane(tb);
      if (tb >= (unsigned)T) break;
      {
        u32x4 iv[4], wv4[4];
#pragma unroll
        for (int j4 = 0; j4 < 4; ++j4) {
          iv[j4] = __builtin_nontemporal_load((gp_u32x4)(p.sel_id + (size_t)tb * 128 + j4 * 256 + lane * 4));
          wv4[j4] = __builtin_nontemporal_load((gp_u32x4)(p.sel_g + (size_t)tb * 128 + j4 * 256 + lane * 4));
        }
#pragma unroll
        for (int j4 = 0; j4 < 4; ++j4) { *(u32x4*)(wid + j4 * 256 + lane * 4) = iv[j4]; *(u32x4*)(ww + j4 * 256 + lane * 4) = wv4[j4]; }
      }
      asm volatile("s_waitcnt lgkmcnt(0)" ::: "memory");
      auto issue = [&](int hh_, u32x4 (&g)[8]) {
        const int k = hh_ >> 1, hf = hh_ & 1;
        int ids[8];
#pragma unroll
        for (int i = 0; i < 2; ++i) {
          const u32x4 t4 = *(const u32x4*)(wid + k * 128 + grp * 16 + hf * 8 + i * 4);
          ids[4 * i] = t4[0]; ids[4 * i + 1] = t4[1]; ids[4 * i + 2] = t4[2]; ids[4 * i + 3] = t4[3];
        }
#pragma unroll
        for (int i = 0; i < 8; ++i) g[i] = gload16(V8 + (size_t)ids[i] * 128);
      };
      float o[16];
      u32x2 hcur;
      auto accum = [&](int hh_, const u32x4 (&g)[8]) {
        const int k = hh_ >> 1, hf = hh_ & 1;
        if (hf == 0) {
#pragma unroll
          for (int i = 0; i < 16; ++i) o[i] = 0.f;
          hcur = __builtin_nontemporal_load((GAS u32x2*)((GAS float*)p.h + ((size_t)tb + k) * D + chan));
        }
#pragma unroll
        for (int i = 0; i < 8; ++i) {
          const u32x4 v8 = g[i];
          const float w = ww[k * 128 + grp * 16 + hf * 8 + i];
          const int v0 = (int)v8[0], v1 = (int)v8[1], v2 = (int)v8[2], v3 = (int)v8[3];
          f32x2v t2;
          t2 = __builtin_amdgcn_cvt_pk_f32_fp8(v0, false); o[0] = fmaf(w, t2[0], o[0]); o[1] = fmaf(w, t2[1], o[1]);
          t2 = __builtin_amdgcn_cvt_pk_f32_fp8(v0, true);  o[2] = fmaf(w, t2[0], o[2]); o[3] = fmaf(w, t2[1], o[3]);
          t2 = __builtin_amdgcn_cvt_pk_f32_fp8(v1, false); o[4] = fmaf(w, t2[0], o[4]); o[5] = fmaf(w, t2[1], o[5]);
          t2 = __builtin_amdgcn_cvt_pk_f32_fp8(v1, true);  o[6] = fmaf(w, t2[0], o[6]); o[7] = fmaf(w, t2[1], o[7]);
          t2 = __builtin_amdgcn_cvt_pk_f32_fp8(v2, false); o[8] = fmaf(w, t2[0], o[8]); o[9] = fmaf(w, t2[1], o[9]);
          t2 = __builtin_amdgcn_cvt_pk_f32_fp8(v2, true);  o[10] = fmaf(w, t2[0], o[10]); o[11] = fmaf(w, t2[1], o[11]);
          t2 = __builtin_amdgcn_cvt_pk_f32_fp8(v3, false); o[12] = fmaf(w, t2[0], o[12]); o[13] = fmaf(w, t2[1], o[13]);
          t2 = __builtin_amdgcn_cvt_pk_f32_fp8(v3, true);  o[14] = fmaf(w, t2[0], o[14]); o[15] = fmaf(w, t2[1], o[15]);
        }
        if (hf == 1) {
          float r8[8], r4[4], r2[2];
#pragma unroll
          for (int i = 0; i < 8; ++i) { const float mine = g2 ? o[i + 8] : o[i], oth = g2 ? o[i] : o[i + 8]; r8[i] = mine + shx(oth, 32, lane); }
#pragma unroll
          for (int i = 0; i < 4; ++i) { const float mine = g1 ? r8[i + 4] : r8[i], oth = g1 ? r8[i] : r8[i + 4]; r4[i] = mine + shx(oth, 16, lane); }
#pragma unroll
          for (int i = 0; i < 2; ++i) { const float mine = g0 ? r4[i + 2] : r4[i], oth = g0 ? r4[i] : r4[i + 2]; r2[i] = mine + shx(oth, 8, lane); }
          if (!dry) {
            const size_t token = (size_t)tb + k;
            GAS float* hp = (GAS float*)p.h + token * D + chan;
            const u32x2 ch = hcur;
            const float h0 = __uint_as_float(ch[0]) + r2[0], h1 = __uint_as_float(ch[1]) + r2[1];
            u32x2 sv; sv[0] = __float_as_uint(h0); sv[1] = __float_as_uint(h1);
            __builtin_nontemporal_store(sv, (GAS u32x2*)hp);
            *(GAS unsigned*)(p.hn + token * D + chan) = pack2(h0, h1);
            if (rss_idx >= 0) {
              const float ss = wave_sum(h0 * h0 + h1 * h1);
              if (lane < 2) p.rss[((size_t)rss_idx * T + token) * 16 + 2 * c + lane] = lane == 0 ? ss : 0.f;
            }
          }
        }
      };
      u32x4 gA[8], gB[8], gC[8];
      issue(0, gA); issue(1, gB);
#pragma unroll
      for (int h3 = 0; h3 < 15; h3 += 3) {
        asm volatile("" ::: "memory");
        issue(h3 + 2, gC); accum(h3, gA);
        asm volatile("" ::: "memory");
        issue(h3 + 3, gA); accum(h3 + 1, gB);
        asm volatile("" ::: "memory");
        if (h3 + 4 < 16) issue(h3 + 4, gB);
        accum(h3 + 2, gC);
      }
      accum(15, gA);
      asm volatile("s_waitcnt lgkmcnt(0)" ::: "memory");
    }
  }
}

DI void phase_final_norm(const int wq, const float* __restrict__ in, const float* __restrict__ g, float* __restrict__ out, int rows) {
  const int tid = ltid(wq); const int bid = lbid();
  const int lane = tid & 63, wv = tid >> 6;
  f32x4v gv[4];
#pragma unroll
  for (int i = 0; i < 4; ++i) gv[i] = *(const f32x4v*)(g + i * 256 + lane * 4);
  for (int r = bid * 4 + wv; r < rows; r += gridDim.x * 4) {
    const float* pr = in + (size_t)r * D;
    u32x4 v[4];
#pragma unroll
    for (int i = 0; i < 4; ++i) v[i] = gload16(pr + i * 256 + lane * 4);
    float ss = 0.f;
#pragma unroll
    for (int i = 0; i < 4; ++i) {
      const float a = __uint_as_float(v[i][0]), b = __uint_as_float(v[i][1]), c = __uint_as_float(v[i][2]), d = __uint_as_float(v[i][3]);
      ss += a * a + b * b + c * c + d * d;
    }
    ss = wave_sum(ss);
    const float rs = rsqrtf(ss / (float)D + 1e-6f);
#pragma unroll
    for (int i = 0; i < 4; ++i) {
      u32x4 ov;
#pragma unroll
      for (int e = 0; e < 4; ++e) ov[e] = __float_as_uint(__uint_as_float(v[i][e]) * rs * gv[i][e]);
      *(GAS u32x4*)(out + (size_t)r * D + i * 256 + lane * 4) = ov;
    }
  }
}

#define PROBE 0
constexpr int SMEM_BYTES = 73728;
__global__ void __launch_bounds__(NT, 2) mega(Params pk) {
  __shared__ __attribute__((aligned(16))) char smem_c[SMEM_BYTES];
  __shared__ uint4 xb_words;
  __shared__ Params sp;
  {
    const unsigned long long* src = (const unsigned long long*)&pk;
    unsigned long long* dst = (unsigned long long*)&sp;
    if (threadIdx.x < sizeof(Params) / 8) dst[threadIdx.x] = src[threadIdx.x];
  }
  if (threadIdx.x == 0) xb_words = make_uint4(0u, 0u, 0u, 0u);
  __syncthreads();
#define p (*lp((const __attribute__((address_space(3))) Params*)&sp))
  float* smem = (float*)smem_c;
  const int wq = __builtin_amdgcn_readfirstlane((int)(threadIdx.x >> 6));
  (void)xcd_barrier_post(p.bar, (volatile LAS unsigned*)&xb_words);
#define GRID_BARRIER() do { XcdBarrier bb_; bb_.bar = p.bar; bb_.x = xb_xcc_id(); bb_.st = (volatile LAS unsigned*)&xb_words; xcd_barrier(bb_); } while (0)

  phase_convert(wq, p.even_w_in, D, EVEN_IN, EVEN_IN, p.w_even_in, EVEN_IN, nullptr, 2, (size_t)D * EVEN_IN, (size_t)EVEN_IN * D, 0, smem, p.mix_norm, 2 * D);
  phase_convert(wq, p.even_pool_w, 128, 128, 128, p.w_even_pool, 128, p.even_pool_scale, 8, 128 * 128, 128 * 128, 128, smem);
  phase_convert(wq, p.even_w_out, D, D, D, p.w_even_out, D, nullptr, 2, (size_t)D * D, (size_t)D * D, 0, smem);
  phase_convert(wq, p.odd_w_in, D, ODD_IN, ODD_IN, p.w_odd_in, 3840, nullptr, 2, (size_t)D * ODD_IN, (size_t)3840 * D, 0, smem, p.mix_norm + D, 2 * D);
  phase_convert(wq, p.odd_w_uv, 128, 64, 64, p.w_odd_uv, 128, nullptr, 16, 128 * 64, 128 * 128, 0, smem);
  phase_convert(wq, p.odd_w_out, D, D, D, p.w_odd_out, D, nullptr, 2, (size_t)D * D, (size_t)D * D, 0, smem);
  phase_convert(wq, p.xattn_wq, D, D, D, p.w_xq, D, nullptr, 4, (size_t)D * D, (size_t)D * D, 0, smem, p.xattn_norm, D);
  phase_convert(wq, p.xattn_wkv, D, 2048, 2048, p.w_xkv, 2048, nullptr, 4, (size_t)D * 2048, (size_t)2048 * D, 0, smem);
  phase_convert(wq, p.xattn_wo, D, D, D, p.w_xo, D, nullptr, 4, (size_t)D * D, (size_t)D * D, 0, smem);
  phase_convert(wq, p.peer_wq, D, 2048, 2048, p.w_pq, 2048, nullptr, 4, (size_t)D * 2048, (size_t)2048 * D, 0, smem, p.peer_norm, D);
  phase_quant_u(wq, p.peer_u, p.u8, p.su, DEPTH * 16384, p.peer_norm);
  phase_cvt_v8(wq, p.peer_v, p.v8, (size_t)DEPTH * 16384 * 1024 / 16);
  phase_cvt_rows(wq, p.peer_keys, p.keys16, (size_t)DEPTH * 16 * 128 * 128 / 8);
  phase_init_h(wq, p.x, p.h, p.hn, p.rss);
  phase_lb(wq, p);
  phase_rmsnorm_bf(wq, p.mem, D, p.mem_norm, p.memn, D, NB * NMEM, D);
  GRID_BARRIER();
  for (int l = 0; l < DEPTH; ++l)
    phase_gemm_bf16<3>(wq, p.memn, D, p.w_xkv + (size_t)l * 2048 * D, p.kvh + (size_t)l * 2 * 2048 * 1024, 2048, NB * NMEM, 2048, D, smem_c, 0);
  GRID_BARRIER();
  for (int l = 0; l < DEPTH; ++l) {
    const int j = l >> 1;
    if ((l & 1) == 0) {
      phase_gemm_bf16<2, 1>(wq, p.hn, D, p.w_even_in + (size_t)j * EVEN_IN * D, p.P16, EVEN_IN, T, EVEN_IN, D, smem_c, 0, 1, 0, 0, 0, 1, 0, 0, p.rss + (size_t)(3 * l) * T * 16);
      GRID_BARRIER();
      phase_evenmix(wq, p, j);
      GRID_BARRIER();
      phase_gemm_bf16<2>(wq, p.pool, 512, p.w_even_pool + (size_t)j * 4 * 128 * 128, p.Y + 512, D, T, 128, 128, smem_c, 0, 4, 128, 128 * 128, 128);
      GRID_BARRIER();
      phase_gemm_bf16<1>(wq, p.Y, D, p.w_even_out + (size_t)j * D * D, p.h, D, T, D, D, smem_c, 0, 1, 0, 0, 0, 1, 0, 0, nullptr, p.hn, p.rss + (size_t)(3 * l + 1) * T * 16);
      GRID_BARRIER();
    } else {
      phase_gemm_bf16<2, 1>(wq, p.hn, D, p.w_odd_in + (size_t)j * 3840 * D, p.P16, ODD_IN, T, ODD_IN, D, smem_c, 0, 1, 0, 0, 0, 1, 0, 0, p.rss + (size_t)(3 * l) * T * 16);
      GRID_BARRIER();
      phase_dsa_prep(wq, p, j);
      GRID_BARRIER();
      phase_dsa_scores(wq, p, smem_c);
      GRID_BARRIER();
      phase_hgrn_scan(wq, p, l, smem_c);
      phase_dsa_attend(wq, p, j, smem_c, 64 * j);
      GRID_BARRIER();
      phase_gemm_bf16<2>(wq, p.lat, D, p.w_odd_uv + (size_t)j * 8 * 128 * 128, p.Y, D, T, 64, 128, smem_c, 0, 8, 128, 128 * 128, 64);
      phase_hgrn_post(wq, p, j);
      GRID_BARRIER();
      phase_gemm_bf16<1>(wq, p.Y, D, p.w_odd_out + (size_t)j * D * D, p.h, D, T, D, D, smem_c, 0, 1, 0, 0, 0, 1, 0, 0, nullptr, p.hn, p.rss + (size_t)(3 * l + 1) * T * 16);
      GRID_BARRIER();
    }
    phase_gemm_bf16<2, 1>(wq, p.hn, D, p.w_xq + (size_t)l * D * D, p.q16, D, T, D, D, smem_c, 0, 1, 0, 0, 0, 1, 0, 0, p.rss + (size_t)(3 * l + 1) * T * 16);
    GRID_BARRIER();
    phase_gemm_bf16<4>(wq, p.q16, D, p.kvh + (size_t)l * 2 * 2048 * 1024, p.sx, 256, S, 256, 256, smem_c, 0, 32, (size_t)S * D, 256 * 256, (size_t)S * 1024, 4, 256, (size_t)S * 256);
    GRID_BARRIER();
    phase_softmax256(wq, (const bf16_t*)p.sx, p.p16, T * 4);
    GRID_BARRIER();
    phase_gemm_bf16<2>(wq, p.p16, 256, p.kvh + (size_t)l * 2 * 2048 * 1024 + (size_t)2048 * 1024, p.Y, D, S, 256, 256, smem_c, 0, 32, (size_t)S * 1024, 256 * 256, (size_t)S * D, 4, (size_t)S * 256, 256);
    GRID_BARRIER();
    phase_gemm_bf16<1>(wq, p.Y, D, p.w_xo + (size_t)l * D * D, p.h, D, T, D, D, smem_c, 0, 1, 0, 0, 0, 1, 0, 0, nullptr, p.hn, p.rss + (size_t)(3 * l + 2) * T * 16);
    GRID_BARRIER();
    phase_peer_qs(wq, p.hn, p.w_pq + (size_t)l * 2048 * D, p.keys16 + (size_t)l * 16 * 128 * 128, p.tops, smem_c, p.rss + (size_t)(3 * l + 2) * T * 16);
    GRID_BARRIER();
    phase_peer_combine8(wq, p, l, smem_c, p.rss + (size_t)(3 * l + 2) * T * 16);
    GRID_BARRIER();
    phase_peer_udot8(wq, p, l, smem_c, 256 + (l * 2 + 0) * 128);
    GRID_BARRIER();
    phase_peer_w(wq, p);
    GRID_BARRIER();
    phase_peer_vacc8(wq, p, l, smem_c, 256 + (l * 2 + 1) * 128, 0, l + 1 < DEPTH ? 3 * l + 3 : -1);
    GRID_BARRIER();
  }
  phase_final_norm(wq, p.h, p.final_norm, p.out, T);
}

#undef p
extern "C" void kernel_launch(void* const* d_in, const int* in_sizes, int n_in, void* d_out, int out_size, void* d_ws, size_t ws_size,
                              hipStream_t stream) {
  Params p; memset(&p, 0, sizeof(p));
  const float* const* in = (const float* const*)d_in;
  p.x = in[0]; p.mem = in[1]; p.mix_norm = in[2]; p.even_w_in = in[3]; p.even_conv_w = in[4]; p.even_pool_w = in[5];
  p.even_pool_scale = in[6]; p.even_w_out = in[7]; p.odd_w_in = in[8]; p.odd_kv_norm = in[9]; p.odd_w_uv = in[10];
  p.odd_hg_norm = in[11]; p.odd_w_out = in[12]; p.hgrn_gamma = in[13]; p.rel_bias = in[14]; p.mem_norm = in[15];
  p.xattn_norm = in[16]; p.xattn_wq = in[17]; p.xattn_wkv = in[18]; p.xattn_wo = in[19]; p.peer_norm = in[20];
  p.peer_wq = in[21]; p.peer_keys = in[22]; p.peer_u = in[23]; p.peer_v = in[24]; p.final_norm = in[25];
  p.out = (float*)d_out;
  char* w = (char*)d_ws;
  auto take = [&](size_t bytes) { char* r = w; w += (bytes + 255) / 256 * 256; return r; };
  p.bar = (unsigned*)take((XCD_BAR_WORDS + 2048) * 4); p.qctr = p.bar + XCD_BAR_WORDS;
  p.h = (float*)take((size_t)T * D * 4); p.P = (float*)take((size_t)T * ODD_IN * 4); p.P16 = (bf16_t*)p.P;
  p.oraw = (float*)take((size_t)T * 512 * 4); p.lb = (float*)take(DEPTH * 512 * 4);
  p.hn = (bf16_t*)take((size_t)T * D * 2); p.Y = (bf16_t*)take((size_t)T * D * 2); p.pool = (bf16_t*)take((size_t)T * 512 * 2);
  p.memn = (bf16_t*)take((size_t)NB * NMEM * D * 2); p.lat = (bf16_t*)take((size_t)T * D * 2);
  p.w_even_in = (bf16_t*)take((size_t)2 * EVEN_IN * D * 2); p.w_even_pool = (bf16_t*)take((size_t)8 * 128 * 128 * 2);
  p.w_even_out = (bf16_t*)take((size_t)2 * D * D * 2); p.w_odd_in = (bf16_t*)take((size_t)2 * 3840 * D * 2);
  p.w_odd_uv = (bf16_t*)take((size_t)16 * 128 * 128 * 2); p.w_odd_out = (bf16_t*)take((size_t)2 * D * D * 2);
  p.w_xq = (bf16_t*)take((size_t)4 * D * D * 2); p.w_xkv = (bf16_t*)take((size_t)4 * 2048 * D * 2); p.w_xo = (bf16_t*)take((size_t)4 * D * D * 2);
  p.w_pq = (bf16_t*)take((size_t)4 * 2048 * D * 2);
  p.u8 = (signed char*)take((size_t)DEPTH * 16384 * 1024); p.v8 = (signed char*)take((size_t)DEPTH * 16384 * 1024); p.x8 = (signed char*)take((size_t)T * 1024);
  p.su = (float*)take((size_t)DEPTH * 16384 * 4); p.sxq = (float*)take((size_t)T * 4); p.sel_su = (float*)take((size_t)T * 128 * 4);
  p.keys16 = (bf16_t*)take((size_t)DEPTH * 16 * 128 * 128 * 2); p.kvh = (bf16_t*)take((size_t)DEPTH * 2 * 2048 * 1024 * 2); p.rss = (float*)take((size_t)12 * T * 16 * 4);
  {
    char* a = (char*)p.P;
    p.sx = (float*)a; a += (size_t)T * 4 * 256 * 4;
    p.p16 = (bf16_t*)a; a += (size_t)T * 4 * 256 * 2;
    p.q16 = (bf16_t*)a; a += (size_t)T * D * 2;
    p.tops = (int*)a; a += (size_t)T * 256 * 4;
    p.sel_id = (int*)a; a += (size_t)T * 128 * 4;
    p.sel_g = (float*)a; a += (size_t)T * 128 * 4;
    p.pbuf = (float*)a;
  }
  p.qlat16 = (bf16_t*)take((size_t)T * 1024 * 2); p.ckv16 = (bf16_t*)take((size_t)T * 128 * 2); p.iq16 = (bf16_t*)take((size_t)T * 512 * 2);
  p.ik16 = (bf16_t*)take((size_t)T * 64 * 2); p.sc = (float*)take((size_t)T * 2048 * 4);

  p.probe = 1;
  static int grid = 0;
  if (!grid) {
    int dev = 0, cus = 0, per_cu = 0;
    (void)hipGetDevice(&dev);
    (void)hipDeviceGetAttribute(&cus, hipDeviceAttributeMultiprocessorCount, dev);
    (void)hipOccupancyMaxActiveBlocksPerMultiprocessor(&per_cu, mega, NT, 0);
    if (per_cu > 2) per_cu = 2;
    if (per_cu < 1) per_cu = 1;
    grid = cus * per_cu;
  }
  (void)hipMemsetAsync(p.bar, 0, (XCD_BAR_WORDS + 2048) * sizeof(unsigned), stream);
  mega<<<grid, NT, 0, stream>>>(p);
}
```

```cpp
#include <hip/hip_runtime.h>
#include <hip/hip_bf16.h>
#include <stdint.h>
#include <math.h>
#include <string.h>

#define DI __device__ __forceinline__

constexpr int D = 1024, NB = 8, S = 2048, T = NB * S, DEPTH = 4, NMEM = 256;
constexpr int EVEN_IN = 2048, ODD_IN = 3784;
constexpr int NT = 256;

typedef unsigned short bf16_t;
struct Params {
  const float *x, *mem, *mix_norm, *even_w_in, *even_conv_w, *even_pool_w, *even_pool_scale, *even_w_out;
  const float *odd_w_in, *odd_kv_norm, *odd_w_uv, *odd_hg_norm, *odd_w_out, *hgrn_gamma, *rel_bias, *mem_norm;
  const float *xattn_norm, *xattn_wq, *xattn_wkv, *xattn_wo, *peer_norm, *peer_wq, *peer_keys, *peer_u, *peer_v, *final_norm;
  float* out;
  float *h, *P, *kv, *ckv, *oraw, *lb; bf16_t* P16;
  bf16_t *hn, *Y, *pool, *memn, *lat;
  bf16_t *u16, *v16, *keys16; int* tops; signed char *u8, *v8, *x8; float *su, *sxq, *sel_su;
  float* rss;
  bf16_t *q16, *kvh, *p16; float* sx; int* sel_id; float* sel_g; float* pbuf;
  bf16_t *qlat16, *ckv16, *iq16, *ik16; float* sc; unsigned* qctr;
  bf16_t *w_even_in, *w_even_pool, *w_even_out, *w_odd_in, *w_odd_uv, *w_odd_out, *w_xq, *w_xkv, *w_xo, *w_pq;
  unsigned* bar;
  int probe, pad_;
};

#define XB_TMO      128
#define XB_XCNT(j)  (256  + 64 * (j))
#define XB_XSUB(j)  (1280 + 64 * (j))
#define XB_XGEN(j)  (2304 + 64 * (j))
#define XB_TOP      3328
#define XB_TOPGEN   3392
#define XCD_BAR_WORDS 3456
#define XB_SPIN_CAP (1u << 18)
#define LAS __attribute__((address_space(3)))

__device__ __forceinline__ unsigned xb_ld(unsigned* p)              { return __hip_atomic_load(p, __ATOMIC_RELAXED, __HIP_MEMORY_SCOPE_AGENT); }
__device__ __forceinline__ unsigned xb_add(unsigned* p, unsigned v) { return __hip_atomic_fetch_add(p, v, __ATOMIC_RELAXED, __HIP_MEMORY_SCOPE_AGENT); }
__device__ __forceinline__ unsigned xb_xcc_id() { return (unsigned)__builtin_amdgcn_s_getreg((3 << 11) | 20) & 0xFu; }
#define XB_SPIN(cond, bar) do { unsigned _sp = 0; while (cond) { __builtin_amdgcn_s_sleep(1); \
    if ((++_sp & 255u) == 0u) { if (xb_ld(&(bar)[XB_TMO])) break; if (_sp > XB_SPIN_CAP) { atomicAdd(&(bar)[XB_TMO], 1u); break; } } } } while (0)

typedef const __attribute__((address_space(3))) Params& PRef;
DI const __attribute__((address_space(3))) Params* lp(const __attribute__((address_space(3))) Params* q) { asm volatile("" : "+v"(q)); return q; }
struct XcdBarrier {
    unsigned* bar; unsigned x;
    volatile LAS unsigned* st;
};

__device__ __forceinline__ XcdBarrier xcd_barrier_post(unsigned* bar, volatile LAS unsigned* st) {
    XcdBarrier b; b.bar = bar; b.x = xb_xcc_id(); b.st = st;
    if (threadIdx.x == 0) (void)xb_add(&bar[XB_XCNT(b.x)], 1u);
    return b;
}
__device__ __forceinline__ void xcd_barrier_complete(unsigned* bar, unsigned x, unsigned& nloc, unsigned& nx) {
    const unsigned G = gridDim.x * gridDim.y * gridDim.z;
    unsigned sum, cnt, mine, sp = 0u;
    for (;;) {
        sum = 0u; cnt = 0u; mine = 0u;
#pragma unroll
        for (unsigned j = 0; j < 16; ++j) { const unsigned c = xb_ld(&bar[XB_XCNT(j)]); sum += c; cnt += (c > 0u) ? 1u : 0u; mine = (j == x) ? c : mine; }
        if (sum == G) break;
        __builtin_amdgcn_s_sleep(1);
        if ((++sp & 255u) == 0u) { if (xb_ld(&bar[XB_TMO])) break; if (sp > XB_SPIN_CAP) { atomicAdd(&bar[XB_TMO], 1u); break; } }
    }
    nloc = mine > 0u ? mine : 1u; nx = cnt > 0u ? cnt : 1u;
}

__device__ __forceinline__ void xcd_barrier(const XcdBarrier& b) {
    asm volatile("s_waitcnt vmcnt(0)" ::: "memory");
    __syncthreads();
    if (threadIdx.x == 0) {
        unsigned* bar = b.bar;
        __builtin_amdgcn_s_waitcnt(0);
        unsigned nloc = b.st[0], nx = b.st[1];
        if (nloc == 0u) { xcd_barrier_complete(bar, b.x, nloc, nx); b.st[0] = nloc; b.st[1] = nx; }
        const unsigned old = xb_add(&bar[XB_XSUB(b.x)], 1u);
        const unsigned gen = old / nloc;
        if (old + 1u == (gen + 1u) * nloc) {
            __builtin_amdgcn_fence(__ATOMIC_RELEASE, "agent");
            asm volatile("s_waitcnt vmcnt(0)" ::: "memory");
            const unsigned og = xb_add(&bar[XB_TOP], 1u);
            const unsigned tg = og / nx;
            if (og + 1u == (tg + 1u) * nx) xb_add(&bar[XB_TOPGEN], 1u);
            else XB_SPIN(xb_ld(&bar[XB_TOPGEN]) == tg, bar);
            __builtin_amdgcn_fence(__ATOMIC_ACQUIRE, "agent");
            xb_add(&bar[XB_XGEN(b.x)], 1u);
            asm volatile("s_waitcnt vmcnt(0)" ::: "memory");
        } else {
            XB_SPIN(xb_ld(&bar[XB_XGEN(b.x)]) == gen, bar);
            __builtin_amdgcn_fence(__ATOMIC_ACQUIRE, "agent");
            asm volatile("s_waitcnt vmcnt(0)" ::: "memory");
        }
    }
    __syncthreads();
}


typedef __bf16 bf16x2_t __attribute__((ext_vector_type(2)));
typedef float f32x2_t __attribute__((ext_vector_type(2)));
using bf16x8 = __attribute__((ext_vector_type(8))) short;
using f32x16 = __attribute__((ext_vector_type(16))) float;
using u32x4 = __attribute__((ext_vector_type(4))) unsigned;
using u32x2 = __attribute__((ext_vector_type(2))) unsigned;
using f32x4v = __attribute__((ext_vector_type(4))) float;
using f32x2v = __attribute__((ext_vector_type(2))) float;
#define GAS __attribute__((address_space(1)))
typedef const GAS u32x4* gp_u32x4;
DI u32x4 gload16(const void* p) { return *(gp_u32x4)(p); }
DI bf16_t f2bf(float f) { __bf16 b = (__bf16)f; return __builtin_bit_cast(unsigned short, b); }
DI unsigned pack2(float a, float b) { f32x2_t v = {a, b}; bf16x2_t r = __builtin_convertvector(v, bf16x2_t); return __builtin_bit_cast(unsigned, r); }
DI float bf2f(bf16_t u) { return __uint_as_float(((unsigned)u) << 16); }
DI float bflo(unsigned u) { return __uint_as_float(u << 16); }
DI float bfhi(unsigned u) { return __uint_as_float(u & 0xffff0000u); }
DI f32x4v bf4_to_f(const u32x2 v) { const unsigned a = v[0], b = v[1]; f32x4v r; r[0] = bflo(a); r[1] = bfhi(a); r[2] = bflo(b); r[3] = bfhi(b); return r; }
DI int ltid(int wq) { int t; asm volatile("v_mbcnt_lo_u32_b32 %0, -1, 0\n\tv_mbcnt_hi_u32_b32 %0, -1, %0" : "=v"(t)); return (wq << 6) | t; }
DI int lbid() { int b = blockIdx.x; asm volatile("" : "+s"(b)); return b; }
#define DPP_F(v, ctrl, rmask, bctl) __int_as_float(__builtin_amdgcn_update_dpp(0, __float_as_int(v), (ctrl), (rmask), 0xF, (bctl)))
DI float wave_sum(float v) {
  v += DPP_F(v, 0xB1, 0xF, true);
  v += DPP_F(v, 0x4E, 0xF, true);
  v += DPP_F(v, 0x141, 0xF, true);
  v += DPP_F(v, 0x140, 0xF, true);
  v += DPP_F(v, 0x142, 0xA, false);
  v += DPP_F(v, 0x143, 0xC, false);
  return __int_as_float(__builtin_amdgcn_readlane(__float_as_int(v), 63));
}
#define DPP_I(v, ctrl, rmask, bctl) __builtin_amdgcn_update_dpp(0, (v), (ctrl), (rmask), 0xF, (bctl))
DI int wave_sum_i(int v) {
  v += DPP_I(v, 0xB1, 0xF, true); v += DPP_I(v, 0x4E, 0xF, true); v += DPP_I(v, 0x141, 0xF, true); v += DPP_I(v, 0x140, 0xF, true);
  v += DPP_I(v, 0x142, 0xA, false); v += DPP_I(v, 0x143, 0xC, false);
  return __builtin_amdgcn_readlane(v, 63);
}
DI float wave_max(float v) {
  v = fmaxf(v, DPP_F(v, 0xB1, 0xF, true));
  v = fmaxf(v, DPP_F(v, 0x4E, 0xF, true));
  v = fmaxf(v, DPP_F(v, 0x141, 0xF, true));
  v = fmaxf(v, DPP_F(v, 0x140, 0xF, true));
  { const float t = __int_as_float(__builtin_amdgcn_update_dpp(__float_as_int(v), __float_as_int(v), 0x142, 0xA, 0xF, false)); v = fmaxf(v, t); }
  { const float t = __int_as_float(__builtin_amdgcn_update_dpp(__float_as_int(v), __float_as_int(v), 0x143, 0xC, 0xF, false)); v = fmaxf(v, t); }
  return __int_as_float(__builtin_amdgcn_readlane(__float_as_int(v), 63));
}
DI float rowsum16(float v) { v += DPP_F(v, 0x128, 0xF, true); v += DPP_F(v, 0x124, 0xF, true); v += DPP_F(v, 0x122, 0xF, true); v += DPP_F(v, 0x121, 0xF, true); return v; }
DI float rowmax16(float v) { v = fmaxf(v, DPP_F(v, 0x128, 0xF, true)); v = fmaxf(v, DPP_F(v, 0x124, 0xF, true)); v = fmaxf(v, DPP_F(v, 0x122, 0xF, true)); v = fmaxf(v, DPP_F(v, 0x121, 0xF, true)); return v; }
DI float shx(float v, int mask, int lane) { return __int_as_float(__builtin_amdgcn_ds_bpermute((lane ^ mask) << 2, __float_as_int(v))); }
DI int shxi(int v, int mask, int lane) { return __builtin_amdgcn_ds_bpermute((lane ^ mask) << 2, v); }
DI float gelu_tanh(float x) {
  const float k0 = 0.7978845608028654f, k1 = 0.044715f;
  return 0.5f * x * (1.f + tanhf(k0 * (x + k1 * x * x * x)));
}
DI float sigmoidf(float x) { return 1.f / (1.f + expf(-x)); }

DI float rstd_of(const float* __restrict__ rss, int row) {
  const float* q = rss + (size_t)row * 16;
  const f32x4v a = *(const f32x4v*)q, b = *(const f32x4v*)(q + 4), c = *(const f32x4v*)(q + 8), d = *(const f32x4v*)(q + 12);
  const float s0 = (a[0] + a[1]) + (a[2] + a[3]), s1 = (b[0] + b[1]) + (b[2] + b[3]), s2 = (c[0] + c[1]) + (c[2] + c[3]), s3 = (d[0] + d[1]) + (d[2] + d[3]);
  return rsqrtf(((s0 + s1) + (s2 + s3)) * (1.f / 1024.f) + 1e-6f);
}
DI void phase_init_h(const int wq, const float* __restrict__ x, float* __restrict__ h, bf16_t* __restrict__ hb, float* __restrict__ rss) {
  const int tid = ltid(wq); const int bid = lbid();
  const int lane = tid & 63, wv = tid >> 6;
  for (int r = bid * 4 + wv; r < T; r += gridDim.x * 4) {
    float ss = 0.f;
#pragma unroll
    for (int i = 0; i < 4; ++i) {
      const u32x4 v = gload16(x + (size_t)r * D + i * 256 + lane * 4);
      const unsigned v0 = v[0], v1 = v[1], v2 = v[2], v3 = v[3];
      const float a = __uint_as_float(v0), b = __uint_as_float(v1), c = __uint_as_float(v2), d = __uint_as_float(v3);
      ss += a * a + b * b + c * c + d * d;
      *(GAS u32x4*)(h + (size_t)r * D + i * 256 + lane * 4) = v;
      u32x2 o; o[0] = pack2(a, b); o[1] = pack2(c, d);
      *(GAS u32x2*)(hb + (size_t)r * D + i * 256 + lane * 4) = o;
    }
    ss = wave_sum(ss);
    if (lane < 16) rss[(size_t)r * 16 + lane] = lane == 0 ? ss : 0.f;
  }
}

DI void phase_rmsnorm_bf(const int wq, const float* __restrict__ in, int ldi, const float* __restrict__ g, bf16_t* __restrict__ out, int ldo, int rows, int W) {
  const int tid_ = ltid(wq); const int bid_ = lbid();
  const int lane = tid_ & 63, wv = tid_ >> 6;
  f32x4v gv[4];
#pragma unroll
  for (int i = 0; i < 4; ++i) gv[i] = *(const f32x4v*)(g + i * 256 + lane * 4);
  for (int r = bid_ * 4 + wv; r < rows; r += gridDim.x * 4) {
    const float* p = in + (size_t)r * ldi;
    u32x4 v[4];
#pragma unroll
    for (int i = 0; i < 4; ++i) v[i] = gload16(p + i * 256 + lane * 4);
    float ss = 0.f;
#pragma unroll
    for (int i = 0; i < 4; ++i) {
      const float a = __uint_as_float(v[i][0]), b = __uint_as_float(v[i][1]), c = __uint_as_float(v[i][2]), d = __uint_as_float(v[i][3]);
      ss += a * a + b * b + c * c + d * d;
    }
    ss = wave_sum(ss);
    const float rs = rsqrtf(ss / (float)W + 1e-6f);
    bf16_t* o = out + (size_t)r * ldo;
#pragma unroll
    for (int i = 0; i < 4; ++i) {
      u32x2 ov;
      ov[0] = pack2(__uint_as_float(v[i][0]) * rs * gv[i][0], __uint_as_float(v[i][1]) * rs * gv[i][1]);
      ov[1] = pack2(__uint_as_float(v[i][2]) * rs * gv[i][2], __uint_as_float(v[i][3]) * rs * gv[i][3]);
      *(GAS u32x2*)(o + i * 256 + lane * 4) = ov;
    }
  }
}

DI void phase_convert(const int wq, const float* __restrict__ W0, int K, int N, int ldw, bf16_t* __restrict__ Bt0, int Npad, const float* __restrict__ cs0,
                      int nbatch, size_t sW, size_t sBt, size_t sCS, float* smem, const float* __restrict__ rs0 = nullptr, size_t sRS = 0) {
  const int tid = ltid(wq); const int bid = lbid();
  float (*tl)[65] = (float (*)[65])smem;
  const int tk = K / 64, tn = Npad / 64;
  for (int tile0 = bid; tile0 < tk * tn * nbatch; tile0 += gridDim.x) {
    const int bt = tile0 / (tk * tn), tile = tile0 % (tk * tn);
    const int k0 = (tile / tn) * 64, n0 = (tile % tn) * 64;
    const float* W = W0 + (size_t)bt * sW;
    bf16_t* Bt = Bt0 + (size_t)bt * sBt;
    __syncthreads();
#pragma unroll 4
    for (int i = 0; i < 16; ++i) {
      const int k = i * 4 + (tid >> 6), n = tid & 63;
      float v = 0.f;
      if (n0 + n < N) { v = W[(size_t)(k0 + k) * ldw + n0 + n]; if (cs0) v *= cs0[(size_t)bt * sCS + n0 + n]; if (rs0) v *= rs0[(size_t)bt * sRS + k0 + k]; }
      tl[k][n] = v;
    }
    __syncthreads();
#pragma unroll 4
    for (int i = 0; i < 16; ++i) {
      const int n = i * 4 + (tid >> 6), k = tid & 63;
      Bt[(size_t)(n0 + n) * K + k0 + k] = f2bf(tl[k][n]);
    }
  }
}

constexpr int G_LDS_ROW = 144;
constexpr int G_TILE_B = 128 * G_LDS_ROW;
template <int MODE, int RS = 0>
DI void phase_gemm_bf16(const int wq, const bf16_t* __restrict__ A0, int lda, const bf16_t* __restrict__ B0, void* __restrict__ C0, int ldc,
                        int M, int N, int K, char* smem, int dry, int nbatch = 1, size_t sA = 0, size_t sB = 0, size_t sC = 0,
                        int inner = 1, size_t sA2 = 0, size_t sC2 = 0, const float* __restrict__ rss_in = nullptr, bf16_t* __restrict__ hb_out = nullptr, float* __restrict__ rss_out = nullptr) {
  const int tid = ltid(wq); const int bid = lbid();
  const int lane = tid & 63, wv = tid >> 6, wm = wv >> 1, wn = wv & 1;
  const int r = lane & 31, hh = lane >> 5;
  const int tm = M / 128, tn = (N + 127) / 128;
  const int nk = K / 64;
  const int srow = tid >> 3, skc = tid & 7;
  const int ntile_all = tm * tn * nbatch;
  const int per_x = (ntile_all + 7) >> 3;
  const int t_beg = (bid & 7) * per_x, t_end = (t_beg + per_x < ntile_all) ? t_beg + per_x : ntile_all;
  for (int tile0 = t_beg + (bid >> 3); tile0 < t_end; tile0 += (int)(gridDim.x >> 3)) {
    const int bt = tile0 / (tm * tn), tile = tile0 % (tm * tn);
    const int m0 = (tile / tn) * 128, n0 = (tile % tn) * 128;
    const int bhi = bt / inner, blo = bt % inner;
    const bf16_t* Ag = A0 + (size_t)bhi * sA + (size_t)blo * sA2 + (size_t)(m0 + srow) * lda + skc * 8;
    const bf16_t* Bg = B0 + (size_t)bt * sB + (size_t)(n0 + srow) * K + skc * 8;
    f32x16 acc[2][2];
#pragma unroll
    for (int i = 0; i < 2; ++i)
#pragma unroll
      for (int j = 0; j < 2; ++j)
#pragma unroll
        for (int e = 0; e < 16; ++e) acc[i][j][e] = 0.f;
    u32x4 ra[4], rb[4];
#pragma unroll
    for (int i = 0; i < 4; ++i) {
      ra[i] = gload16(Ag + (size_t)(32 * i) * lda);
      rb[i] = gload16(Bg + (size_t)(32 * i) * K);
    }
    __syncthreads();
#pragma unroll
    for (int i = 0; i < 4; ++i) {
      *(u32x4*)(smem + (srow + 32 * i) * G_LDS_ROW + skc * 16) = ra[i];
      *(u32x4*)(smem + 2 * G_TILE_B + (srow + 32 * i) * G_LDS_ROW + skc * 16) = rb[i];
    }
    __syncthreads();
#pragma unroll 1
    for (int kt = 0; kt < nk; ++kt) {
      const int cur = kt & 1;
      if (kt + 1 < nk) {
#pragma unroll
        for (int i = 0; i < 4; ++i) {
          ra[i] = gload16(Ag + (size_t)(32 * i) * lda + (kt + 1) * 64);
          rb[i] = gload16(Bg + (size_t)(32 * i) * K + (kt + 1) * 64);
        }
      }
      const char* As = smem + cur * G_TILE_B + (wm * 64 + r) * G_LDS_ROW + hh * 16;
      const char* Bs = smem + 2 * G_TILE_B + cur * G_TILE_B + (wn * 64 + r) * G_LDS_ROW + hh * 16;
#pragma unroll
      for (int ks = 0; ks < 4; ++ks) {
        bf16x8 a0 = *(const bf16x8*)(As + ks * 32);
        bf16x8 a1 = *(const bf16x8*)(As + 32 * G_LDS_ROW + ks * 32);
        bf16x8 b0 = *(const bf16x8*)(Bs + ks * 32);
        bf16x8 b1 = *(const bf16x8*)(Bs + 32 * G_LDS_ROW + ks * 32);
        acc[0][0] = __builtin_amdgcn_mfma_f32_32x32x16_bf16(a0, b0, acc[0][0], 0, 0, 0);
        acc[0][1] = __builtin_amdgcn_mfma_f32_32x32x16_bf16(a0, b1, acc[0][1], 0, 0, 0);
        acc[1][0] = __builtin_amdgcn_mfma_f32_32x32x16_bf16(a1, b0, acc[1][0], 0, 0, 0);
        acc[1][1] = __builtin_amdgcn_mfma_f32_32x32x16_bf16(a1, b1, acc[1][1], 0, 0, 0);
      }
      if (kt + 1 < nk) {
        const int nxt = cur ^ 1;
#pragma unroll
        for (int i = 0; i < 4; ++i) {
          *(u32x4*)(smem + nxt * G_TILE_B + (srow + 32 * i) * G_LDS_ROW + skc * 16) = ra[i];
          *(u32x4*)(smem + 2 * G_TILE_B + nxt * G_TILE_B + (srow + 32 * i) * G_LDS_ROW + skc * 16) = rb[i];
        }
      }
      __syncthreads();
    }
    if (RS) {
      if (tid < 128) ((float*)smem)[tid] = rstd_of(rss_in, m0 + tid);
      __syncthreads();
    }
#pragma unroll
    for (int i = 0; i < 2; ++i)
#pragma unroll
      for (int j = 0; j < 2; ++j) {
        const int col = n0 + wn * 64 + j * 32 + r;
        if (col < N && !dry) {
          const size_t base = (size_t)bhi * sC + (size_t)blo * sC2 + (size_t)(m0 + wm * 64 + i * 32 + 4 * hh) * ldc + col;
          if (RS) {
            const float* rp = (const float*)smem + wm * 64 + i * 32 + 4 * hh;
#pragma unroll
            for (int e = 0; e < 16; ++e) acc[i][j][e] *= rp[(e & 3) + 8 * (e >> 2)];
          }
          if (MODE == 1) {
            GAS float* cp = (GAS float*)C0 + base;
            float old[16];
#pragma unroll
            for (int e = 0; e < 16; ++e) old[e] = cp[(size_t)((e & 3) + 8 * (e >> 2)) * ldc];
#pragma unroll
            for (int e = 0; e < 16; ++e) { old[e] += acc[i][j][e]; acc[i][j][e] = old[e]; cp[(size_t)((e & 3) + 8 * (e >> 2)) * ldc] = old[e]; }
            if (hb_out) {
              GAS bf16_t* hp = (GAS bf16_t*)hb_out + base;
#pragma unroll
              for (int e = 0; e < 16; ++e) hp[(size_t)((e & 3) + 8 * (e >> 2)) * ldc] = f2bf(old[e]);
            }
          } else if (MODE == 0) {
            GAS float* cp = (GAS float*)C0 + base;
#pragma unroll
            for (int e = 0; e < 16; ++e) cp[(size_t)((e & 3) + 8 * (e >> 2)) * ldc] = acc[i][j][e];
          } else if (MODE == 2) {
            GAS bf16_t* cp = (GAS bf16_t*)C0 + base;
#pragma unroll
            for (int e = 0; e < 16; ++e) cp[(size_t)((e & 3) + 8 * (e >> 2)) * ldc] = f2bf(acc[i][j][e]);
          } else if (MODE == 4) {
            GAS bf16_t* cp = (GAS bf16_t*)C0 + base;
#pragma unroll
            for (int e = 0; e < 16; ++e) cp[(size_t)((e & 3) + 8 * (e >> 2)) * ldc] = f2bf(acc[i][j][e] * 0.0625f);
          } else {
            const int rowb = m0 + wm * 64 + i * 32 + 4 * hh;
            const int b_ = rowb >> 8, mm = rowb & 255;
            const int cc = col & 1023, hd_ = cc >> 8, dd = cc & 255;
            GAS bf16_t* kb = (GAS bf16_t*)C0;
            if (col < 1024) {
#pragma unroll
              for (int e = 0; e < 16; ++e) kb[((size_t)(b_ * 4 + hd_) * 256 + mm + (e & 3) + 8 * (e >> 2)) * 256 + dd] = f2bf(acc[i][j][e]);
            } else {
#pragma unroll
              for (int e = 0; e < 16; ++e) kb[(size_t)2048 * 1024 + ((size_t)(b_ * 4 + hd_) * 256 + dd) * 256 + mm + (e & 3) + 8 * (e >> 2)] = f2bf(acc[i][j][e]);
            }
          }
        }
      }
    if (MODE == 1 && rss_out && !dry) {
#pragma unroll
      for (int i = 0; i < 2; ++i) {
        float myv = 0.f;
#pragma unroll
        for (int e = 0; e < 16; ++e) {
          float v = acc[i][0][e] * acc[i][0][e] + acc[i][1][e] * acc[i][1][e];
          v = rowsum16(v);
          v += shx(v, 16, lane);
          if ((lane & 15) == e) myv = v;
        }
        if ((lane & 16) == 0) rss_out[(size_t)(m0 + wm * 64 + i * 32 + (lane & 3) + 8 * ((lane & 15) >> 2) + 4 * hh) * 16 + (n0 >> 7) * 2 + wn] = myv;
      }
    }
  }
}

template <int W>
DI void evenmix_run(const bf16_t* __restrict__ P, const float* __restrict__ cw, bf16_t* __restrict__ Y, bf16_t* __restrict__ pool, int t0, int c) {
  const int s0 = t0 & (S - 1);
  f32x4v w0 = *(const f32x4v*)(cw + c), w1 = *(const f32x4v*)(cw + 512 + c), w2 = *(const f32x4v*)(cw + 1024 + c);
  const f32x4v zero = {0.f, 0.f, 0.f, 0.f};
  auto ld = [&](int t, int off) { const u32x2 v = *(const GAS u32x2*)(P + (size_t)t * EVEN_IN + off + c); return bf4_to_f(v); };
  f32x4v xm2 = zero, xm1 = zero;
  if (s0 >= 2) xm2 = ld(t0 - 2, 512) * ld(t0 - 2, 0);
  if (s0 >= 1) xm1 = ld(t0 - 1, 512) * ld(t0 - 1, 0);
  f32x4v ring[W];
  f32x4v sum = zero;
#pragma unroll
  for (int i = 0; i < W; ++i) { ring[i] = (s0 + i - W >= 0) ? ld(t0 + i - W, 1536) : zero; sum += ring[i]; }
#pragma unroll
  for (int tt = 0; tt < 32; ++tt) {
    const int t = t0 + tt;
    const f32x4v x0 = ld(t, 512) * ld(t, 0);
    const f32x4v z = w0 * xm2 + w1 * xm1 + w2 * x0;
    xm2 = xm1; xm1 = x0;
    const f32x4v ya = ld(t, 1024) * z;
    const f32x4v pv = ld(t, 1536);
    sum += pv - ring[tt % W]; ring[tt % W] = pv;
    const int cnt = (s0 + tt + 1 < W) ? (s0 + tt + 1) : W;
    const float ic = 1.f / (float)cnt;
    const f32x4v pl = sum * ic - pv;
    u32x2 oa, ob;
    oa[0] = pack2(ya[0], ya[1]); oa[1] = pack2(ya[2], ya[3]);
    ob[0] = pack2(pl[0], pl[1]); ob[1] = pack2(pl[2], pl[3]);
    *(GAS u32x2*)(Y + (size_t)t * D + c) = oa;
    *(GAS u32x2*)(pool + (size_t)t * 512 + c) = ob;
  }
}
DI void phase_evenmix(const int wq, PRef p, int j) {
  const int tid = ltid(wq); const int bid = lbid();
  const int lane = tid & 63, wv = tid >> 6;
  const float* cw = p.even_conv_w + (size_t)j * 3 * 512;
  for (int Wg = bid * 4 + wv; Wg < 1024; Wg += gridDim.x * 4) {
    const int g = Wg & 3, cp = Wg >> 2;
    const int t0 = (cp * 2 + (lane >> 5)) * 32;
    const int c = g * 128 + (lane & 31) * 4;
    if (g == 0) evenmix_run<2>(p.P16, cw, p.Y, p.pool, t0, c);
    else if (g == 1) evenmix_run<4>(p.P16, cw, p.Y, p.pool, t0, c);
    else if (g == 2) evenmix_run<8>(p.P16, cw, p.Y, p.pool, t0, c);
    else evenmix_run<16>(p.P16, cw, p.Y, p.pool, t0, c);
  }
}

DI void phase_lb(const int wq, PRef p) {
  const int tid_ = ltid(wq); const int bid_ = lbid(); (void)tid_; (void)bid_;
  for (int c = bid_ * NT + tid_; c < 512; c += gridDim.x * NT) {
    float g[DEPTH], m = -INFINITY;
#pragma unroll
    for (int l = 0; l < DEPTH; ++l) { g[l] = p.hgrn_gamma[l * 512 + c]; m = fmaxf(m, g[l]); }
    float sum = 0.f;
#pragma unroll
    for (int l = 0; l < DEPTH; ++l) { g[l] = expf(g[l] - m); sum += g[l]; }
    float cum = 0.f;
#pragma unroll
    for (int l = 0; l < DEPTH; ++l) { p.lb[l * 512 + c] = cum; cum += g[l] / sum; }
  }
}

DI int t5_bucket(int dist) {
  const int d = dist < 0 ? 0 : dist;
  if (d < 16) return d;
  const float lr = logf((float)d / 16.f) / 2.0794415416798357f;
  int large = 16 + (int)(lr * 16.f);
  return large < 31 ? large : 31;
}

DI unsigned fkey(float f) { unsigned u = __float_as_uint(f); return (u & 0x80000000u) ? ~u : (u | 0x80000000u); }

DI void phase_hgrn_post(const int wq, PRef p, int j) {
  const int tid_ = ltid(wq); const int bid_ = lbid(); (void)tid_; (void)bid_;
  const int lane = tid_ & 63, wv = tid_ >> 6;
  for (int r = bid_ * 4 + wv; r < T * 4; r += gridDim.x * 4) {
    const int t = r >> 2, hd = r & 3;
    const float* o = p.oraw + (size_t)t * 512 + hd * 128;
    const float a = o[lane], bq = o[lane + 64];
    const float ss = wave_sum(a * a + bq * bq);
    const float rs = rsqrtf(ss / 128.f + 1e-6f);
    const bf16_t* gate = p.P16 + (size_t)t * ODD_IN + 3272 + hd * 128;
    const float* gn = p.odd_hg_norm + j * 512 + hd * 128;
    const float g0 = bf2f(gate[lane]), g1 = bf2f(gate[lane + 64]);
    p.Y[(size_t)t * D + 512 + hd * 128 + lane] = f2bf(a * rs * gn[lane] * (g0 * sigmoidf(g0)));
    p.Y[(size_t)t * D + 512 + hd * 128 + lane + 64] = f2bf(bq * rs * gn[lane + 64] * (g1 * sigmoidf(g1)));
  }
}

DI void phase_dsa_prep(const int wq, PRef p, int j) {
  const int tid = ltid(wq); const int bid = lbid();
  const int lane = tid & 63, wv = tid >> 6;
  for (int t = bid * 4 + wv; t < T; t += gridDim.x * 4) {
    const bf16_t* row = p.P16 + (size_t)t * ODD_IN;
#pragma unroll
    for (int c = 0; c < 2; ++c) *(GAS u32x4*)(p.qlat16 + (size_t)t * 1024 + c * 512 + lane * 8) = gload16(row + c * 512 + lane * 8);
    {
      const unsigned cv = *(const GAS unsigned*)(row + 1024 + 2 * lane);
      const float c0 = bflo(cv), c1 = bfhi(cv);
      const float ss = wave_sum(c0 * c0 + c1 * c1);
      const float rs = rsqrtf(ss / 128.f + 1e-6f);
      const float* g = p.odd_kv_norm + j * 128;
      *(GAS unsigned*)(p.ckv16 + (size_t)t * 128 + 2 * lane) = pack2(c0 * rs * g[2 * lane], c1 * rs * g[2 * lane + 1]);
    }
    *(GAS u32x4*)(p.iq16 + (size_t)t * 512 + lane * 8) = gload16(row + 1152 + lane * 8);
    p.ik16[(size_t)t * 64 + lane] = row[1664 + lane];
  }
}

DI void phase_dsa_scores(const int wq, PRef p, char* smem) {
  const int tid = ltid(wq); const int bid = lbid();
  const int lane = tid & 63, wv = tid >> 6, wm = wv >> 1, wn = wv & 1;
  const int r = lane & 31, hh = lane >> 5;
  const int srow = tid >> 3, skc = tid & 7;
  char* Ks = smem;
  char* Qs = smem + G_TILE_B;
  float* Ws = (float*)(smem + 3 * G_TILE_B);
  for (int tile = bid; tile < NB * 136; tile += gridDim.x) {
    const int b = tile / 136, u = tile % 136;
    int qb = 0;
    while ((qb + 1) * (qb + 2) / 2 <= u) ++qb;
    const int kb = u - qb * (qb + 1) / 2;
    const int q0 = b * S + qb * 128, k0 = b * S + kb * 128;
    const bf16_t* Kg = p.ik16 + (size_t)(k0 + srow) * 64 + skc * 8;
    const bf16_t* Qg = p.iq16 + (size_t)(q0 + srow) * 512 + skc * 8;
    u32x4 rk[4], rq[4];
#pragma unroll
    for (int i = 0; i < 4; ++i) { rk[i] = gload16(Kg + (size_t)(32 * i) * 64); rq[i] = gload16(Qg + (size_t)(32 * i) * 512); }
    u32x4 wv4 = {0u, 0u, 0u, 0u};
    if (tid < 128) wv4 = gload16(p.P16 + (size_t)(q0 + tid) * ODD_IN + 1728);
    __syncthreads();
#pragma unroll
    for (int i = 0; i < 4; ++i) {
      *(u32x4*)(Ks + (srow + 32 * i) * G_LDS_ROW + skc * 16) = rk[i];
      *(u32x4*)(Qs + (srow + 32 * i) * G_LDS_ROW + skc * 16) = rq[i];
    }
    if (tid < 128) {
      const unsigned w0 = wv4[0], w1 = wv4[1], w2 = wv4[2], w3 = wv4[3];
      f32x4v a4, b4;
      a4[0] = bflo(w0) * 0.35355339059327373f; a4[1] = bfhi(w0) * 0.35355339059327373f; a4[2] = bflo(w1) * 0.35355339059327373f; a4[3] = bfhi(w1) * 0.35355339059327373f;
      b4[0] = bflo(w2) * 0.35355339059327373f; b4[1] = bfhi(w2) * 0.35355339059327373f; b4[2] = bflo(w3) * 0.35355339059327373f; b4[3] = bfhi(w3) * 0.35355339059327373f;
      *(f32x4v*)(Ws + tid * 8) = a4; *(f32x4v*)(Ws + tid * 8 + 4) = b4;
    }
    __syncthreads();
    f32x16 sc[2][2];
#pragma unroll
    for (int i = 0; i < 2; ++i)
#pragma unroll
      for (int jx = 0; jx < 2; ++jx)
#pragma unroll
        for (int e = 0; e < 16; ++e) sc[i][jx][e] = 0.f;
#pragma unroll 1
    for (int hd = 0; hd < 8; ++hd) {
      const int cur = hd & 1;
      if (hd + 1 < 8) {
#pragma unroll
        for (int i = 0; i < 4; ++i) rq[i] = gload16(Qg + (size_t)(32 * i) * 512 + (hd + 1) * 64);
      }
      f32x16 acc[2][2];
#pragma unroll
      for (int i = 0; i < 2; ++i)
#pragma unroll
        for (int jx = 0; jx < 2; ++jx)
#pragma unroll
          for (int e = 0; e < 16; ++e) acc[i][jx][e] = 0.f;
      const char* As = Qs + cur * G_TILE_B + (wm * 64 + r) * G_LDS_ROW + hh * 16;
      const char* Bs = Ks + (wn * 64 + r) * G_LDS_ROW + hh * 16;
#pragma unroll
      for (int ks = 0; ks < 4; ++ks) {
        const bf16x8 a0 = *(const bf16x8*)(As + ks * 32), a1 = *(const bf16x8*)(As + 32 * G_LDS_ROW + ks * 32);
        const bf16x8 b0 = *(const bf16x8*)(Bs + ks * 32), b1 = *(const bf16x8*)(Bs + 32 * G_LDS_ROW + ks * 32);
        acc[0][0] = __builtin_amdgcn_mfma_f32_32x32x16_bf16(a0, b0, acc[0][0], 0, 0, 0);
        acc[0][1] = __builtin_amdgcn_mfma_f32_32x32x16_bf16(a0, b1, acc[0][1], 0, 0, 0);
        acc[1][0] = __builtin_amdgcn_mfma_f32_32x32x16_bf16(a1, b0, acc[1][0], 0, 0, 0);
        acc[1][1] = __builtin_amdgcn_mfma_f32_32x32x16_bf16(a1, b1, acc[1][1], 0, 0, 0);
      }
#pragma unroll
      for (int i = 0; i < 2; ++i)
#pragma unroll
        for (int e = 0; e < 16; ++e) {
          const float w = Ws[(wm * 64 + i * 32 + (e & 3) + 8 * (e >> 2) + 4 * hh) * 8 + hd];
          sc[i][0][e] = fmaf(w, fmaxf(acc[i][0][e] * 0.125f, 0.f), sc[i][0][e]);
          sc[i][1][e] = fmaf(w, fmaxf(acc[i][1][e] * 0.125f, 0.f), sc[i][1][e]);
        }
      if (hd + 1 < 8) {
#pragma unroll
        for (int i = 0; i < 4; ++i) *(u32x4*)(Qs + (cur ^ 1) * G_TILE_B + (srow + 32 * i) * G_LDS_ROW + skc * 16) = rq[i];
      }
      __syncthreads();
    }
#pragma unroll
    for (int i = 0; i < 2; ++i)
#pragma unroll
      for (int jx = 0; jx < 2; ++jx) {
        GAS float* cp = (GAS float*)p.sc + (size_t)(q0 + wm * 64 + i * 32 + 4 * hh) * 2048 + kb * 128 + wn * 64 + jx * 32 + r;
#pragma unroll
        for (int e = 0; e < 16; ++e) cp[(size_t)((e & 3) + 8 * (e >> 2)) * 2048] = sc[i][jx][e];
      }
  }
}

DI void phase_hgrn_scan(const int wq, PRef p, int l, char* smem) {
  const int tid = ltid(wq); const int bid = lbid();
  const int lane = tid & 63, wv = tid >> 6;
  const int kq = wv * 4 + (lane & 3), v = lane >> 2;
  constexpr int BUF = (2048 + 2048 + 256);
  float* bufs = (float*)smem;
  float* opart = bufs + 2 * BUF;
  for (int unit = bid; unit < 256; unit += gridDim.x) {
    const int b = unit >> 5, hd = (unit >> 3) & 3, vs = unit & 7;
    const int ltok = tid >> 4, lc = (tid & 15) * 8;
    const bf16_t* Pb = p.P16 + (size_t)(b * S) * ODD_IN;
    f32x4v lbv0, lbv1;
    { const float* lbp = p.lb + l * 512 + hd * 128 + lc; lbv0 = *(const f32x4v*)lbp; lbv1 = *(const f32x4v*)(lbp + 4); }
    float st[8];
#pragma unroll
    for (int i = 0; i < 8; ++i) st[i] = 0.f;
    u32x4 rq, rf; float riv;
    auto gl = [&](int bt) {
      const bf16_t* row = Pb + (size_t)(bt * 16 + ltok) * ODD_IN;
      rq = gload16(row + 1736 + hd * 128 + lc);
      rf = gload16(row + 2248 + hd * 128 + lc);
      riv = bf2f(row[2760 + hd * 128 + vs * 16 + (tid & 15)]);
    };
    auto st_lds = [&](int which) {
      float* bq = bufs + which * BUF; float* bf = bq + 2048; float* bi = bf + 2048;
      const unsigned q0_ = rq[0], q1_ = rq[1], q2_ = rq[2], q3_ = rq[3], f0_ = rf[0], f1_ = rf[1], f2_ = rf[2], f3_ = rf[3];
      f32x4v qa, qb, fa, fb;
      qa[0] = bflo(q0_); qa[1] = bfhi(q0_); qa[2] = bflo(q1_); qa[3] = bfhi(q1_); qb[0] = bflo(q2_); qb[1] = bfhi(q2_); qb[2] = bflo(q3_); qb[3] = bfhi(q3_);
      fa[0] = bflo(f0_); fa[1] = bfhi(f0_); fa[2] = bflo(f1_); fa[3] = bfhi(f1_); fb[0] = bflo(f2_); fb[1] = bfhi(f2_); fb[2] = bflo(f3_); fb[3] = bfhi(f3_);
      *(f32x4v*)(bq + ltok * 128 + lc) = qa; *(f32x4v*)(bq + ltok * 128 + lc + 4) = qb;
      f32x4v f0, f1;
#pragma unroll
      for (int i = 0; i < 4; ++i) {
        f0[i] = lbv0[i] + (1.f - lbv0[i]) * sigmoidf(fa[i]);
        f1[i] = lbv1[i] + (1.f - lbv1[i]) * sigmoidf(fb[i]);
      }
      *(f32x4v*)(bf + ltok * 128 + lc) = f0; *(f32x4v*)(bf + ltok * 128 + lc + 4) = f1;
      bi[ltok * 16 + (tid & 15)] = riv;
    };
    gl(0);
    __syncthreads();
    st_lds(0);
    __syncthreads();
#pragma unroll 1
    for (int bt = 0; bt < S / 16; ++bt) {
      const int cur = bt & 1;
      if (bt + 1 < S / 16) gl(bt + 1);
      const float* bq = bufs + cur * BUF; const float* bf = bq + 2048; const float* bi = bf + 2048;
#pragma unroll 4
      for (int tt = 0; tt < 16; ++tt) {
        const float iv = bi[tt * 16 + v];
        const f32x4v f0 = *(const f32x4v*)(bf + tt * 128 + kq * 8), f1 = *(const f32x4v*)(bf + tt * 128 + kq * 8 + 4);
        const f32x4v q0 = *(const f32x4v*)(bq + tt * 128 + kq * 8), q1 = *(const f32x4v*)(bq + tt * 128 + kq * 8 + 4);
        float o = 0.f;
#pragma unroll
        for (int i = 0; i < 4; ++i) {
          st[i] = fmaf(f0[i], st[i], (1.f - f0[i]) * iv); o = fmaf(q0[i], st[i], o);
          st[4 + i] = fmaf(f1[i], st[4 + i], (1.f - f1[i]) * iv); o = fmaf(q1[i], st[4 + i], o);
        }
        o += __int_as_float(__builtin_amdgcn_update_dpp(0, __float_as_int(o), 0xB1, 0xF, 0xF, true));
        o += __int_as_float(__builtin_amdgcn_update_dpp(0, __float_as_int(o), 0x4E, 0xF, 0xF, true));
        if ((lane & 3) == 0) opart[(tt * 4 + wv) * 16 + v] = o;
      }
      __syncthreads();
      {
        const int tt = tid >> 4, vo = tid & 15;
        const float o = opart[(tt * 4 + 0) * 16 + vo] + opart[(tt * 4 + 1) * 16 + vo] + opart[(tt * 4 + 2) * 16 + vo] + opart[(tt * 4 + 3) * 16 + vo];
        p.oraw[(size_t)(b * S + bt * 16 + tt) * 512 + hd * 128 + vs * 16 + vo] = o;
      }
      if (bt + 1 < S / 16) st_lds(cur ^ 1);
      __syncthreads();
    }
  }
}

DI float dot2bf(unsigned a, unsigned b, float acc) { return __builtin_amdgcn_fdot2_f32_bf16(__builtin_bit_cast(bf16x2_t, a), __builtin_bit_cast(bf16x2_t, b), acc, false); }
DI unsigned fkey_u(float f) { const unsigned u = __float_as_uint(f); return (u & 0x80000000u) ? ~u : (u | 0x80000000u); }
DI void phase_dsa_attend(const int wq, PRef p, int j, char* smem, int qoff) {
  const int tid = ltid(wq); const int bid = lbid(); (void)bid;
  const int lane = tid & 63, wv = tid >> 6;
  int* selL = (int*)smem;
  int* nselL = selL + 1024;
  float* bias = (float*)(smem + 4096 + 64);
  float* part = (float*)(smem + 4096 + 64 + 1024);
  float* msb = part + 2 * 4 * 8 * 128;
  float* plw = msb + 2 * 4 * 16 + wv * 64 * 8;
  int* sel = selL + wv * 256;
  __syncthreads();
  bias[tid] = p.rel_bias[tid];
  const int n16 = lane & 15, kg = lane >> 4;
  const unsigned long long ltmask = (1ull << lane) - 1ull;
  for (;;) {
    __syncthreads();
    if (tid == 0) nselL[4] = (int)atomicAdd(p.qctr + qoff, 4u);
    __syncthreads();
    const int base = nselL[4];
    if (base >= T) break;
    {
      const int q = base + wv;
      const int t = q % S;
      const float* row = p.sc + (size_t)q * 2048;
      int nsel;
      if (t < 256) {
        nsel = t + 1;
#pragma unroll
        for (int i = 0; i < 4; ++i) sel[i * 64 + lane] = i * 64 + lane;
      } else {
        nsel = 256;
        const int ni = (t >> 6) + 1;
        unsigned keys[32];
#pragma unroll
        for (int i = 0; i < 32; ++i) {
          keys[i] = 0u;
          if (i < ni) { const int s_ = i * 64 + lane; if (s_ <= t) keys[i] = fkey_u(row[s_]); }
        }
        unsigned thr = 0u;
#pragma unroll 1
        for (int bit = 31; bit >= 0; --bit) {
          const unsigned cand = thr | (1u << bit);
          int cl = 0;
#pragma unroll
          for (int g = 0; g < 4; ++g) if (g * 8 < ni) {
#pragma unroll
            for (int i = g * 8; i < g * 8 + 8; ++i) cl += (keys[i] >= cand) ? 1 : 0;
          }
          const int cnt = wave_sum_i(cl);
          if (cnt >= 256) thr = cand;
        }
        int ngt = 0;
#pragma unroll
        for (int i = 0; i < 32; ++i) if (i < ni) ngt += __builtin_popcountll(__ballot(keys[i] > thr));
        const int need = 256 - ngt;
        int pg = 0, pe = 0;
#pragma unroll
        for (int i = 0; i < 32; ++i) if (i < ni) {
          const unsigned long long mg = __ballot(keys[i] > thr), me = __ballot(keys[i] == thr);
          const int myg = pg + __builtin_popcountll(mg & ltmask), mye = pe + __builtin_popcountll(me & ltmask);
          if (keys[i] > thr) sel[myg] = i * 64 + lane;
          else if (keys[i] == thr && mye < need) sel[ngt + mye] = i * 64 + lane;
          pg += __builtin_popcountll(mg); pe += __builtin_popcountll(me);
        }
      }
      if (lane == 0) nselL[wv] = nsel;
    }
    __syncthreads();
#pragma unroll 1
    for (int qi = 0; qi < 4; ++qi) {
      const int tid = ltid(wq);
      const int lane = tid & 63;
      const int n16 = lane & 15, kg = lane >> 4;
      const int q = base + qi;
      const int b = q / S, t = q % S;
      const int nsel = nselL[qi];
      const int* qsel = selL + qi * 256 + wv * 64;
      const int slot0 = wv * 64;
      float* pw = part + ((qi & 1) * 4 + wv) * 8 * 128;
      float* mw = msb + ((qi & 1) * 4 + wv) * 16;
      bf16x8 aq[4];
#pragma unroll
      for (int ks = 0; ks < 4; ++ks) {
        u32x4 z = {0u, 0u, 0u, 0u};
        if (n16 < 8) z = gload16(p.qlat16 + (size_t)q * 1024 + n16 * 128 + ks * 32 + kg * 8);
        aq[ks] = __builtin_bit_cast(bf16x8, z);
      }
      u32x4 bv[4][4];
#pragma unroll
      for (int bb = 0; bb < 4; ++bb) {
        const int sl = bb * 16 + n16;
        const int sxv = (slot0 + sl < nsel) ? qsel[sl] : 0;
        const bf16_t* crow = p.ckv16 + (size_t)(b * S + sxv) * 128 + kg * 8;
#pragma unroll
        for (int ks = 0; ks < 4; ++ks) bv[bb][ks] = gload16(crow + ks * 32);
      }
      const bf16_t* cb = p.ckv16 + (size_t)(b * S) * 128 + 2 * lane;
      unsigned cbuf[64];
#pragma unroll
      for (int i4 = 0; i4 < 8; ++i4) {
        const u32x4 s4 = *(const u32x4*)(qsel + i4 * 4);
#pragma unroll
        for (int e = 0; e < 4; ++e) {
          const int k = i4 * 4 + e;
          const int sk = (slot0 + k < nsel) ? __builtin_amdgcn_readfirstlane((int)s4[e]) : 0;
          cbuf[k] = *(const GAS unsigned*)(cb + (size_t)sk * 128);
        }
      }
      asm volatile("" ::: "memory");
      f32x4v lg[4];
#pragma unroll
      for (int bb = 0; bb < 4; ++bb) {
        f32x4v acc = {0.f, 0.f, 0.f, 0.f};
#pragma unroll
        for (int ks = 0; ks < 4; ++ks) acc = __builtin_amdgcn_mfma_f32_16x16x32_bf16(aq[ks], __builtin_bit_cast(bf16x8, bv[bb][ks]), acc, 0, 0, 0);
        lg[bb] = acc;
      }
      asm volatile("" ::: "memory");
#pragma unroll
      for (int i4 = 8; i4 < 16; ++i4) {
        const u32x4 s4 = *(const u32x4*)(qsel + i4 * 4);
#pragma unroll
        for (int e = 0; e < 4; ++e) {
          const int k = i4 * 4 + e;
          const int sk = (slot0 + k < nsel) ? __builtin_amdgcn_readfirstlane((int)s4[e]) : 0;
          cbuf[k] = *(const GAS unsigned*)(cb + (size_t)sk * 128);
        }
      }
      float mx[4] = {-INFINITY, -INFINITY, -INFINITY, -INFINITY};
#pragma unroll
      for (int bb = 0; bb < 4; ++bb) {
        const bool ok = slot0 + bb * 16 + n16 < nsel;
        const int bk = t5_bucket(t - (ok ? qsel[bb * 16 + n16] : 0));
#pragma unroll
        for (int i = 0; i < 4; ++i) {
          const float lv = ok ? lg[bb][i] * 0.08838834764831845f + bias[bk * 8 + ((4 * kg + i) & 7)] : -INFINITY;
          lg[bb][i] = lv; mx[i] = fmaxf(mx[i], lv);
        }
      }
#pragma unroll
      for (int i = 0; i < 4; ++i) mx[i] = rowmax16(mx[i]);
      float sm[4] = {0.f, 0.f, 0.f, 0.f};
#pragma unroll
      for (int bb = 0; bb < 4; ++bb)
#pragma unroll
        for (int i = 0; i < 4; ++i) {
          const float e_ = (mx[i] == -INFINITY) ? 0.f : __expf(lg[bb][i] - mx[i]);
          lg[bb][i] = e_; sm[i] += e_;
        }
#pragma unroll
      for (int i = 0; i < 4; ++i) sm[i] = rowsum16(sm[i]);
#pragma unroll
      for (int bb = 0; bb < 4; ++bb) {
        u32x4 pr;
#pragma unroll
        for (int i = 0; i < 4; ++i) {
          const float other = DPP_F(lg[bb][i], 0xB1, 0xF, true);
          pr[i] = pack2(lg[bb][i], other);
        }
        if (kg < 2 && (n16 & 1) == 0) *(u32x4*)((unsigned*)plw + ((bb * 16 + n16) >> 1) * 8 + 4 * kg) = pr;
      }
      if (kg < 2) {
        if (n16 == 0) {
#pragma unroll
          for (int i = 0; i < 4; ++i) { mw[4 * kg + i] = mx[i]; mw[8 + 4 * kg + i] = sm[i]; }
        }
      }
      asm volatile("s_waitcnt lgkmcnt(0)" ::: "memory");
      float o[16];
#pragma unroll
      for (int i = 0; i < 16; ++i) o[i] = 0.f;
#pragma unroll
      for (int kp = 0; kp < 32; ++kp) {
        if ((kp & 1) == 0) asm volatile("" ::: "memory");
        const unsigned ca = cbuf[2 * kp], cbx = cbuf[2 * kp + 1];
        const unsigned x0 = __builtin_amdgcn_perm(cbx, ca, 0x05040100u);
        const unsigned x1 = __builtin_amdgcn_perm(cbx, ca, 0x07060302u);
        const u32x4 pa4 = *(const u32x4*)((const unsigned*)plw + kp * 8), pb4 = *(const u32x4*)((const unsigned*)plw + kp * 8 + 4);
        const unsigned q0 = pa4[0], q1 = pa4[1], q2 = pa4[2], q3 = pa4[3], q4 = pb4[0], q5 = pb4[1], q6 = pb4[2], q7 = pb4[3];
        o[0] = dot2bf(q0, x0, o[0]); o[1] = dot2bf(q0, x1, o[1]); o[2] = dot2bf(q1, x0, o[2]); o[3] = dot2bf(q1, x1, o[3]);
        o[4] = dot2bf(q2, x0, o[4]); o[5] = dot2bf(q2, x1, o[5]); o[6] = dot2bf(q3, x0, o[6]); o[7] = dot2bf(q3, x1, o[7]);
        o[8] = dot2bf(q4, x0, o[8]); o[9] = dot2bf(q4, x1, o[9]); o[10] = dot2bf(q5, x0, o[10]); o[11] = dot2bf(q5, x1, o[11]);
        o[12] = dot2bf(q6, x0, o[12]); o[13] = dot2bf(q6, x1, o[13]); o[14] = dot2bf(q7, x0, o[14]); o[15] = dot2bf(q7, x1, o[15]);
      }
#pragma unroll
      for (int hd = 0; hd < 8; ++hd) { float2 ov; ov.x = o[2 * hd]; ov.y = o[2 * hd + 1]; *(float2*)(pw + hd * 128 + 2 * lane) = ov; }
      __syncthreads();
      {
        const int hd = tid >> 5, ch = (tid & 31) * 4;
        const float* pq = part + (qi & 1) * 4 * 8 * 128;
        const float* mq = msb + (qi & 1) * 4 * 16;
        float m0 = mq[hd], m1 = mq[16 + hd], m2 = mq[32 + hd], m3 = mq[48 + hd];
        const float M = fmaxf(fmaxf(m0, m1), fmaxf(m2, m3));
        const float f0 = __expf(m0 - M), f1 = __expf(m1 - M), f2 = __expf(m2 - M), f3 = __expf(m3 - M);
        const float den = f0 * mq[8 + hd] + f1 * mq[24 + hd] + f2 * mq[40 + hd] + f3 * mq[56 + hd];
        const f32x4v a0 = *(const f32x4v*)(pq + (0 * 8 + hd) * 128 + ch), a1 = *(const f32x4v*)(pq + (1 * 8 + hd) * 128 + ch);
        const f32x4v a2 = *(const f32x4v*)(pq + (2 * 8 + hd) * 128 + ch), a3 = *(const f32x4v*)(pq + (3 * 8 + hd) * 128 + ch);
        const float inv = 1.f / den;
        const f32x4v r = (a0 * f0 + a1 * f1 + a2 * f2 + a3 * f3) * inv;
        u32x2 ov; ov[0] = pack2(r[0], r[1]); ov[1] = pack2(r[2], r[3]);
        *(GAS u32x2*)(p.lat + (size_t)q * D + hd * 128 + ch) = ov;
      }
    }
  }
}

DI void phase_softmax256(const int wq, const bf16_t* __restrict__ S, bf16_t* __restrict__ Pm, int rows) {
  const int tid = ltid(wq); const int bid = lbid();
  const int lane = tid & 63, wv = tid >> 6;
  for (int r = bid * 4 + wv; r < rows; r += gridDim.x * 4) {
    const f32x4v v = bf4_to_f(*(const GAS u32x2*)(S + (size_t)r * 256 + lane * 4));
    const float a = v[0], b = v[1], c = v[2], d = v[3];
    const float m = wave_max(fmaxf(fmaxf(a, b), fmaxf(c, d)));
    const float ea = __expf(a - m), eb = __expf(b - m), ec = __expf(c - m), ed = __expf(d - m);
    const float inv = 1.f / wave_sum(ea + eb + ec + ed);
    u32x2 o; o[0] = pack2(ea * inv, eb * inv); o[1] = pack2(ec * inv, ed * inv);
    *(GAS u32x2*)(Pm + (size_t)r * 256 + lane * 4) = o;
  }
}

DI int fkey_s(int b) { return b ^ ((b >> 31) & 0x7fffffff); }

template <int N, int KMAX>
DI void bitonic_blocks(int (&v)[N]) {
#pragma unroll
  for (int k = 2; k <= KMAX; k <<= 1)
#pragma unroll
    for (int j = k >> 1; j > 0; j >>= 1)
#pragma unroll
      for (int i = 0; i < N; ++i) {
        const int l = i ^ j;
        if (l > i) {
          const bool desc = ((i & k) == 0);
          const int a = v[i], b = v[l];
          const int hi = a > b ? a : b, lo = a > b ? b : a;
          v[i] = desc ? hi : lo;
          v[l] = desc ? lo : hi;
        }
      }
}
template <bool DESC>
DI void bitonic_merge16(int (&v)[16]) {
#pragma unroll
  for (int j = 8; j > 0; j >>= 1)
#pragma unroll
    for (int i = 0; i < 16; ++i) {
      const int l = i ^ j;
      if (l > i) {
        const int a = v[i], b = v[l];
        const int hi = a > b ? a : b, lo = a > b ? b : a;
        v[i] = DESC ? hi : lo;
        v[l] = DESC ? lo : hi;
      }
    }
}

DI void phase_cvt_rows(const int wq, const float* __restrict__ src, bf16_t* __restrict__ dst, size_t n8) {
  const int tid = ltid(wq); const int bid = lbid();
  for (size_t i = (size_t)bid * NT + tid; i < n8; i += (size_t)gridDim.x * NT) {
    const u32x4 a = gload16(src + i * 8), b = gload16(src + i * 8 + 4);
    u32x4 o;
    o[0] = pack2(__uint_as_float(a[0]), __uint_as_float(a[1])); o[1] = pack2(__uint_as_float(a[2]), __uint_as_float(a[3]));
    o[2] = pack2(__uint_as_float(b[0]), __uint_as_float(b[1])); o[3] = pack2(__uint_as_float(b[2]), __uint_as_float(b[3]));
    *(GAS u32x4*)(dst + i * 8) = o;
  }
}

constexpr int KEY_ROW = 264;
DI void phase_peer_qs(const int wq, const bf16_t* __restrict__ X0, const bf16_t* __restrict__ W0, const bf16_t* __restrict__ keys0, int* __restrict__ tops, char* smem, const float* __restrict__ rss_in) {
  const int tid = ltid(wq); const int bid = lbid();
  const int lane = tid & 63, wv = tid >> 6;
  const int r = lane & 31, hh = lane >> 5;
  const int srow = tid >> 3, skc = tid & 7;
  constexpr int nk = D / 64;
  for (int tile = bid; tile < (T / 128) * 16; tile += gridDim.x) {
    const int mt = tile >> 4, hp = tile & 15;
    const bf16_t* Wg = W0 + (size_t)(hp * 128 + srow) * D + skc * 8;
    const bf16_t* Xg = X0 + (size_t)(mt * 128 + srow) * D + skc * 8;
    f32x16 acc[4];
#pragma unroll
    for (int i = 0; i < 4; ++i)
#pragma unroll
      for (int e = 0; e < 16; ++e) acc[i][e] = 0.f;
    u32x4 ra[4], rb[4];
#pragma unroll
    for (int i = 0; i < 4; ++i) { ra[i] = gload16(Wg + (size_t)(32 * i) * D); rb[i] = gload16(Xg + (size_t)(32 * i) * D); }
    __syncthreads();
#pragma unroll
    for (int i = 0; i < 4; ++i) {
      *(u32x4*)(smem + (srow + 32 * i) * G_LDS_ROW + skc * 16) = ra[i];
      *(u32x4*)(smem + 2 * G_TILE_B + (srow + 32 * i) * G_LDS_ROW + skc * 16) = rb[i];
    }
    __syncthreads();
#pragma unroll 1
    for (int kt = 0; kt < nk; ++kt) {
      const int cur = kt & 1;
      if (kt + 1 < nk) {
#pragma unroll
        for (int i = 0; i < 4; ++i) { ra[i] = gload16(Wg + (size_t)(32 * i) * D + (kt + 1) * 64); rb[i] = gload16(Xg + (size_t)(32 * i) * D + (kt + 1) * 64); }
      }
      const char* As = smem + cur * G_TILE_B + r * G_LDS_ROW + hh * 16;
      const char* Bs = smem + 2 * G_TILE_B + cur * G_TILE_B + (wv * 32 + r) * G_LDS_ROW + hh * 16;
#pragma unroll
      for (int ks = 0; ks < 4; ++ks) {
        const bf16x8 b = *(const bf16x8*)(Bs + ks * 32);
#pragma unroll
        for (int mb = 0; mb < 4; ++mb) {
          const bf16x8 a = *(const bf16x8*)(As + mb * 32 * G_LDS_ROW + ks * 32);
          acc[mb] = __builtin_amdgcn_mfma_f32_32x32x16_bf16(a, b, acc[mb], 0, 0, 0);
        }
      }
      if (kt + 1 < nk) {
        const int nxt = cur ^ 1;
#pragma unroll
        for (int i = 0; i < 4; ++i) {
          *(u32x4*)(smem + nxt * G_TILE_B + (srow + 32 * i) * G_LDS_ROW + skc * 16) = ra[i];
          *(u32x4*)(smem + 2 * G_TILE_B + nxt * G_TILE_B + (srow + 32 * i) * G_LDS_ROW + skc * 16) = rb[i];
        }
      }
      __syncthreads();
    }
    {
      const bf16_t* kg = keys0 + (size_t)hp * 128 * 128;
#pragma unroll
      for (int i = 0; i < 8; ++i) {
        const int c = tid + NT * i, row = c >> 4, c16 = c & 15;
        const u32x4 v = gload16(kg + row * 128 + c16 * 8);
        uint2 lo, hi2; lo.x = v[0]; lo.y = v[1]; hi2.x = v[2]; hi2.y = v[3];
        *(uint2*)(smem + row * KEY_ROW + c16 * 16) = lo;
        *(uint2*)(smem + row * KEY_ROW + c16 * 16 + 8) = hi2;
      }
    }
    __syncthreads();
    u32x4 qf[8];
    const float rstd_t = rstd_of(rss_in, mt * 128 + wv * 32 + r);
#pragma unroll
    for (int mb = 0; mb < 4; ++mb)
#pragma unroll
      for (int s2 = 0; s2 < 2; ++s2) {
        u32x4 f;
#pragma unroll
        for (int jj = 0; jj < 4; ++jj) f[jj] = pack2(acc[mb][8 * s2 + 2 * jj] * rstd_t, acc[mb][8 * s2 + 2 * jj + 1] * rstd_t);
        qf[mb * 2 + s2] = f;
      }
    int v[64];
#pragma unroll
    for (int kb = 0; kb < 4; ++kb) {
      f32x16 sa;
#pragma unroll
      for (int e = 0; e < 16; ++e) sa[e] = 0.f;
      const char* kr = smem + (kb * 32 + r) * KEY_ROW + hh * 8;
#pragma unroll
      for (int ksi = 0; ksi < 8; ++ksi) {
        const uint2 lo = *(const uint2*)(kr + ksi * 32);
        const uint2 hi2 = *(const uint2*)(kr + ksi * 32 + 16);
        u32x4 a; a[0] = lo.x; a[1] = lo.y; a[2] = hi2.x; a[3] = hi2.y;
        sa = __builtin_amdgcn_mfma_f32_32x32x16_bf16(__builtin_bit_cast(bf16x8, a), __builtin_bit_cast(bf16x8, qf[ksi]), sa, 0, 0, 0);
      }
#pragma unroll
      for (int e = 0; e < 16; ++e) {
        const int kidx = kb * 32 + (e & 3) + 8 * (e >> 2) + 4 * hh;
        v[kb * 16 + e] = (fkey_s(__float_as_int(sa[e])) & ~127) | kidx;
      }
    }
    bitonic_blocks<64, 16>(v);
    int c01[16], c23[16];
#pragma unroll
    for (int i = 0; i < 16; ++i) { c01[i] = v[i] > v[16 + i] ? v[i] : v[16 + i]; c23[i] = v[32 + i] > v[48 + i] ? v[32 + i] : v[48 + i]; }
    bitonic_merge16<true>(c01);
    bitonic_merge16<false>(c23);
    int d[16];
#pragma unroll
    for (int i = 0; i < 16; ++i) d[i] = c01[i] > c23[i] ? c01[i] : c23[i];
    bitonic_merge16<true>(d);
    int f[16];
#pragma unroll
    for (int i = 0; i < 16; ++i) { const int o = shxi(d[15 - i], 32, lane); f[i] = d[i] > o ? d[i] : o; }
    bitonic_merge16<true>(f);
    {
      const int token = mt * 128 + wv * 32 + r;
      GAS int* op = (GAS int*)tops + ((size_t)token * 16 + hp) * 16 + hh * 8;
      u32x4 o0, o1;
      if (hh) {
#pragma unroll
        for (int i = 0; i < 4; ++i) { o0[i] = f[8 + i]; o1[i] = f[12 + i]; }
        asm volatile("" : "+v"(o0), "+v"(o1));
      } else {
#pragma unroll
        for (int i = 0; i < 4; ++i) { o0[i] = f[i]; o1[i] = f[4 + i]; }
        asm volatile("" : "+v"(o0), "+v"(o1));
      }
      *(GAS u32x4*)op = o0; *(GAS u32x4*)(op + 4) = o1;
    }
  }
}

DI float dot8(const u32x4 a, const u32x4 b, float acc) {
  const unsigned a0 = a[0], a1 = a[1], a2 = a[2], a3 = a[3], b0 = b[0], b1 = b[1], b2 = b[2], b3 = b[3];
  acc = dot2bf(a0, b0, acc); acc = dot2bf(a1, b1, acc); acc = dot2bf(a2, b2, acc); acc = dot2bf(a3, b3, acc);
  return acc;
}
typedef signed char i8_t;
using i32x2 = __attribute__((ext_vector_type(2))) int;
DI void phase_quant_u(const int wq, const float* __restrict__ src, i8_t* __restrict__ dst, float* __restrict__ su, int nrows, const float* __restrict__ gain) {
  const int tid = ltid(wq); const int bid = lbid();
  const int lane = tid & 63, wv = tid >> 6;
  for (int row = bid * 4 + wv; row < nrows; row += gridDim.x * 4) {
    const float* r = src + (size_t)row * 1024 + 16 * lane;
    u32x4 a[4];
    {
      const float* gp = gain + (size_t)(row >> 14) * 1024 + 16 * lane;
#pragma unroll
      for (int i = 0; i < 4; ++i) {
        const u32x4 t = gload16(r + 4 * i);
        const f32x4v g4 = *(const f32x4v*)(gp + 4 * i);
        const unsigned t0 = t[0], t1 = t[1], t2 = t[2], t3 = t[3];
        a[i][0] = __float_as_uint(__uint_as_float(t0) * g4[0]); a[i][1] = __float_as_uint(__uint_as_float(t1) * g4[1]);
        a[i][2] = __float_as_uint(__uint_as_float(t2) * g4[2]); a[i][3] = __float_as_uint(__uint_as_float(t3) * g4[3]);
      }
    }
    float am = 0.f;
#pragma unroll
    for (int i = 0; i < 4; ++i) {
      const unsigned x0 = a[i][0], x1 = a[i][1], x2 = a[i][2], x3 = a[i][3];
      am = fmaxf(am, fmaxf(fmaxf(fabsf(__uint_as_float(x0)), fabsf(__uint_as_float(x1))), fmaxf(fabsf(__uint_as_float(x2)), fabsf(__uint_as_float(x3)))));
    }
    am = wave_max(am);
    const float inv = am > 0.f ? 127.f / am : 0.f;
    u32x4 o;
#pragma unroll
    for (int i = 0; i < 4; ++i) {
      const unsigned x0 = a[i][0], x1 = a[i][1], x2 = a[i][2], x3 = a[i][3];
      const int q0 = (int)rintf(__uint_as_float(x0) * inv), q1 = (int)rintf(__uint_as_float(x1) * inv);
      const int q2 = (int)rintf(__uint_as_float(x2) * inv), q3 = (int)rintf(__uint_as_float(x3) * inv);
      o[i] = (unsigned)(q0 & 255) | ((unsigned)(q1 & 255) << 8) | ((unsigned)(q2 & 255) << 16) | ((unsigned)(q3 & 255) << 24);
    }
    const size_t lyr = (size_t)row >> 14, e = (size_t)row & 16383;
    *(GAS u32x4*)(dst + (((lyr * 8 + (lane >> 3)) * 16384 + e) * 128 + (lane & 7) * 16)) = o;
    if (lane == 0) su[row] = am * (1.f / 127.f);
  }
}
DI void phase_cvt_v8(const int wq, const float* __restrict__ src, i8_t* __restrict__ dst, size_t n16) {
  const int tid = ltid(wq); const int bid = lbid();
  for (size_t i = (size_t)bid * NT + tid; i < n16; i += (size_t)gridDim.x * NT) {
    u32x4 o;
#pragma unroll
    for (int k = 0; k < 4; ++k) {
      const u32x4 a = gload16(src + i * 16 + 4 * k);
      const unsigned x0 = a[0], x1 = a[1], x2 = a[2], x3 = a[3];
      int pk = 0;
      pk = __builtin_amdgcn_cvt_pk_fp8_f32(__uint_as_float(x0) * 16.f, __uint_as_float(x1) * 16.f, pk, false);
      pk = __builtin_amdgcn_cvt_pk_fp8_f32(__uint_as_float(x2) * 16.f, __uint_as_float(x3) * 16.f, pk, true);
      o[k] = (unsigned)pk;
    }
    const size_t row = i >> 6; const int j = (int)(i & 63);
    const size_t lyr = row >> 14, e = row & 16383;
    *(GAS u32x4*)(dst + (((lyr * 8 + (j >> 3)) * 16384 + e) * 128 + (j & 7) * 16)) = o;
  }
}

DI void phase_peer_combine8(const int wq, PRef p, int l, char* smem, const float* __restrict__ rss_in) {
  const int tid = ltid(wq); const int bid = lbid();
  const int lane = tid & 63, wv = tid >> 6;
  int* wtops = (int*)(smem + wv * 1024);
  int ci, cj;
  if (lane < 16) { ci = 0; cj = lane; } else if (lane < 24) { ci = 1; cj = lane - 16; } else if (lane < 29) { ci = 2; cj = lane - 24; }
  else if (lane < 33) { ci = 3; cj = lane - 29; } else if (lane < 36) { ci = 4; cj = lane - 33; } else if (lane < 38) { ci = 5; cj = lane - 36; }
  else if (lane < 40) { ci = 6; cj = lane - 38; } else if (lane < 42) { ci = 7; cj = lane - 40; } else { ci = lane - 42 + 8; cj = 0; }
  const bool cvalid = lane < 50;
  if (!cvalid) { ci = 0; cj = 0; }
  const float* sul = p.su + (size_t)l * 16384;
  for (int token = bid * 4 + wv; token < T; token += gridDim.x * 4) {
    {
      const u32x4 tv = gload16(p.tops + (size_t)token * 256 + lane * 4);
      *(u32x4*)(wtops + lane * 4) = tv;
    }
    {
      const u32x4 a = gload16(p.hn + (size_t)token * D + 16 * lane), b2 = gload16(p.hn + (size_t)token * D + 16 * lane + 8);
      float xv[16];
      { const unsigned a0 = a[0], a1 = a[1], a2 = a[2], a3 = a[3], c0 = b2[0], c1 = b2[1], c2 = b2[2], c3 = b2[3];
        xv[0] = bflo(a0); xv[1] = bfhi(a0); xv[2] = bflo(a1); xv[3] = bfhi(a1); xv[4] = bflo(a2); xv[5] = bfhi(a2); xv[6] = bflo(a3); xv[7] = bfhi(a3);
        xv[8] = bflo(c0); xv[9] = bfhi(c0); xv[10] = bflo(c1); xv[11] = bfhi(c1); xv[12] = bflo(c2); xv[13] = bfhi(c2); xv[14] = bflo(c3); xv[15] = bfhi(c3); }
      float am = 0.f;
#pragma unroll
      for (int i = 0; i < 16; ++i) am = fmaxf(am, fabsf(xv[i]));
      am = wave_max(am);
      const float inv = am > 0.f ? 127.f / am : 0.f;
      u32x4 o;
#pragma unroll
      for (int i = 0; i < 4; ++i) {
        const int q0 = (int)rintf(xv[4 * i] * inv), q1 = (int)rintf(xv[4 * i + 1] * inv), q2 = (int)rintf(xv[4 * i + 2] * inv), q3 = (int)rintf(xv[4 * i + 3] * inv);
        o[i] = (unsigned)(q0 & 255) | ((unsigned)(q1 & 255) << 8) | ((unsigned)(q2 & 255) << 16) | ((unsigned)(q3 & 255) << 24);
      }
      *(GAS u32x4*)(p.x8 + (size_t)token * 1024 + 16 * lane) = o;
      if (lane == 0) p.sxq[token] = am * (1.f / 127.f) * rstd_of(rss_in, token);
    }
    asm volatile("s_waitcnt lgkmcnt(0)" ::: "memory");
#pragma unroll 1
    for (int hd = 0; hd < 8; ++hd) {
      const int k1 = wtops[(2 * hd) * 16 + ci], k2 = wtops[(2 * hd + 1) * 16 + cj];
      const float s1 = __int_as_float(fkey_s(k1 & ~127)), s2 = __int_as_float(fkey_s(k2 & ~127));
      const float val = s1 + s2;
      const int vk = cvalid ? ((fkey_s(__float_as_int(val)) & ~63) | (63 - lane)) : (int)0x80000000;
      int rank = 0;
#pragma unroll
      for (int c = 0; c < 50; ++c) rank += (__builtin_amdgcn_readlane(vk, c) > vk) ? 1 : 0;
      const float m = __int_as_float(__builtin_amdgcn_readlane(__float_as_int(val), 0));
      const bool sel = cvalid && rank < 16;
      const float ev = sel ? __expf(val - m) : 0.f;
      const float sum = wave_sum(ev);
      if (sel) {
        const int eid = (k1 & 127) * 128 + (k2 & 127);
        p.sel_id[(size_t)token * 128 + hd * 16 + rank] = eid;
        p.sel_g[(size_t)token * 128 + hd * 16 + rank] = ev / sum;
        p.sel_su[(size_t)token * 128 + hd * 16 + rank] = sul[eid];
      }
    }
    asm volatile("s_waitcnt lgkmcnt(0)" ::: "memory");
  }
}

DI void phase_peer_udot8(const int wq, PRef p, int l, char* smem, int coff) {
  const int tid = ltid(wq);
  const int lane = tid & 63, wv = tid >> 6;
  const int grp = lane >> 3, li = lane & 7;
  int* wid = (int*)(smem + wv * 4096);
  const bool b2 = li & 4, b1 = li & 2, b0 = li & 1;
  const int myx = (int)(xb_xcc_id() & 7u);
  for (int cs = 0; cs < 8; ++cs) {
    const int c = (myx + cs) & 7;
    const i8_t* U8 = p.u8 + ((size_t)l * 8 + c) * 16384 * 128 + li * 16;
    int* pb = (int*)p.pbuf + (size_t)c * T * 128;
    for (;;) {
      unsigned tb = 0;
      if (lane == 0) tb = atomicAdd(p.qctr + coff + c * 16, 8u);
      tb = __builtin_amdgcn_readfirstlane(tb);
      if (tb >= (unsigned)T) break;
      u32x4 xs[8];
      {
        int idl[16];
#pragma unroll
        for (int k = 0; k < 8; ++k) {
          idl[2 * k] = __builtin_nontemporal_load((const GAS int*)p.sel_id + (size_t)(tb + k) * 128 + lane);
          idl[2 * k + 1] = __builtin_nontemporal_load((const GAS int*)p.sel_id + (size_t)(tb + k) * 128 + 64 + lane);
          xs[k] = __builtin_nontemporal_load((gp_u32x4)(p.x8 + (size_t)(tb + k) * 1024 + c * 128 + li * 16));
        }
#pragma unroll
        for (int k = 0; k < 8; ++k) { wid[k * 128 + lane] = idl[2 * k]; wid[k * 128 + 64 + lane] = idl[2 * k + 1]; }
      }
      asm volatile("s_waitcnt lgkmcnt(0)" ::: "memory");
      auto issue = [&](int k, u32x4 (&g)[16]) {
        int ids[16];
#pragma unroll
        for (int i = 0; i < 4; ++i) {
          const u32x4 t4 = *(const u32x4*)(wid + k * 128 + grp * 16 + i * 4);
          ids[4 * i] = t4[0]; ids[4 * i + 1] = t4[1]; ids[4 * i + 2] = t4[2]; ids[4 * i + 3] = t4[3];
        }
#pragma unroll
        for (int i = 0; i < 16; ++i) g[i] = gload16(U8 + (size_t)ids[i] * 128);
      };
      auto consume = [&](int k, const u32x4 (&g)[16], const u32x4 cx) {
        const int x0 = (int)cx[0], x1 = (int)cx[1], x2 = (int)cx[2], x3 = (int)cx[3];
        int pp[16];
#pragma unroll
        for (int i = 0; i < 16; ++i) {
          const u32x4 u8 = g[i];
          const int u0 = (int)u8[0], u1 = (int)u8[1], u2 = (int)u8[2], u3 = (int)u8[3];
          int acc = __builtin_amdgcn_sdot4(x0, u0, 0, false);
          acc = __builtin_amdgcn_sdot4(x1, u1, acc, false);
          acc = __builtin_amdgcn_sdot4(x2, u2, acc, false);
          pp[i] = __builtin_amdgcn_sdot4(x3, u3, acc, false);
        }
        int q8[8], q4[4], q2[2];
#pragma unroll
        for (int i = 0; i < 8; ++i) { const int mine = b2 ? pp[i + 8] : pp[i], oth = b2 ? pp[i] : pp[i + 8]; q8[i] = mine + shxi(oth, 4, lane); }
#pragma unroll
        for (int i = 0; i < 4; ++i) { const int mine = b1 ? q8[i + 4] : q8[i], oth = b1 ? q8[i] : q8[i + 4]; q4[i] = mine + shxi(oth, 2, lane); }
#pragma unroll
        for (int i = 0; i < 2; ++i) { const int mine = b0 ? q4[i + 2] : q4[i], oth = b0 ? q4[i] : q4[i + 2]; q2[i] = mine + shxi(oth, 1, lane); }
        i32x2 ov; ov[0] = q2[0]; ov[1] = q2[1];
        __builtin_nontemporal_store(ov, (GAS i32x2*)(pb + (size_t)(tb + k) * 128 + 2 * lane));
      };
      u32x4 ga[16], gb[16];
      issue(0, ga);
#pragma unroll
      for (int k2 = 0; k2 < 4; ++k2) {
        issue(2 * k2 + 1, gb);
        consume(2 * k2, ga, xs[2 * k2]);
        if (k2 < 3) issue(2 * k2 + 2, ga);
        consume(2 * k2 + 1, gb, xs[2 * k2 + 1]);
      }
      asm volatile("s_waitcnt lgkmcnt(0)" ::: "memory");
    }
  }
}

DI void phase_peer_w(const int wq, PRef p) {
  const int tid = ltid(wq); const int bid = lbid();
  const int lane = tid & 63, wv = tid >> 6;
  for (int token = bid * 4 + wv; token < T; token += gridDim.x * 4) {
    i32x2 pp8[8];
#pragma unroll
    for (int cc = 0; cc < 8; ++cc) pp8[cc] = __builtin_nontemporal_load((const GAS i32x2*)((const int*)p.pbuf + ((size_t)cc * T + token) * 128 + 2 * lane));
    const u32x2 gg = __builtin_nontemporal_load((const GAS u32x2*)(p.sel_g + (size_t)token * 128 + 2 * lane));
    const u32x2 su2 = __builtin_nontemporal_load((const GAS u32x2*)(p.sel_su + (size_t)token * 128 + 2 * lane));
    const float sxv = p.sxq[token];
    int d0 = 0, d1 = 0;
#pragma unroll
    for (int cc = 0; cc < 8; ++cc) { d0 += pp8[cc][0]; d1 += pp8[cc][1]; }
    const float f0 = (float)d0 * (sxv * __uint_as_float(su2[0])), f1 = (float)d1 * (sxv * __uint_as_float(su2[1]));
    u32x2 w2; w2[0] = __float_as_uint(__uint_as_float(gg[0]) * gelu_tanh(f0) * 0.0625f); w2[1] = __float_as_uint(__uint_as_float(gg[1]) * gelu_tanh(f1) * 0.0625f);
    *(GAS u32x2*)(p.sel_g + (size_t)token * 128 + 2 * lane) = w2;
  }
}

DI void phase_peer_vacc8(const int wq, PRef p, int l, char* smem, int coff, int dry, int rss_idx) {
  const int myx = (int)(xb_xcc_id() & 7u);
  for (int cs = 0; cs < 8; ++cs) {
    const int c = (myx + cs) & 7;
    unsigned tbq = 0; bool have = false;
    for (;;) {
      const int tid = ltid(wq);
      const int lane = tid & 63, wv = tid >> 6;
      int* wid = (int*)(smem + wv * 8192);
      float* ww = (float*)(smem + wv * 8192 + 4096);
      const int grp = lane >> 3, li = lane & 7;
      const bool g2 = grp & 4, g1 = grp & 2, g0 = grp & 1;
      const i8_t* V8 = p.v8 + ((size_t)l * 8 + c) * 16384 * 128 + li * 16;
      const int chan = c * 128 + li * 16 + 2 * grp;
      unsigned tb = tbq;
      if (!have) {
        unsigned t0 = 0;
        if (lane == 0) t0 = atomicAdd(p.qctr + coff + c * 16, 8u);
        tb = __builtin_amdgcn_readfirstlane(t0);
      }
      if (tb >= (unsigned)T) break;
      {
        u32x4 iv[4], wv4[4];
#pragma unroll
        for (int j4 = 0; j4 < 4; ++j4) {
          iv[j4] = __builtin_nontemporal_load((gp_u32x4)(p.sel_id + (size_t)tb * 128 + j4 * 256 + lane * 4));
          wv4[j4] = __builtin_nontemporal_load((gp_u32x4)(p.sel_g + (size_t)tb * 128 + j4 * 256 + lane * 4));
        }
#pragma unroll
        for (int j4 = 0; j4 < 4; ++j4) { *(u32x4*)(wid + j4 * 256 + lane * 4) = iv[j4]; *(u32x4*)(ww + j4 * 256 + lane * 4) = wv4[j4]; }
      }
      asm volatile("s_waitcnt lgkmcnt(0)" ::: "memory");
      auto issue = [&](int hh_, u32x4 (&g)[8]) {
        const int k = hh_ >> 1, hf = hh_ & 1;
        int ids[8];
#pragma unroll
        for (int i = 0; i < 2; ++i) {
          const u32x4 t4 = *(const u32x4*)(wid + k * 128 + grp * 16 + hf * 8 + i * 4);
          ids[4 * i] = t4[0]; ids[4 * i + 1] = t4[1]; ids[4 * i + 2] = t4[2]; ids[4 * i + 3] = t4[3];
        }
#pragma unroll
        for (int i = 0; i < 8; ++i) g[i] = gload16(V8 + (size_t)ids[i] * 128);
      };
      float o[16];
      u32x2 hcur;
      auto accum = [&](int hh_, const u32x4 (&g)[8]) {
        const int k = hh_ >> 1, hf = hh_ & 1;
        if (hf == 0) {
#pragma unroll
          for (int i = 0; i < 16; ++i) o[i] = 0.f;
          hcur = __builtin_nontemporal_load((GAS u32x2*)((GAS float*)p.h + ((size_t)tb + k) * D + chan));
        }
#pragma unroll
        for (int i = 0; i < 8; ++i) {
          const u32x4 v8 = g[i];
          const float w = ww[k * 128 + grp * 16 + hf * 8 + i];
          const int v0 = (int)v8[0], v1 = (int)v8[1], v2 = (int)v8[2], v3 = (int)v8[3];
          f32x2v t2;
          t2 = __builtin_amdgcn_cvt_pk_f32_fp8(v0, false); o[0] = fmaf(w, t2[0], o[0]); o[1] = fmaf(w, t2[1], o[1]);
          t2 = __builtin_amdgcn_cvt_pk_f32_fp8(v0, true);  o[2] = fmaf(w, t2[0], o[2]); o[3] = fmaf(w, t2[1], o[3]);
          t2 = __builtin_amdgcn_cvt_pk_f32_fp8(v1, false); o[4] = fmaf(w, t2[0], o[4]); o[5] = fmaf(w, t2[1], o[5]);
          t2 = __builtin_amdgcn_cvt_pk_f32_fp8(v1, true);  o[6] = fmaf(w, t2[0], o[6]); o[7] = fmaf(w, t2[1], o[7]);
          t2 = __builtin_amdgcn_cvt_pk_f32_fp8(v2, false); o[8] = fmaf(w, t2[0], o[8]); o[9] = fmaf(w, t2[1], o[9]);
          t2 = __builtin_amdgcn_cvt_pk_f32_fp8(v2, true);  o[10] = fmaf(w, t2[0], o[10]); o[11] = fmaf(w, t2[1], o[11]);
          t2 = __builtin_amdgcn_cvt_pk_f32_fp8(v3, false); o[12] = fmaf(w, t2[0], o[12]); o[13] = fmaf(w, t2[1], o[13]);
          t2 = __builtin_amdgcn_cvt_pk_f32_fp8(v3, true);  o[14] = fmaf(w, t2[0], o[14]); o[15] = fmaf(w, t2[1], o[15]);
        }
        if (hf == 1) {
          float r8[8], r4[4], r2[2];
#pragma unroll
          for (int i = 0; i < 8; ++i) { const float mine = g2 ? o[i + 8] : o[i], oth = g2 ? o[i] : o[i + 8]; r8[i] = mine + shx(oth, 32, lane); }
#pragma unroll
          for (int i = 0; i < 4; ++i) { const float mine = g1 ? r8[i + 4] : r8[i], oth = g1 ? r8[i] : r8[i + 4]; r4[i] = mine + shx(oth, 16, lane); }
#pragma unroll
          for (int i = 0; i < 2; ++i) { const float mine = g0 ? r4[i + 2] : r4[i], oth = g0 ? r4[i] : r4[i + 2]; r2[i] = mine + shx(oth, 8, lane); }
          if (!dry) {
            const size_t token = (size_t)tb + k;
            GAS float* hp = (GAS float*)p.h + token * D + chan;
            const u32x2 ch = hcur;
            const float h0 = __uint_as_float(ch[0]) + r2[0], h1 = __uint_as_float(ch[1]) + r2[1];
            u32x2 sv; sv[0] = __float_as_uint(h0); sv[1] = __float_as_uint(h1);
            __builtin_nontemporal_store(sv, (GAS u32x2*)hp);
            *(GAS unsigned*)(p.hn + token * D + chan) = pack2(h0, h1);
            if (rss_idx >= 0) {
              const float ss = wave_sum(h0 * h0 + h1 * h1);
              if (lane < 2) p.rss[((size_t)rss_idx * T + token) * 16 + 2 * c + lane] = lane == 0 ? ss : 0.f;
            }
          }
        }
      };
      u32x4 gA[8], gB[8], gC[8];
      issue(0, gA); issue(1, gB);
      have = (cs == 0) && tb < (unsigned)(T - 8 * 384);
      unsigned tnx = 0;
      if (have && lane == 0) tnx = atomicAdd(p.qctr + coff + c * 16, 8u);
#pragma unroll
      for (int h3 = 0; h3 < 15; h3 += 3) {
        asm volatile("" ::: "memory");
        issue(h3 + 2, gC); accum(h3, gA);
        asm volatile("" ::: "memory");
        issue(h3 + 3, gA); accum(h3 + 1, gB);
        asm volatile("" ::: "memory");
        if (h3 + 4 < 16) issue(h3 + 4, gB);
        accum(h3 + 2, gC);
      }
      accum(15, gA);
      asm volatile("s_waitcnt lgkmcnt(0)" ::: "memory");
      tbq = __builtin_amdgcn_readfirstlane(tnx);
    }
  }
}

DI void phase_final_norm(const int wq, const float* __restrict__ in, const float* __restrict__ g, float* __restrict__ out, int rows) {
  const int tid = ltid(wq); const int bid = lbid();
  const int lane = tid & 63, wv = tid >> 6;
  f32x4v gv[4];
#pragma unroll
  for (int i = 0; i < 4; ++i) gv[i] = *(const f32x4v*)(g + i * 256 + lane * 4);
  for (int r = bid * 4 + wv; r < rows; r += gridDim.x * 4) {
    const float* pr = in + (size_t)r * D;
    u32x4 v[4];
#pragma unroll
    for (int i = 0; i < 4; ++i) v[i] = gload16(pr + i * 256 + lane * 4);
    float ss = 0.f;
#pragma unroll
    for (int i = 0; i < 4; ++i) {
      const float a = __uint_as_float(v[i][0]), b = __uint_as_float(v[i][1]), c = __uint_as_float(v[i][2]), d = __uint_as_float(v[i][3]);
      ss += a * a + b * b + c * c + d * d;
    }
    ss = wave_sum(ss);
    const float rs = rsqrtf(ss / (float)D + 1e-6f);
#pragma unroll
    for (int i = 0; i < 4; ++i) {
      u32x4 ov;
#pragma unroll
      for (int e = 0; e < 4; ++e) ov[e] = __float_as_uint(__uint_as_float(v[i][e]) * rs * gv[i][e]);
      *(GAS u32x4*)(out + (size_t)r * D + i * 256 + lane * 4) = ov;
    }
  }
}

#define PROBE 0
constexpr int SMEM_BYTES = 73728;
__global__ void __launch_bounds__(NT, 2) mega(Params pk) {
  __shared__ __attribute__((aligned(16))) char smem_c[SMEM_BYTES];
  __shared__ uint4 xb_words;
  __shared__ Params sp;
  {
    const unsigned long long* src = (const unsigned long long*)&pk;
    unsigned long long* dst = (unsigned long long*)&sp;
    if (threadIdx.x < sizeof(Params) / 8) dst[threadIdx.x] = src[threadIdx.x];
  }
  if (threadIdx.x == 0) xb_words = make_uint4(0u, 0u, 0u, 0u);
  __syncthreads();
#define p (*lp((const __attribute__((address_space(3))) Params*)&sp))
  float* smem = (float*)smem_c;
  const int wq = __builtin_amdgcn_readfirstlane((int)(threadIdx.x >> 6));
  (void)xcd_barrier_post(p.bar, (volatile LAS unsigned*)&xb_words);
#define GRID_BARRIER() do { XcdBarrier bb_; bb_.bar = p.bar; bb_.x = xb_xcc_id(); bb_.st = (volatile LAS unsigned*)&xb_words; xcd_barrier(bb_); } while (0)

  phase_convert(wq, p.even_w_in, D, EVEN_IN, EVEN_IN, p.w_even_in, EVEN_IN, nullptr, 2, (size_t)D * EVEN_IN, (size_t)EVEN_IN * D, 0, smem, p.mix_norm, 2 * D);
  phase_convert(wq, p.even_pool_w, 128, 128, 128, p.w_even_pool, 128, p.even_pool_scale, 8, 128 * 128, 128 * 128, 128, smem);
  phase_convert(wq, p.even_w_out, D, D, D, p.w_even_out, D, nullptr, 2, (size_t)D * D, (size_t)D * D, 0, smem);
  phase_convert(wq, p.odd_w_in, D, ODD_IN, ODD_IN, p.w_odd_in, 3840, nullptr, 2, (size_t)D * ODD_IN, (size_t)3840 * D, 0, smem, p.mix_norm + D, 2 * D);
  phase_convert(wq, p.odd_w_uv, 128, 64, 64, p.w_odd_uv, 128, nullptr, 16, 128 * 64, 128 * 128, 0, smem);
  phase_convert(wq, p.odd_w_out, D, D, D, p.w_odd_out, D, nullptr, 2, (size_t)D * D, (size_t)D * D, 0, smem);
  phase_convert(wq, p.xattn_wq, D, D, D, p.w_xq, D, nullptr, 4, (size_t)D * D, (size_t)D * D, 0, smem, p.xattn_norm, D);
  phase_convert(wq, p.xattn_wkv, D, 2048, 2048, p.w_xkv, 2048, nullptr, 4, (size_t)D * 2048, (size_t)2048 * D, 0, smem);
  phase_convert(wq, p.xattn_wo, D, D, D, p.w_xo, D, nullptr, 4, (size_t)D * D, (size_t)D * D, 0, smem);
  phase_convert(wq, p.peer_wq, D, 2048, 2048, p.w_pq, 2048, nullptr, 4, (size_t)D * 2048, (size_t)2048 * D, 0, smem, p.peer_norm, D);
  phase_quant_u(wq, p.peer_u, p.u8, p.su, DEPTH * 16384, p.peer_norm);
  phase_cvt_v8(wq, p.peer_v, p.v8, (size_t)DEPTH * 16384 * 1024 / 16);
  phase_cvt_rows(wq, p.peer_keys, p.keys16, (size_t)DEPTH * 16 * 128 * 128 / 8);
  phase_init_h(wq, p.x, p.h, p.hn, p.rss);
  phase_lb(wq, p);
  phase_rmsnorm_bf(wq, p.mem, D, p.mem_norm, p.memn, D, NB * NMEM, D);
  GRID_BARRIER();
  for (int l = 0; l < DEPTH; ++l)
    phase_gemm_bf16<3>(wq, p.memn, D, p.w_xkv + (size_t)l * 2048 * D, p.kvh + (size_t)l * 2 * 2048 * 1024, 2048, NB * NMEM, 2048, D, smem_c, 0);
  GRID_BARRIER();
  for (int l = 0; l < DEPTH; ++l) {
    const int j = l >> 1;
    if ((l & 1) == 0) {
      phase_gemm_bf16<2, 1>(wq, p.hn, D, p.w_even_in + (size_t)j * EVEN_IN * D, p.P16, EVEN_IN, T, EVEN_IN, D, smem_c, 0, 1, 0, 0, 0, 1, 0, 0, p.rss + (size_t)(3 * l) * T * 16);
      GRID_BARRIER();
      phase_evenmix(wq, p, j);
      GRID_BARRIER();
      phase_gemm_bf16<2>(wq, p.pool, 512, p.w_even_pool + (size_t)j * 4 * 128 * 128, p.Y + 512, D, T, 128, 128, smem_c, 0, 4, 128, 128 * 128, 128);
      GRID_BARRIER();
      phase_gemm_bf16<1>(wq, p.Y, D, p.w_even_out + (size_t)j * D * D, p.h, D, T, D, D, smem_c, 0, 1, 0, 0, 0, 1, 0, 0, nullptr, p.hn, p.rss + (size_t)(3 * l + 1) * T * 16);
      GRID_BARRIER();
    } else {
      phase_gemm_bf16<2, 1>(wq, p.hn, D, p.w_odd_in + (size_t)j * 3840 * D, p.P16, ODD_IN, T, ODD_IN, D, smem_c, 0, 1, 0, 0, 0, 1, 0, 0, p.rss + (size_t)(3 * l) * T * 16);
      GRID_BARRIER();
      phase_dsa_prep(wq, p, j);
      GRID_BARRIER();
      phase_dsa_scores(wq, p, smem_c);
      GRID_BARRIER();
      phase_hgrn_scan(wq, p, l, smem_c);
      phase_dsa_attend(wq, p, j, smem_c, 64 * j);
      GRID_BARRIER();
      phase_gemm_bf16<2>(wq, p.lat, D, p.w_odd_uv + (size_t)j * 8 * 128 * 128, p.Y, D, T, 64, 128, smem_c, 0, 8, 128, 128 * 128, 64);
      phase_hgrn_post(wq, p, j);
      GRID_BARRIER();
      phase_gemm_bf16<1>(wq, p.Y, D, p.w_odd_out + (size_t)j * D * D, p.h, D, T, D, D, smem_c, 0, 1, 0, 0, 0, 1, 0, 0, nullptr, p.hn, p.rss + (size_t)(3 * l + 1) * T * 16);
      GRID_BARRIER();
    }
    phase_gemm_bf16<2, 1>(wq, p.hn, D, p.w_xq + (size_t)l * D * D, p.q16, D, T, D, D, smem_c, 0, 1, 0, 0, 0, 1, 0, 0, p.rss + (size_t)(3 * l + 1) * T * 16);
    GRID_BARRIER();
    phase_gemm_bf16<4>(wq, p.q16, D, p.kvh + (size_t)l * 2 * 2048 * 1024, p.sx, 256, S, 256, 256, smem_c, 0, 32, (size_t)S * D, 256 * 256, (size_t)S * 1024, 4, 256, (size_t)S * 256);
    GRID_BARRIER();
    phase_softmax256(wq, (const bf16_t*)p.sx, p.p16, T * 4);
    GRID_BARRIER();
    phase_gemm_bf16<2>(wq, p.p16, 256, p.kvh + (size_t)l * 2 * 2048 * 1024 + (size_t)2048 * 1024, p.Y, D, S, 256, 256, smem_c, 0, 32, (size_t)S * 1024, 256 * 256, (size_t)S * D, 4, (size_t)S * 256, 256);
    GRID_BARRIER();
    phase_gemm_bf16<1>(wq, p.Y, D, p.w_xo + (size_t)l * D * D, p.h, D, T, D, D, smem_c, 0, 1, 0, 0, 0, 1, 0, 0, nullptr, p.hn, p.rss + (size_t)(3 * l + 2) * T * 16);
    GRID_BARRIER();
    phase_peer_qs(wq, p.hn, p.w_pq + (size_t)l * 2048 * D, p.keys16 + (size_t)l * 16 * 128 * 128, p.tops, smem_c, p.rss + (size_t)(3 * l + 2) * T * 16);
    GRID_BARRIER();
    phase_peer_combine8(wq, p, l, smem_c, p.rss + (size_t)(3 * l + 2) * T * 16);
    GRID_BARRIER();
    phase_peer_udot8(wq, p, l, smem_c, 256 + (l * 2 + 0) * 128);
    GRID_BARRIER();
    phase_peer_w(wq, p);
    GRID_BARRIER();
    phase_peer_vacc8(wq, p, l, smem_c, 256 + (l * 2 + 1) * 128, 0, l + 1 < DEPTH ? 3 * l + 3 : -1);
    GRID_BARRIER();
  }
  phase_final_norm(wq, p.h, p.final_norm, p.out, T);
}

#undef p
extern "C" void kernel_launch(void* const* d_in, const int* in_sizes, int n_in, void* d_out, int out_size, void* d_ws, size_t ws_size,
                              hipStream_t stream) {
  Params p; memset(&p, 0, sizeof(p));
  const float* const* in = (const float* const*)d_in;
  p.x = in[0]; p.mem = in[1]; p.mix_norm = in[2]; p.even_w_in = in[3]; p.even_conv_w = in[4]; p.even_pool_w = in[5];
  p.even_pool_scale = in[6]; p.even_w_out = in[7]; p.odd_w_in = in[8]; p.odd_kv_norm = in[9]; p.odd_w_uv = in[10];
  p.odd_hg_norm = in[11]; p.odd_w_out = in[12]; p.hgrn_gamma = in[13]; p.rel_bias = in[14]; p.mem_norm = in[15];
  p.xattn_norm = in[16]; p.xattn_wq = in[17]; p.xattn_wkv = in[18]; p.xattn_wo = in[19]; p.peer_norm = in[20];
  p.peer_wq = in[21]; p.peer_keys = in[22]; p.peer_u = in[23]; p.peer_v = in[24]; p.final_norm = in[25];
  p.out = (float*)d_out;
  char* w = (char*)d_ws;
  auto take = [&](size_t bytes) { char* r = w; w += (bytes + 255) / 256 * 256; return r; };
  p.bar = (unsigned*)take((XCD_BAR_WORDS + 2048) * 4); p.qctr = p.bar + XCD_BAR_WORDS;
  p.h = (float*)take((size_t)T * D * 4); p.P = (float*)take((size_t)T * ODD_IN * 4); p.P16 = (bf16_t*)p.P;
  p.oraw = (float*)take((size_t)T * 512 * 4); p.lb = (float*)take(DEPTH * 512 * 4);
  p.hn = (bf16_t*)take((size_t)T * D * 2); p.Y = (bf16_t*)take((size_t)T * D * 2); p.pool = (bf16_t*)take((size_t)T * 512 * 2);
  p.memn = (bf16_t*)take((size_t)NB * NMEM * D * 2); p.lat = (bf16_t*)take((size_t)T * D * 2);
  p.w_even_in = (bf16_t*)take((size_t)2 * EVEN_IN * D * 2); p.w_even_pool = (bf16_t*)take((size_t)8 * 128 * 128 * 2);
  p.w_even_out = (bf16_t*)take((size_t)2 * D * D * 2); p.w_odd_in = (bf16_t*)take((size_t)2 * 3840 * D * 2);
  p.w_odd_uv = (bf16_t*)take((size_t)16 * 128 * 128 * 2); p.w_odd_out = (bf16_t*)take((size_t)2 * D * D * 2);
  p.w_xq = (bf16_t*)take((size_t)4 * D * D * 2); p.w_xkv = (bf16_t*)take((size_t)4 * 2048 * D * 2); p.w_xo = (bf16_t*)take((size_t)4 * D * D * 2);
  p.w_pq = (bf16_t*)take((size_t)4 * 2048 * D * 2);
  p.u8 = (signed char*)take((size_t)DEPTH * 16384 * 1024); p.v8 = (signed char*)take((size_t)DEPTH * 16384 * 1024); p.x8 = (signed char*)take((size_t)T * 1024);
  p.su = (float*)take((size_t)DEPTH * 16384 * 4); p.sxq = (float*)take((size_t)T * 4); p.sel_su = (float*)take((size_t)T * 128 * 4);
  p.keys16 = (bf16_t*)take((size_t)DEPTH * 16 * 128 * 128 * 2); p.kvh = (bf16_t*)take((size_t)DEPTH * 2 * 2048 * 1024 * 2); p.rss = (float*)take((size_t)12 * T * 16 * 4);
  {
    char* a = (char*)p.P;
    p.sx = (float*)a; a += (size_t)T * 4 * 256 * 4;
    p.p16 = (bf16_t*)a; a += (size_t)T * 4 * 256 * 2;
    p.q16 = (bf16_t*)a; a += (size_t)T * D * 2;
    p.tops = (int*)a; a += (size_t)T * 256 * 4;
    p.sel_id = (int*)a; a += (size_t)T * 128 * 4;
    p.sel_g = (float*)a; a += (size_t)T * 128 * 4;
    p.pbuf = (float*)a;
  }
  p.qlat16 = (bf16_t*)take((size_t)T * 1024 * 2); p.ckv16 = (bf16_t*)take((size_t)T * 128 * 2); p.iq16 = (bf16_t*)take((size_t)T * 512 * 2);
  p.ik16 = (bf16_t*)take((size_t)T * 64 * 2); p.sc = (float*)take((size_t)T * 2048 * 4);

  p.probe = 1;
  static int grid = 0;
  if (!grid) {
    int dev = 0, cus = 0, per_cu = 0;
    (void)hipGetDevice(&dev);
    (void)hipDeviceGetAttribute(&cus, hipDeviceAttributeMultiprocessorCount, dev);
    (void)hipOccupancyMaxActiveBlocksPerMultiprocessor(&per_cu, mega, NT, 0);
    if (per_cu > 2) per_cu = 2;
    if (per_cu < 1) per_cu = 1;
    grid = cus * per_cu;
  }
  (void)hipMemsetAsync(p.bar, 0, (XCD_BAR_WORDS + 2048) * sizeof(unsigned), stream);
  mega<<<grid, NT, 0, stream>>>(p);
}
```

```cpp
#include <hip/hip_runtime.h>
#include <hip/hip_bf16.h>
#include <stdint.h>
#include <math.h>
#include <string.h>

#define DI __device__ __forceinline__

constexpr int D = 1024, NB = 8, S = 2048, T = NB * S, DEPTH = 4, NMEM = 256;
constexpr int EVEN_IN = 2048, ODD_IN = 3784;
constexpr int NT = 256;

typedef unsigned short bf16_t;
struct Params {
  const float *x, *mem, *mix_norm, *even_w_in, *even_conv_w, *even_pool_w, *even_pool_scale, *even_w_out;
  const float *odd_w_in, *odd_kv_norm, *odd_w_uv, *odd_hg_norm, *odd_w_out, *hgrn_gamma, *rel_bias, *mem_norm;
  const float *xattn_norm, *xattn_wq, *xattn_wkv, *xattn_wo, *peer_norm, *peer_wq, *peer_keys, *peer_u, *peer_v, *final_norm;
  float* out;
  float *h, *P, *kv, *ckv, *oraw, *lb; bf16_t* P16;
  bf16_t *hn, *Y, *pool, *memn, *lat;
  bf16_t *u16, *v16, *keys16; int* tops; signed char *u8, *v8, *x8; float *su, *sxq, *sel_su;
  float* rss;
  bf16_t *q16, *kvh, *p16; float* sx; int* sel_id; float* sel_g; float* pbuf;
  bf16_t *qlat16, *ckv16, *iq16, *ik16; float* sc; unsigned* qctr;
  bf16_t *w_even_in, *w_even_pool, *w_even_out, *w_odd_in, *w_odd_uv, *w_odd_out, *w_xq, *w_xkv, *w_xo, *w_pq;
  unsigned* bar;
  int probe, pad_;
};

#define XB_TMO      128
#define XB_XCNT(j)  (256  + 64 * (j))
#define XB_XSUB(j)  (1280 + 64 * (j))
#define XB_XGEN(j)  (2304 + 64 * (j))
#define XB_TOP      3328
#define XB_TOPGEN   3392
#define XCD_BAR_WORDS 3456
#define XB_SPIN_CAP (1u << 18)
#define LAS __attribute__((address_space(3)))

__device__ __forceinline__ unsigned xb_ld(unsigned* p)              { return __hip_atomic_load(p, __ATOMIC_RELAXED, __HIP_MEMORY_SCOPE_AGENT); }
__device__ __forceinline__ unsigned xb_add(unsigned* p, unsigned v) { return __hip_atomic_fetch_add(p, v, __ATOMIC_RELAXED, __HIP_MEMORY_SCOPE_AGENT); }
__device__ __forceinline__ unsigned xb_xcc_id() { return (unsigned)__builtin_amdgcn_s_getreg((3 << 11) | 20) & 0xFu; }
#define XB_SPIN(cond, bar) do { unsigned _sp = 0; while (cond) { __builtin_amdgcn_s_sleep(1); \
    if ((++_sp & 255u) == 0u) { if (xb_ld(&(bar)[XB_TMO])) break; if (_sp > XB_SPIN_CAP) { atomicAdd(&(bar)[XB_TMO], 1u); break; } } } } while (0)

typedef const __attribute__((address_space(3))) Params& PRef;
DI const __attribute__((address_space(3))) Params* lp(const __attribute__((address_space(3))) Params* q) { asm volatile("" : "+v"(q)); return q; }
struct XcdBarrier {
    unsigned* bar; unsigned x;
    volatile LAS unsigned* st;
};

__device__ __forceinline__ XcdBarrier xcd_barrier_post(unsigned* bar, volatile LAS unsigned* st) {
    XcdBarrier b; b.bar = bar; b.x = xb_xcc_id(); b.st = st;
    if (threadIdx.x == 0) (void)xb_add(&bar[XB_XCNT(b.x)], 1u);
    return b;
}
__device__ __forceinline__ void xcd_barrier_complete(unsigned* bar, unsigned x, unsigned& nloc, unsigned& nx) {
    const unsigned G = gridDim.x * gridDim.y * gridDim.z;
    unsigned sum, cnt, mine, sp = 0u;
    for (;;) {
        sum = 0u; cnt = 0u; mine = 0u;
#pragma unroll
        for (unsigned j = 0; j < 16; ++j) { const unsigned c = xb_ld(&bar[XB_XCNT(j)]); sum += c; cnt += (c > 0u) ? 1u : 0u; mine = (j == x) ? c : mine; }
        if (sum == G) break;
        __builtin_amdgcn_s_sleep(1);
        if ((++sp & 255u) == 0u) { if (xb_ld(&bar[XB_TMO])) break; if (sp > XB_SPIN_CAP) { atomicAdd(&bar[XB_TMO], 1u); break; } }
    }
    nloc = mine > 0u ? mine : 1u; nx = cnt > 0u ? cnt : 1u;
}

__device__ __forceinline__ void xcd_barrier(const XcdBarrier& b) {
    asm volatile("s_waitcnt vmcnt(0)" ::: "memory");
    __syncthreads();
    if (threadIdx.x == 0) {
        unsigned* bar = b.bar;
        __builtin_amdgcn_s_waitcnt(0);
        unsigned nloc = b.st[0], nx = b.st[1];
        if (nloc == 0u) { xcd_barrier_complete(bar, b.x, nloc, nx); b.st[0] = nloc; b.st[1] = nx; }
        const unsigned old = xb_add(&bar[XB_XSUB(b.x)], 1u);
        const unsigned gen = old / nloc;
        if (old + 1u == (gen + 1u) * nloc) {
            __builtin_amdgcn_fence(__ATOMIC_RELEASE, "agent");
            asm volatile("s_waitcnt vmcnt(0)" ::: "memory");
            const unsigned og = xb_add(&bar[XB_TOP], 1u);
            const unsigned tg = og / nx;
            if (og + 1u == (tg + 1u) * nx) xb_add(&bar[XB_TOPGEN], 1u);
            else XB_SPIN(xb_ld(&bar[XB_TOPGEN]) == tg, bar);
            __builtin_amdgcn_fence(__ATOMIC_ACQUIRE, "agent");
            xb_add(&bar[XB_XGEN(b.x)], 1u);
            asm volatile("s_waitcnt vmcnt(0)" ::: "memory");
        } else {
            XB_SPIN(xb_ld(&bar[XB_XGEN(b.x)]) == gen, bar);
            __builtin_amdgcn_fence(__ATOMIC_ACQUIRE, "agent");
            asm volatile("s_waitcnt vmcnt(0)" ::: "memory");
        }
    }
    __syncthreads();
}


typedef __bf16 bf16x2_t __attribute__((ext_vector_type(2)));
typedef float f32x2_t __attribute__((ext_vector_type(2)));
using bf16x8 = __attribute__((ext_vector_type(8))) short;
using f32x16 = __attribute__((ext_vector_type(16))) float;
using u32x4 = __attribute__((ext_vector_type(4))) unsigned;
using u32x2 = __attribute__((ext_vector_type(2))) unsigned;
using f32x4v = __attribute__((ext_vector_type(4))) float;
using f32x2v = __attribute__((ext_vector_type(2))) float;
#define GAS __attribute__((address_space(1)))
typedef const GAS u32x4* gp_u32x4;
DI u32x4 gload16(const void* p) { return *(gp_u32x4)(p); }
DI bf16_t f2bf(float f) { __bf16 b = (__bf16)f; return __builtin_bit_cast(unsigned short, b); }
DI unsigned pack2(float a, float b) { f32x2_t v = {a, b}; bf16x2_t r = __builtin_convertvector(v, bf16x2_t); return __builtin_bit_cast(unsigned, r); }
DI float bf2f(bf16_t u) { return __uint_as_float(((unsigned)u) << 16); }
DI float bflo(unsigned u) { return __uint_as_float(u << 16); }
DI float bfhi(unsigned u) { return __uint_as_float(u & 0xffff0000u); }
DI f32x4v bf4_to_f(const u32x2 v) { const unsigned a = v[0], b = v[1]; f32x4v r; r[0] = bflo(a); r[1] = bfhi(a); r[2] = bflo(b); r[3] = bfhi(b); return r; }
DI int ltid(int wq) { int t; asm volatile("v_mbcnt_lo_u32_b32 %0, -1, 0\n\tv_mbcnt_hi_u32_b32 %0, -1, %0" : "=v"(t)); return (wq << 6) | t; }
DI int lbid() { int b = blockIdx.x; asm volatile("" : "+s"(b)); return b; }
#define DPP_F(v, ctrl, rmask, bctl) __int_as_float(__builtin_amdgcn_update_dpp(0, __float_as_int(v), (ctrl), (rmask), 0xF, (bctl)))
DI float wave_sum(float v) {
  v += DPP_F(v, 0xB1, 0xF, true);
  v += DPP_F(v, 0x4E, 0xF, true);
  v += DPP_F(v, 0x141, 0xF, true);
  v += DPP_F(v, 0x140, 0xF, true);
  v += DPP_F(v, 0x142, 0xA, false);
  v += DPP_F(v, 0x143, 0xC, false);
  return __int_as_float(__builtin_amdgcn_readlane(__float_as_int(v), 63));
}
#define DPP_I(v, ctrl, rmask, bctl) __builtin_amdgcn_update_dpp(0, (v), (ctrl), (rmask), 0xF, (bctl))
DI int wave_sum_i(int v) {
  v += DPP_I(v, 0xB1, 0xF, true); v += DPP_I(v, 0x4E, 0xF, true); v += DPP_I(v, 0x141, 0xF, true); v += DPP_I(v, 0x140, 0xF, true);
  v += DPP_I(v, 0x142, 0xA, false); v += DPP_I(v, 0x143, 0xC, false);
  return __builtin_amdgcn_readlane(v, 63);
}
DI float wave_max(float v) {
  v = fmaxf(v, DPP_F(v, 0xB1, 0xF, true));
  v = fmaxf(v, DPP_F(v, 0x4E, 0xF, true));
  v = fmaxf(v, DPP_F(v, 0x141, 0xF, true));
  v = fmaxf(v, DPP_F(v, 0x140, 0xF, true));
  { const float t = __int_as_float(__builtin_amdgcn_update_dpp(__float_as_int(v), __float_as_int(v), 0x142, 0xA, 0xF, false)); v = fmaxf(v, t); }
  { const float t = __int_as_float(__builtin_amdgcn_update_dpp(__float_as_int(v), __float_as_int(v), 0x143, 0xC, 0xF, false)); v = fmaxf(v, t); }
  return __int_as_float(__builtin_amdgcn_readlane(__float_as_int(v), 63));
}
DI float rowsum16(float v) { v += DPP_F(v, 0x128, 0xF, true); v += DPP_F(v, 0x124, 0xF, true); v += DPP_F(v, 0x122, 0xF, true); v += DPP_F(v, 0x121, 0xF, true); return v; }
DI float rowmax16(float v) { v = fmaxf(v, DPP_F(v, 0x128, 0xF, true)); v = fmaxf(v, DPP_F(v, 0x124, 0xF, true)); v = fmaxf(v, DPP_F(v, 0x122, 0xF, true)); v = fmaxf(v, DPP_F(v, 0x121, 0xF, true)); return v; }
DI float shx(float v, int mask, int lane) { return __int_as_float(__builtin_amdgcn_ds_bpermute((lane ^ mask) << 2, __float_as_int(v))); }
DI int shxi(int v, int mask, int lane) { return __builtin_amdgcn_ds_bpermute((lane ^ mask) << 2, v); }
DI float gelu_tanh(float x) {
  const float k0 = 0.7978845608028654f, k1 = 0.044715f;
  return 0.5f * x * (1.f + tanhf(k0 * (x + k1 * x * x * x)));
}
DI float sigmoidf(float x) { return 1.f / (1.f + expf(-x)); }

DI float rstd_of(const float* __restrict__ rss, int row) {
  const float* q = rss + (size_t)row * 16;
  const f32x4v a = *(const f32x4v*)q, b = *(const f32x4v*)(q + 4), c = *(const f32x4v*)(q + 8), d = *(const f32x4v*)(q + 12);
  const float s0 = (a[0] + a[1]) + (a[2] + a[3]), s1 = (b[0] + b[1]) + (b[2] + b[3]), s2 = (c[0] + c[1]) + (c[2] + c[3]), s3 = (d[0] + d[1]) + (d[2] + d[3]);
  return rsqrtf(((s0 + s1) + (s2 + s3)) * (1.f / 1024.f) + 1e-6f);
}
DI void phase_init_h(const int wq, const float* __restrict__ x, float* __restrict__ h, bf16_t* __restrict__ hb, float* __restrict__ rss) {
  const int tid = ltid(wq); const int bid = lbid();
  const int lane = tid & 63, wv = tid >> 6;
  for (int r = bid * 4 + wv; r < T; r += gridDim.x * 4) {
    float ss = 0.f;
#pragma unroll
    for (int i = 0; i < 4; ++i) {
      const u32x4 v = gload16(x + (size_t)r * D + i * 256 + lane * 4);
      const unsigned v0 = v[0], v1 = v[1], v2 = v[2], v3 = v[3];
      const float a = __uint_as_float(v0), b = __uint_as_float(v1), c = __uint_as_float(v2), d = __uint_as_float(v3);
      ss += a * a + b * b + c * c + d * d;
      *(GAS u32x4*)(h + (size_t)r * D + i * 256 + lane * 4) = v;
      u32x2 o; o[0] = pack2(a, b); o[1] = pack2(c, d);
      *(GAS u32x2*)(hb + (size_t)r * D + i * 256 + lane * 4) = o;
    }
    ss = wave_sum(ss);
    if (lane < 16) rss[(size_t)r * 16 + lane] = lane == 0 ? ss : 0.f;
  }
}

DI void phase_rmsnorm_bf(const int wq, const float* __restrict__ in, int ldi, const float* __restrict__ g, bf16_t* __restrict__ out, int ldo, int rows, int W) {
  const int tid_ = ltid(wq); const int bid_ = lbid();
  const int lane = tid_ & 63, wv = tid_ >> 6;
  f32x4v gv[4];
#pragma unroll
  for (int i = 0; i < 4; ++i) gv[i] = *(const f32x4v*)(g + i * 256 + lane * 4);
  for (int r = bid_ * 4 + wv; r < rows; r += gridDim.x * 4) {
    const float* p = in + (size_t)r * ldi;
    u32x4 v[4];
#pragma unroll
    for (int i = 0; i < 4; ++i) v[i] = gload16(p + i * 256 + lane * 4);
    float ss = 0.f;
#pragma unroll
    for (int i = 0; i < 4; ++i) {
      const float a = __uint_as_float(v[i][0]), b = __uint_as_float(v[i][1]), c = __uint_as_float(v[i][2]), d = __uint_as_float(v[i][3]);
      ss += a * a + b * b + c * c + d * d;
    }
    ss = wave_sum(ss);
    const float rs = rsqrtf(ss / (float)W + 1e-6f);
    bf16_t* o = out + (size_t)r * ldo;
#pragma unroll
    for (int i = 0; i < 4; ++i) {
      u32x2 ov;
      ov[0] = pack2(__uint_as_float(v[i][0]) * rs * gv[i][0], __uint_as_float(v[i][1]) * rs * gv[i][1]);
      ov[1] = pack2(__uint_as_float(v[i][2]) * rs * gv[i][2], __uint_as_float(v[i][3]) * rs * gv[i][3]);
      *(GAS u32x2*)(o + i * 256 + lane * 4) = ov;
    }
  }
}

DI void phase_convert(const int wq, const float* __restrict__ W0, int K, int N, int ldw, bf16_t* __restrict__ Bt0, int Npad, const float* __restrict__ cs0,
                      int nbatch, size_t sW, size_t sBt, size_t sCS, float* smem, const float* __restrict__ rs0 = nullptr, size_t sRS = 0) {
  const int tid = ltid(wq); const int bid = lbid();
  float (*tl)[65] = (float (*)[65])smem;
  const int tk = K / 64, tn = Npad / 64;
  for (int tile0 = bid; tile0 < tk * tn * nbatch; tile0 += gridDim.x) {
    const int bt = tile0 / (tk * tn), tile = tile0 % (tk * tn);
    const int k0 = (tile / tn) * 64, n0 = (tile % tn) * 64;
    const float* W = W0 + (size_t)bt * sW;
    bf16_t* Bt = Bt0 + (size_t)bt * sBt;
    __syncthreads();
#pragma unroll 4
    for (int i = 0; i < 16; ++i) {
      const int k = i * 4 + (tid >> 6), n = tid & 63;
      float v = 0.f;
      if (n0 + n < N) { v = W[(size_t)(k0 + k) * ldw + n0 + n]; if (cs0) v *= cs0[(size_t)bt * sCS + n0 + n]; if (rs0) v *= rs0[(size_t)bt * sRS + k0 + k]; }
      tl[k][n] = v;
    }
    __syncthreads();
#pragma unroll 4
    for (int i = 0; i < 16; ++i) {
      const int n = i * 4 + (tid >> 6), k = tid & 63;
      Bt[(size_t)(n0 + n) * K + k0 + k] = f2bf(tl[k][n]);
    }
  }
}

constexpr int G_LDS_ROW = 144;
constexpr int G_TILE_B = 128 * G_LDS_ROW;
template <int MODE, int RS = 0>
DI void phase_gemm_bf16(const int wq, const bf16_t* __restrict__ A0, int lda, const bf16_t* __restrict__ B0, void* __restrict__ C0, int ldc,
                        int M, int N, int K, char* smem, int dry, int nbatch = 1, size_t sA = 0, size_t sB = 0, size_t sC = 0,
                        int inner = 1, size_t sA2 = 0, size_t sC2 = 0, const float* __restrict__ rss_in = nullptr, bf16_t* __restrict__ hb_out = nullptr, float* __restrict__ rss_out = nullptr) {
  const int tid = ltid(wq); const int bid = lbid();
  const int lane = tid & 63, wv = tid >> 6, wm = wv >> 1, wn = wv & 1;
  const int r = lane & 31, hh = lane >> 5;
  const int tm = M / 128, tn = (N + 127) / 128;
  const int nk = K / 64;
  const int srow = tid >> 3, skc = tid & 7;
  const int ntile_all = tm * tn * nbatch;
  const int per_x = (ntile_all + 7) >> 3;
  const int t_beg = (bid & 7) * per_x, t_end = (t_beg + per_x < ntile_all) ? t_beg + per_x : ntile_all;
  for (int tile0 = t_beg + (bid >> 3); tile0 < t_end; tile0 += (int)(gridDim.x >> 3)) {
    const int bt = tile0 / (tm * tn), tile = tile0 % (tm * tn);
    const int m0 = (tile / tn) * 128, n0 = (tile % tn) * 128;
    const int bhi = bt / inner, blo = bt % inner;
    const bf16_t* Ag = A0 + (size_t)bhi * sA + (size_t)blo * sA2 + (size_t)(m0 + srow) * lda + skc * 8;
    const bf16_t* Bg = B0 + (size_t)bt * sB + (size_t)(n0 + srow) * K + skc * 8;
    f32x16 acc[2][2];
#pragma unroll
    for (int i = 0; i < 2; ++i)
#pragma unroll
      for (int j = 0; j < 2; ++j)
#pragma unroll
        for (int e = 0; e < 16; ++e) acc[i][j][e] = 0.f;
    u32x4 ra[4], rb[4];
#pragma unroll
    for (int i = 0; i < 4; ++i) {
      ra[i] = gload16(Ag + (size_t)(32 * i) * lda);
      rb[i] = gload16(Bg + (size_t)(32 * i) * K);
    }
    __syncthreads();
#pragma unroll
    for (int i = 0; i < 4; ++i) {
      *(u32x4*)(smem + (srow + 32 * i) * G_LDS_ROW + skc * 16) = ra[i];
      *(u32x4*)(smem + 2 * G_TILE_B + (srow + 32 * i) * G_LDS_ROW + skc * 16) = rb[i];
    }
    __syncthreads();
#pragma unroll 1
    for (int kt = 0; kt < nk; ++kt) {
      const int cur = kt & 1;
      if (kt + 1 < nk) {
#pragma unroll
        for (int i = 0; i < 4; ++i) {
          ra[i] = gload16(Ag + (size_t)(32 * i) * lda + (kt + 1) * 64);
          rb[i] = gload16(Bg + (size_t)(32 * i) * K + (kt + 1) * 64);
        }
      }
      const char* As = smem + cur * G_TILE_B + (wm * 64 + r) * G_LDS_ROW + hh * 16;
      const char* Bs = smem + 2 * G_TILE_B + cur * G_TILE_B + (wn * 64 + r) * G_LDS_ROW + hh * 16;
#pragma unroll
      for (int ks = 0; ks < 4; ++ks) {
        bf16x8 a0 = *(const bf16x8*)(As + ks * 32);
        bf16x8 a1 = *(const bf16x8*)(As + 32 * G_LDS_ROW + ks * 32);
        bf16x8 b0 = *(const bf16x8*)(Bs + ks * 32);
        bf16x8 b1 = *(const bf16x8*)(Bs + 32 * G_LDS_ROW + ks * 32);
        acc[0][0] = __builtin_amdgcn_mfma_f32_32x32x16_bf16(a0, b0, acc[0][0], 0, 0, 0);
        acc[0][1] = __builtin_amdgcn_mfma_f32_32x32x16_bf16(a0, b1, acc[0][1], 0, 0, 0);
        acc[1][0] = __builtin_amdgcn_mfma_f32_32x32x16_bf16(a1, b0, acc[1][0], 0, 0, 0);
        acc[1][1] = __builtin_amdgcn_mfma_f32_32x32x16_bf16(a1, b1, acc[1][1], 0, 0, 0);
      }
      if (kt + 1 < nk) {
        const int nxt = cur ^ 1;
#pragma unroll
        for (int i = 0; i < 4; ++i) {
          *(u32x4*)(smem + nxt * G_TILE_B + (srow + 32 * i) * G_LDS_ROW + skc * 16) = ra[i];
          *(u32x4*)(smem + 2 * G_TILE_B + nxt * G_TILE_B + (srow + 32 * i) * G_LDS_ROW + skc * 16) = rb[i];
        }
      }
      __syncthreads();
    }
    if (RS) {
      if (tid < 128) ((float*)smem)[tid] = rstd_of(rss_in, m0 + tid);
      __syncthreads();
    }
#pragma unroll
    for (int i = 0; i < 2; ++i)
#pragma unroll
      for (int j = 0; j < 2; ++j) {
        const int col = n0 + wn * 64 + j * 32 + r;
        if (col < N && !dry) {
          const size_t base = (size_t)bhi * sC + (size_t)blo * sC2 + (size_t)(m0 + wm * 64 + i * 32 + 4 * hh) * ldc + col;
          if (RS) {
            const float* rp = (const float*)smem + wm * 64 + i * 32 + 4 * hh;
#pragma unroll
            for (int e = 0; e < 16; ++e) acc[i][j][e] *= rp[(e & 3) + 8 * (e >> 2)];
          }
          if (MODE == 1) {
            GAS float* cp = (GAS float*)C0 + base;
            float old[16];
#pragma unroll
            for (int e = 0; e < 16; ++e) old[e] = cp[(size_t)((e & 3) + 8 * (e >> 2)) * ldc];
#pragma unroll
            for (int e = 0; e < 16; ++e) { old[e] += acc[i][j][e]; acc[i][j][e] = old[e]; cp[(size_t)((e & 3) + 8 * (e >> 2)) * ldc] = old[e]; }
            if (hb_out) {
              GAS bf16_t* hp = (GAS bf16_t*)hb_out + base;
#pragma unroll
              for (int e = 0; e < 16; ++e) hp[(size_t)((e & 3) + 8 * (e >> 2)) * ldc] = f2bf(old[e]);
            }
          } else if (MODE == 0) {
            GAS float* cp = (GAS float*)C0 + base;
#pragma unroll
            for (int e = 0; e < 16; ++e) cp[(size_t)((e & 3) + 8 * (e >> 2)) * ldc] = acc[i][j][e];
          } else if (MODE == 2) {
            GAS bf16_t* cp = (GAS bf16_t*)C0 + base;
#pragma unroll
            for (int e = 0; e < 16; ++e) cp[(size_t)((e & 3) + 8 * (e >> 2)) * ldc] = f2bf(acc[i][j][e]);
          } else if (MODE == 4) {
            GAS bf16_t* cp = (GAS bf16_t*)C0 + base;
#pragma unroll
            for (int e = 0; e < 16; ++e) cp[(size_t)((e & 3) + 8 * (e >> 2)) * ldc] = f2bf(acc[i][j][e] * 0.0625f);
          } else {
            const int rowb = m0 + wm * 64 + i * 32 + 4 * hh;
            const int b_ = rowb >> 8, mm = rowb & 255;
            const int cc = col & 1023, hd_ = cc >> 8, dd = cc & 255;
            GAS bf16_t* kb = (GAS bf16_t*)C0;
            if (col < 1024) {
#pragma unroll
              for (int e = 0; e < 16; ++e) kb[((size_t)(b_ * 4 + hd_) * 256 + mm + (e & 3) + 8 * (e >> 2)) * 256 + dd] = f2bf(acc[i][j][e]);
            } else {
#pragma unroll
              for (int e = 0; e < 16; ++e) kb[(size_t)2048 * 1024 + ((size_t)(b_ * 4 + hd_) * 256 + dd) * 256 + mm + (e & 3) + 8 * (e >> 2)] = f2bf(acc[i][j][e]);
            }
          }
        }
      }
    if (MODE == 1 && rss_out && !dry) {
#pragma unroll
      for (int i = 0; i < 2; ++i) {
        float myv = 0.f;
#pragma unroll
        for (int e = 0; e < 16; ++e) {
          float v = acc[i][0][e] * acc[i][0][e] + acc[i][1][e] * acc[i][1][e];
          v = rowsum16(v);
          v += shx(v, 16, lane);
          if ((lane & 15) == e) myv = v;
        }
        if ((lane & 16) == 0) rss_out[(size_t)(m0 + wm * 64 + i * 32 + (lane & 3) + 8 * ((lane & 15) >> 2) + 4 * hh) * 16 + (n0 >> 7) * 2 + wn] = myv;
      }
    }
  }
}

template <int W>
DI void evenmix_run(const bf16_t* __restrict__ P, const float* __restrict__ cw, bf16_t* __restrict__ Y, bf16_t* __restrict__ pool, int t0, int c) {
  const int s0 = t0 & (S - 1);
  f32x4v w0 = *(const f32x4v*)(cw + c), w1 = *(const f32x4v*)(cw + 512 + c), w2 = *(const f32x4v*)(cw + 1024 + c);
  const f32x4v zero = {0.f, 0.f, 0.f, 0.f};
  auto ld = [&](int t, int off) { const u32x2 v = *(const GAS u32x2*)(P + (size_t)t * EVEN_IN + off + c); return bf4_to_f(v); };
  f32x4v xm2 = zero, xm1 = zero;
  if (s0 >= 2) xm2 = ld(t0 - 2, 512) * ld(t0 - 2, 0);
  if (s0 >= 1) xm1 = ld(t0 - 1, 512) * ld(t0 - 1, 0);
  f32x4v ring[W];
  f32x4v sum = zero;
#pragma unroll
  for (int i = 0; i < W; ++i) { ring[i] = (s0 + i - W >= 0) ? ld(t0 + i - W, 1536) : zero; sum += ring[i]; }
#pragma unroll
  for (int tt = 0; tt < 32; ++tt) {
    const int t = t0 + tt;
    const f32x4v x0 = ld(t, 512) * ld(t, 0);
    const f32x4v z = w0 * xm2 + w1 * xm1 + w2 * x0;
    xm2 = xm1; xm1 = x0;
    const f32x4v ya = ld(t, 1024) * z;
    const f32x4v pv = ld(t, 1536);
    sum += pv - ring[tt % W]; ring[tt % W] = pv;
    const int cnt = (s0 + tt + 1 < W) ? (s0 + tt + 1) : W;
    const float ic = 1.f / (float)cnt;
    const f32x4v pl = sum * ic - pv;
    u32x2 oa, ob;
    oa[0] = pack2(ya[0], ya[1]); oa[1] = pack2(ya[2], ya[3]);
    ob[0] = pack2(pl[0], pl[1]); ob[1] = pack2(pl[2], pl[3]);
    *(GAS u32x2*)(Y + (size_t)t * D + c) = oa;
    *(GAS u32x2*)(pool + (size_t)t * 512 + c) = ob;
  }
}
DI void phase_evenmix(const int wq, PRef p, int j) {
  const int tid = ltid(wq); const int bid = lbid();
  const int lane = tid & 63, wv = tid >> 6;
  const float* cw = p.even_conv_w + (size_t)j * 3 * 512;
  for (int Wg = bid * 4 + wv; Wg < 1024; Wg += gridDim.x * 4) {
    const int g = Wg & 3, cp = Wg >> 2;
    const int t0 = (cp * 2 + (lane >> 5)) * 32;
    const int c = g * 128 + (lane & 31) * 4;
    if (g == 0) evenmix_run<2>(p.P16, cw, p.Y, p.pool, t0, c);
    else if (g == 1) evenmix_run<4>(p.P16, cw, p.Y, p.pool, t0, c);
    else if (g == 2) evenmix_run<8>(p.P16, cw, p.Y, p.pool, t0, c);
    else evenmix_run<16>(p.P16, cw, p.Y, p.pool, t0, c);
  }
}

DI void phase_lb(const int wq, PRef p) {
  const int tid_ = ltid(wq); const int bid_ = lbid(); (void)tid_; (void)bid_;
  for (int c = bid_ * NT + tid_; c < 512; c += gridDim.x * NT) {
    float g[DEPTH], m = -INFINITY;
#pragma unroll
    for (int l = 0; l < DEPTH; ++l) { g[l] = p.hgrn_gamma[l * 512 + c]; m = fmaxf(m, g[l]); }
    float sum = 0.f;
#pragma unroll
    for (int l = 0; l < DEPTH; ++l) { g[l] = expf(g[l] - m); sum += g[l]; }
    float cum = 0.f;
#pragma unroll
    for (int l = 0; l < DEPTH; ++l) { p.lb[l * 512 + c] = cum; cum += g[l] / sum; }
  }
}

DI int t5_bucket(int dist) {
  const int d = dist < 0 ? 0 : dist;
  if (d < 16) return d;
  const float lr = logf((float)d / 16.f) / 2.0794415416798357f;
  int large = 16 + (int)(lr * 16.f);
  return large < 31 ? large : 31;
}

DI unsigned fkey(float f) { unsigned u = __float_as_uint(f); return (u & 0x80000000u) ? ~u : (u | 0x80000000u); }

DI void phase_hgrn_post(const int wq, PRef p, int j) {
  const int tid_ = ltid(wq); const int bid_ = lbid(); (void)tid_; (void)bid_;
  const int lane = tid_ & 63, wv = tid_ >> 6;
  for (int r = bid_ * 4 + wv; r < T * 4; r += gridDim.x * 4) {
    const int t = r >> 2, hd = r & 3;
    const float* o = p.oraw + (size_t)t * 512 + hd * 128;
    const float a = o[lane], bq = o[lane + 64];
    const float ss = wave_sum(a * a + bq * bq);
    const float rs = rsqrtf(ss / 128.f + 1e-6f);
    const bf16_t* gate = p.P16 + (size_t)t * ODD_IN + 3272 + hd * 128;
    const float* gn = p.odd_hg_norm + j * 512 + hd * 128;
    const float g0 = bf2f(gate[lane]), g1 = bf2f(gate[lane + 64]);
    p.Y[(size_t)t * D + 512 + hd * 128 + lane] = f2bf(a * rs * gn[lane] * (g0 * sigmoidf(g0)));
    p.Y[(size_t)t * D + 512 + hd * 128 + lane + 64] = f2bf(bq * rs * gn[lane + 64] * (g1 * sigmoidf(g1)));
  }
}

DI void phase_dsa_prep(const int wq, PRef p, int j) {
  const int tid = ltid(wq); const int bid = lbid();
  const int lane = tid & 63, wv = tid >> 6;
  for (int t = bid * 4 + wv; t < T; t += gridDim.x * 4) {
    const bf16_t* row = p.P16 + (size_t)t * ODD_IN;
#pragma unroll
    for (int c = 0; c < 2; ++c) *(GAS u32x4*)(p.qlat16 + (size_t)t * 1024 + c * 512 + lane * 8) = gload16(row + c * 512 + lane * 8);
    {
      const unsigned cv = *(const GAS unsigned*)(row + 1024 + 2 * lane);
      const float c0 = bflo(cv), c1 = bfhi(cv);
      const float ss = wave_sum(c0 * c0 + c1 * c1);
      const float rs = rsqrtf(ss / 128.f + 1e-6f);
      const float* g = p.odd_kv_norm + j * 128;
      *(GAS unsigned*)(p.ckv16 + (size_t)t * 128 + 2 * lane) = pack2(c0 * rs * g[2 * lane], c1 * rs * g[2 * lane + 1]);
    }
    *(GAS u32x4*)(p.iq16 + (size_t)t * 512 + lane * 8) = gload16(row + 1152 + lane * 8);
    p.ik16[(size_t)t * 64 + lane] = row[1664 + lane];
  }
}

DI void phase_dsa_scores(const int wq, PRef p, char* smem) {
  const int tid = ltid(wq); const int bid = lbid();
  const int lane = tid & 63, wv = tid >> 6, wm = wv >> 1, wn = wv & 1;
  const int r = lane & 31, hh = lane >> 5;
  const int srow = tid >> 3, skc = tid & 7;
  char* Ks = smem;
  char* Qs = smem + G_TILE_B;
  float* Ws = (float*)(smem + 3 * G_TILE_B);
  for (int tile = bid; tile < NB * 136; tile += gridDim.x) {
    const int b = tile / 136, u = tile % 136;
    int qb = 0;
    while ((qb + 1) * (qb + 2) / 2 <= u) ++qb;
    const int kb = u - qb * (qb + 1) / 2;
    const int q0 = b * S + qb * 128, k0 = b * S + kb * 128;
    const bf16_t* Kg = p.ik16 + (size_t)(k0 + srow) * 64 + skc * 8;
    const bf16_t* Qg = p.iq16 + (size_t)(q0 + srow) * 512 + skc * 8;
    u32x4 rk[4], rq[4];
#pragma unroll
    for (int i = 0; i < 4; ++i) { rk[i] = gload16(Kg + (size_t)(32 * i) * 64); rq[i] = gload16(Qg + (size_t)(32 * i) * 512); }
    u32x4 wv4 = {0u, 0u, 0u, 0u};
    if (tid < 128) wv4 = gload16(p.P16 + (size_t)(q0 + tid) * ODD_IN + 1728);
    __syncthreads();
#pragma unroll
    for (int i = 0; i < 4; ++i) {
      *(u32x4*)(Ks + (srow + 32 * i) * G_LDS_ROW + skc * 16) = rk[i];
      *(u32x4*)(Qs + (srow + 32 * i) * G_LDS_ROW + skc * 16) = rq[i];
    }
    if (tid < 128) {
      const unsigned w0 = wv4[0], w1 = wv4[1], w2 = wv4[2], w3 = wv4[3];
      f32x4v a4, b4;
      a4[0] = bflo(w0) * 0.35355339059327373f; a4[1] = bfhi(w0) * 0.35355339059327373f; a4[2] = bflo(w1) * 0.35355339059327373f; a4[3] = bfhi(w1) * 0.35355339059327373f;
      b4[0] = bflo(w2) * 0.35355339059327373f; b4[1] = bfhi(w2) * 0.35355339059327373f; b4[2] = bflo(w3) * 0.35355339059327373f; b4[3] = bfhi(w3) * 0.35355339059327373f;
      *(f32x4v*)(Ws + tid * 8) = a4; *(f32x4v*)(Ws + tid * 8 + 4) = b4;
    }
    __syncthreads();
    f32x16 sc[2][2];
#pragma unroll
    for (int i = 0; i < 2; ++i)
#pragma unroll
      for (int jx = 0; jx < 2; ++jx)
#pragma unroll
        for (int e = 0; e < 16; ++e) sc[i][jx][e] = 0.f;
#pragma unroll 1
    for (int hd = 0; hd < 8; ++hd) {
      const int cur = hd & 1;
      if (hd + 1 < 8) {
#pragma unroll
        for (int i = 0; i < 4; ++i) rq[i] = gload16(Qg + (size_t)(32 * i) * 512 + (hd + 1) * 64);
      }
      f32x16 acc[2][2];
#pragma unroll
      for (int i = 0; i < 2; ++i)
#pragma unroll
        for (int jx = 0; jx < 2; ++jx)
#pragma unroll
          for (int e = 0; e < 16; ++e) acc[i][jx][e] = 0.f;
      const char* As = Qs + cur * G_TILE_B + (wm * 64 + r) * G_LDS_ROW + hh * 16;
      const char* Bs = Ks + (wn * 64 + r) * G_LDS_ROW + hh * 16;
#pragma unroll
      for (int ks = 0; ks < 4; ++ks) {
        const bf16x8 a0 = *(const bf16x8*)(As + ks * 32), a1 = *(const bf16x8*)(As + 32 * G_LDS_ROW + ks * 32);
        const bf16x8 b0 = *(const bf16x8*)(Bs + ks * 32), b1 = *(const bf16x8*)(Bs + 32 * G_LDS_ROW + ks * 32);
        acc[0][0] = __builtin_amdgcn_mfma_f32_32x32x16_bf16(a0, b0, acc[0][0], 0, 0, 0);
        acc[0][1] = __builtin_amdgcn_mfma_f32_32x32x16_bf16(a0, b1, acc[0][1], 0, 0, 0);
        acc[1][0] = __builtin_amdgcn_mfma_f32_32x32x16_bf16(a1, b0, acc[1][0], 0, 0, 0);
        acc[1][1] = __builtin_amdgcn_mfma_f32_32x32x16_bf16(a1, b1, acc[1][1], 0, 0, 0);
      }
#pragma unroll
      for (int i = 0; i < 2; ++i)
#pragma unroll
        for (int e = 0; e < 16; ++e) {
          const float w = Ws[(wm * 64 + i * 32 + (e & 3) + 8 * (e >> 2) + 4 * hh) * 8 + hd];
          sc[i][0][e] = fmaf(w, fmaxf(acc[i][0][e] * 0.125f, 0.f), sc[i][0][e]);
          sc[i][1][e] = fmaf(w, fmaxf(acc[i][1][e] * 0.125f, 0.f), sc[i][1][e]);
        }
      if (hd + 1 < 8) {
#pragma unroll
        for (int i = 0; i < 4; ++i) *(u32x4*)(Qs + (cur ^ 1) * G_TILE_B + (srow + 32 * i) * G_LDS_ROW + skc * 16) = rq[i];
      }
      __syncthreads();
    }
#pragma unroll
    for (int i = 0; i < 2; ++i)
#pragma unroll
      for (int jx = 0; jx < 2; ++jx) {
        GAS float* cp = (GAS float*)p.sc + (size_t)(q0 + wm * 64 + i * 32 + 4 * hh) * 2048 + kb * 128 + wn * 64 + jx * 32 + r;
#pragma unroll
        for (int e = 0; e < 16; ++e) cp[(size_t)((e & 3) + 8 * (e >> 2)) * 2048] = sc[i][jx][e];
      }
  }
}

DI void phase_hgrn_scan(const int wq, PRef p, int l, char* smem) {
  const int tid = ltid(wq); const int bid = lbid();
  const int lane = tid & 63, wv = tid >> 6;
  const int kq = wv * 4 + (lane & 3), v = lane >> 2;
  constexpr int BUF = (2048 + 2048 + 256);
  float* bufs = (float*)smem;
  float* opart = bufs + 2 * BUF;
  for (int unit = bid; unit < 256; unit += gridDim.x) {
    const int b = unit >> 5, hd = (unit >> 3) & 3, vs = unit & 7;
    const int ltok = tid >> 4, lc = (tid & 15) * 8;
    const bf16_t* Pb = p.P16 + (size_t)(b * S) * ODD_IN;
    f32x4v lbv0, lbv1;
    { const float* lbp = p.lb + l * 512 + hd * 128 + lc; lbv0 = *(const f32x4v*)lbp; lbv1 = *(const f32x4v*)(lbp + 4); }
    float st[8];
#pragma unroll
    for (int i = 0; i < 8; ++i) st[i] = 0.f;
    u32x4 rq, rf; float riv;
    auto gl = [&](int bt) {
      const bf16_t* row = Pb + (size_t)(bt * 16 + ltok) * ODD_IN;
      rq = gload16(row + 1736 + hd * 128 + lc);
      rf = gload16(row + 2248 + hd * 128 + lc);
      riv = bf2f(row[2760 + hd * 128 + vs * 16 + (tid & 15)]);
    };
    auto st_lds = [&](int which) {
      float* bq = bufs + which * BUF; float* bf = bq + 2048; float* bi = bf + 2048;
      const unsigned q0_ = rq[0], q1_ = rq[1], q2_ = rq[2], q3_ = rq[3], f0_ = rf[0], f1_ = rf[1], f2_ = rf[2], f3_ = rf[3];
      f32x4v qa, qb, fa, fb;
      qa[0] = bflo(q0_); qa[1] = bfhi(q0_); qa[2] = bflo(q1_); qa[3] = bfhi(q1_); qb[0] = bflo(q2_); qb[1] = bfhi(q2_); qb[2] = bflo(q3_); qb[3] = bfhi(q3_);
      fa[0] = bflo(f0_); fa[1] = bfhi(f0_); fa[2] = bflo(f1_); fa[3] = bfhi(f1_); fb[0] = bflo(f2_); fb[1] = bfhi(f2_); fb[2] = bflo(f3_); fb[3] = bfhi(f3_);
      *(f32x4v*)(bq + ltok * 128 + lc) = qa; *(f32x4v*)(bq + ltok * 128 + lc + 4) = qb;
      f32x4v f0, f1;
#pragma unroll
      for (int i = 0; i < 4; ++i) {
        f0[i] = lbv0[i] + (1.f - lbv0[i]) * sigmoidf(fa[i]);
        f1[i] = lbv1[i] + (1.f - lbv1[i]) * sigmoidf(fb[i]);
      }
      *(f32x4v*)(bf + ltok * 128 + lc) = f0; *(f32x4v*)(bf + ltok * 128 + lc + 4) = f1;
      bi[ltok * 16 + (tid & 15)] = riv;
    };
    gl(0);
    __syncthreads();
    st_lds(0);
    __syncthreads();
#pragma unroll 1
    for (int bt = 0; bt < S / 16; ++bt) {
      const int cur = bt & 1;
      if (bt + 1 < S / 16) gl(bt + 1);
      const float* bq = bufs + cur * BUF; const float* bf = bq + 2048; const float* bi = bf + 2048;
#pragma unroll 4
      for (int tt = 0; tt < 16; ++tt) {
        const float iv = bi[tt * 16 + v];
        const f32x4v f0 = *(const f32x4v*)(bf + tt * 128 + kq * 8), f1 = *(const f32x4v*)(bf + tt * 128 + kq * 8 + 4);
        const f32x4v q0 = *(const f32x4v*)(bq + tt * 128 + kq * 8), q1 = *(const f32x4v*)(bq + tt * 128 + kq * 8 + 4);
        float o = 0.f;
#pragma unroll
        for (int i = 0; i < 4; ++i) {
          st[i] = fmaf(f0[i], st[i] - iv, iv); o = fmaf(q0[i], st[i], o);
          st[4 + i] = fmaf(f1[i], st[4 + i] - iv, iv); o = fmaf(q1[i], st[4 + i], o);
        }
        o += __int_as_float(__builtin_amdgcn_update_dpp(0, __float_as_int(o), 0xB1, 0xF, 0xF, true));
        o += __int_as_float(__builtin_amdgcn_update_dpp(0, __float_as_int(o), 0x4E, 0xF, 0xF, true));
        if ((lane & 3) == 0) opart[(tt * 4 + wv) * 16 + v] = o;
      }
      __syncthreads();
      {
        const int tt = tid >> 4, vo = tid & 15;
        const float o = opart[(tt * 4 + 0) * 16 + vo] + opart[(tt * 4 + 1) * 16 + vo] + opart[(tt * 4 + 2) * 16 + vo] + opart[(tt * 4 + 3) * 16 + vo];
        p.oraw[(size_t)(b * S + bt * 16 + tt) * 512 + hd * 128 + vs * 16 + vo] = o;
      }
      if (bt + 1 < S / 16) st_lds(cur ^ 1);
      __syncthreads();
    }
  }
}

DI float dot2bf(unsigned a, unsigned b, float acc) { return __builtin_amdgcn_fdot2_f32_bf16(__builtin_bit_cast(bf16x2_t, a), __builtin_bit_cast(bf16x2_t, b), acc, false); }
DI unsigned fkey_u(float f) { const unsigned u = __float_as_uint(f); return (u & 0x80000000u) ? ~u : (u | 0x80000000u); }
DI void phase_dsa_attend(const int wq, PRef p, int j, char* smem, int qoff) {
  const int tid = ltid(wq); const int bid = lbid(); (void)bid;
  const int lane = tid & 63, wv = tid >> 6;
  int* selL = (int*)smem;
  int* nselL = selL + 1024;
  float* bias = (float*)(smem + 4096 + 64);
  float* part = (float*)(smem + 4096 + 64 + 1024);
  float* msb = part + 2 * 4 * 8 * 128;
  float* plw = msb + 2 * 4 * 16 + wv * 64 * 8;
  int* sel = selL + wv * 256;
  __syncthreads();
  bias[tid] = p.rel_bias[tid];
  const int n16 = lane & 15, kg = lane >> 4;
  const unsigned long long ltmask = (1ull << lane) - 1ull;
  for (;;) {
    __syncthreads();
    if (tid == 0) nselL[4] = (int)atomicAdd(p.qctr + qoff, 4u);
    __syncthreads();
    const int base = nselL[4];
    if (base >= T) break;
    {
      const int q = base + wv;
      const int t = q % S;
      const float* row = p.sc + (size_t)q * 2048;
      int nsel;
      if (t < 256) {
        nsel = t + 1;
#pragma unroll
        for (int i = 0; i < 4; ++i) sel[i * 64 + lane] = i * 64 + lane;
      } else {
        nsel = 256;
        const int ni = (t >> 6) + 1;
        unsigned keys[32];
#pragma unroll
        for (int i = 0; i < 32; ++i) {
          keys[i] = 0u;
          if (i < ni) { const int s_ = i * 64 + lane; if (s_ <= t) keys[i] = fkey_u(row[s_]); }
        }
        unsigned thr = 0u;
#pragma unroll 1
        for (int bit = 31; bit >= 0; --bit) {
          const unsigned cand = thr | (1u << bit);
          int cl = 0;
#pragma unroll
          for (int g = 0; g < 4; ++g) if (g * 8 < ni) {
#pragma unroll
            for (int i = g * 8; i < g * 8 + 8; ++i) cl += (keys[i] >= cand) ? 1 : 0;
          }
          const int cnt = wave_sum_i(cl);
          if (cnt >= 256) thr = cand;
        }
        int ngt = 0;
#pragma unroll
        for (int i = 0; i < 32; ++i) if (i < ni) ngt += __builtin_popcountll(__ballot(keys[i] > thr));
        const int need = 256 - ngt;
        int pg = 0, pe = 0;
#pragma unroll
        for (int i = 0; i < 32; ++i) if (i < ni) {
          const unsigned long long mg = __ballot(keys[i] > thr), me = __ballot(keys[i] == thr);
          const int myg = pg + __builtin_popcountll(mg & ltmask), mye = pe + __builtin_popcountll(me & ltmask);
          if (keys[i] > thr) sel[myg] = i * 64 + lane;
          else if (keys[i] == thr && mye < need) sel[ngt + mye] = i * 64 + lane;
          pg += __builtin_popcountll(mg); pe += __builtin_popcountll(me);
        }
      }
      if (lane == 0) nselL[wv] = nsel;
    }
    __syncthreads();
#pragma unroll 1
    for (int qi = 0; qi < 4; ++qi) {
      const int tid = ltid(wq);
      const int lane = tid & 63;
      const int n16 = lane & 15, kg = lane >> 4;
      const int q = base + qi;
      const int b = q / S, t = q % S;
      const int nsel = nselL[qi];
      const int* qsel = selL + qi * 256 + wv * 64;
      const int slot0 = wv * 64;
      float* pw = part + ((qi & 1) * 4 + wv) * 8 * 128;
      float* mw = msb + ((qi & 1) * 4 + wv) * 16;
      bf16x8 aq[4];
#pragma unroll
      for (int ks = 0; ks < 4; ++ks) {
        u32x4 z = {0u, 0u, 0u, 0u};
        if (n16 < 8) z = gload16(p.qlat16 + (size_t)q * 1024 + n16 * 128 + ks * 32 + kg * 8);
        aq[ks] = __builtin_bit_cast(bf16x8, z);
      }
      u32x4 bv[4][4];
#pragma unroll
      for (int bb = 0; bb < 4; ++bb) {
        const int sl = bb * 16 + n16;
        const int sxv = (slot0 + sl < nsel) ? qsel[sl] : 0;
        const bf16_t* crow = p.ckv16 + (size_t)(b * S + sxv) * 128 + kg * 8;
#pragma unroll
        for (int ks = 0; ks < 4; ++ks) bv[bb][ks] = gload16(crow + ks * 32);
      }
      const bf16_t* cb = p.ckv16 + (size_t)(b * S) * 128 + 2 * lane;
      unsigned cbuf[64];
#pragma unroll
      for (int i4 = 0; i4 < 8; ++i4) {
        const u32x4 s4 = *(const u32x4*)(qsel + i4 * 4);
#pragma unroll
        for (int e = 0; e < 4; ++e) {
          const int k = i4 * 4 + e;
          const int sk = (slot0 + k < nsel) ? __builtin_amdgcn_readfirstlane((int)s4[e]) : 0;
          cbuf[k] = *(const GAS unsigned*)(cb + (size_t)sk * 128);
        }
      }
      asm volatile("" ::: "memory");
      f32x4v lg[4];
#pragma unroll
      for (int bb = 0; bb < 4; ++bb) {
        f32x4v acc = {0.f, 0.f, 0.f, 0.f};
#pragma unroll
        for (int ks = 0; ks < 4; ++ks) acc = __builtin_amdgcn_mfma_f32_16x16x32_bf16(aq[ks], __builtin_bit_cast(bf16x8, bv[bb][ks]), acc, 0, 0, 0);
        lg[bb] = acc;
      }
      asm volatile("" ::: "memory");
#pragma unroll
      for (int i4 = 8; i4 < 16; ++i4) {
        const u32x4 s4 = *(const u32x4*)(qsel + i4 * 4);
#pragma unroll
        for (int e = 0; e < 4; ++e) {
          const int k = i4 * 4 + e;
          const int sk = (slot0 + k < nsel) ? __builtin_amdgcn_readfirstlane((int)s4[e]) : 0;
          cbuf[k] = *(const GAS unsigned*)(cb + (size_t)sk * 128);
        }
      }
      float mx[4] = {-INFINITY, -INFINITY, -INFINITY, -INFINITY};
#pragma unroll
      for (int bb = 0; bb < 4; ++bb) {
        const bool ok = slot0 + bb * 16 + n16 < nsel;
        const int bk = t5_bucket(t - (ok ? qsel[bb * 16 + n16] : 0));
#pragma unroll
        for (int i = 0; i < 4; ++i) {
          const float lv = ok ? lg[bb][i] * 0.08838834764831845f + bias[bk * 8 + ((4 * kg + i) & 7)] : -INFINITY;
          lg[bb][i] = lv; mx[i] = fmaxf(mx[i], lv);
        }
      }
#pragma unroll
      for (int i = 0; i < 4; ++i) mx[i] = rowmax16(mx[i]);
      float sm[4] = {0.f, 0.f, 0.f, 0.f};
#pragma unroll
      for (int bb = 0; bb < 4; ++bb)
#pragma unroll
        for (int i = 0; i < 4; ++i) {
          const float e_ = (mx[i] == -INFINITY) ? 0.f : __expf(lg[bb][i] - mx[i]);
          lg[bb][i] = e_; sm[i] += e_;
        }
#pragma unroll
      for (int i = 0; i < 4; ++i) sm[i] = rowsum16(sm[i]);
#pragma unroll
      for (int bb = 0; bb < 4; ++bb) {
        u32x4 pr;
#pragma unroll
        for (int i = 0; i < 4; ++i) {
          const float other = DPP_F(lg[bb][i], 0xB1, 0xF, true);
          pr[i] = pack2(lg[bb][i], other);
        }
        if (kg < 2 && (n16 & 1) == 0) *(u32x4*)((unsigned*)plw + ((bb * 16 + n16) >> 1) * 8 + 4 * kg) = pr;
      }
      if (kg < 2) {
        if (n16 == 0) {
#pragma unroll
          for (int i = 0; i < 4; ++i) { mw[4 * kg + i] = mx[i]; mw[8 + 4 * kg + i] = sm[i]; }
        }
      }
      asm volatile("s_waitcnt lgkmcnt(0)" ::: "memory");
      float o[16];
#pragma unroll
      for (int i = 0; i < 16; ++i) o[i] = 0.f;
#pragma unroll
      for (int kp = 0; kp < 32; ++kp) {
        if ((kp & 1) == 0) asm volatile("" ::: "memory");
        const unsigned ca = cbuf[2 * kp], cbx = cbuf[2 * kp + 1];
        const unsigned x0 = __builtin_amdgcn_perm(cbx, ca, 0x05040100u);
        const unsigned x1 = __builtin_amdgcn_perm(cbx, ca, 0x07060302u);
        const u32x4 pa4 = *(const u32x4*)((const unsigned*)plw + kp * 8), pb4 = *(const u32x4*)((const unsigned*)plw + kp * 8 + 4);
        const unsigned q0 = pa4[0], q1 = pa4[1], q2 = pa4[2], q3 = pa4[3], q4 = pb4[0], q5 = pb4[1], q6 = pb4[2], q7 = pb4[3];
        o[0] = dot2bf(q0, x0, o[0]); o[1] = dot2bf(q0, x1, o[1]); o[2] = dot2bf(q1, x0, o[2]); o[3] = dot2bf(q1, x1, o[3]);
        o[4] = dot2bf(q2, x0, o[4]); o[5] = dot2bf(q2, x1, o[5]); o[6] = dot2bf(q3, x0, o[6]); o[7] = dot2bf(q3, x1, o[7]);
        o[8] = dot2bf(q4, x0, o[8]); o[9] = dot2bf(q4, x1, o[9]); o[10] = dot2bf(q5, x0, o[10]); o[11] = dot2bf(q5, x1, o[11]);
        o[12] = dot2bf(q6, x0, o[12]); o[13] = dot2bf(q6, x1, o[13]); o[14] = dot2bf(q7, x0, o[14]); o[15] = dot2bf(q7, x1, o[15]);
      }
#pragma unroll
      for (int hd = 0; hd < 8; ++hd) { float2 ov; ov.x = o[2 * hd]; ov.y = o[2 * hd + 1]; *(float2*)(pw + hd * 128 + 2 * lane) = ov; }
      __syncthreads();
      {
        const int hd = tid >> 5, ch = (tid & 31) * 4;
        const float* pq = part + (qi & 1) * 4 * 8 * 128;
        const float* mq = msb + (qi & 1) * 4 * 16;
        float m0 = mq[hd], m1 = mq[16 + hd], m2 = mq[32 + hd], m3 = mq[48 + hd];
        const float M = fmaxf(fmaxf(m0, m1), fmaxf(m2, m3));
        const float f0 = __expf(m0 - M), f1 = __expf(m1 - M), f2 = __expf(m2 - M), f3 = __expf(m3 - M);
        const float den = f0 * mq[8 + hd] + f1 * mq[24 + hd] + f2 * mq[40 + hd] + f3 * mq[56 + hd];
        const f32x4v a0 = *(const f32x4v*)(pq + (0 * 8 + hd) * 128 + ch), a1 = *(const f32x4v*)(pq + (1 * 8 + hd) * 128 + ch);
        const f32x4v a2 = *(const f32x4v*)(pq + (2 * 8 + hd) * 128 + ch), a3 = *(const f32x4v*)(pq + (3 * 8 + hd) * 128 + ch);
        const float inv = 1.f / den;
        const f32x4v r = (a0 * f0 + a1 * f1 + a2 * f2 + a3 * f3) * inv;
        u32x2 ov; ov[0] = pack2(r[0], r[1]); ov[1] = pack2(r[2], r[3]);
        *(GAS u32x2*)(p.lat + (size_t)q * D + hd * 128 + ch) = ov;
      }
    }
  }
}

DI void phase_softmax256(const int wq, const bf16_t* __restrict__ S, bf16_t* __restrict__ Pm, int rows) {
  const int tid = ltid(wq); const int bid = lbid();
  const int lane = tid & 63, wv = tid >> 6;
  for (int r = bid * 4 + wv; r < rows; r += gridDim.x * 4) {
    const f32x4v v = bf4_to_f(*(const GAS u32x2*)(S + (size_t)r * 256 + lane * 4));
    const float a = v[0], b = v[1], c = v[2], d = v[3];
    const float m = wave_max(fmaxf(fmaxf(a, b), fmaxf(c, d)));
    const float ea = __expf(a - m), eb = __expf(b - m), ec = __expf(c - m), ed = __expf(d - m);
    const float inv = 1.f / wave_sum(ea + eb + ec + ed);
    u32x2 o; o[0] = pack2(ea * inv, eb * inv); o[1] = pack2(ec * inv, ed * inv);
    *(GAS u32x2*)(Pm + (size_t)r * 256 + lane * 4) = o;
  }
}

DI int fkey_s(int b) { return b ^ ((b >> 31) & 0x7fffffff); }

template <int N, int KMAX>
DI void bitonic_blocks(int (&v)[N]) {
#pragma unroll
  for (int k = 2; k <= KMAX; k <<= 1)
#pragma unroll
    for (int j = k >> 1; j > 0; j >>= 1)
#pragma unroll
      for (int i = 0; i < N; ++i) {
        const int l = i ^ j;
        if (l > i) {
          const bool desc = ((i & k) == 0);
          const int a = v[i], b = v[l];
          const int hi = a > b ? a : b, lo = a > b ? b : a;
          v[i] = desc ? hi : lo;
          v[l] = desc ? lo : hi;
        }
      }
}
template <bool DESC>
DI void bitonic_merge16(int (&v)[16]) {
#pragma unroll
  for (int j = 8; j > 0; j >>= 1)
#pragma unroll
    for (int i = 0; i < 16; ++i) {
      const int l = i ^ j;
      if (l > i) {
        const int a = v[i], b = v[l];
        const int hi = a > b ? a : b, lo = a > b ? b : a;
        v[i] = DESC ? hi : lo;
        v[l] = DESC ? lo : hi;
      }
    }
}

DI void phase_cvt_rows(const int wq, const float* __restrict__ src, bf16_t* __restrict__ dst, size_t n8) {
  const int tid = ltid(wq); const int bid = lbid();
  for (size_t i = (size_t)bid * NT + tid; i < n8; i += (size_t)gridDim.x * NT) {
    const u32x4 a = gload16(src + i * 8), b = gload16(src + i * 8 + 4);
    u32x4 o;
    o[0] = pack2(__uint_as_float(a[0]), __uint_as_float(a[1])); o[1] = pack2(__uint_as_float(a[2]), __uint_as_float(a[3]));
    o[2] = pack2(__uint_as_float(b[0]), __uint_as_float(b[1])); o[3] = pack2(__uint_as_float(b[2]), __uint_as_float(b[3]));
    *(GAS u32x4*)(dst + i * 8) = o;
  }
}

constexpr int KEY_ROW = 264;
DI void phase_peer_qs(const int wq, const bf16_t* __restrict__ X0, const bf16_t* __restrict__ W0, const bf16_t* __restrict__ keys0, int* __restrict__ tops, char* smem, const float* __restrict__ rss_in) {
  const int tid = ltid(wq); const int bid = lbid();
  const int lane = tid & 63, wv = tid >> 6;
  const int r = lane & 31, hh = lane >> 5;
  const int srow = tid >> 3, skc = tid & 7;
  constexpr int nk = D / 64;
  for (int tile = bid; tile < (T / 128) * 16; tile += gridDim.x) {
    const int mt = tile >> 4, hp = tile & 15;
    const bf16_t* Wg = W0 + (size_t)(hp * 128 + srow) * D + skc * 8;
    const bf16_t* Xg = X0 + (size_t)(mt * 128 + srow) * D + skc * 8;
    f32x16 acc[4];
#pragma unroll
    for (int i = 0; i < 4; ++i)
#pragma unroll
      for (int e = 0; e < 16; ++e) acc[i][e] = 0.f;
    u32x4 ra[4], rb[4];
#pragma unroll
    for (int i = 0; i < 4; ++i) { ra[i] = gload16(Wg + (size_t)(32 * i) * D); rb[i] = gload16(Xg + (size_t)(32 * i) * D); }
    __syncthreads();
#pragma unroll
    for (int i = 0; i < 4; ++i) {
      *(u32x4*)(smem + (srow + 32 * i) * G_LDS_ROW + skc * 16) = ra[i];
      *(u32x4*)(smem + 2 * G_TILE_B + (srow + 32 * i) * G_LDS_ROW + skc * 16) = rb[i];
    }
    __syncthreads();
#pragma unroll 1
    for (int kt = 0; kt < nk; ++kt) {
      const int cur = kt & 1;
      if (kt + 1 < nk) {
#pragma unroll
        for (int i = 0; i < 4; ++i) { ra[i] = gload16(Wg + (size_t)(32 * i) * D + (kt + 1) * 64); rb[i] = gload16(Xg + (size_t)(32 * i) * D + (kt + 1) * 64); }
      }
      const char* As = smem + cur * G_TILE_B + r * G_LDS_ROW + hh * 16;
      const char* Bs = smem + 2 * G_TILE_B + cur * G_TILE_B + (wv * 32 + r) * G_LDS_ROW + hh * 16;
#pragma unroll
      for (int ks = 0; ks < 4; ++ks) {
        const bf16x8 b = *(const bf16x8*)(Bs + ks * 32);
#pragma unroll
        for (int mb = 0; mb < 4; ++mb) {
          const bf16x8 a = *(const bf16x8*)(As + mb * 32 * G_LDS_ROW + ks * 32);
          acc[mb] = __builtin_amdgcn_mfma_f32_32x32x16_bf16(a, b, acc[mb], 0, 0, 0);
        }
      }
      if (kt + 1 < nk) {
        const int nxt = cur ^ 1;
#pragma unroll
        for (int i = 0; i < 4; ++i) {
          *(u32x4*)(smem + nxt * G_TILE_B + (srow + 32 * i) * G_LDS_ROW + skc * 16) = ra[i];
          *(u32x4*)(smem + 2 * G_TILE_B + nxt * G_TILE_B + (srow + 32 * i) * G_LDS_ROW + skc * 16) = rb[i];
        }
      }
      __syncthreads();
    }
    {
      const bf16_t* kg = keys0 + (size_t)hp * 128 * 128;
#pragma unroll
      for (int i = 0; i < 8; ++i) {
        const int c = tid + NT * i, row = c >> 4, c16 = c & 15;
        const u32x4 v = gload16(kg + row * 128 + c16 * 8);
        uint2 lo, hi2; lo.x = v[0]; lo.y = v[1]; hi2.x = v[2]; hi2.y = v[3];
        *(uint2*)(smem + row * KEY_ROW + c16 * 16) = lo;
        *(uint2*)(smem + row * KEY_ROW + c16 * 16 + 8) = hi2;
      }
    }
    __syncthreads();
    u32x4 qf[8];
    const float rstd_t = rstd_of(rss_in, mt * 128 + wv * 32 + r);
#pragma unroll
    for (int mb = 0; mb < 4; ++mb)
#pragma unroll
      for (int s2 = 0; s2 < 2; ++s2) {
        u32x4 f;
#pragma unroll
        for (int jj = 0; jj < 4; ++jj) f[jj] = pack2(acc[mb][8 * s2 + 2 * jj] * rstd_t, acc[mb][8 * s2 + 2 * jj + 1] * rstd_t);
        qf[mb * 2 + s2] = f;
      }
    int v[64];
#pragma unroll
    for (int kb = 0; kb < 4; ++kb) {
      f32x16 sa;
#pragma unroll
      for (int e = 0; e < 16; ++e) sa[e] = 0.f;
      const char* kr = smem + (kb * 32 + r) * KEY_ROW + hh * 8;
#pragma unroll
      for (int ksi = 0; ksi < 8; ++ksi) {
        const uint2 lo = *(const uint2*)(kr + ksi * 32);
        const uint2 hi2 = *(const uint2*)(kr + ksi * 32 + 16);
        u32x4 a; a[0] = lo.x; a[1] = lo.y; a[2] = hi2.x; a[3] = hi2.y;
        sa = __builtin_amdgcn_mfma_f32_32x32x16_bf16(__builtin_bit_cast(bf16x8, a), __builtin_bit_cast(bf16x8, qf[ksi]), sa, 0, 0, 0);
      }
#pragma unroll
      for (int e = 0; e < 16; ++e) {
        const int kidx = kb * 32 + (e & 3) + 8 * (e >> 2) + 4 * hh;
        v[kb * 16 + e] = (fkey_s(__float_as_int(sa[e])) & ~127) | kidx;
      }
    }
    bitonic_blocks<64, 16>(v);
    int c01[16], c23[16];
#pragma unroll
    for (int i = 0; i < 16; ++i) { c01[i] = v[i] > v[16 + i] ? v[i] : v[16 + i]; c23[i] = v[32 + i] > v[48 + i] ? v[32 + i] : v[48 + i]; }
    bitonic_merge16<true>(c01);
    bitonic_merge16<false>(c23);
    int d[16];
#pragma unroll
    for (int i = 0; i < 16; ++i) d[i] = c01[i] > c23[i] ? c01[i] : c23[i];
    bitonic_merge16<true>(d);
    int f[16];
#pragma unroll
    for (int i = 0; i < 16; ++i) { const int o = shxi(d[15 - i], 32, lane); f[i] = d[i] > o ? d[i] : o; }
    bitonic_merge16<true>(f);
    {
      const int token = mt * 128 + wv * 32 + r;
      GAS int* op = (GAS int*)tops + ((size_t)token * 16 + hp) * 16 + hh * 8;
      u32x4 o0, o1;
      if (hh) {
#pragma unroll
        for (int i = 0; i < 4; ++i) { o0[i] = f[8 + i]; o1[i] = f[12 + i]; }
        asm volatile("" : "+v"(o0), "+v"(o1));
      } else {
#pragma unroll
        for (int i = 0; i < 4; ++i) { o0[i] = f[i]; o1[i] = f[4 + i]; }
        asm volatile("" : "+v"(o0), "+v"(o1));
      }
      *(GAS u32x4*)op = o0; *(GAS u32x4*)(op + 4) = o1;
    }
  }
}

DI float dot8(const u32x4 a, const u32x4 b, float acc) {
  const unsigned a0 = a[0], a1 = a[1], a2 = a[2], a3 = a[3], b0 = b[0], b1 = b[1], b2 = b[2], b3 = b[3];
  acc = dot2bf(a0, b0, acc); acc = dot2bf(a1, b1, acc); acc = dot2bf(a2, b2, acc); acc = dot2bf(a3, b3, acc);
  return acc;
}
typedef signed char i8_t;
using i32x2 = __attribute__((ext_vector_type(2))) int;
DI void phase_quant_u(const int wq, const float* __restrict__ src, i8_t* __restrict__ dst, float* __restrict__ su, int nrows, const float* __restrict__ gain) {
  const int tid = ltid(wq); const int bid = lbid();
  const int lane = tid & 63, wv = tid >> 6;
  for (int row = bid * 4 + wv; row < nrows; row += gridDim.x * 4) {
    const float* r = src + (size_t)row * 1024 + 16 * lane;
    u32x4 a[4];
    {
      const float* gp = gain + (size_t)(row >> 14) * 1024 + 16 * lane;
#pragma unroll
      for (int i = 0; i < 4; ++i) {
        const u32x4 t = gload16(r + 4 * i);
        const f32x4v g4 = *(const f32x4v*)(gp + 4 * i);
        const unsigned t0 = t[0], t1 = t[1], t2 = t[2], t3 = t[3];
        a[i][0] = __float_as_uint(__uint_as_float(t0) * g4[0]); a[i][1] = __float_as_uint(__uint_as_float(t1) * g4[1]);
        a[i][2] = __float_as_uint(__uint_as_float(t2) * g4[2]); a[i][3] = __float_as_uint(__uint_as_float(t3) * g4[3]);
      }
    }
    float am = 0.f;
#pragma unroll
    for (int i = 0; i < 4; ++i) {
      const unsigned x0 = a[i][0], x1 = a[i][1], x2 = a[i][2], x3 = a[i][3];
      am = fmaxf(am, fmaxf(fmaxf(fabsf(__uint_as_float(x0)), fabsf(__uint_as_float(x1))), fmaxf(fabsf(__uint_as_float(x2)), fabsf(__uint_as_float(x3)))));
    }
    am = wave_max(am);
    const float inv = am > 0.f ? 127.f / am : 0.f;
    u32x4 o;
#pragma unroll
    for (int i = 0; i < 4; ++i) {
      const unsigned x0 = a[i][0], x1 = a[i][1], x2 = a[i][2], x3 = a[i][3];
      const int q0 = (int)rintf(__uint_as_float(x0) * inv), q1 = (int)rintf(__uint_as_float(x1) * inv);
      const int q2 = (int)rintf(__uint_as_float(x2) * inv), q3 = (int)rintf(__uint_as_float(x3) * inv);
      o[i] = (unsigned)(q0 & 255) | ((unsigned)(q1 & 255) << 8) | ((unsigned)(q2 & 255) << 16) | ((unsigned)(q3 & 255) << 24);
    }
    const size_t lyr = (size_t)row >> 14, e = (size_t)row & 16383;
    *(GAS u32x4*)(dst + (((lyr * 8 + (lane >> 3)) * 16384 + e) * 128 + (lane & 7) * 16)) = o;
    if (lane == 0) su[row] = am * (1.f / 127.f);
  }
}
DI void phase_cvt_v8(const int wq, const float* __restrict__ src, i8_t* __restrict__ dst, size_t n16) {
  const int tid = ltid(wq); const int bid = lbid();
  for (size_t i = (size_t)bid * NT + tid; i < n16; i += (size_t)gridDim.x * NT) {
    u32x4 o;
#pragma unroll
    for (int k = 0; k < 4; ++k) {
      const u32x4 a = gload16(src + i * 16 + 4 * k);
      const unsigned x0 = a[0], x1 = a[1], x2 = a[2], x3 = a[3];
      int pk = 0;
      pk = __builtin_amdgcn_cvt_pk_fp8_f32(__uint_as_float(x0) * 16.f, __uint_as_float(x1) * 16.f, pk, false);
      pk = __builtin_amdgcn_cvt_pk_fp8_f32(__uint_as_float(x2) * 16.f, __uint_as_float(x3) * 16.f, pk, true);
      o[k] = (unsigned)pk;
    }
    const size_t row = i >> 6; const int j = (int)(i & 63);
    const size_t lyr = row >> 14, e = row & 16383;
    *(GAS u32x4*)(dst + (((lyr * 8 + (j >> 3)) * 16384 + e) * 128 + (j & 7) * 16)) = o;
  }
}

DI void phase_peer_combine8(const int wq, PRef p, int l, char* smem, const float* __restrict__ rss_in) {
  const int tid = ltid(wq); const int bid = lbid();
  const int lane = tid & 63, wv = tid >> 6;
  int* wtops = (int*)(smem + wv * 1024);
  int ci, cj;
  if (lane < 16) { ci = 0; cj = lane; } else if (lane < 24) { ci = 1; cj = lane - 16; } else if (lane < 29) { ci = 2; cj = lane - 24; }
  else if (lane < 33) { ci = 3; cj = lane - 29; } else if (lane < 36) { ci = 4; cj = lane - 33; } else if (lane < 38) { ci = 5; cj = lane - 36; }
  else if (lane < 40) { ci = 6; cj = lane - 38; } else if (lane < 42) { ci = 7; cj = lane - 40; } else { ci = lane - 42 + 8; cj = 0; }
  const bool cvalid = lane < 50;
  if (!cvalid) { ci = 0; cj = 0; }
  const float* sul = p.su + (size_t)l * 16384;
  for (int token = bid * 4 + wv; token < T; token += gridDim.x * 4) {
    {
      const u32x4 tv = gload16(p.tops + (size_t)token * 256 + lane * 4);
      *(u32x4*)(wtops + lane * 4) = tv;
    }
    {
      const u32x4 a = gload16(p.hn + (size_t)token * D + 16 * lane), b2 = gload16(p.hn + (size_t)token * D + 16 * lane + 8);
      float xv[16];
      { const unsigned a0 = a[0], a1 = a[1], a2 = a[2], a3 = a[3], c0 = b2[0], c1 = b2[1], c2 = b2[2], c3 = b2[3];
        xv[0] = bflo(a0); xv[1] = bfhi(a0); xv[2] = bflo(a1); xv[3] = bfhi(a1); xv[4] = bflo(a2); xv[5] = bfhi(a2); xv[6] = bflo(a3); xv[7] = bfhi(a3);
        xv[8] = bflo(c0); xv[9] = bfhi(c0); xv[10] = bflo(c1); xv[11] = bfhi(c1); xv[12] = bflo(c2); xv[13] = bfhi(c2); xv[14] = bflo(c3); xv[15] = bfhi(c3); }
      float am = 0.f;
#pragma unroll
      for (int i = 0; i < 16; ++i) am = fmaxf(am, fabsf(xv[i]));
      am = wave_max(am);
      const float inv = am > 0.f ? 127.f / am : 0.f;
      u32x4 o;
#pragma unroll
      for (int i = 0; i < 4; ++i) {
        const int q0 = (int)rintf(xv[4 * i] * inv), q1 = (int)rintf(xv[4 * i + 1] * inv), q2 = (int)rintf(xv[4 * i + 2] * inv), q3 = (int)rintf(xv[4 * i + 3] * inv);
        o[i] = (unsigned)(q0 & 255) | ((unsigned)(q1 & 255) << 8) | ((unsigned)(q2 & 255) << 16) | ((unsigned)(q3 & 255) << 24);
      }
      *(GAS u32x4*)(p.x8 + (size_t)token * 1024 + 16 * lane) = o;
      if (lane == 0) p.sxq[token] = am * (1.f / 127.f) * rstd_of(rss_in, token);
    }
    asm volatile("s_waitcnt lgkmcnt(0)" ::: "memory");
#pragma unroll 1
    for (int hd = 0; hd < 8; ++hd) {
      const int k1 = wtops[(2 * hd) * 16 + ci], k2 = wtops[(2 * hd + 1) * 16 + cj];
      const float s1 = __int_as_float(fkey_s(k1 & ~127)), s2 = __int_as_float(fkey_s(k2 & ~127));
      const float val = s1 + s2;
      const int vk = cvalid ? ((fkey_s(__float_as_int(val)) & ~63) | (63 - lane)) : (int)0x80000000;
      int rank = 0;
#pragma unroll
      for (int c = 0; c < 50; ++c) rank += (__builtin_amdgcn_readlane(vk, c) > vk) ? 1 : 0;
      const float m = __int_as_float(__builtin_amdgcn_readlane(__float_as_int(val), 0));
      const bool sel = cvalid && rank < 16;
      const float ev = sel ? __expf(val - m) : 0.f;
      const float sum = wave_sum(ev);
      if (sel) {
        const int eid = (k1 & 127) * 128 + (k2 & 127);
        p.sel_id[(size_t)token * 128 + hd * 16 + rank] = eid;
        p.sel_g[(size_t)token * 128 + hd * 16 + rank] = ev / sum;
        p.sel_su[(size_t)token * 128 + hd * 16 + rank] = sul[eid];
      }
    }
    asm volatile("s_waitcnt lgkmcnt(0)" ::: "memory");
  }
}

DI void phase_peer_udot8(const int wq, PRef p, int l, char* smem, int coff) {
  const int tid = ltid(wq);
  const int lane = tid & 63, wv = tid >> 6;
  const int grp = lane >> 3, li = lane & 7;
  int* wid = (int*)(smem + wv * 4096);
  const bool b2 = li & 4, b1 = li & 2, b0 = li & 1;
  const int myx = (int)(xb_xcc_id() & 7u);
  for (int cs = 0; cs < 8; ++cs) {
    const int c = (myx + cs) & 7;
    const i8_t* U8 = p.u8 + ((size_t)l * 8 + c) * 16384 * 128 + li * 16;
    int* pb = (int*)p.pbuf + (size_t)c * T * 128;
    for (;;) {
      unsigned tb = 0;
      if (lane == 0) tb = atomicAdd(p.qctr + coff + c * 16, 8u);
      tb = __builtin_amdgcn_readfirstlane(tb);
      if (tb >= (unsigned)T) break;
      u32x4 xs[8];
      {
        int idl[16];
#pragma unroll
        for (int k = 0; k < 8; ++k) {
          idl[2 * k] = __builtin_nontemporal_load((const GAS int*)p.sel_id + (size_t)(tb + k) * 128 + lane);
          idl[2 * k + 1] = __builtin_nontemporal_load((const GAS int*)p.sel_id + (size_t)(tb + k) * 128 + 64 + lane);
          xs[k] = __builtin_nontemporal_load((gp_u32x4)(p.x8 + (size_t)(tb + k) * 1024 + c * 128 + li * 16));
        }
#pragma unroll
        for (int k = 0; k < 8; ++k) { wid[k * 128 + lane] = idl[2 * k]; wid[k * 128 + 64 + lane] = idl[2 * k + 1]; }
      }
      asm volatile("s_waitcnt lgkmcnt(0)" ::: "memory");
      auto issue = [&](int k, u32x4 (&g)[16]) {
        int ids[16];
#pragma unroll
        for (int i = 0; i < 4; ++i) {
          const u32x4 t4 = *(const u32x4*)(wid + k * 128 + grp * 16 + i * 4);
          ids[4 * i] = t4[0]; ids[4 * i + 1] = t4[1]; ids[4 * i + 2] = t4[2]; ids[4 * i + 3] = t4[3];
        }
#pragma unroll
        for (int i = 0; i < 16; ++i) g[i] = gload16(U8 + (size_t)ids[i] * 128);
      };
      auto consume = [&](int k, const u32x4 (&g)[16], const u32x4 cx) {
        const int x0 = (int)cx[0], x1 = (int)cx[1], x2 = (int)cx[2], x3 = (int)cx[3];
        int pp[16];
#pragma unroll
        for (int i = 0; i < 16; ++i) {
          const u32x4 u8 = g[i];
          const int u0 = (int)u8[0], u1 = (int)u8[1], u2 = (int)u8[2], u3 = (int)u8[3];
          int acc = __builtin_amdgcn_sdot4(x0, u0, 0, false);
          acc = __builtin_amdgcn_sdot4(x1, u1, acc, false);
          acc = __builtin_amdgcn_sdot4(x2, u2, acc, false);
          pp[i] = __builtin_amdgcn_sdot4(x3, u3, acc, false);
        }
        int q8[8], q4[4], q2[2];
#pragma unroll
        for (int i = 0; i < 8; ++i) { const int mine = b2 ? pp[i + 8] : pp[i], oth = b2 ? pp[i] : pp[i + 8]; q8[i] = mine + shxi(oth, 4, lane); }
#pragma unroll
        for (int i = 0; i < 4; ++i) { const int mine = b1 ? q8[i + 4] : q8[i], oth = b1 ? q8[i] : q8[i + 4]; q4[i] = mine + shxi(oth, 2, lane); }
#pragma unroll
        for (int i = 0; i < 2; ++i) { const int mine = b0 ? q4[i + 2] : q4[i], oth = b0 ? q4[i] : q4[i + 2]; q2[i] = mine + shxi(oth, 1, lane); }
        i32x2 ov; ov[0] = q2[0]; ov[1] = q2[1];
        __builtin_nontemporal_store(ov, (GAS i32x2*)(pb + (size_t)(tb + k) * 128 + 2 * lane));
      };
      u32x4 ga[16], gb[16];
      issue(0, ga);
#pragma unroll
      for (int k2 = 0; k2 < 4; ++k2) {
        issue(2 * k2 + 1, gb);
        consume(2 * k2, ga, xs[2 * k2]);
        if (k2 < 3) issue(2 * k2 + 2, ga);
        consume(2 * k2 + 1, gb, xs[2 * k2 + 1]);
      }
      asm volatile("s_waitcnt lgkmcnt(0)" ::: "memory");
    }
  }
}

DI void phase_peer_w(const int wq, PRef p) {
  const int tid = ltid(wq); const int bid = lbid();
  const int lane = tid & 63, wv = tid >> 6;
  for (int token = bid * 4 + wv; token < T; token += gridDim.x * 4) {
    i32x2 pp8[8];
#pragma unroll
    for (int cc = 0; cc < 8; ++cc) pp8[cc] = __builtin_nontemporal_load((const GAS i32x2*)((const int*)p.pbuf + ((size_t)cc * T + token) * 128 + 2 * lane));
    const u32x2 gg = __builtin_nontemporal_load((const GAS u32x2*)(p.sel_g + (size_t)token * 128 + 2 * lane));
    const u32x2 su2 = __builtin_nontemporal_load((const GAS u32x2*)(p.sel_su + (size_t)token * 128 + 2 * lane));
    const float sxv = p.sxq[token];
    int d0 = 0, d1 = 0;
#pragma unroll
    for (int cc = 0; cc < 8; ++cc) { d0 += pp8[cc][0]; d1 += pp8[cc][1]; }
    const float f0 = (float)d0 * (sxv * __uint_as_float(su2[0])), f1 = (float)d1 * (sxv * __uint_as_float(su2[1]));
    u32x2 w2; w2[0] = __float_as_uint(__uint_as_float(gg[0]) * gelu_tanh(f0) * 0.0625f); w2[1] = __float_as_uint(__uint_as_float(gg[1]) * gelu_tanh(f1) * 0.0625f);
    *(GAS u32x2*)(p.sel_g + (size_t)token * 128 + 2 * lane) = w2;
  }
}

DI void phase_peer_vacc8(const int wq, PRef p, int l, char* smem, int coff, int dry, int rss_idx) {
  const int myx = (int)(xb_xcc_id() & 7u);
  for (int cs = 0; cs < 8; ++cs) {
    const int c = (myx + cs) & 7;
    for (;;) {
      const int tid = ltid(wq);
      const int lane = tid & 63, wv = tid >> 6;
      int* wid = (int*)(smem + wv * 8192);
      float* ww = (float*)(smem + wv * 8192 + 4096);
      const int grp = lane >> 3, li = lane & 7;
      const bool g2 = grp & 4, g1 = grp & 2, g0 = grp & 1;
      const i8_t* V8 = p.v8 + ((size_t)l * 8 + c) * 16384 * 128 + li * 16;
      const int chan = c * 128 + li * 16 + 2 * grp;
      unsigned tb = 0;
      if (lane == 0) tb = atomicAdd(p.qctr + coff + c * 16, 8u);
      tb = __builtin_amdgcn_readfirstlane(tb);
      if (tb >= (unsigned)T) break;
      {
        u32x4 iv[4], wv4[4];
#pragma unroll
        for (int j4 = 0; j4 < 4; ++j4) {
          iv[j4] = __builtin_nontemporal_load((gp_u32x4)(p.sel_id + (size_t)tb * 128 + j4 * 256 + lane * 4));
          wv4[j4] = __builtin_nontemporal_load((gp_u32x4)(p.sel_g + (size_t)tb * 128 + j4 * 256 + lane * 4));
        }
#pragma unroll
        for (int j4 = 0; j4 < 4; ++j4) { *(u32x4*)(wid + j4 * 256 + lane * 4) = iv[j4]; *(u32x4*)(ww + j4 * 256 + lane * 4) = wv4[j4]; }
      }
      asm volatile("s_waitcnt lgkmcnt(0)" ::: "memory");
      auto issue = [&](int hh_, u32x4 (&g)[8]) {
        const int k = hh_ >> 1, hf = hh_ & 1;
        int ids[8];
#pragma unroll
        for (int i = 0; i < 2; ++i) {
          const u32x4 t4 = *(const u32x4*)(wid + k * 128 + grp * 16 + hf * 8 + i * 4);
          ids[4 * i] = t4[0]; ids[4 * i + 1] = t4[1]; ids[4 * i + 2] = t4[2]; ids[4 * i + 3] = t4[3];
        }
#pragma unroll
        for (int i = 0; i < 8; ++i) g[i] = gload16(V8 + (size_t)ids[i] * 128);
      };
      float o[16];
      u32x2 hcur;
      auto accum = [&](int hh_, const u32x4 (&g)[8]) {
        const int k = hh_ >> 1, hf = hh_ & 1;
        if (hf == 0) {
#pragma unroll
          for (int i = 0; i < 16; ++i) o[i] = 0.f;
          hcur = __builtin_nontemporal_load((GAS u32x2*)((GAS float*)p.h + ((size_t)tb + k) * D + chan));
        }
#pragma unroll
        for (int i = 0; i < 8; ++i) {
          const u32x4 v8 = g[i];
          const float w = ww[k * 128 + grp * 16 + hf * 8 + i];
          const int v0 = (int)v8[0], v1 = (int)v8[1], v2 = (int)v8[2], v3 = (int)v8[3];
          f32x2v t2;
          t2 = __builtin_amdgcn_cvt_pk_f32_fp8(v0, false); o[0] = fmaf(w, t2[0], o[0]); o[1] = fmaf(w, t2[1], o[1]);
          t2 = __builtin_amdgcn_cvt_pk_f32_fp8(v0, true);  o[2] = fmaf(w, t2[0], o[2]); o[3] = fmaf(w, t2[1], o[3]);
          t2 = __builtin_amdgcn_cvt_pk_f32_fp8(v1, false); o[4] = fmaf(w, t2[0], o[4]); o[5] = fmaf(w, t2[1], o[5]);
          t2 = __builtin_amdgcn_cvt_pk_f32_fp8(v1, true);  o[6] = fmaf(w, t2[0], o[6]); o[7] = fmaf(w, t2[1], o[7]);
          t2 = __builtin_amdgcn_cvt_pk_f32_fp8(v2, false); o[8] = fmaf(w, t2[0], o[8]); o[9] = fmaf(w, t2[1], o[9]);
          t2 = __builtin_amdgcn_cvt_pk_f32_fp8(v2, true);  o[10] = fmaf(w, t2[0], o[10]); o[11] = fmaf(w, t2[1], o[11]);
          t2 = __builtin_amdgcn_cvt_pk_f32_fp8(v3, false); o[12] = fmaf(w, t2[0], o[12]); o[13] = fmaf(w, t2[1], o[13]);
          t2 = __builtin_amdgcn_cvt_pk_f32_fp8(v3, true);  o[14] = fmaf(w, t2[0], o[14]); o[15] = fmaf(w, t2[1], o[15]);
        }
        if (hf == 1) {
          float r8[8], r4[4], r2[2];
#pragma unroll
          for (int i = 0; i < 8; ++i) { const float mine = g2 ? o[i + 8] : o[i], oth = g2 ? o[i] : o[i + 8]; r8[i] = mine + shx(oth, 32, lane); }
#pragma unroll
          for (int i = 0; i < 4; ++i) { const float mine = g1 ? r8[i + 4] : r8[i], oth = g1 ? r8[i] : r8[i + 4]; r4[i] = mine + shx(oth, 16, lane); }
#pragma unroll
          for (int i = 0; i < 2; ++i) { const float mine = g0 ? r4[i + 2] : r4[i], oth = g0 ? r4[i] : r4[i + 2]; r2[i] = mine + shx(oth, 8, lane); }
          if (!dry) {
            const size_t token = (size_t)tb + k;
            GAS float* hp = (GAS float*)p.h + token * D + chan;
            const u32x2 ch = hcur;
            const float h0 = __uint_as_float(ch[0]) + r2[0], h1 = __uint_as_float(ch[1]) + r2[1];
            u32x2 sv; sv[0] = __float_as_uint(h0); sv[1] = __float_as_uint(h1);
            __builtin_nontemporal_store(sv, (GAS u32x2*)hp);
            *(GAS unsigned*)(p.hn + token * D + chan) = pack2(h0, h1);
            if (rss_idx >= 0) {
              const float ss = wave_sum(h0 * h0 + h1 * h1);
              if (lane < 2) p.rss[((size_t)rss_idx * T + token) * 16 + 2 * c + lane] = lane == 0 ? ss : 0.f;
            }
          }
        }
      };
      u32x4 gA[8], gB[8], gC[8];
      issue(0, gA); issue(1, gB);
#pragma unroll
      for (int h3 = 0; h3 < 15; h3 += 3) {
        asm volatile("" ::: "memory");
        issue(h3 + 2, gC); accum(h3, gA);
        asm volatile("" ::: "memory");
        issue(h3 + 3, gA); accum(h3 + 1, gB);
        asm volatile("" ::: "memory");
        if (h3 + 4 < 16) issue(h3 + 4, gB);
        accum(h3 + 2, gC);
      }
      accum(15, gA);
      asm volatile("s_waitcnt lgkmcnt(0)" ::: "memory");
    }
  }
}

DI void phase_final_norm(const int wq, const float* __restrict__ in, const float* __restrict__ g, float* __restrict__ out, int rows) {
  const int tid = ltid(wq); const int bid = lbid();
  const int lane = tid & 63, wv = tid >> 6;
  f32x4v gv[4];
#pragma unroll
  for (int i = 0; i < 4; ++i) gv[i] = *(const f32x4v*)(g + i * 256 + lane * 4);
  for (int r = bid * 4 + wv; r < rows; r += gridDim.x * 4) {
    const float* pr = in + (size_t)r * D;
    u32x4 v[4];
#pragma unroll
    for (int i = 0; i < 4; ++i) v[i] = gload16(pr + i * 256 + lane * 4);
    float ss = 0.f;
#pragma unroll
    for (int i = 0; i < 4; ++i) {
      const float a = __uint_as_float(v[i][0]), b = __uint_as_float(v[i][1]), c = __uint_as_float(v[i][2]), d = __uint_as_float(v[i][3]);
      ss += a * a + b * b + c * c + d * d;
    }
    ss = wave_sum(ss);
    const float rs = rsqrtf(ss / (float)D + 1e-6f);
#pragma unroll
    for (int i = 0; i < 4; ++i) {
      u32x4 ov;
#pragma unroll
      for (int e = 0; e < 4; ++e) ov[e] = __float_as_uint(__uint_as_float(v[i][e]) * rs * gv[i][e]);
      *(GAS u32x4*)(out + (size_t)r * D + i * 256 + lane * 4) = ov;
    }
  }
}

#define PROBE 0
constexpr int SMEM_BYTES = 73728;
__global__ void __launch_bounds__(NT, 2) mega(Params pk) {
  __shared__ __attribute__((aligned(16))) char smem_c[SMEM_BYTES];
  __shared__ uint4 xb_words;
  __shared__ Params sp;
  {
    const unsigned long long* src = (const unsigned long long*)&pk;
    unsigned long long* dst = (unsigned long long*)&sp;
    if (threadIdx.x < sizeof(Params) / 8) dst[threadIdx.x] = src[threadIdx.x];
  }
  if (threadIdx.x == 0) xb_words = make_uint4(0u, 0u, 0u, 0u);
  __syncthreads();
#define p (*lp((const __attribute__((address_space(3))) Params*)&sp))
  float* smem = (float*)smem_c;
  const int wq = __builtin_amdgcn_readfirstlane((int)(threadIdx.x >> 6));
  (void)xcd_barrier_post(p.bar, (volatile LAS unsigned*)&xb_words);
#define GRID_BARRIER() do { XcdBarrier bb_; bb_.bar = p.bar; bb_.x = xb_xcc_id(); bb_.st = (volatile LAS unsigned*)&xb_words; xcd_barrier(bb_); } while (0)

  phase_convert(wq, p.even_w_in, D, EVEN_IN, EVEN_IN, p.w_even_in, EVEN_IN, nullptr, 2, (size_t)D * EVEN_IN, (size_t)EVEN_IN * D, 0, smem, p.mix_norm, 2 * D);
  phase_convert(wq, p.even_pool_w, 128, 128, 128, p.w_even_pool, 128, p.even_pool_scale, 8, 128 * 128, 128 * 128, 128, smem);
  phase_convert(wq, p.even_w_out, D, D, D, p.w_even_out, D, nullptr, 2, (size_t)D * D, (size_t)D * D, 0, smem);
  phase_convert(wq, p.odd_w_in, D, ODD_IN, ODD_IN, p.w_odd_in, 3840, nullptr, 2, (size_t)D * ODD_IN, (size_t)3840 * D, 0, smem, p.mix_norm + D, 2 * D);
  phase_convert(wq, p.odd_w_uv, 128, 64, 64, p.w_odd_uv, 128, nullptr, 16, 128 * 64, 128 * 128, 0, smem);
  phase_convert(wq, p.odd_w_out, D, D, D, p.w_odd_out, D, nullptr, 2, (size_t)D * D, (size_t)D * D, 0, smem);
  phase_convert(wq, p.xattn_wq, D, D, D, p.w_xq, D, nullptr, 4, (size_t)D * D, (size_t)D * D, 0, smem, p.xattn_norm, D);
  phase_convert(wq, p.xattn_wkv, D, 2048, 2048, p.w_xkv, 2048, nullptr, 4, (size_t)D * 2048, (size_t)2048 * D, 0, smem);
  phase_convert(wq, p.xattn_wo, D, D, D, p.w_xo, D, nullptr, 4, (size_t)D * D, (size_t)D * D, 0, smem);
  phase_convert(wq, p.peer_wq, D, 2048, 2048, p.w_pq, 2048, nullptr, 4, (size_t)D * 2048, (size_t)2048 * D, 0, smem, p.peer_norm, D);
  phase_quant_u(wq, p.peer_u, p.u8, p.su, DEPTH * 16384, p.peer_norm);
  phase_cvt_v8(wq, p.peer_v, p.v8, (size_t)DEPTH * 16384 * 1024 / 16);
  phase_cvt_rows(wq, p.peer_keys, p.keys16, (size_t)DEPTH * 16 * 128 * 128 / 8);
  phase_init_h(wq, p.x, p.h, p.hn, p.rss);
  phase_lb(wq, p);
  phase_rmsnorm_bf(wq, p.mem, D, p.mem_norm, p.memn, D, NB * NMEM, D);
  GRID_BARRIER();
  for (int l = 0; l < DEPTH; ++l)
    phase_gemm_bf16<3>(wq, p.memn, D, p.w_xkv + (size_t)l * 2048 * D, p.kvh + (size_t)l * 2 * 2048 * 1024, 2048, NB * NMEM, 2048, D, smem_c, 0);
  GRID_BARRIER();
  for (int l = 0; l < DEPTH; ++l) {
    const int j = l >> 1;
    if ((l & 1) == 0) {
      phase_gemm_bf16<2, 1>(wq, p.hn, D, p.w_even_in + (size_t)j * EVEN_IN * D, p.P16, EVEN_IN, T, EVEN_IN, D, smem_c, 0, 1, 0, 0, 0, 1, 0, 0, p.rss + (size_t)(3 * l) * T * 16);
      GRID_BARRIER();
      phase_evenmix(wq, p, j);
      GRID_BARRIER();
      phase_gemm_bf16<2>(wq, p.pool, 512, p.w_even_pool + (size_t)j * 4 * 128 * 128, p.Y + 512, D, T, 128, 128, smem_c, 0, 4, 128, 128 * 128, 128);
      GRID_BARRIER();
      phase_gemm_bf16<1>(wq, p.Y, D, p.w_even_out + (size_t)j * D * D, p.h, D, T, D, D, smem_c, 0, 1, 0, 0, 0, 1, 0, 0, nullptr, p.hn, p.rss + (size_t)(3 * l + 1) * T * 16);
      GRID_BARRIER();
    } else {
      phase_gemm_bf16<2, 1>(wq, p.hn, D, p.w_odd_in + (size_t)j * 3840 * D, p.P16, ODD_IN, T, ODD_IN, D, smem_c, 0, 1, 0, 0, 0, 1, 0, 0, p.rss + (size_t)(3 * l) * T * 16);
      GRID_BARRIER();
      phase_dsa_prep(wq, p, j);
      GRID_BARRIER();
      phase_dsa_scores(wq, p, smem_c);
      GRID_BARRIER();
      phase_hgrn_scan(wq, p, l, smem_c);
      phase_dsa_attend(wq, p, j, smem_c, 64 * j);
      GRID_BARRIER();
      phase_gemm_bf16<2>(wq, p.lat, D, p.w_odd_uv + (size_t)j * 8 * 128 * 128, p.Y, D, T, 64, 128, smem_c, 0, 8, 128, 128 * 128, 64);
      phase_hgrn_post(wq, p, j);
      GRID_BARRIER();
      phase_gemm_bf16<1>(wq, p.Y, D, p.w_odd_out + (size_t)j * D * D, p.h, D, T, D, D, smem_c, 0, 1, 0, 0, 0, 1, 0, 0, nullptr, p.hn, p.rss + (size_t)(3 * l + 1) * T * 16);
      GRID_BARRIER();
    }
    phase_gemm_bf16<2, 1>(wq, p.hn, D, p.w_xq + (size_t)l * D * D, p.q16, D, T, D, D, smem_c, 0, 1, 0, 0, 0, 1, 0, 0, p.rss + (size_t)(3 * l + 1) * T * 16);
    GRID_BARRIER();
    phase_gemm_bf16<4>(wq, p.q16, D, p.kvh + (size_t)l * 2 * 2048 * 1024, p.sx, 256, S, 256, 256, smem_c, 0, 32, (size_t)S * D, 256 * 256, (size_t)S * 1024, 4, 256, (size_t)S * 256);
    GRID_BARRIER();
    phase_softmax256(wq, (const bf16_t*)p.sx, p.p16, T * 4);
    GRID_BARRIER();
    phase_gemm_bf16<2>(wq, p.p16, 256, p.kvh + (size_t)l * 2 * 2048 * 1024 + (size_t)2048 * 1024, p.Y, D, S, 256, 256, smem_c, 0, 32, (size_t)S * 1024, 256 * 256, (size_t)S * D, 4, (size_t)S * 256, 256);
    GRID_BARRIER();
    phase_gemm_bf16<1>(wq, p.Y, D, p.w_xo + (size_t)l * D * D, p.h, D, T, D, D, smem_c, 0, 1, 0, 0, 0, 1, 0, 0, nullptr, p.hn, p.rss + (size_t)(3 * l + 2) * T * 16);
    GRID_BARRIER();
    phase_peer_qs(wq, p.hn, p.w_pq + (size_t)l * 2048 * D, p.keys16 + (size_t)l * 16 * 128 * 128, p.tops, smem_c, p.rss + (size_t)(3 * l + 2) * T * 16);
    GRID_BARRIER();
    phase_peer_combine8(wq, p, l, smem_c, p.rss + (size_t)(3 * l + 2) * T * 16);
    GRID_BARRIER();
    phase_peer_udot8(wq, p, l, smem_c, 256 + (l * 2 + 0) * 128);
    GRID_BARRIER();
    phase_peer_w(wq, p);
    GRID_BARRIER();
    phase_peer_vacc8(wq, p, l, smem_c, 256 + (l * 2 + 1) * 128, 0, l + 1 < DEPTH ? 3 * l + 3 : -1);
    GRID_BARRIER();
  }
  phase_final_norm(wq, p.h, p.final_norm, p.out, T);
}

#undef p
extern "C" void kernel_launch(void* const* d_in, const int* in_sizes, int n_in, void* d_out, int out_size, void* d_ws, size_t ws_size,
                              hipStream_t stream) {
  Params p; memset(&p, 0, sizeof(p));
  const float* const* in = (const float* const*)d_in;
  p.x = in[0]; p.mem = in[1]; p.mix_norm = in[2]; p.even_w_in = in[3]; p.even_conv_w = in[4]; p.even_pool_w = in[5];
  p.even_pool_scale = in[6]; p.even_w_out = in[7]; p.odd_w_in = in[8]; p.odd_kv_norm = in[9]; p.odd_w_uv = in[10];
  p.odd_hg_norm = in[11]; p.odd_w_out = in[12]; p.hgrn_gamma = in[13]; p.rel_bias = in[14]; p.mem_norm = in[15];
  p.xattn_norm = in[16]; p.xattn_wq = in[17]; p.xattn_wkv = in[18]; p.xattn_wo = in[19]; p.peer_norm = in[20];
  p.peer_wq = in[21]; p.peer_keys = in[22]; p.peer_u = in[23]; p.peer_v = in[24]; p.final_norm = in[25];
  p.out = (float*)d_out;
  char* w = (char*)d_ws;
  auto take = [&](size_t bytes) { char* r = w; w += (bytes + 255) / 256 * 256; return r; };
  p.bar = (unsigned*)take((XCD_BAR_WORDS + 2048) * 4); p.qctr = p.bar + XCD_BAR_WORDS;
  p.h = (float*)take((size_t)T * D * 4); p.P = (float*)take((size_t)T * ODD_IN * 4); p.P16 = (bf16_t*)p.P;
  p.oraw = (float*)take((size_t)T * 512 * 4); p.lb = (float*)take(DEPTH * 512 * 4);
  p.hn = (bf16_t*)take((size_t)T * D * 2); p.Y = (bf16_t*)take((size_t)T * D * 2); p.pool = (bf16_t*)take((size_t)T * 512 * 2);
  p.memn = (bf16_t*)take((size_t)NB * NMEM * D * 2); p.lat = (bf16_t*)take((size_t)T * D * 2);
  p.w_even_in = (bf16_t*)take((size_t)2 * EVEN_IN * D * 2); p.w_even_pool = (bf16_t*)take((size_t)8 * 128 * 128 * 2);
  p.w_even_out = (bf16_t*)take((size_t)2 * D * D * 2); p.w_odd_in = (bf16_t*)take((size_t)2 * 3840 * D * 2);
  p.w_odd_uv = (bf16_t*)take((size_t)16 * 128 * 128 * 2); p.w_odd_out = (bf16_t*)take((size_t)2 * D * D * 2);
  p.w_xq = (bf16_t*)take((size_t)4 * D * D * 2); p.w_xkv = (bf16_t*)take((size_t)4 * 2048 * D * 2); p.w_xo = (bf16_t*)take((size_t)4 * D * D * 2);
  p.w_pq = (bf16_t*)take((size_t)4 * 2048 * D * 2);
  p.u8 = (signed char*)take((size_t)DEPTH * 16384 * 1024); p.v8 = (signed char*)take((size_t)DEPTH * 16384 * 1024); p.x8 = (signed char*)take((size_t)T * 1024);
  p.su = (float*)take((size_t)DEPTH * 16384 * 4); p.sxq = (float*)take((size_t)T * 4); p.sel_su = (float*)take((size_t)T * 128 * 4);
  p.keys16 = (bf16_t*)take((size_t)DEPTH * 16 * 128 * 128 * 2); p.kvh = (bf16_t*)take((size_t)DEPTH * 2 * 2048 * 1024 * 2); p.rss = (float*)take((size_t)12 * T * 16 * 4);
  {
    char* a = (char*)p.P;
    p.sx = (float*)a; a += (size_t)T * 4 * 256 * 4;
    p.p16 = (bf16_t*)a; a += (size_t)T * 4 * 256 * 2;
    p.q16 = (bf16_t*)a; a += (size_t)T * D * 2;
    p.tops = (int*)a; a += (size_t)T * 256 * 4;
    p.sel_id = (int*)a; a += (size_t)T * 128 * 4;
    p.sel_g = (float*)a; a += (size_t)T * 128 * 4;
    p.pbuf = (float*)a;
  }
  p.qlat16 = (bf16_t*)take((size_t)T * 1024 * 2); p.ckv16 = (bf16_t*)take((size_t)T * 128 * 2); p.iq16 = (bf16_t*)take((size_t)T * 512 * 2);
  p.ik16 = (bf16_t*)take((size_t)T * 64 * 2); p.sc = (float*)take((size_t)T * 2048 * 4);

  p.probe = 1;
  static int grid = 0;
  if (!grid) {
    int dev = 0, cus = 0, per_cu = 0;
    (void)hipGetDevice(&dev);
    (void)hipDeviceGetAttribute(&cus, hipDeviceAttributeMultiprocessorCount, dev);
    (void)hipOccupancyMaxActiveBlocksPerMultiprocessor(&per_cu, mega, NT, 0);
    if (per_cu > 2) per_cu = 2;
    if (per_cu < 1) per_cu = 1;
    grid = cus * per_cu;
  }
  (void)hipMemsetAsync(p.bar, 0, (XCD_BAR_WORDS + 2048) * sizeof(unsigned), stream);
  mega<<<grid, NT, 0, stream>>>(p);
}
```

```cpp
#include <hip/hip_runtime.h>
#include <hip/hip_bf16.h>
#include <stdint.h>
#include <math.h>
#include <string.h>

#define DI __device__ __forceinline__

constexpr int D = 1024, NB = 8, S = 2048, T = NB * S, DEPTH = 4, NMEM = 256;
constexpr int EVEN_IN = 2048, ODD_IN = 3784;
constexpr int NT = 256;

typedef unsigned short bf16_t;
struct Params {
  const float *x, *mem, *mix_norm, *even_w_in, *even_conv_w, *even_pool_w, *even_pool_scale, *even_w_out;
  const float *odd_w_in, *odd_kv_norm, *odd_w_uv, *odd_hg_norm, *odd_w_out, *hgrn_gamma, *rel_bias, *mem_norm;
  const float *xattn_norm, *xattn_wq, *xattn_wkv, *xattn_wo, *peer_norm, *peer_wq, *peer_keys, *peer_u, *peer_v, *final_norm;
  float* out;
  float *h, *P, *kv, *ckv, *oraw, *lb; bf16_t* P16;
  bf16_t *hn, *Y, *pool, *memn, *lat;
  bf16_t *u16, *v16, *keys16; int* tops; signed char *u8, *v8, *x8; float *su, *sxq, *sel_su;
  float* rss;
  bf16_t *q16, *kvh, *p16; float* sx; int* sel_id; float* sel_g; float* pbuf;
  bf16_t *qlat16, *ckv16, *iq16, *ik16; float* sc; unsigned* qctr;
  bf16_t *w_even_in, *w_even_pool, *w_even_out, *w_odd_in, *w_odd_uv, *w_odd_out, *w_xq, *w_xkv, *w_xo, *w_pq;
  unsigned* bar;
  int probe, pad_;
};

#define XB_TMO      128
#define XB_XCNT(j)  (256  + 64 * (j))
#define XB_XSUB(j)  (1280 + 64 * (j))
#define XB_XGEN(j)  (2304 + 64 * (j))
#define XB_TOP      3328
#define XB_TOPGEN   3392
#define XCD_BAR_WORDS 3456
#define XB_SPIN_CAP (1u << 18)
#define LAS __attribute__((address_space(3)))

__device__ __forceinline__ unsigned xb_ld(unsigned* p)              { return __hip_atomic_load(p, __ATOMIC_RELAXED, __HIP_MEMORY_SCOPE_AGENT); }
__device__ __forceinline__ unsigned xb_add(unsigned* p, unsigned v) { return __hip_atomic_fetch_add(p, v, __ATOMIC_RELAXED, __HIP_MEMORY_SCOPE_AGENT); }
__device__ __forceinline__ unsigned xb_xcc_id() { return (unsigned)__builtin_amdgcn_s_getreg((3 << 11) | 20) & 0xFu; }
#define XB_SPIN(cond, bar) do { unsigned _sp = 0; while (cond) { __builtin_amdgcn_s_sleep(1); \
    if ((++_sp & 255u) == 0u) { if (xb_ld(&(bar)[XB_TMO])) break; if (_sp > XB_SPIN_CAP) { atomicAdd(&(bar)[XB_TMO], 1u); break; } } } } while (0)

typedef const __attribute__((address_space(3))) Params& PRef;
DI const __attribute__((address_space(3))) Params* lp(const __attribute__((address_space(3))) Params* q) { asm volatile("" : "+v"(q)); return q; }
struct XcdBarrier {
    unsigned* bar; unsigned x;
    volatile LAS unsigned* st;
};

__device__ __forceinline__ XcdBarrier xcd_barrier_post(unsigned* bar, volatile LAS unsigned* st) {
    XcdBarrier b; b.bar = bar; b.x = xb_xcc_id(); b.st = st;
    if (threadIdx.x == 0) (void)xb_add(&bar[XB_XCNT(b.x)], 1u);
    return b;
}
__device__ __forceinline__ void xcd_barrier_complete(unsigned* bar, unsigned x, unsigned& nloc, unsigned& nx) {
    const unsigned G = gridDim.x * gridDim.y * gridDim.z;
    unsigned sum, cnt, mine, sp = 0u;
    for (;;) {
        sum = 0u; cnt = 0u; mine = 0u;
#pragma unroll
        for (unsigned j = 0; j < 16; ++j) { const unsigned c = xb_ld(&bar[XB_XCNT(j)]); sum += c; cnt += (c > 0u) ? 1u : 0u; mine = (j == x) ? c : mine; }
        if (sum == G) break;
        __builtin_amdgcn_s_sleep(1);
        if ((++sp & 255u) == 0u) { if (xb_ld(&bar[XB_TMO])) break; if (sp > XB_SPIN_CAP) { atomicAdd(&bar[XB_TMO], 1u); break; } }
    }
    nloc = mine > 0u ? mine : 1u; nx = cnt > 0u ? cnt : 1u;
}

__device__ __forceinline__ void xcd_barrier(const XcdBarrier& b) {
    asm volatile("s_waitcnt vmcnt(0)" ::: "memory");
    __syncthreads();
    if (threadIdx.x == 0) {
        unsigned* bar = b.bar;
        __builtin_amdgcn_s_waitcnt(0);
        unsigned nloc = b.st[0], nx = b.st[1];
        if (nloc == 0u) { xcd_barrier_complete(bar, b.x, nloc, nx); b.st[0] = nloc; b.st[1] = nx; }
        const unsigned old = xb_add(&bar[XB_XSUB(b.x)], 1u);
        const unsigned gen = old / nloc;
        if (old + 1u == (gen + 1u) * nloc) {
            __builtin_amdgcn_fence(__ATOMIC_RELEASE, "agent");
            asm volatile("s_waitcnt vmcnt(0)" ::: "memory");
            const unsigned og = xb_add(&bar[XB_TOP], 1u);
            const unsigned tg = og / nx;
            if (og + 1u == (tg + 1u) * nx) xb_add(&bar[XB_TOPGEN], 1u);
            else XB_SPIN(xb_ld(&bar[XB_TOPGEN]) == tg, bar);
            __builtin_amdgcn_fence(__ATOMIC_ACQUIRE, "agent");
            xb_add(&bar[XB_XGEN(b.x)], 1u);
            asm volatile("s_waitcnt vmcnt(0)" ::: "memory");
        } else {
            XB_SPIN(xb_ld(&bar[XB_XGEN(b.x)]) == gen, bar);
            __builtin_amdgcn_fence(__ATOMIC_ACQUIRE, "agent");
            asm volatile("s_waitcnt vmcnt(0)" ::: "memory");
        }
    }
    __syncthreads();
}


typedef __bf16 bf16x2_t __attribute__((ext_vector_type(2)));
typedef float f32x2_t __attribute__((ext_vector_type(2)));
using bf16x8 = __attribute__((ext_vector_type(8))) short;
using f32x16 = __attribute__((ext_vector_type(16))) float;
using u32x4 = __attribute__((ext_vector_type(4))) unsigned;
using u32x2 = __attribute__((ext_vector_type(2))) unsigned;
using f32x4v = __attribute__((ext_vector_type(4))) float;
using f32x2v = __attribute__((ext_vector_type(2))) float;
#define GAS __attribute__((address_space(1)))
typedef const GAS u32x4* gp_u32x4;
DI u32x4 gload16(const void* p) { return *(gp_u32x4)(p); }
DI bf16_t f2bf(float f) { __bf16 b = (__bf16)f; return __builtin_bit_cast(unsigned short, b); }
DI unsigned pack2(float a, float b) { f32x2_t v = {a, b}; bf16x2_t r = __builtin_convertvector(v, bf16x2_t); return __builtin_bit_cast(unsigned, r); }
DI float bf2f(bf16_t u) { return __uint_as_float(((unsigned)u) << 16); }
DI float bflo(unsigned u) { return __uint_as_float(u << 16); }
DI float bfhi(unsigned u) { return __uint_as_float(u & 0xffff0000u); }
DI f32x4v bf4_to_f(const u32x2 v) { const unsigned a = v[0], b = v[1]; f32x4v r; r[0] = bflo(a); r[1] = bfhi(a); r[2] = bflo(b); r[3] = bfhi(b); return r; }
DI int ltid(int wq) { int t; asm volatile("v_mbcnt_lo_u32_b32 %0, -1, 0\n\tv_mbcnt_hi_u32_b32 %0, -1, %0" : "=v"(t)); return (wq << 6) | t; }
DI int lbid() { int b = blockIdx.x; asm volatile("" : "+s"(b)); return b; }
#define DPP_F(v, ctrl, rmask, bctl) __int_as_float(__builtin_amdgcn_update_dpp(0, __float_as_int(v), (ctrl), (rmask), 0xF, (bctl)))
DI float wave_sum(float v) {
  v += DPP_F(v, 0xB1, 0xF, true);
  v += DPP_F(v, 0x4E, 0xF, true);
  v += DPP_F(v, 0x141, 0xF, true);
  v += DPP_F(v, 0x140, 0xF, true);
  v += DPP_F(v, 0x142, 0xA, false);
  v += DPP_F(v, 0x143, 0xC, false);
  return __int_as_float(__builtin_amdgcn_readlane(__float_as_int(v), 63));
}
#define DPP_I(v, ctrl, rmask, bctl) __builtin_amdgcn_update_dpp(0, (v), (ctrl), (rmask), 0xF, (bctl))
DI int wave_sum_i(int v) {
  v += DPP_I(v, 0xB1, 0xF, true); v += DPP_I(v, 0x4E, 0xF, true); v += DPP_I(v, 0x141, 0xF, true); v += DPP_I(v, 0x140, 0xF, true);
  v += DPP_I(v, 0x142, 0xA, false); v += DPP_I(v, 0x143, 0xC, false);
  return __builtin_amdgcn_readlane(v, 63);
}
DI float wave_max(float v) {
  v = fmaxf(v, DPP_F(v, 0xB1, 0xF, true));
  v = fmaxf(v, DPP_F(v, 0x4E, 0xF, true));
  v = fmaxf(v, DPP_F(v, 0x141, 0xF, true));
  v = fmaxf(v, DPP_F(v, 0x140, 0xF, true));
  { const float t = __int_as_float(__builtin_amdgcn_update_dpp(__float_as_int(v), __float_as_int(v), 0x142, 0xA, 0xF, false)); v = fmaxf(v, t); }
  { const float t = __int_as_float(__builtin_amdgcn_update_dpp(__float_as_int(v), __float_as_int(v), 0x143, 0xC, 0xF, false)); v = fmaxf(v, t); }
  return __int_as_float(__builtin_amdgcn_readlane(__float_as_int(v), 63));
}
DI float rowsum16(float v) { v += DPP_F(v, 0x128, 0xF, true); v += DPP_F(v, 0x124, 0xF, true); v += DPP_F(v, 0x122, 0xF, true); v += DPP_F(v, 0x121, 0xF, true); return v; }
DI float rowmax16(float v) { v = fmaxf(v, DPP_F(v, 0x128, 0xF, true)); v = fmaxf(v, DPP_F(v, 0x124, 0xF, true)); v = fmaxf(v, DPP_F(v, 0x122, 0xF, true)); v = fmaxf(v, DPP_F(v, 0x121, 0xF, true)); return v; }
DI float shx(float v, int mask, int lane) { return __int_as_float(__builtin_amdgcn_ds_bpermute((lane ^ mask) << 2, __float_as_int(v))); }
DI int shxi(int v, int mask, int lane) { return __builtin_amdgcn_ds_bpermute((lane ^ mask) << 2, v); }
DI float gelu_tanh(float x) {
  const float k0 = 0.7978845608028654f, k1 = 0.044715f;
  return 0.5f * x * (1.f + tanhf(k0 * (x + k1 * x * x * x)));
}
DI float sigmoidf(float x) { return 1.f / (1.f + expf(-x)); }

DI float rstd_of(const float* __restrict__ rss, int row) {
  const float* q = rss + (size_t)row * 16;
  const f32x4v a = *(const f32x4v*)q, b = *(const f32x4v*)(q + 4), c = *(const f32x4v*)(q + 8), d = *(const f32x4v*)(q + 12);
  const float s0 = (a[0] + a[1]) + (a[2] + a[3]), s1 = (b[0] + b[1]) + (b[2] + b[3]), s2 = (c[0] + c[1]) + (c[2] + c[3]), s3 = (d[0] + d[1]) + (d[2] + d[3]);
  return rsqrtf(((s0 + s1) + (s2 + s3)) * (1.f / 1024.f) + 1e-6f);
}
DI void phase_init_h(const int wq, const float* __restrict__ x, float* __restrict__ h, bf16_t* __restrict__ hb, float* __restrict__ rss) {
  const int tid = ltid(wq); const int bid = lbid();
  const int lane = tid & 63, wv = tid >> 6;
  for (int r = bid * 4 + wv; r < T; r += gridDim.x * 4) {
    float ss = 0.f;
#pragma unroll
    for (int i = 0; i < 4; ++i) {
      const u32x4 v = gload16(x + (size_t)r * D + i * 256 + lane * 4);
      const unsigned v0 = v[0], v1 = v[1], v2 = v[2], v3 = v[3];
      const float a = __uint_as_float(v0), b = __uint_as_float(v1), c = __uint_as_float(v2), d = __uint_as_float(v3);
      ss += a * a + b * b + c * c + d * d;
      *(GAS u32x4*)(h + (size_t)r * D + i * 256 + lane * 4) = v;
      u32x2 o; o[0] = pack2(a, b); o[1] = pack2(c, d);
      *(GAS u32x2*)(hb + (size_t)r * D + i * 256 + lane * 4) = o;
    }
    ss = wave_sum(ss);
    if (lane < 16) rss[(size_t)r * 16 + lane] = lane == 0 ? ss : 0.f;
  }
}

DI void phase_rmsnorm_bf(const int wq, const float* __restrict__ in, int ldi, const float* __restrict__ g, bf16_t* __restrict__ out, int ldo, int rows, int W) {
  const int tid_ = ltid(wq); const int bid_ = lbid();
  const int lane = tid_ & 63, wv = tid_ >> 6;
  f32x4v gv[4];
#pragma unroll
  for (int i = 0; i < 4; ++i) gv[i] = *(const f32x4v*)(g + i * 256 + lane * 4);
  for (int r = bid_ * 4 + wv; r < rows; r += gridDim.x * 4) {
    const float* p = in + (size_t)r * ldi;
    u32x4 v[4];
#pragma unroll
    for (int i = 0; i < 4; ++i) v[i] = gload16(p + i * 256 + lane * 4);
    float ss = 0.f;
#pragma unroll
    for (int i = 0; i < 4; ++i) {
      const float a = __uint_as_float(v[i][0]), b = __uint_as_float(v[i][1]), c = __uint_as_float(v[i][2]), d = __uint_as_float(v[i][3]);
      ss += a * a + b * b + c * c + d * d;
    }
    ss = wave_sum(ss);
    const float rs = rsqrtf(ss / (float)W + 1e-6f);
    bf16_t* o = out + (size_t)r * ldo;
#pragma unroll
    for (int i = 0; i < 4; ++i) {
      u32x2 ov;
      ov[0] = pack2(__uint_as_float(v[i][0]) * rs * gv[i][0], __uint_as_float(v[i][1]) * rs * gv[i][1]);
      ov[1] = pack2(__uint_as_float(v[i][2]) * rs * gv[i][2], __uint_as_float(v[i][3]) * rs * gv[i][3]);
      *(GAS u32x2*)(o + i * 256 + lane * 4) = ov;
    }
  }
}

DI void phase_convert(const int wq, const float* __restrict__ W0, int K, int N, int ldw, bf16_t* __restrict__ Bt0, int Npad, const float* __restrict__ cs0,
                      int nbatch, size_t sW, size_t sBt, size_t sCS, float* smem, const float* __restrict__ rs0 = nullptr, size_t sRS = 0) {
  const int tid = ltid(wq); const int bid = lbid();
  float (*tl)[65] = (float (*)[65])smem;
  const int tk = K / 64, tn = Npad / 64;
  for (int tile0 = bid; tile0 < tk * tn * nbatch; tile0 += gridDim.x) {
    const int bt = tile0 / (tk * tn), tile = tile0 % (tk * tn);
    const int k0 = (tile / tn) * 64, n0 = (tile % tn) * 64;
    const float* W = W0 + (size_t)bt * sW;
    bf16_t* Bt = Bt0 + (size_t)bt * sBt;
    __syncthreads();
#pragma unroll 4
    for (int i = 0; i < 16; ++i) {
      const int k = i * 4 + (tid >> 6), n = tid & 63;
      float v = 0.f;
      if (n0 + n < N) { v = W[(size_t)(k0 + k) * ldw + n0 + n]; if (cs0) v *= cs0[(size_t)bt * sCS + n0 + n]; if (rs0) v *= rs0[(size_t)bt * sRS + k0 + k]; }
      tl[k][n] = v;
    }
    __syncthreads();
#pragma unroll 4
    for (int i = 0; i < 16; ++i) {
      const int n = i * 4 + (tid >> 6), k = tid & 63;
      Bt[(size_t)(n0 + n) * K + k0 + k] = f2bf(tl[k][n]);
    }
  }
}

constexpr int G_LDS_ROW = 144;
constexpr int G_TILE_B = 128 * G_LDS_ROW;
template <int MODE, int RS = 0>
DI void phase_gemm_bf16(const int wq, const bf16_t* __restrict__ A0, int lda, const bf16_t* __restrict__ B0, void* __restrict__ C0, int ldc,
                        int M, int N, int K, char* smem, int dry, int nbatch = 1, size_t sA = 0, size_t sB = 0, size_t sC = 0,
                        int inner = 1, size_t sA2 = 0, size_t sC2 = 0, const float* __restrict__ rss_in = nullptr, bf16_t* __restrict__ hb_out = nullptr, float* __restrict__ rss_out = nullptr) {
  const int tid = ltid(wq); const int bid = lbid();
  const int lane = tid & 63, wv = tid >> 6, wm = wv >> 1, wn = wv & 1;
  const int r = lane & 31, hh = lane >> 5;
  const int tm = M / 128, tn = (N + 127) / 128;
  const int nk = K / 64;
  const int srow = tid >> 3, skc = tid & 7;
  const int ntile_all = tm * tn * nbatch;
  const int per_x = (ntile_all + 7) >> 3;
  const int t_beg = (bid & 7) * per_x, t_end = (t_beg + per_x < ntile_all) ? t_beg + per_x : ntile_all;
  for (int tile0 = t_beg + (bid >> 3); tile0 < t_end; tile0 += (int)(gridDim.x >> 3)) {
    const int bt = tile0 / (tm * tn), tile = tile0 % (tm * tn);
    const int m0 = (tile / tn) * 128, n0 = (tile % tn) * 128;
    const int bhi = bt / inner, blo = bt % inner;
    const bf16_t* Ag = A0 + (size_t)bhi * sA + (size_t)blo * sA2 + (size_t)(m0 + srow) * lda + skc * 8;
    const bf16_t* Bg = B0 + (size_t)bt * sB + (size_t)(n0 + srow) * K + skc * 8;
    f32x16 acc[2][2];
#pragma unroll
    for (int i = 0; i < 2; ++i)
#pragma unroll
      for (int j = 0; j < 2; ++j)
#pragma unroll
        for (int e = 0; e < 16; ++e) acc[i][j][e] = 0.f;
    u32x4 ra[4], rb[4];
#pragma unroll
    for (int i = 0; i < 4; ++i) {
      ra[i] = gload16(Ag + (size_t)(32 * i) * lda);
      rb[i] = gload16(Bg + (size_t)(32 * i) * K);
    }
    __syncthreads();
#pragma unroll
    for (int i = 0; i < 4; ++i) {
      *(u32x4*)(smem + (srow + 32 * i) * G_LDS_ROW + skc * 16) = ra[i];
      *(u32x4*)(smem + 2 * G_TILE_B + (srow + 32 * i) * G_LDS_ROW + skc * 16) = rb[i];
    }
    __syncthreads();
#pragma unroll 1
    for (int kt = 0; kt < nk; ++kt) {
      const int cur = kt & 1;
      if (kt + 1 < nk) {
#pragma unroll
        for (int i = 0; i < 4; ++i) {
          ra[i] = gload16(Ag + (size_t)(32 * i) * lda + (kt + 1) * 64);
          rb[i] = gload16(Bg + (size_t)(32 * i) * K + (kt + 1) * 64);
        }
      }
      const char* As = smem + cur * G_TILE_B + (wm * 64 + r) * G_LDS_ROW + hh * 16;
      const char* Bs = smem + 2 * G_TILE_B + cur * G_TILE_B + (wn * 64 + r) * G_LDS_ROW + hh * 16;
#pragma unroll
      for (int ks = 0; ks < 4; ++ks) {
        bf16x8 a0 = *(const bf16x8*)(As + ks * 32);
        bf16x8 a1 = *(const bf16x8*)(As + 32 * G_LDS_ROW + ks * 32);
        bf16x8 b0 = *(const bf16x8*)(Bs + ks * 32);
        bf16x8 b1 = *(const bf16x8*)(Bs + 32 * G_LDS_ROW + ks * 32);
        acc[0][0] = __builtin_amdgcn_mfma_f32_32x32x16_bf16(a0, b0, acc[0][0], 0, 0, 0);
        acc[0][1] = __builtin_amdgcn_mfma_f32_32x32x16_bf16(a0, b1, acc[0][1], 0, 0, 0);
        acc[1][0] = __builtin_amdgcn_mfma_f32_32x32x16_bf16(a1, b0, acc[1][0], 0, 0, 0);
        acc[1][1] = __builtin_amdgcn_mfma_f32_32x32x16_bf16(a1, b1, acc[1][1], 0, 0, 0);
      }
      if (kt + 1 < nk) {
        const int nxt = cur ^ 1;
#pragma unroll
        for (int i = 0; i < 4; ++i) {
          *(u32x4*)(smem + nxt * G_TILE_B + (srow + 32 * i) * G_LDS_ROW + skc * 16) = ra[i];
          *(u32x4*)(smem + 2 * G_TILE_B + nxt * G_TILE_B + (srow + 32 * i) * G_LDS_ROW + skc * 16) = rb[i];
        }
      }
      __syncthreads();
    }
    if (RS) {
      if (tid < 128) ((float*)smem)[tid] = rstd_of(rss_in, m0 + tid);
      __syncthreads();
    }
#pragma unroll
    for (int i = 0; i < 2; ++i)
#pragma unroll
      for (int j = 0; j < 2; ++j) {
        const int col = n0 + wn * 64 + j * 32 + r;
        if (col < N && !dry) {
          const size_t base = (size_t)bhi * sC + (size_t)blo * sC2 + (size_t)(m0 + wm * 64 + i * 32 + 4 * hh) * ldc + col;
          if (RS) {
            const float* rp = (const float*)smem + wm * 64 + i * 32 + 4 * hh;
#pragma unroll
            for (int e = 0; e < 16; ++e) acc[i][j][e] *= rp[(e & 3) + 8 * (e >> 2)];
          }
          if (MODE == 1) {
            GAS float* cp = (GAS float*)C0 + base;
            float old[16];
#pragma unroll
            for (int e = 0; e < 16; ++e) old[e] = cp[(size_t)((e & 3) + 8 * (e >> 2)) * ldc];
#pragma unroll
            for (int e = 0; e < 16; ++e) { old[e] += acc[i][j][e]; acc[i][j][e] = old[e]; cp[(size_t)((e & 3) + 8 * (e >> 2)) * ldc] = old[e]; }
            if (hb_out) {
              GAS bf16_t* hp = (GAS bf16_t*)hb_out + base;
#pragma unroll
              for (int e = 0; e < 16; ++e) hp[(size_t)((e & 3) + 8 * (e >> 2)) * ldc] = f2bf(old[e]);
            }
          } else if (MODE == 0) {
            GAS float* cp = (GAS float*)C0 + base;
#pragma unroll
            for (int e = 0; e < 16; ++e) cp[(size_t)((e & 3) + 8 * (e >> 2)) * ldc] = acc[i][j][e];
          } else if (MODE == 2) {
            GAS bf16_t* cp = (GAS bf16_t*)C0 + base;
#pragma unroll
            for (int e = 0; e < 16; ++e) cp[(size_t)((e & 3) + 8 * (e >> 2)) * ldc] = f2bf(acc[i][j][e]);
          } else if (MODE == 4) {
            GAS bf16_t* cp = (GAS bf16_t*)C0 + base;
#pragma unroll
            for (int e = 0; e < 16; ++e) cp[(size_t)((e & 3) + 8 * (e >> 2)) * ldc] = f2bf(acc[i][j][e] * 0.0625f);
          } else {
            const int rowb = m0 + wm * 64 + i * 32 + 4 * hh;
            const int b_ = rowb >> 8, mm = rowb & 255;
            const int cc = col & 1023, hd_ = cc >> 8, dd = cc & 255;
            GAS bf16_t* kb = (GAS bf16_t*)C0;
            if (col < 1024) {
#pragma unroll
              for (int e = 0; e < 16; ++e) kb[((size_t)(b_ * 4 + hd_) * 256 + mm + (e & 3) + 8 * (e >> 2)) * 256 + dd] = f2bf(acc[i][j][e]);
            } else {
#pragma unroll
              for (int e = 0; e < 16; ++e) kb[(size_t)2048 * 1024 + ((size_t)(b_ * 4 + hd_) * 256 + dd) * 256 + mm + (e & 3) + 8 * (e >> 2)] = f2bf(acc[i][j][e]);
            }
          }
        }
      }
    if (MODE == 1 && rss_out && !dry) {
#pragma unroll
      for (int i = 0; i < 2; ++i) {
        float myv = 0.f;
#pragma unroll
        for (int e = 0; e < 16; ++e) {
          float v = acc[i][0][e] * acc[i][0][e] + acc[i][1][e] * acc[i][1][e];
          v = rowsum16(v);
          v += shx(v, 16, lane);
          if ((lane & 15) == e) myv = v;
        }
        if ((lane & 16) == 0) rss_out[(size_t)(m0 + wm * 64 + i * 32 + (lane & 3) + 8 * ((lane & 15) >> 2) + 4 * hh) * 16 + (n0 >> 7) * 2 + wn] = myv;
      }
    }
  }
}

template <int W>
DI void evenmix_run(const bf16_t* __restrict__ P, const float* __restrict__ cw, bf16_t* __restrict__ Y, bf16_t* __restrict__ pool, int t0, int c) {
  const int s0 = t0 & (S - 1);
  f32x4v w0 = *(const f32x4v*)(cw + c), w1 = *(const f32x4v*)(cw + 512 + c), w2 = *(const f32x4v*)(cw + 1024 + c);
  const f32x4v zero = {0.f, 0.f, 0.f, 0.f};
  auto ld = [&](int t, int off) { const u32x2 v = *(const GAS u32x2*)(P + (size_t)t * EVEN_IN + off + c); return bf4_to_f(v); };
  f32x4v xm2 = zero, xm1 = zero;
  if (s0 >= 2) xm2 = ld(t0 - 2, 512) * ld(t0 - 2, 0);
  if (s0 >= 1) xm1 = ld(t0 - 1, 512) * ld(t0 - 1, 0);
  f32x4v ring[W];
  f32x4v sum = zero;
#pragma unroll
  for (int i = 0; i < W; ++i) { ring[i] = (s0 + i - W >= 0) ? ld(t0 + i - W, 1536) : zero; sum += ring[i]; }
#pragma unroll
  for (int tt = 0; tt < 32; ++tt) {
    const int t = t0 + tt;
    const f32x4v x0 = ld(t, 512) * ld(t, 0);
    const f32x4v z = w0 * xm2 + w1 * xm1 + w2 * x0;
    xm2 = xm1; xm1 = x0;
    const f32x4v ya = ld(t, 1024) * z;
    const f32x4v pv = ld(t, 1536);
    sum += pv - ring[tt % W]; ring[tt % W] = pv;
    const int cnt = (s0 + tt + 1 < W) ? (s0 + tt + 1) : W;
    const float ic = 1.f / (float)cnt;
    const f32x4v pl = sum * ic - pv;
    u32x2 oa, ob;
    oa[0] = pack2(ya[0], ya[1]); oa[1] = pack2(ya[2], ya[3]);
    ob[0] = pack2(pl[0], pl[1]); ob[1] = pack2(pl[2], pl[3]);
    *(GAS u32x2*)(Y + (size_t)t * D + c) = oa;
    *(GAS u32x2*)(pool + (size_t)t * 512 + c) = ob;
  }
}
DI void phase_evenmix(const int wq, PRef p, int j) {
  const int tid = ltid(wq); const int bid = lbid();
  const int lane = tid & 63, wv = tid >> 6;
  const float* cw = p.even_conv_w + (size_t)j * 3 * 512;
  for (int Wg = bid * 4 + wv; Wg < 1024; Wg += gridDim.x * 4) {
    const int g = Wg & 3, cp = Wg >> 2;
    const int t0 = (cp * 2 + (lane >> 5)) * 32;
    const int c = g * 128 + (lane & 31) * 4;
    if (g == 0) evenmix_run<2>(p.P16, cw, p.Y, p.pool, t0, c);
    else if (g == 1) evenmix_run<4>(p.P16, cw, p.Y, p.pool, t0, c);
    else if (g == 2) evenmix_run<8>(p.P16, cw, p.Y, p.pool, t0, c);
    else evenmix_run<16>(p.P16, cw, p.Y, p.pool, t0, c);
  }
}

DI void phase_lb(const int wq, PRef p) {
  const int tid_ = ltid(wq); const int bid_ = lbid(); (void)tid_; (void)bid_;
  for (int c = bid_ * NT + tid_; c < 512; c += gridDim.x * NT) {
    float g[DEPTH], m = -INFINITY;
#pragma unroll
    for (int l = 0; l < DEPTH; ++l) { g[l] = p.hgrn_gamma[l * 512 + c]; m = fmaxf(m, g[l]); }
    float sum = 0.f;
#pragma unroll
    for (int l = 0; l < DEPTH; ++l) { g[l] = expf(g[l] - m); sum += g[l]; }
    float cum = 0.f;
#pragma unroll
    for (int l = 0; l < DEPTH; ++l) { p.lb[l * 512 + c] = cum; cum += g[l] / sum; }
  }
}

DI int t5_bucket(int dist) {
  const int d = dist < 0 ? 0 : dist;
  if (d < 16) return d;
  const float lr = logf((float)d / 16.f) / 2.0794415416798357f;
  int large = 16 + (int)(lr * 16.f);
  return large < 31 ? large : 31;
}

DI unsigned fkey(float f) { unsigned u = __float_as_uint(f); return (u & 0x80000000u) ? ~u : (u | 0x80000000u); }

DI void phase_hgrn_post(const int wq, PRef p, int j) {
  const int tid_ = ltid(wq); const int bid_ = lbid(); (void)tid_; (void)bid_;
  const int lane = tid_ & 63, wv = tid_ >> 6;
  for (int r = bid_ * 4 + wv; r < T * 4; r += gridDim.x * 4) {
    const int t = r >> 2, hd = r & 3;
    const float* o = p.oraw + (size_t)t * 512 + hd * 128;
    const float a = o[lane], bq = o[lane + 64];
    const float ss = wave_sum(a * a + bq * bq);
    const float rs = rsqrtf(ss / 128.f + 1e-6f);
    const bf16_t* gate = p.P16 + (size_t)t * ODD_IN + 3272 + hd * 128;
    const float* gn = p.odd_hg_norm + j * 512 + hd * 128;
    const float g0 = bf2f(gate[lane]), g1 = bf2f(gate[lane + 64]);
    p.Y[(size_t)t * D + 512 + hd * 128 + lane] = f2bf(a * rs * gn[lane] * (g0 * sigmoidf(g0)));
    p.Y[(size_t)t * D + 512 + hd * 128 + lane + 64] = f2bf(bq * rs * gn[lane + 64] * (g1 * sigmoidf(g1)));
  }
}

DI void phase_dsa_prep(const int wq, PRef p, int j) {
  const int tid = ltid(wq); const int bid = lbid();
  const int lane = tid & 63, wv = tid >> 6;
  for (int t = bid * 4 + wv; t < T; t += gridDim.x * 4) {
    const bf16_t* row = p.P16 + (size_t)t * ODD_IN;
#pragma unroll
    for (int c = 0; c < 2; ++c) *(GAS u32x4*)(p.qlat16 + (size_t)t * 1024 + c * 512 + lane * 8) = gload16(row + c * 512 + lane * 8);
    {
      const unsigned cv = *(const GAS unsigned*)(row + 1024 + 2 * lane);
      const float c0 = bflo(cv), c1 = bfhi(cv);
      const float ss = wave_sum(c0 * c0 + c1 * c1);
      const float rs = rsqrtf(ss / 128.f + 1e-6f);
      const float* g = p.odd_kv_norm + j * 128;
      *(GAS unsigned*)(p.ckv16 + (size_t)t * 128 + 2 * lane) = pack2(c0 * rs * g[2 * lane], c1 * rs * g[2 * lane + 1]);
    }
    *(GAS u32x4*)(p.iq16 + (size_t)t * 512 + lane * 8) = gload16(row + 1152 + lane * 8);
    p.ik16[(size_t)t * 64 + lane] = row[1664 + lane];
  }
}

DI void phase_dsa_scores(const int wq, PRef p, char* smem) {
  const int tid = ltid(wq); const int bid = lbid();
  const int lane = tid & 63, wv = tid >> 6, wm = wv >> 1, wn = wv & 1;
  const int r = lane & 31, hh = lane >> 5;
  const int srow = tid >> 3, skc = tid & 7;
  char* Ks = smem;
  char* Qs = smem + G_TILE_B;
  float* Ws = (float*)(smem + 3 * G_TILE_B);
  for (int tile = bid; tile < NB * 136; tile += gridDim.x) {
    const int b = tile / 136, u = tile % 136;
    int qb = 0;
    while ((qb + 1) * (qb + 2) / 2 <= u) ++qb;
    const int kb = u - qb * (qb + 1) / 2;
    const int q0 = b * S + qb * 128, k0 = b * S + kb * 128;
    const bf16_t* Kg = p.ik16 + (size_t)(k0 + srow) * 64 + skc * 8;
    const bf16_t* Qg = p.iq16 + (size_t)(q0 + srow) * 512 + skc * 8;
    u32x4 rk[4], rq[4];
#pragma unroll
    for (int i = 0; i < 4; ++i) { rk[i] = gload16(Kg + (size_t)(32 * i) * 64); rq[i] = gload16(Qg + (size_t)(32 * i) * 512); }
    u32x4 wv4 = {0u, 0u, 0u, 0u};
    if (tid < 128) wv4 = gload16(p.P16 + (size_t)(q0 + tid) * ODD_IN + 1728);
    __syncthreads();
#pragma unroll
    for (int i = 0; i < 4; ++i) {
      *(u32x4*)(Ks + (srow + 32 * i) * G_LDS_ROW + skc * 16) = rk[i];
      *(u32x4*)(Qs + (srow + 32 * i) * G_LDS_ROW + skc * 16) = rq[i];
    }
    if (tid < 128) {
      const unsigned w0 = wv4[0], w1 = wv4[1], w2 = wv4[2], w3 = wv4[3];
      f32x4v a4, b4;
      a4[0] = bflo(w0) * 0.35355339059327373f; a4[1] = bfhi(w0) * 0.35355339059327373f; a4[2] = bflo(w1) * 0.35355339059327373f; a4[3] = bfhi(w1) * 0.35355339059327373f;
      b4[0] = bflo(w2) * 0.35355339059327373f; b4[1] = bfhi(w2) * 0.35355339059327373f; b4[2] = bflo(w3) * 0.35355339059327373f; b4[3] = bfhi(w3) * 0.35355339059327373f;
      *(f32x4v*)(Ws + tid * 8) = a4; *(f32x4v*)(Ws + tid * 8 + 4) = b4;
    }
    __syncthreads();
    f32x16 sc[2][2];
#pragma unroll
    for (int i = 0; i < 2; ++i)
#pragma unroll
      for (int jx = 0; jx < 2; ++jx)
#pragma unroll
        for (int e = 0; e < 16; ++e) sc[i][jx][e] = 0.f;
#pragma unroll 1
    for (int hd = 0; hd < 8; ++hd) {
      const int cur = hd & 1;
      if (hd + 1 < 8) {
#pragma unroll
        for (int i = 0; i < 4; ++i) rq[i] = gload16(Qg + (size_t)(32 * i) * 512 + (hd + 1) * 64);
      }
      f32x16 acc[2][2];
#pragma unroll
      for (int i = 0; i < 2; ++i)
#pragma unroll
        for (int jx = 0; jx < 2; ++jx)
#pragma unroll
          for (int e = 0; e < 16; ++e) acc[i][jx][e] = 0.f;
      const char* As = Qs + cur * G_TILE_B + (wm * 64 + r) * G_LDS_ROW + hh * 16;
      const char* Bs = Ks + (wn * 64 + r) * G_LDS_ROW + hh * 16;
#pragma unroll
      for (int ks = 0; ks < 4; ++ks) {
        const bf16x8 a0 = *(const bf16x8*)(As + ks * 32), a1 = *(const bf16x8*)(As + 32 * G_LDS_ROW + ks * 32);
        const bf16x8 b0 = *(const bf16x8*)(Bs + ks * 32), b1 = *(const bf16x8*)(Bs + 32 * G_LDS_ROW + ks * 32);
        acc[0][0] = __builtin_amdgcn_mfma_f32_32x32x16_bf16(a0, b0, acc[0][0], 0, 0, 0);
        acc[0][1] = __builtin_amdgcn_mfma_f32_32x32x16_bf16(a0, b1, acc[0][1], 0, 0, 0);
        acc[1][0] = __builtin_amdgcn_mfma_f32_32x32x16_bf16(a1, b0, acc[1][0], 0, 0, 0);
        acc[1][1] = __builtin_amdgcn_mfma_f32_32x32x16_bf16(a1, b1, acc[1][1], 0, 0, 0);
      }
#pragma unroll
      for (int i = 0; i < 2; ++i)
#pragma unroll
        for (int e = 0; e < 16; ++e) {
          const float w = Ws[(wm * 64 + i * 32 + (e & 3) + 8 * (e >> 2) + 4 * hh) * 8 + hd];
          sc[i][0][e] = fmaf(w, fmaxf(acc[i][0][e] * 0.125f, 0.f), sc[i][0][e]);
          sc[i][1][e] = fmaf(w, fmaxf(acc[i][1][e] * 0.125f, 0.f), sc[i][1][e]);
        }
      if (hd + 1 < 8) {
#pragma unroll
        for (int i = 0; i < 4; ++i) *(u32x4*)(Qs + (cur ^ 1) * G_TILE_B + (srow + 32 * i) * G_LDS_ROW + skc * 16) = rq[i];
      }
      __syncthreads();
    }
#pragma unroll
    for (int i = 0; i < 2; ++i)
#pragma unroll
      for (int jx = 0; jx < 2; ++jx) {
        GAS float* cp = (GAS float*)p.sc + (size_t)(q0 + wm * 64 + i * 32 + 4 * hh) * 2048 + kb * 128 + wn * 64 + jx * 32 + r;
#pragma unroll
        for (int e = 0; e < 16; ++e) cp[(size_t)((e & 3) + 8 * (e >> 2)) * 2048] = sc[i][jx][e];
      }
  }
}

DI void phase_hgrn_scan(const int wq, PRef p, int l, char* smem) {
  const int tid = ltid(wq); const int bid = lbid();
  const int lane = tid & 63, wv = tid >> 6;
  const int kq = wv * 4 + (lane & 3), v = lane >> 2;
  constexpr int BUF = (2048 + 2048 + 256);
  float* bufs = (float*)smem;
  float* opart = bufs + 2 * BUF;
  for (int unit = bid; unit < 256; unit += gridDim.x) {
    const int b = unit >> 5, hd = (unit >> 3) & 3, vs = unit & 7;
    const int ltok = tid >> 4, lc = (tid & 15) * 8;
    const bf16_t* Pb = p.P16 + (size_t)(b * S) * ODD_IN;
    f32x4v lbv0, lbv1;
    { const float* lbp = p.lb + l * 512 + hd * 128 + lc; lbv0 = *(const f32x4v*)lbp; lbv1 = *(const f32x4v*)(lbp + 4); }
    f32x2v st[4];
#pragma unroll
    for (int i = 0; i < 4; ++i) { st[i][0] = 0.f; st[i][1] = 0.f; }
    u32x4 rq, rf; float riv;
    auto gl = [&](int bt) {
      const bf16_t* row = Pb + (size_t)(bt * 16 + ltok) * ODD_IN;
      rq = gload16(row + 1736 + hd * 128 + lc);
      rf = gload16(row + 2248 + hd * 128 + lc);
      riv = bf2f(row[2760 + hd * 128 + vs * 16 + (tid & 15)]);
    };
    auto st_lds = [&](int which) {
      float* bq = bufs + which * BUF; float* bf = bq + 2048; float* bi = bf + 2048;
      const unsigned q0_ = rq[0], q1_ = rq[1], q2_ = rq[2], q3_ = rq[3], f0_ = rf[0], f1_ = rf[1], f2_ = rf[2], f3_ = rf[3];
      f32x4v qa, qb, fa, fb;
      qa[0] = bflo(q0_); qa[1] = bfhi(q0_); qa[2] = bflo(q1_); qa[3] = bfhi(q1_); qb[0] = bflo(q2_); qb[1] = bfhi(q2_); qb[2] = bflo(q3_); qb[3] = bfhi(q3_);
      fa[0] = bflo(f0_); fa[1] = bfhi(f0_); fa[2] = bflo(f1_); fa[3] = bfhi(f1_); fb[0] = bflo(f2_); fb[1] = bfhi(f2_); fb[2] = bflo(f3_); fb[3] = bfhi(f3_);
      *(f32x4v*)(bq + ltok * 128 + lc) = qa; *(f32x4v*)(bq + ltok * 128 + lc + 4) = qb;
      f32x4v f0, f1;
#pragma unroll
      for (int i = 0; i < 4; ++i) {
        f0[i] = lbv0[i] + (1.f - lbv0[i]) * __builtin_amdgcn_rcpf(1.f + __expf(-fa[i]));
        f1[i] = lbv1[i] + (1.f - lbv1[i]) * __builtin_amdgcn_rcpf(1.f + __expf(-fb[i]));
      }
      *(f32x4v*)(bf + ltok * 128 + lc) = f0; *(f32x4v*)(bf + ltok * 128 + lc + 4) = f1;
      bi[ltok * 16 + (tid & 15)] = riv;
    };
    gl(0);
    __syncthreads();
    st_lds(0);
    __syncthreads();
#pragma unroll 1
    for (int bt = 0; bt < S / 16; ++bt) {
      const int cur = bt & 1;
      if (bt + 1 < S / 16) gl(bt + 1);
      const float* bq = bufs + cur * BUF; const float* bf = bq + 2048; const float* bi = bf + 2048;
      f32x4v F0, F1, Q0, Q1; float IV;
      auto ldstep = [&](int tt) {
        IV = bi[tt * 16 + v];
        F0 = *(const f32x4v*)(bf + tt * 128 + kq * 8); F1 = *(const f32x4v*)(bf + tt * 128 + kq * 8 + 4);
        Q0 = *(const f32x4v*)(bq + tt * 128 + kq * 8); Q1 = *(const f32x4v*)(bq + tt * 128 + kq * 8 + 4);
      };
      ldstep(0);
#pragma unroll
      for (int tt = 0; tt < 16; ++tt) {
        const float iv = IV;
        const f32x4v f0 = F0, f1 = F1, q0 = Q0, q1 = Q1;
        if (tt + 1 < 16) ldstep(tt + 1);
        f32x2v iv2; iv2[0] = iv; iv2[1] = iv;
        f32x2v fa, fb, fc, fd, qa, qb, qc, qd;
        fa[0] = f0[0]; fa[1] = f0[1]; fb[0] = f0[2]; fb[1] = f0[3]; fc[0] = f1[0]; fc[1] = f1[1]; fd[0] = f1[2]; fd[1] = f1[3];
        qa[0] = q0[0]; qa[1] = q0[1]; qb[0] = q0[2]; qb[1] = q0[3]; qc[0] = q1[0]; qc[1] = q1[1]; qd[0] = q1[2]; qd[1] = q1[3];
        st[0] = __builtin_elementwise_fma(fa, st[0] - iv2, iv2);
        st[1] = __builtin_elementwise_fma(fb, st[1] - iv2, iv2);
        st[2] = __builtin_elementwise_fma(fc, st[2] - iv2, iv2);
        st[3] = __builtin_elementwise_fma(fd, st[3] - iv2, iv2);
        f32x2v o2 = qa * st[0];
        o2 = __builtin_elementwise_fma(qb, st[1], o2);
        o2 = __builtin_elementwise_fma(qc, st[2], o2);
        o2 = __builtin_elementwise_fma(qd, st[3], o2);
        float o = o2[0] + o2[1];
        o += __int_as_float(__builtin_amdgcn_update_dpp(0, __float_as_int(o), 0xB1, 0xF, 0xF, true));
        o += __int_as_float(__builtin_amdgcn_update_dpp(0, __float_as_int(o), 0x4E, 0xF, 0xF, true));
        opart[(tt * 4 + wv) * 16 + v] = o;
      }
      __syncthreads();
      {
        const int tt = tid >> 4, vo = tid & 15;
        const float o = opart[(tt * 4 + 0) * 16 + vo] + opart[(tt * 4 + 1) * 16 + vo] + opart[(tt * 4 + 2) * 16 + vo] + opart[(tt * 4 + 3) * 16 + vo];
        p.oraw[(size_t)(b * S + bt * 16 + tt) * 512 + hd * 128 + vs * 16 + vo] = o;
      }
      if (bt + 1 < S / 16) st_lds(cur ^ 1);
      __syncthreads();
    }
  }
}

DI float dot2bf(unsigned a, unsigned b, float acc) { return __builtin_amdgcn_fdot2_f32_bf16(__builtin_bit_cast(bf16x2_t, a), __builtin_bit_cast(bf16x2_t, b), acc, false); }
DI unsigned fkey_u(float f) { const unsigned u = __float_as_uint(f); return (u & 0x80000000u) ? ~u : (u | 0x80000000u); }
DI void phase_dsa_attend(const int wq, PRef p, int j, char* smem, int qoff) {
  const int tid = ltid(wq); const int bid = lbid(); (void)bid;
  const int lane = tid & 63, wv = tid >> 6;
  int* selL = (int*)smem;
  int* nselL = selL + 1024;
  float* bias = (float*)(smem + 4096 + 64);
  float* part = (float*)(smem + 4096 + 64 + 1024);
  float* msb = part + 2 * 4 * 8 * 128;
  float* plw = msb + 2 * 4 * 16 + wv * 64 * 8;
  int* sel = selL + wv * 256;
  __syncthreads();
  bias[tid] = p.rel_bias[tid];
  const int n16 = lane & 15, kg = lane >> 4;
  const unsigned long long ltmask = (1ull << lane) - 1ull;
  for (;;) {
    __syncthreads();
    if (tid == 0) nselL[4] = (int)atomicAdd(p.qctr + qoff, 4u);
    __syncthreads();
    const int base = nselL[4];
    if (base >= T) break;
    {
      const int q = base + wv;
      const int t = q % S;
      const float* row = p.sc + (size_t)q * 2048;
      int nsel;
      if (t < 256) {
        nsel = t + 1;
#pragma unroll
        for (int i = 0; i < 4; ++i) sel[i * 64 + lane] = i * 64 + lane;
      } else {
        nsel = 256;
        const int ni = (t >> 6) + 1;
        unsigned keys[32];
#pragma unroll
        for (int i = 0; i < 32; ++i) {
          keys[i] = 0u;
          if (i < ni) { const int s_ = i * 64 + lane; if (s_ <= t) keys[i] = fkey_u(row[s_]); }
        }
        unsigned thr = 0u;
#pragma unroll 1
        for (int bit = 31; bit >= 0; --bit) {
          const unsigned cand = thr | (1u << bit);
          int cl = 0;
#pragma unroll
          for (int g = 0; g < 4; ++g) if (g * 8 < ni) {
#pragma unroll
            for (int i = g * 8; i < g * 8 + 8; ++i) cl += (keys[i] >= cand) ? 1 : 0;
          }
          const int cnt = wave_sum_i(cl);
          if (cnt >= 256) thr = cand;
        }
        int ngt = 0;
#pragma unroll
        for (int i = 0; i < 32; ++i) if (i < ni) ngt += __builtin_popcountll(__ballot(keys[i] > thr));
        const int need = 256 - ngt;
        int pg = 0, pe = 0;
#pragma unroll
        for (int i = 0; i < 32; ++i) if (i < ni) {
          const unsigned long long mg = __ballot(keys[i] > thr), me = __ballot(keys[i] == thr);
          const int myg = pg + __builtin_popcountll(mg & ltmask), mye = pe + __builtin_popcountll(me & ltmask);
          if (keys[i] > thr) sel[myg] = i * 64 + lane;
          else if (keys[i] == thr && mye < need) sel[ngt + mye] = i * 64 + lane;
          pg += __builtin_popcountll(mg); pe += __builtin_popcountll(me);
        }
      }
      if (lane == 0) nselL[wv] = nsel;
    }
    __syncthreads();
#pragma unroll 1
    for (int qi = 0; qi < 4; ++qi) {
      const int tid = ltid(wq);
      const int lane = tid & 63;
      const int n16 = lane & 15, kg = lane >> 4;
      const int q = base + qi;
      const int b = q / S, t = q % S;
      const int nsel = nselL[qi];
      const int* qsel = selL + qi * 256 + wv * 64;
      const int slot0 = wv * 64;
      float* pw = part + ((qi & 1) * 4 + wv) * 8 * 128;
      float* mw = msb + ((qi & 1) * 4 + wv) * 16;
      bf16x8 aq[4];
#pragma unroll
      for (int ks = 0; ks < 4; ++ks) {
        u32x4 z = {0u, 0u, 0u, 0u};
        if (n16 < 8) z = gload16(p.qlat16 + (size_t)q * 1024 + n16 * 128 + ks * 32 + kg * 8);
        aq[ks] = __builtin_bit_cast(bf16x8, z);
      }
      u32x4 bv[4][4];
#pragma unroll
      for (int bb = 0; bb < 4; ++bb) {
        const int sl = bb * 16 + n16;
        const int sxv = (slot0 + sl < nsel) ? qsel[sl] : 0;
        const bf16_t* crow = p.ckv16 + (size_t)(b * S + sxv) * 128 + kg * 8;
#pragma unroll
        for (int ks = 0; ks < 4; ++ks) bv[bb][ks] = gload16(crow + ks * 32);
      }
      const bf16_t* cb = p.ckv16 + (size_t)(b * S) * 128 + 2 * lane;
      unsigned cbuf[64];
#pragma unroll
      for (int i4 = 0; i4 < 8; ++i4) {
        const u32x4 s4 = *(const u32x4*)(qsel + i4 * 4);
#pragma unroll
        for (int e = 0; e < 4; ++e) {
          const int k = i4 * 4 + e;
          const int sk = (slot0 + k < nsel) ? __builtin_amdgcn_readfirstlane((int)s4[e]) : 0;
          cbuf[k] = *(const GAS unsigned*)(cb + (size_t)sk * 128);
        }
      }
      asm volatile("" ::: "memory");
      f32x4v lg[4];
#pragma unroll
      for (int bb = 0; bb < 4; ++bb) {
        f32x4v acc = {0.f, 0.f, 0.f, 0.f};
#pragma unroll
        for (int ks = 0; ks < 4; ++ks) acc = __builtin_amdgcn_mfma_f32_16x16x32_bf16(aq[ks], __builtin_bit_cast(bf16x8, bv[bb][ks]), acc, 0, 0, 0);
        lg[bb] = acc;
      }
      asm volatile("" ::: "memory");
#pragma unroll
      for (int i4 = 8; i4 < 16; ++i4) {
        const u32x4 s4 = *(const u32x4*)(qsel + i4 * 4);
#pragma unroll
        for (int e = 0; e < 4; ++e) {
          const int k = i4 * 4 + e;
          const int sk = (slot0 + k < nsel) ? __builtin_amdgcn_readfirstlane((int)s4[e]) : 0;
          cbuf[k] = *(const GAS unsigned*)(cb + (size_t)sk * 128);
        }
      }
      float mx[4] = {-INFINITY, -INFINITY, -INFINITY, -INFINITY};
#pragma unroll
      for (int bb = 0; bb < 4; ++bb) {
        const bool ok = slot0 + bb * 16 + n16 < nsel;
        const int bk = t5_bucket(t - (ok ? qsel[bb * 16 + n16] : 0));
#pragma unroll
        for (int i = 0; i < 4; ++i) {
          const float lv = ok ? lg[bb][i] * 0.08838834764831845f + bias[bk * 8 + ((4 * kg + i) & 7)] : -INFINITY;
          lg[bb][i] = lv; mx[i] = fmaxf(mx[i], lv);
        }
      }
#pragma unroll
      for (int i = 0; i < 4; ++i) mx[i] = rowmax16(mx[i]);
      float sm[4] = {0.f, 0.f, 0.f, 0.f};
#pragma unroll
      for (int bb = 0; bb < 4; ++bb)
#pragma unroll
        for (int i = 0; i < 4; ++i) {
          const float e_ = (mx[i] == -INFINITY) ? 0.f : __expf(lg[bb][i] - mx[i]);
          lg[bb][i] = e_; sm[i] += e_;
        }
#pragma unroll
      for (int i = 0; i < 4; ++i) sm[i] = rowsum16(sm[i]);
#pragma unroll
      for (int bb = 0; bb < 4; ++bb) {
        u32x4 pr;
#pragma unroll
        for (int i = 0; i < 4; ++i) {
          const float other = DPP_F(lg[bb][i], 0xB1, 0xF, true);
          pr[i] = pack2(lg[bb][i], other);
        }
        if (kg < 2 && (n16 & 1) == 0) *(u32x4*)((unsigned*)plw + ((bb * 16 + n16) >> 1) * 8 + 4 * kg) = pr;
      }
      if (kg < 2) {
        if (n16 == 0) {
#pragma unroll
          for (int i = 0; i < 4; ++i) { mw[4 * kg + i] = mx[i]; mw[8 + 4 * kg + i] = sm[i]; }
        }
      }
      asm volatile("s_waitcnt lgkmcnt(0)" ::: "memory");
      float o[16];
#pragma unroll
      for (int i = 0; i < 16; ++i) o[i] = 0.f;
#pragma unroll
      for (int kp = 0; kp < 32; ++kp) {
        if ((kp & 1) == 0) asm volatile("" ::: "memory");
        const unsigned ca = cbuf[2 * kp], cbx = cbuf[2 * kp + 1];
        const unsigned x0 = __builtin_amdgcn_perm(cbx, ca, 0x05040100u);
        const unsigned x1 = __builtin_amdgcn_perm(cbx, ca, 0x07060302u);
        const u32x4 pa4 = *(const u32x4*)((const unsigned*)plw + kp * 8), pb4 = *(const u32x4*)((const unsigned*)plw + kp * 8 + 4);
        const unsigned q0 = pa4[0], q1 = pa4[1], q2 = pa4[2], q3 = pa4[3], q4 = pb4[0], q5 = pb4[1], q6 = pb4[2], q7 = pb4[3];
        o[0] = dot2bf(q0, x0, o[0]); o[1] = dot2bf(q0, x1, o[1]); o[2] = dot2bf(q1, x0, o[2]); o[3] = dot2bf(q1, x1, o[3]);
        o[4] = dot2bf(q2, x0, o[4]); o[5] = dot2bf(q2, x1, o[5]); o[6] = dot2bf(q3, x0, o[6]); o[7] = dot2bf(q3, x1, o[7]);
        o[8] = dot2bf(q4, x0, o[8]); o[9] = dot2bf(q4, x1, o[9]); o[10] = dot2bf(q5, x0, o[10]); o[11] = dot2bf(q5, x1, o[11]);
        o[12] = dot2bf(q6, x0, o[12]); o[13] = dot2bf(q6, x1, o[13]); o[14] = dot2bf(q7, x0, o[14]); o[15] = dot2bf(q7, x1, o[15]);
      }
#pragma unroll
      for (int hd = 0; hd < 8; ++hd) { float2 ov; ov.x = o[2 * hd]; ov.y = o[2 * hd + 1]; *(float2*)(pw + hd * 128 + 2 * lane) = ov; }
      __syncthreads();
      {
        const int hd = tid >> 5, ch = (tid & 31) * 4;
        const float* pq = part + (qi & 1) * 4 * 8 * 128;
        const float* mq = msb + (qi & 1) * 4 * 16;
        float m0 = mq[hd], m1 = mq[16 + hd], m2 = mq[32 + hd], m3 = mq[48 + hd];
        const float M = fmaxf(fmaxf(m0, m1), fmaxf(m2, m3));
        const float f0 = __expf(m0 - M), f1 = __expf(m1 - M), f2 = __expf(m2 - M), f3 = __expf(m3 - M);
        const float den = f0 * mq[8 + hd] + f1 * mq[24 + hd] + f2 * mq[40 + hd] + f3 * mq[56 + hd];
        const f32x4v a0 = *(const f32x4v*)(pq + (0 * 8 + hd) * 128 + ch), a1 = *(const f32x4v*)(pq + (1 * 8 + hd) * 128 + ch);
        const f32x4v a2 = *(const f32x4v*)(pq + (2 * 8 + hd) * 128 + ch), a3 = *(const f32x4v*)(pq + (3 * 8 + hd) * 128 + ch);
        const float inv = 1.f / den;
        const f32x4v r = (a0 * f0 + a1 * f1 + a2 * f2 + a3 * f3) * inv;
        u32x2 ov; ov[0] = pack2(r[0], r[1]); ov[1] = pack2(r[2], r[3]);
        *(GAS u32x2*)(p.lat + (size_t)q * D + hd * 128 + ch) = ov;
      }
    }
  }
}

DI void phase_softmax256(const int wq, const bf16_t* __restrict__ S, bf16_t* __restrict__ Pm, int rows) {
  const int tid = ltid(wq); const int bid = lbid();
  const int lane = tid & 63, wv = tid >> 6;
  for (int r = bid * 4 + wv; r < rows; r += gridDim.x * 4) {
    const f32x4v v = bf4_to_f(*(const GAS u32x2*)(S + (size_t)r * 256 + lane * 4));
    const float a = v[0], b = v[1], c = v[2], d = v[3];
    const float m = wave_max(fmaxf(fmaxf(a, b), fmaxf(c, d)));
    const float ea = __expf(a - m), eb = __expf(b - m), ec = __expf(c - m), ed = __expf(d - m);
    const float inv = 1.f / wave_sum(ea + eb + ec + ed);
    u32x2 o; o[0] = pack2(ea * inv, eb * inv); o[1] = pack2(ec * inv, ed * inv);
    *(GAS u32x2*)(Pm + (size_t)r * 256 + lane * 4) = o;
  }
}

DI int fkey_s(int b) { return b ^ ((b >> 31) & 0x7fffffff); }

template <int N, int KMAX>
DI void bitonic_blocks(int (&v)[N]) {
#pragma unroll
  for (int k = 2; k <= KMAX; k <<= 1)
#pragma unroll
    for (int j = k >> 1; j > 0; j >>= 1)
#pragma unroll
      for (int i = 0; i < N; ++i) {
        const int l = i ^ j;
        if (l > i) {
          const bool desc = ((i & k) == 0);
          const int a = v[i], b = v[l];
          const int hi = a > b ? a : b, lo = a > b ? b : a;
          v[i] = desc ? hi : lo;
          v[l] = desc ? lo : hi;
        }
      }
}
template <bool DESC>
DI void bitonic_merge16(int (&v)[16]) {
#pragma unroll
  for (int j = 8; j > 0; j >>= 1)
#pragma unroll
    for (int i = 0; i < 16; ++i) {
      const int l = i ^ j;
      if (l > i) {
        const int a = v[i], b = v[l];
        const int hi = a > b ? a : b, lo = a > b ? b : a;
        v[i] = DESC ? hi : lo;
        v[l] = DESC ? lo : hi;
      }
    }
}

DI void phase_cvt_rows(const int wq, const float* __restrict__ src, bf16_t* __restrict__ dst, size_t n8) {
  const int tid = ltid(wq); const int bid = lbid();
  for (size_t i = (size_t)bid * NT + tid; i < n8; i += (size_t)gridDim.x * NT) {
    const u32x4 a = gload16(src + i * 8), b = gload16(src + i * 8 + 4);
    u32x4 o;
    o[0] = pack2(__uint_as_float(a[0]), __uint_as_float(a[1])); o[1] = pack2(__uint_as_float(a[2]), __uint_as_float(a[3]));
    o[2] = pack2(__uint_as_float(b[0]), __uint_as_float(b[1])); o[3] = pack2(__uint_as_float(b[2]), __uint_as_float(b[3]));
    *(GAS u32x4*)(dst + i * 8) = o;
  }
}

constexpr int KEY_ROW = 264;
DI void phase_peer_qs(const int wq, const bf16_t* __restrict__ X0, const bf16_t* __restrict__ W0, const bf16_t* __restrict__ keys0, int* __restrict__ tops, char* smem, const float* __restrict__ rss_in) {
  const int tid = ltid(wq); const int bid = lbid();
  const int lane = tid & 63, wv = tid >> 6;
  const int r = lane & 31, hh = lane >> 5;
  const int srow = tid >> 3, skc = tid & 7;
  constexpr int nk = D / 64;
  for (int tile = bid; tile < (T / 128) * 16; tile += gridDim.x) {
    const int mt = tile >> 4, hp = tile & 15;
    const bf16_t* Wg = W0 + (size_t)(hp * 128 + srow) * D + skc * 8;
    const bf16_t* Xg = X0 + (size_t)(mt * 128 + srow) * D + skc * 8;
    f32x16 acc[4];
#pragma unroll
    for (int i = 0; i < 4; ++i)
#pragma unroll
      for (int e = 0; e < 16; ++e) acc[i][e] = 0.f;
    u32x4 ra[4], rb[4];
#pragma unroll
    for (int i = 0; i < 4; ++i) { ra[i] = gload16(Wg + (size_t)(32 * i) * D); rb[i] = gload16(Xg + (size_t)(32 * i) * D); }
    __syncthreads();
#pragma unroll
    for (int i = 0; i < 4; ++i) {
      *(u32x4*)(smem + (srow + 32 * i) * G_LDS_ROW + skc * 16) = ra[i];
      *(u32x4*)(smem + 2 * G_TILE_B + (srow + 32 * i) * G_LDS_ROW + skc * 16) = rb[i];
    }
    __syncthreads();
#pragma unroll 1
    for (int kt = 0; kt < nk; ++kt) {
      const int cur = kt & 1;
      if (kt + 1 < nk) {
#pragma unroll
        for (int i = 0; i < 4; ++i) { ra[i] = gload16(Wg + (size_t)(32 * i) * D + (kt + 1) * 64); rb[i] = gload16(Xg + (size_t)(32 * i) * D + (kt + 1) * 64); }
      }
      const char* As = smem + cur * G_TILE_B + r * G_LDS_ROW + hh * 16;
      const char* Bs = smem + 2 * G_TILE_B + cur * G_TILE_B + (wv * 32 + r) * G_LDS_ROW + hh * 16;
#pragma unroll
      for (int ks = 0; ks < 4; ++ks) {
        const bf16x8 b = *(const bf16x8*)(Bs + ks * 32);
#pragma unroll
        for (int mb = 0; mb < 4; ++mb) {
          const bf16x8 a = *(const bf16x8*)(As + mb * 32 * G_LDS_ROW + ks * 32);
          acc[mb] = __builtin_amdgcn_mfma_f32_32x32x16_bf16(a, b, acc[mb], 0, 0, 0);
        }
      }
      if (kt + 1 < nk) {
        const int nxt = cur ^ 1;
#pragma unroll
        for (int i = 0; i < 4; ++i) {
          *(u32x4*)(smem + nxt * G_TILE_B + (srow + 32 * i) * G_LDS_ROW + skc * 16) = ra[i];
          *(u32x4*)(smem + 2 * G_TILE_B + nxt * G_TILE_B + (srow + 32 * i) * G_LDS_ROW + skc * 16) = rb[i];
        }
      }
      __syncthreads();
    }
    {
      const bf16_t* kg = keys0 + (size_t)hp * 128 * 128;
#pragma unroll
      for (int i = 0; i < 8; ++i) {
        const int c = tid + NT * i, row = c >> 4, c16 = c & 15;
        const u32x4 v = gload16(kg + row * 128 + c16 * 8);
        uint2 lo, hi2; lo.x = v[0]; lo.y = v[1]; hi2.x = v[2]; hi2.y = v[3];
        *(uint2*)(smem + row * KEY_ROW + c16 * 16) = lo;
        *(uint2*)(smem + row * KEY_ROW + c16 * 16 + 8) = hi2;
      }
    }
    __syncthreads();
    u32x4 qf[8];
    const float rstd_t = rstd_of(rss_in, mt * 128 + wv * 32 + r);
#pragma unroll
    for (int mb = 0; mb < 4; ++mb)
#pragma unroll
      for (int s2 = 0; s2 < 2; ++s2) {
        u32x4 f;
#pragma unroll
        for (int jj = 0; jj < 4; ++jj) f[jj] = pack2(acc[mb][8 * s2 + 2 * jj] * rstd_t, acc[mb][8 * s2 + 2 * jj + 1] * rstd_t);
        qf[mb * 2 + s2] = f;
      }
    int v[64];
#pragma unroll
    for (int kb = 0; kb < 4; ++kb) {
      f32x16 sa;
#pragma unroll
      for (int e = 0; e < 16; ++e) sa[e] = 0.f;
      const char* kr = smem + (kb * 32 + r) * KEY_ROW + hh * 8;
#pragma unroll
      for (int ksi = 0; ksi < 8; ++ksi) {
        const uint2 lo = *(const uint2*)(kr + ksi * 32);
        const uint2 hi2 = *(const uint2*)(kr + ksi * 32 + 16);
        u32x4 a; a[0] = lo.x; a[1] = lo.y; a[2] = hi2.x; a[3] = hi2.y;
        sa = __builtin_amdgcn_mfma_f32_32x32x16_bf16(__builtin_bit_cast(bf16x8, a), __builtin_bit_cast(bf16x8, qf[ksi]), sa, 0, 0, 0);
      }
#pragma unroll
      for (int e = 0; e < 16; ++e) {
        const int kidx = kb * 32 + (e & 3) + 8 * (e >> 2) + 4 * hh;
        v[kb * 16 + e] = (fkey_s(__float_as_int(sa[e])) & ~127) | kidx;
      }
    }
    bitonic_blocks<64, 16>(v);
    int c01[16], c23[16];
#pragma unroll
    for (int i = 0; i < 16; ++i) { c01[i] = v[i] > v[16 + i] ? v[i] : v[16 + i]; c23[i] = v[32 + i] > v[48 + i] ? v[32 + i] : v[48 + i]; }
    bitonic_merge16<true>(c01);
    bitonic_merge16<false>(c23);
    int d[16];
#pragma unroll
    for (int i = 0; i < 16; ++i) d[i] = c01[i] > c23[i] ? c01[i] : c23[i];
    bitonic_merge16<true>(d);
    int f[16];
#pragma unroll
    for (int i = 0; i < 16; ++i) { const int o = shxi(d[15 - i], 32, lane); f[i] = d[i] > o ? d[i] : o; }
    bitonic_merge16<true>(f);
    {
      const int token = mt * 128 + wv * 32 + r;
      GAS int* op = (GAS int*)tops + ((size_t)token * 16 + hp) * 16 + hh * 8;
      u32x4 o0, o1;
      if (hh) {
#pragma unroll
        for (int i = 0; i < 4; ++i) { o0[i] = f[8 + i]; o1[i] = f[12 + i]; }
        asm volatile("" : "+v"(o0), "+v"(o1));
      } else {
#pragma unroll
        for (int i = 0; i < 4; ++i) { o0[i] = f[i]; o1[i] = f[4 + i]; }
        asm volatile("" : "+v"(o0), "+v"(o1));
      }
      *(GAS u32x4*)op = o0; *(GAS u32x4*)(op + 4) = o1;
    }
  }
}

DI float dot8(const u32x4 a, const u32x4 b, float acc) {
  const unsigned a0 = a[0], a1 = a[1], a2 = a[2], a3 = a[3], b0 = b[0], b1 = b[1], b2 = b[2], b3 = b[3];
  acc = dot2bf(a0, b0, acc); acc = dot2bf(a1, b1, acc); acc = dot2bf(a2, b2, acc); acc = dot2bf(a3, b3, acc);
  return acc;
}
typedef signed char i8_t;
using i32x2 = __attribute__((ext_vector_type(2))) int;
DI void phase_quant_u(const int wq, const float* __restrict__ src, i8_t* __restrict__ dst, float* __restrict__ su, int nrows, const float* __restrict__ gain) {
  const int tid = ltid(wq); const int bid = lbid();
  const int lane = tid & 63, wv = tid >> 6;
  for (int row = bid * 4 + wv; row < nrows; row += gridDim.x * 4) {
    const float* r = src + (size_t)row * 1024 + 16 * lane;
    u32x4 a[4];
    {
      const float* gp = gain + (size_t)(row >> 14) * 1024 + 16 * lane;
#pragma unroll
      for (int i = 0; i < 4; ++i) {
        const u32x4 t = gload16(r + 4 * i);
        const f32x4v g4 = *(const f32x4v*)(gp + 4 * i);
        const unsigned t0 = t[0], t1 = t[1], t2 = t[2], t3 = t[3];
        a[i][0] = __float_as_uint(__uint_as_float(t0) * g4[0]); a[i][1] = __float_as_uint(__uint_as_float(t1) * g4[1]);
        a[i][2] = __float_as_uint(__uint_as_float(t2) * g4[2]); a[i][3] = __float_as_uint(__uint_as_float(t3) * g4[3]);
      }
    }
    float am = 0.f;
#pragma unroll
    for (int i = 0; i < 4; ++i) {
      const unsigned x0 = a[i][0], x1 = a[i][1], x2 = a[i][2], x3 = a[i][3];
      am = fmaxf(am, fmaxf(fmaxf(fabsf(__uint_as_float(x0)), fabsf(__uint_as_float(x1))), fmaxf(fabsf(__uint_as_float(x2)), fabsf(__uint_as_float(x3)))));
    }
    am = wave_max(am);
    const float inv = am > 0.f ? 127.f / am : 0.f;
    u32x4 o;
#pragma unroll
    for (int i = 0; i < 4; ++i) {
      const unsigned x0 = a[i][0], x1 = a[i][1], x2 = a[i][2], x3 = a[i][3];
      const int q0 = (int)rintf(__uint_as_float(x0) * inv), q1 = (int)rintf(__uint_as_float(x1) * inv);
      const int q2 = (int)rintf(__uint_as_float(x2) * inv), q3 = (int)rintf(__uint_as_float(x3) * inv);
      o[i] = (unsigned)(q0 & 255) | ((unsigned)(q1 & 255) << 8) | ((unsigned)(q2 & 255) << 16) | ((unsigned)(q3 & 255) << 24);
    }
    const size_t lyr = (size_t)row >> 14, e = (size_t)row & 16383;
    *(GAS u32x4*)(dst + (((lyr * 8 + (lane >> 3)) * 16384 + e) * 128 + (lane & 7) * 16)) = o;
    if (lane == 0) su[row] = am * (1.f / 127.f);
  }
}
DI void phase_cvt_v8(const int wq, const float* __restrict__ src, i8_t* __restrict__ dst, size_t n16) {
  const int tid = ltid(wq); const int bid = lbid();
  for (size_t i = (size_t)bid * NT + tid; i < n16; i += (size_t)gridDim.x * NT) {
    u32x4 o;
#pragma unroll
    for (int k = 0; k < 4; ++k) {
      const u32x4 a = gload16(src + i * 16 + 4 * k);
      const unsigned x0 = a[0], x1 = a[1], x2 = a[2], x3 = a[3];
      int pk = 0;
      pk = __builtin_amdgcn_cvt_pk_fp8_f32(__uint_as_float(x0) * 16.f, __uint_as_float(x1) * 16.f, pk, false);
      pk = __builtin_amdgcn_cvt_pk_fp8_f32(__uint_as_float(x2) * 16.f, __uint_as_float(x3) * 16.f, pk, true);
      o[k] = (unsigned)pk;
    }
    const size_t row = i >> 6; const int j = (int)(i & 63);
    const size_t lyr = row >> 14, e = row & 16383;
    *(GAS u32x4*)(dst + (((lyr * 8 + (j >> 3)) * 16384 + e) * 128 + (j & 7) * 16)) = o;
  }
}

DI void phase_peer_combine8(const int wq, PRef p, int l, char* smem, const float* __restrict__ rss_in) {
  const int tid = ltid(wq); const int bid = lbid();
  const int lane = tid & 63, wv = tid >> 6;
  int* wtops = (int*)(smem + wv * 1024);
  int ci, cj;
  if (lane < 16) { ci = 0; cj = lane; } else if (lane < 24) { ci = 1; cj = lane - 16; } else if (lane < 29) { ci = 2; cj = lane - 24; }
  else if (lane < 33) { ci = 3; cj = lane - 29; } else if (lane < 36) { ci = 4; cj = lane - 33; } else if (lane < 38) { ci = 5; cj = lane - 36; }
  else if (lane < 40) { ci = 6; cj = lane - 38; } else if (lane < 42) { ci = 7; cj = lane - 40; } else { ci = lane - 42 + 8; cj = 0; }
  const bool cvalid = lane < 50;
  if (!cvalid) { ci = 0; cj = 0; }
  const float* sul = p.su + (size_t)l * 16384;
  for (int token = bid * 4 + wv; token < T; token += gridDim.x * 4) {
    {
      const u32x4 tv = gload16(p.tops + (size_t)token * 256 + lane * 4);
      *(u32x4*)(wtops + lane * 4) = tv;
    }
    {
      const u32x4 a = gload16(p.hn + (size_t)token * D + 16 * lane), b2 = gload16(p.hn + (size_t)token * D + 16 * lane + 8);
      float xv[16];
      { const unsigned a0 = a[0], a1 = a[1], a2 = a[2], a3 = a[3], c0 = b2[0], c1 = b2[1], c2 = b2[2], c3 = b2[3];
        xv[0] = bflo(a0); xv[1] = bfhi(a0); xv[2] = bflo(a1); xv[3] = bfhi(a1); xv[4] = bflo(a2); xv[5] = bfhi(a2); xv[6] = bflo(a3); xv[7] = bfhi(a3);
        xv[8] = bflo(c0); xv[9] = bfhi(c0); xv[10] = bflo(c1); xv[11] = bfhi(c1); xv[12] = bflo(c2); xv[13] = bfhi(c2); xv[14] = bflo(c3); xv[15] = bfhi(c3); }
      float am = 0.f;
#pragma unroll
      for (int i = 0; i < 16; ++i) am = fmaxf(am, fabsf(xv[i]));
      am = wave_max(am);
      const float inv = am > 0.f ? 127.f / am : 0.f;
      u32x4 o;
#pragma unroll
      for (int i = 0; i < 4; ++i) {
        const int q0 = (int)rintf(xv[4 * i] * inv), q1 = (int)rintf(xv[4 * i + 1] * inv), q2 = (int)rintf(xv[4 * i + 2] * inv), q3 = (int)rintf(xv[4 * i + 3] * inv);
        o[i] = (unsigned)(q0 & 255) | ((unsigned)(q1 & 255) << 8) | ((unsigned)(q2 & 255) << 16) | ((unsigned)(q3 & 255) << 24);
      }
      *(GAS u32x4*)(p.x8 + (size_t)token * 1024 + 16 * lane) = o;
      if (lane == 0) p.sxq[token] = am * (1.f / 127.f) * rstd_of(rss_in, token);
    }
    asm volatile("s_waitcnt lgkmcnt(0)" ::: "memory");
#pragma unroll 1
    for (int hd = 0; hd < 8; ++hd) {
      const int k1 = wtops[(2 * hd) * 16 + ci], k2 = wtops[(2 * hd + 1) * 16 + cj];
      const float s1 = __int_as_float(fkey_s(k1 & ~127)), s2 = __int_as_float(fkey_s(k2 & ~127));
      const float val = s1 + s2;
      const int vk = cvalid ? ((fkey_s(__float_as_int(val)) & ~63) | (63 - lane)) : (int)0x80000000;
      int rank = 0;
#pragma unroll
      for (int c = 0; c < 50; ++c) rank += (__builtin_amdgcn_readlane(vk, c) > vk) ? 1 : 0;
      const float m = __int_as_float(__builtin_amdgcn_readlane(__float_as_int(val), 0));
      const bool sel = cvalid && rank < 16;
      const float ev = sel ? __expf(val - m) : 0.f;
      const float sum = wave_sum(ev);
      if (sel) {
        const int eid = (k1 & 127) * 128 + (k2 & 127);
        p.sel_id[(size_t)token * 128 + hd * 16 + rank] = eid;
        p.sel_g[(size_t)token * 128 + hd * 16 + rank] = ev / sum;
        p.sel_su[(size_t)token * 128 + hd * 16 + rank] = sul[eid];
      }
    }
    asm volatile("s_waitcnt lgkmcnt(0)" ::: "memory");
  }
}

DI void phase_peer_udot8(const int wq, PRef p, int l, char* smem, int coff) {
  const int tid = ltid(wq);
  const int lane = tid & 63, wv = tid >> 6;
  const int grp = lane >> 3, li = lane & 7;
  int* wid = (int*)(smem + wv * 4096);
  const bool b2 = li & 4, b1 = li & 2, b0 = li & 1;
  const int myx = (int)(xb_xcc_id() & 7u);
  for (int cs = 0; cs < 8; ++cs) {
    const int c = (myx + cs) & 7;
    const i8_t* U8 = p.u8 + ((size_t)l * 8 + c) * 16384 * 128 + li * 16;
    int* pb = (int*)p.pbuf + (size_t)c * T * 128;
    for (;;) {
      unsigned tb = 0;
      if (lane == 0) tb = atomicAdd(p.qctr + coff + c * 16, 8u);
      tb = __builtin_amdgcn_readfirstlane(tb);
      if (tb >= (unsigned)T) break;
      u32x4 xs[8];
      {
        int idl[16];
#pragma unroll
        for (int k = 0; k < 8; ++k) {
          idl[2 * k] = __builtin_nontemporal_load((const GAS int*)p.sel_id + (size_t)(tb + k) * 128 + lane);
          idl[2 * k + 1] = __builtin_nontemporal_load((const GAS int*)p.sel_id + (size_t)(tb + k) * 128 + 64 + lane);
          xs[k] = __builtin_nontemporal_load((gp_u32x4)(p.x8 + (size_t)(tb + k) * 1024 + c * 128 + li * 16));
        }
#pragma unroll
        for (int k = 0; k < 8; ++k) { wid[k * 128 + lane] = idl[2 * k]; wid[k * 128 + 64 + lane] = idl[2 * k + 1]; }
      }
      asm volatile("s_waitcnt lgkmcnt(0)" ::: "memory");
      auto issue = [&](int k, u32x4 (&g)[16]) {
        int ids[16];
#pragma unroll
        for (int i = 0; i < 4; ++i) {
          const u32x4 t4 = *(const u32x4*)(wid + k * 128 + grp * 16 + i * 4);
          ids[4 * i] = t4[0]; ids[4 * i + 1] = t4[1]; ids[4 * i + 2] = t4[2]; ids[4 * i + 3] = t4[3];
        }
#pragma unroll
        for (int i = 0; i < 16; ++i) g[i] = gload16(U8 + (size_t)ids[i] * 128);
      };
      auto consume = [&](int k, const u32x4 (&g)[16], const u32x4 cx) {
        const int x0 = (int)cx[0], x1 = (int)cx[1], x2 = (int)cx[2], x3 = (int)cx[3];
        int pp[16];
#pragma unroll
        for (int i = 0; i < 16; ++i) {
          const u32x4 u8 = g[i];
          const int u0 = (int)u8[0], u1 = (int)u8[1], u2 = (int)u8[2], u3 = (int)u8[3];
          int acc = __builtin_amdgcn_sdot4(x0, u0, 0, false);
          acc = __builtin_amdgcn_sdot4(x1, u1, acc, false);
          acc = __builtin_amdgcn_sdot4(x2, u2, acc, false);
          pp[i] = __builtin_amdgcn_sdot4(x3, u3, acc, false);
        }
        int q8[8], q4[4], q2[2];
#pragma unroll
        for (int i = 0; i < 8; ++i) { const int mine = b2 ? pp[i + 8] : pp[i], oth = b2 ? pp[i] : pp[i + 8]; q8[i] = mine + shxi(oth, 4, lane); }
#pragma unroll
        for (int i = 0; i < 4; ++i) { const int mine = b1 ? q8[i + 4] : q8[i], oth = b1 ? q8[i] : q8[i + 4]; q4[i] = mine + shxi(oth, 2, lane); }
#pragma unroll
        for (int i = 0; i < 2; ++i) { const int mine = b0 ? q4[i + 2] : q4[i], oth = b0 ? q4[i] : q4[i + 2]; q2[i] = mine + shxi(oth, 1, lane); }
        i32x2 ov; ov[0] = q2[0]; ov[1] = q2[1];
        __builtin_nontemporal_store(ov, (GAS i32x2*)(pb + (size_t)(tb + k) * 128 + 2 * lane));
      };
      u32x4 ga[16], gb[16];
      issue(0, ga);
#pragma unroll
      for (int k2 = 0; k2 < 4; ++k2) {
        issue(2 * k2 + 1, gb);
        consume(2 * k2, ga, xs[2 * k2]);
        if (k2 < 3) issue(2 * k2 + 2, ga);
        consume(2 * k2 + 1, gb, xs[2 * k2 + 1]);
      }
      asm volatile("s_waitcnt lgkmcnt(0)" ::: "memory");
    }
  }
}

DI void phase_peer_w(const int wq, PRef p) {
  const int tid = ltid(wq); const int bid = lbid();
  const int lane = tid & 63, wv = tid >> 6;
  for (int token = bid * 4 + wv; token < T; token += gridDim.x * 4) {
    i32x2 pp8[8];
#pragma unroll
    for (int cc = 0; cc < 8; ++cc) pp8[cc] = __builtin_nontemporal_load((const GAS i32x2*)((const int*)p.pbuf + ((size_t)cc * T + token) * 128 + 2 * lane));
    const u32x2 gg = __builtin_nontemporal_load((const GAS u32x2*)(p.sel_g + (size_t)token * 128 + 2 * lane));
    const u32x2 su2 = __builtin_nontemporal_load((const GAS u32x2*)(p.sel_su + (size_t)token * 128 + 2 * lane));
    const float sxv = p.sxq[token];
    int d0 = 0, d1 = 0;
#pragma unroll
    for (int cc = 0; cc < 8; ++cc) { d0 += pp8[cc][0]; d1 += pp8[cc][1]; }
    const float f0 = (float)d0 * (sxv * __uint_as_float(su2[0])), f1 = (float)d1 * (sxv * __uint_as_float(su2[1]));
    u32x2 w2; w2[0] = __float_as_uint(__uint_as_float(gg[0]) * gelu_tanh(f0) * 0.0625f); w2[1] = __float_as_uint(__uint_as_float(gg[1]) * gelu_tanh(f1) * 0.0625f);
    *(GAS u32x2*)(p.sel_g + (size_t)token * 128 + 2 * lane) = w2;
  }
}

DI void phase_peer_vacc8(const int wq, PRef p, int l, char* smem, int coff, int dry, int rss_idx) {
  const int myx = (int)(xb_xcc_id() & 7u);
  for (int cs = 0; cs < 8; ++cs) {
    const int c = (myx + cs) & 7;
    for (;;) {
      const int tid = ltid(wq);
      const int lane = tid & 63, wv = tid >> 6;
      int* wid = (int*)(smem + wv * 8192);
      float* ww = (float*)(smem + wv * 8192 + 4096);
      const int grp = lane >> 3, li = lane & 7;
      const bool g2 = grp & 4, g1 = grp & 2, g0 = grp & 1;
      const i8_t* V8 = p.v8 + ((size_t)l * 8 + c) * 16384 * 128 + li * 16;
      const int chan = c * 128 + li * 16 + 2 * grp;
      unsigned tb = 0;
      if (lane == 0) tb = atomicAdd(p.qctr + coff + c * 16, 8u);
      tb = __builtin_amdgcn_readfirstlane(tb);
      if (tb >= (unsigned)T) break;
      {
        u32x4 iv[4], wv4[4];
#pragma unroll
        for (int j4 = 0; j4 < 4; ++j4) {
          iv[j4] = __builtin_nontemporal_load((gp_u32x4)(p.sel_id + (size_t)tb * 128 + j4 * 256 + lane * 4));
          wv4[j4] = __builtin_nontemporal_load((gp_u32x4)(p.sel_g + (size_t)tb * 128 + j4 * 256 + lane * 4));
        }
#pragma unroll
        for (int j4 = 0; j4 < 4; ++j4) { *(u32x4*)(wid + j4 * 256 + lane * 4) = iv[j4]; *(u32x4*)(ww + j4 * 256 + lane * 4) = wv4[j4]; }
      }
      asm volatile("s_waitcnt lgkmcnt(0)" ::: "memory");
      auto issue = [&](int hh_, u32x4 (&g)[8]) {
        const int k = hh_ >> 1, hf = hh_ & 1;
        int ids[8];
#pragma unroll
        for (int i = 0; i < 2; ++i) {
          const u32x4 t4 = *(const u32x4*)(wid + k * 128 + grp * 16 + hf * 8 + i * 4);
          ids[4 * i] = t4[0]; ids[4 * i + 1] = t4[1]; ids[4 * i + 2] = t4[2]; ids[4 * i + 3] = t4[3];
        }
#pragma unroll
        for (int i = 0; i < 8; ++i) g[i] = gload16(V8 + (size_t)ids[i] * 128);
      };
      float o[16];
      u32x2 hcur;
      auto accum = [&](int hh_, const u32x4 (&g)[8]) {
        const int k = hh_ >> 1, hf = hh_ & 1;
        if (hf == 0) {
#pragma unroll
          for (int i = 0; i < 16; ++i) o[i] = 0.f;
          hcur = __builtin_nontemporal_load((GAS u32x2*)((GAS float*)p.h + ((size_t)tb + k) * D + chan));
        }
#pragma unroll
        for (int i = 0; i < 8; ++i) {
          const u32x4 v8 = g[i];
          const float w = ww[k * 128 + grp * 16 + hf * 8 + i];
          const int v0 = (int)v8[0], v1 = (int)v8[1], v2 = (int)v8[2], v3 = (int)v8[3];
          f32x2v t2;
          t2 = __builtin_amdgcn_cvt_pk_f32_fp8(v0, false); o[0] = fmaf(w, t2[0], o[0]); o[1] = fmaf(w, t2[1], o[1]);
          t2 = __builtin_amdgcn_cvt_pk_f32_fp8(v0, true);  o[2] = fmaf(w, t2[0], o[2]); o[3] = fmaf(w, t2[1], o[3]);
          t2 = __builtin_amdgcn_cvt_pk_f32_fp8(v1, false); o[4] = fmaf(w, t2[0], o[4]); o[5] = fmaf(w, t2[1], o[5]);
          t2 = __builtin_amdgcn_cvt_pk_f32_fp8(v1, true);  o[6] = fmaf(w, t2[0], o[6]); o[7] = fmaf(w, t2[1], o[7]);
          t2 = __builtin_amdgcn_cvt_pk_f32_fp8(v2, false); o[8] = fmaf(w, t2[0], o[8]); o[9] = fmaf(w, t2[1], o[9]);
          t2 = __builtin_amdgcn_cvt_pk_f32_fp8(v2, true);  o[10] = fmaf(w, t2[0], o[10]); o[11] = fmaf(w, t2[1], o[11]);
          t2 = __builtin_amdgcn_cvt_pk_f32_fp8(v3, false); o[12] = fmaf(w, t2[0], o[12]); o[13] = fmaf(w, t2[1], o[13]);
          t2 = __builtin_amdgcn_cvt_pk_f32_fp8(v3, true);  o[14] = fmaf(w, t2[0], o[14]); o[15] = fmaf(w, t2[1], o[15]);
        }
        if (hf == 1) {
          float r8[8], r4[4], r2[2];
#pragma unroll
          for (int i = 0; i < 8; ++i) { const float mine = g2 ? o[i + 8] : o[i], oth = g2 ? o[i] : o[i + 8]; r8[i] = mine + shx(oth, 32, lane); }
#pragma unroll
          for (int i = 0; i < 4; ++i) { const float mine = g1 ? r8[i + 4] : r8[i], oth = g1 ? r8[i] : r8[i + 4]; r4[i] = mine + shx(oth, 16, lane); }
#pragma unroll
          for (int i = 0; i < 2; ++i) { const float mine = g0 ? r4[i + 2] : r4[i], oth = g0 ? r4[i] : r4[i + 2]; r2[i] = mine + shx(oth, 8, lane); }
          if (!dry) {
            const size_t token = (size_t)tb + k;
            GAS float* hp = (GAS float*)p.h + token * D + chan;
            const u32x2 ch = hcur;
            const float h0 = __uint_as_float(ch[0]) + r2[0], h1 = __uint_as_float(ch[1]) + r2[1];
            u32x2 sv; sv[0] = __float_as_uint(h0); sv[1] = __float_as_uint(h1);
            __builtin_nontemporal_store(sv, (GAS u32x2*)hp);
            *(GAS unsigned*)(p.hn + token * D + chan) = pack2(h0, h1);
            if (rss_idx >= 0) {
              const float ss = wave_sum(h0 * h0 + h1 * h1);
              if (lane < 2) p.rss[((size_t)rss_idx * T + token) * 16 + 2 * c + lane] = lane == 0 ? ss : 0.f;
            }
          }
        }
      };
      u32x4 gA[8], gB[8], gC[8];
      issue(0, gA); issue(1, gB);
#pragma unroll
      for (int h3 = 0; h3 < 15; h3 += 3) {
        asm volatile("" ::: "memory");
        issue(h3 + 2, gC); accum(h3, gA);
        asm volatile("" ::: "memory");
        issue(h3 + 3, gA); accum(h3 + 1, gB);
        asm volatile("" ::: "memory");
        if (h3 + 4 < 16) issue(h3 + 4, gB);
        accum(h3 + 2, gC);
      }
      accum(15, gA);
      asm volatile("s_waitcnt lgkmcnt(0)" ::: "memory");
    }
  }
}

DI void phase_final_norm(const int wq, const float* __restrict__ in, const float* __restrict__ g, float* __restrict__ out, int rows) {
  const int tid = ltid(wq); const int bid = lbid();
  const int lane = tid & 63, wv = tid >> 6;
  f32x4v gv[4];
#pragma unroll
  for (int i = 0; i < 4; ++i) gv[i] = *(const f32x4v*)(g + i * 256 + lane * 4);
  for (int r = bid * 4 + wv; r < rows; r += gridDim.x * 4) {
    const float* pr = in + (size_t)r * D;
    u32x4 v[4];
#pragma unroll
    for (int i = 0; i < 4; ++i) v[i] = gload16(pr + i * 256 + lane * 4);
    float ss = 0.f;
#pragma unroll
    for (int i = 0; i < 4; ++i) {
      const float a = __uint_as_float(v[i][0]), b = __uint_as_float(v[i][1]), c = __uint_as_float(v[i][2]), d = __uint_as_float(v[i][3]);
      ss += a * a + b * b + c * c + d * d;
    }
    ss = wave_sum(ss);
    const float rs = rsqrtf(ss / (float)D + 1e-6f);
#pragma unroll
    for (int i = 0; i < 4; ++i) {
      u32x4 ov;
#pragma unroll
      for (int e = 0; e < 4; ++e) ov[e] = __float_as_uint(__uint_as_float(v[i][e]) * rs * gv[i][e]);
      *(GAS u32x4*)(out + (size_t)r * D + i * 256 + lane * 4) = ov;
    }
  }
}

#define PROBE 0
constexpr int SMEM_BYTES = 73728;
__global__ void __launch_bounds__(NT, 2) mega(Params pk) {
  __shared__ __attribute__((aligned(16))) char smem_c[SMEM_BYTES];
  __shared__ uint4 xb_words;
  __shared__ Params sp;
  {
    const unsigned long long* src = (const unsigned long long*)&pk;
    unsigned long long* dst = (unsigned long long*)&sp;
    if (threadIdx.x < sizeof(Params) / 8) dst[threadIdx.x] = src[threadIdx.x];
  }
  if (threadIdx.x == 0) xb_words = make_uint4(0u, 0u, 0u, 0u);
  __syncthreads();
#define p (*lp((const __attribute__((address_space(3))) Params*)&sp))
  float* smem = (float*)smem_c;
  const int wq = __builtin_amdgcn_readfirstlane((int)(threadIdx.x >> 6));
  (void)xcd_barrier_post(p.bar, (volatile LAS unsigned*)&xb_words);
#define GRID_BARRIER() do { XcdBarrier bb_; bb_.bar = p.bar; bb_.x = xb_xcc_id(); bb_.st = (volatile LAS unsigned*)&xb_words; xcd_barrier(bb_); } while (0)

  phase_convert(wq, p.even_w_in, D, EVEN_IN, EVEN_IN, p.w_even_in, EVEN_IN, nullptr, 2, (size_t)D * EVEN_IN, (size_t)EVEN_IN * D, 0, smem, p.mix_norm, 2 * D);
  phase_convert(wq, p.even_pool_w, 128, 128, 128, p.w_even_pool, 128, p.even_pool_scale, 8, 128 * 128, 128 * 128, 128, smem);
  phase_convert(wq, p.even_w_out, D, D, D, p.w_even_out, D, nullptr, 2, (size_t)D * D, (size_t)D * D, 0, smem);
  phase_convert(wq, p.odd_w_in, D, ODD_IN, ODD_IN, p.w_odd_in, 3840, nullptr, 2, (size_t)D * ODD_IN, (size_t)3840 * D, 0, smem, p.mix_norm + D, 2 * D);
  phase_convert(wq, p.odd_w_uv, 128, 64, 64, p.w_odd_uv, 128, nullptr, 16, 128 * 64, 128 * 128, 0, smem);
  phase_convert(wq, p.odd_w_out, D, D, D, p.w_odd_out, D, nullptr, 2, (size_t)D * D, (size_t)D * D, 0, smem);
  phase_convert(wq, p.xattn_wq, D, D, D, p.w_xq, D, nullptr, 4, (size_t)D * D, (size_t)D * D, 0, smem, p.xattn_norm, D);
  phase_convert(wq, p.xattn_wkv, D, 2048, 2048, p.w_xkv, 2048, nullptr, 4, (size_t)D * 2048, (size_t)2048 * D, 0, smem);
  phase_convert(wq, p.xattn_wo, D, D, D, p.w_xo, D, nullptr, 4, (size_t)D * D, (size_t)D * D, 0, smem);
  phase_convert(wq, p.peer_wq, D, 2048, 2048, p.w_pq, 2048, nullptr, 4, (size_t)D * 2048, (size_t)2048 * D, 0, smem, p.peer_norm, D);
  phase_quant_u(wq, p.peer_u, p.u8, p.su, DEPTH * 16384, p.peer_norm);
  phase_cvt_v8(wq, p.peer_v, p.v8, (size_t)DEPTH * 16384 * 1024 / 16);
  phase_cvt_rows(wq, p.peer_keys, p.keys16, (size_t)DEPTH * 16 * 128 * 128 / 8);
  phase_init_h(wq, p.x, p.h, p.hn, p.rss);
  phase_lb(wq, p);
  phase_rmsnorm_bf(wq, p.mem, D, p.mem_norm, p.memn, D, NB * NMEM, D);
  GRID_BARRIER();
  for (int l = 0; l < DEPTH; ++l)
    phase_gemm_bf16<3>(wq, p.memn, D, p.w_xkv + (size_t)l * 2048 * D, p.kvh + (size_t)l * 2 * 2048 * 1024, 2048, NB * NMEM, 2048, D, smem_c, 0);
  GRID_BARRIER();
  for (int l = 0; l < DEPTH; ++l) {
    const int j = l >> 1;
    if ((l & 1) == 0) {
      phase_gemm_bf16<2, 1>(wq, p.hn, D, p.w_even_in + (size_t)j * EVEN_IN * D, p.P16, EVEN_IN, T, EVEN_IN, D, smem_c, 0, 1, 0, 0, 0, 1, 0, 0, p.rss + (size_t)(3 * l) * T * 16);
      GRID_BARRIER();
      phase_evenmix(wq, p, j);
      GRID_BARRIER();
      phase_gemm_bf16<2>(wq, p.pool, 512, p.w_even_pool + (size_t)j * 4 * 128 * 128, p.Y + 512, D, T, 128, 128, smem_c, 0, 4, 128, 128 * 128, 128);
      GRID_BARRIER();
      phase_gemm_bf16<1>(wq, p.Y, D, p.w_even_out + (size_t)j * D * D, p.h, D, T, D, D, smem_c, 0, 1, 0, 0, 0, 1, 0, 0, nullptr, p.hn, p.rss + (size_t)(3 * l + 1) * T * 16);
      GRID_BARRIER();
    } else {
      phase_gemm_bf16<2, 1>(wq, p.hn, D, p.w_odd_in + (size_t)j * 3840 * D, p.P16, ODD_IN, T, ODD_IN, D, smem_c, 0, 1, 0, 0, 0, 1, 0, 0, p.rss + (size_t)(3 * l) * T * 16);
      GRID_BARRIER();
      phase_dsa_prep(wq, p, j);
      GRID_BARRIER();
      phase_dsa_scores(wq, p, smem_c);
      GRID_BARRIER();
      phase_hgrn_scan(wq, p, l, smem_c);
      phase_dsa_attend(wq, p, j, smem_c, 64 * j);
      GRID_BARRIER();
      phase_gemm_bf16<2>(wq, p.lat, D, p.w_odd_uv + (size_t)j * 8 * 128 * 128, p.Y, D, T, 64, 128, smem_c, 0, 8, 128, 128 * 128, 64);
      phase_hgrn_post(wq, p, j);
      GRID_BARRIER();
      phase_gemm_bf16<1>(wq, p.Y, D, p.w_odd_out + (size_t)j * D * D, p.h, D, T, D, D, smem_c, 0, 1, 0, 0, 0, 1, 0, 0, nullptr, p.hn, p.rss + (size_t)(3 * l + 1) * T * 16);
      GRID_BARRIER();
    }
    phase_gemm_bf16<2, 1>(wq, p.hn, D, p.w_xq + (size_t)l * D * D, p.q16, D, T, D, D, smem_c, 0, 1, 0, 0, 0, 1, 0, 0, p.rss + (size_t)(3 * l + 1) * T * 16);
    GRID_BARRIER();
    phase_gemm_bf16<4>(wq, p.q16, D, p.kvh + (size_t)l * 2 * 2048 * 1024, p.sx, 256, S, 256, 256, smem_c, 0, 32, (size_t)S * D, 256 * 256, (size_t)S * 1024, 4, 256, (size_t)S * 256);
    GRID_BARRIER();
    phase_softmax256(wq, (const bf16_t*)p.sx, p.p16, T * 4);
    GRID_BARRIER();
    phase_gemm_bf16<2>(wq, p.p16, 256, p.kvh + (size_t)l * 2 * 2048 * 1024 + (size_t)2048 * 1024, p.Y, D, S, 256, 256, smem_c, 0, 32, (size_t)S * 1024, 256 * 256, (size_t)S * D, 4, (size_t)S * 256, 256);
    GRID_BARRIER();
    phase_gemm_bf16<1>(wq, p.Y, D, p.w_xo + (size_t)l * D * D, p.h, D, T, D, D, smem_c, 0, 1, 0, 0, 0, 1, 0, 0, nullptr, p.hn, p.rss + (size_t)(3 * l + 2) * T * 16);
    GRID_BARRIER();
    phase_peer_qs(wq, p.hn, p.w_pq + (size_t)l * 2048 * D, p.keys16 + (size_t)l * 16 * 128 * 128, p.tops, smem_c, p.rss + (size_t)(3 * l + 2) * T * 16);
    GRID_BARRIER();
    phase_peer_combine8(wq, p, l, smem_c, p.rss + (size_t)(3 * l + 2) * T * 16);
    GRID_BARRIER();
    phase_peer_udot8(wq, p, l, smem_c, 256 + (l * 2 + 0) * 128);
    GRID_BARRIER();
    phase_peer_w(wq, p);
    GRID_BARRIER();
    phase_peer_vacc8(wq, p, l, smem_c, 256 + (l * 2 + 1) * 128, 0, l + 1 < DEPTH ? 3 * l + 3 : -1);
    GRID_BARRIER();
  }
  phase_final_norm(wq, p.h, p.final_norm, p.out, T);
}

#undef p
extern "C" void kernel_launch(void* const* d_in, const int* in_sizes, int n_in, void* d_out, int out_size, void* d_ws, size_t ws_size,
                              hipStream_t stream) {
  Params p; memset(&p, 0, sizeof(p));
  const float* const* in = (const float* const*)d_in;
  p.x = in[0]; p.mem = in[1]; p.mix_norm = in[2]; p.even_w_in = in[3]; p.even_conv_w = in[4]; p.even_pool_w = in[5];
  p.even_pool_scale = in[6]; p.even_w_out = in[7]; p.odd_w_in = in[8]; p.odd_kv_norm = in[9]; p.odd_w_uv = in[10];
  p.odd_hg_norm = in[11]; p.odd_w_out = in[12]; p.hgrn_gamma = in[13]; p.rel_bias = in[14]; p.mem_norm = in[15];
  p.xattn_norm = in[16]; p.xattn_wq = in[17]; p.xattn_wkv = in[18]; p.xattn_wo = in[19]; p.peer_norm = in[20];
  p.peer_wq = in[21]; p.peer_keys = in[22]; p.peer_u = in[23]; p.peer_v = in[24]; p.final_norm = in[25];
  p.out = (float*)d_out;
  char* w = (char*)d_ws;
  auto take = [&](size_t bytes) { char* r = w; w += (bytes + 255) / 256 * 256; return r; };
  p.bar = (unsigned*)take((XCD_BAR_WORDS + 2048) * 4); p.qctr = p.bar + XCD_BAR_WORDS;
  p.h = (float*)take((size_t)T * D * 4); p.P = (float*)take((size_t)T * ODD_IN * 4); p.P16 = (bf16_t*)p.P;
  p.oraw = (float*)take((size_t)T * 512 * 4); p.lb = (float*)take(DEPTH * 512 * 4);
  p.hn = (bf16_t*)take((size_t)T * D * 2); p.Y = (bf16_t*)take((size_t)T * D * 2); p.pool = (bf16_t*)take((size_t)T * 512 * 2);
  p.memn = (bf16_t*)take((size_t)NB * NMEM * D * 2); p.lat = (bf16_t*)take((size_t)T * D * 2);
  p.w_even_in = (bf16_t*)take((size_t)2 * EVEN_IN * D * 2); p.w_even_pool = (bf16_t*)take((size_t)8 * 128 * 128 * 2);
  p.w_even_out = (bf16_t*)take((size_t)2 * D * D * 2); p.w_odd_in = (bf16_t*)take((size_t)2 * 3840 * D * 2);
  p.w_odd_uv = (bf16_t*)take((size_t)16 * 128 * 128 * 2); p.w_odd_out = (bf16_t*)take((size_t)2 * D * D * 2);
  p.w_xq = (bf16_t*)take((size_t)4 * D * D * 2); p.w_xkv = (bf16_t*)take((size_t)4 * 2048 * D * 2); p.w_xo = (bf16_t*)take((size_t)4 * D * D * 2);
  p.w_pq = (bf16_t*)take((size_t)4 * 2048 * D * 2);
  p.u8 = (signed char*)take((size_t)DEPTH * 16384 * 1024); p.v8 = (signed char*)take((size_t)DEPTH * 16384 * 1024); p.x8 = (signed char*)take((size_t)T * 1024);
  p.su = (float*)take((size_t)DEPTH * 16384 * 4); p.sxq = (float*)take((size_t)T * 4); p.sel_su = (float*)take((size_t)T * 128 * 4);
  p.keys16 = (bf16_t*)take((size_t)DEPTH * 16 * 128 * 128 * 2); p.kvh = (bf16_t*)take((size_t)DEPTH * 2 * 2048 * 1024 * 2); p.rss = (float*)take((size_t)12 * T * 16 * 4);
  {
    char* a = (char*)p.P;
    p.sx = (float*)a; a += (size_t)T * 4 * 256 * 4;
    p.p16 = (bf16_t*)a; a += (size_t)T * 4 * 256 * 2;
    p.q16 = (bf16_t*)a; a += (size_t)T * D * 2;
    p.tops = (int*)a; a += (size_t)T * 256 * 4;
    p.sel_id = (int*)a; a += (size_t)T * 128 * 4;
    p.sel_g = (float*)a; a += (size_t)T * 128 * 4;
    p.pbuf = (float*)a;
  }
  p.qlat16 = (bf16_t*)take((size_t)T * 1024 * 2); p.ckv16 = (bf16_t*)take((size_t)T * 128 * 2); p.iq16 = (bf16_t*)take((size_t)T * 512 * 2);
  p.ik16 = (bf16_t*)take((size_t)T * 64 * 2); p.sc = (float*)take((size_t)T * 2048 * 4);

  p.probe = 1;
  static int grid = 0;
  if (!grid) {
    int dev = 0, cus = 0, per_cu = 0;
    (void)hipGetDevice(&dev);
    (void)hipDeviceGetAttribute(&cus, hipDeviceAttributeMultiprocessorCount, dev);
    (void)hipOccupancyMaxActiveBlocksPerMultiprocessor(&per_cu, mega, NT, 0);
    if (per_cu > 2) per_cu = 2;
    if (per_cu < 1) per_cu = 1;
    grid = cus * per_cu;
  }
  (void)hipMemsetAsync(p.bar, 0, (XCD_BAR_WORDS + 2048) * sizeof(unsigned), stream);
  mega<<<grid, NT, 0, stream>>>(p);
}
```

```cpp
#include <hip/hip_runtime.h>
#include <hip/hip_bf16.h>
#include <stdint.h>
#include <math.h>
#include <string.h>

#define DI __device__ __forceinline__

constexpr int D = 1024, NB = 8, S = 2048, T = NB * S, DEPTH = 4, NMEM = 256;
constexpr int EVEN_IN = 2048, ODD_IN = 3784;
constexpr int NT = 256;

typedef unsigned short bf16_t;
struct Params {
  const float *x, *mem, *mix_norm, *even_w_in, *even_conv_w, *even_pool_w, *even_pool_scale, *even_w_out;
  const float *odd_w_in, *odd_kv_norm, *odd_w_uv, *odd_hg_norm, *odd_w_out, *hgrn_gamma, *rel_bias, *mem_norm;
  const float *xattn_norm, *xattn_wq, *xattn_wkv, *xattn_wo, *peer_norm, *peer_wq, *peer_keys, *peer_u, *peer_v, *final_norm;
  float* out;
  float *h, *P, *kv, *ckv, *oraw, *lb; bf16_t* P16;
  bf16_t *hn, *Y, *pool, *memn, *lat;
  bf16_t *u16, *v16, *keys16; int* tops; signed char *u8, *v8, *x8; float *su, *sxq, *sel_su;
  float* rss;
  bf16_t *q16, *kvh, *p16; float* sx; int* sel_id; float* sel_g; float* pbuf;
  bf16_t *qlat16, *ckv16, *iq16, *ik16; float* sc; unsigned* qctr;
  bf16_t *w_even_in, *w_even_pool, *w_even_out, *w_odd_in, *w_odd_uv, *w_odd_out, *w_xq, *w_xkv, *w_xo, *w_pq;
  unsigned* bar;
  int probe, pad_;
};

#define XB_TMO      128
#define XB_XCNT(j)  (256  + 64 * (j))
#define XB_XSUB(j)  (1280 + 64 * (j))
#define XB_XGEN(j)  (2304 + 64 * (j))
#define XB_TOP      3328
#define XB_TOPGEN   3392
#define XCD_BAR_WORDS 3456
#define XB_SPIN_CAP (1u << 18)
#define LAS __attribute__((address_space(3)))

__device__ __forceinline__ unsigned xb_ld(unsigned* p)              { return __hip_atomic_load(p, __ATOMIC_RELAXED, __HIP_MEMORY_SCOPE_AGENT); }
__device__ __forceinline__ unsigned xb_add(unsigned* p, unsigned v) { return __hip_atomic_fetch_add(p, v, __ATOMIC_RELAXED, __HIP_MEMORY_SCOPE_AGENT); }
__device__ __forceinline__ unsigned xb_xcc_id() { return (unsigned)__builtin_amdgcn_s_getreg((3 << 11) | 20) & 0xFu; }
#define XB_SPIN(cond, bar) do { unsigned _sp = 0; while (cond) { __builtin_amdgcn_s_sleep(1); \
    if ((++_sp & 255u) == 0u) { if (xb_ld(&(bar)[XB_TMO])) break; if (_sp > XB_SPIN_CAP) { atomicAdd(&(bar)[XB_TMO], 1u); break; } } } } while (0)

typedef const __attribute__((address_space(3))) Params& PRef;
DI const __attribute__((address_space(3))) Params* lp(const __attribute__((address_space(3))) Params* q) { asm volatile("" : "+v"(q)); return q; }
struct XcdBarrier {
    unsigned* bar; unsigned x;
    volatile LAS unsigned* st;
};

__device__ __forceinline__ XcdBarrier xcd_barrier_post(unsigned* bar, volatile LAS unsigned* st) {
    XcdBarrier b; b.bar = bar; b.x = xb_xcc_id(); b.st = st;
    if (threadIdx.x == 0) (void)xb_add(&bar[XB_XCNT(b.x)], 1u);
    return b;
}
__device__ __forceinline__ void xcd_barrier_complete(unsigned* bar, unsigned x, unsigned& nloc, unsigned& nx) {
    const unsigned G = gridDim.x * gridDim.y * gridDim.z;
    unsigned sum, cnt, mine, sp = 0u;
    for (;;) {
        sum = 0u; cnt = 0u; mine = 0u;
#pragma unroll
        for (unsigned j = 0; j < 16; ++j) { const unsigned c = xb_ld(&bar[XB_XCNT(j)]); sum += c; cnt += (c > 0u) ? 1u : 0u; mine = (j == x) ? c : mine; }
        if (sum == G) break;
        __builtin_amdgcn_s_sleep(1);
        if ((++sp & 255u) == 0u) { if (xb_ld(&bar[XB_TMO])) break; if (sp > XB_SPIN_CAP) { atomicAdd(&bar[XB_TMO], 1u); break; } }
    }
    nloc = mine > 0u ? mine : 1u; nx = cnt > 0u ? cnt : 1u;
}

__device__ __forceinline__ void xcd_barrier(const XcdBarrier& b) {
    asm volatile("s_waitcnt vmcnt(0)" ::: "memory");
    __syncthreads();
    if (threadIdx.x == 0) {
        unsigned* bar = b.bar;
        __builtin_amdgcn_s_waitcnt(0);
        unsigned nloc = b.st[0], nx = b.st[1];
        if (nloc == 0u) { xcd_barrier_complete(bar, b.x, nloc, nx); b.st[0] = nloc; b.st[1] = nx; }
        const unsigned old = xb_add(&bar[XB_XSUB(b.x)], 1u);
        const unsigned gen = old / nloc;
        if (old + 1u == (gen + 1u) * nloc) {
            __builtin_amdgcn_fence(__ATOMIC_RELEASE, "agent");
            asm volatile("s_waitcnt vmcnt(0)" ::: "memory");
            const unsigned og = xb_add(&bar[XB_TOP], 1u);
            const unsigned tg = og / nx;
            if (og + 1u == (tg + 1u) * nx) xb_add(&bar[XB_TOPGEN], 1u);
            else XB_SPIN(xb_ld(&bar[XB_TOPGEN]) == tg, bar);
            __builtin_amdgcn_fence(__ATOMIC_ACQUIRE, "agent");
            xb_add(&bar[XB_XGEN(b.x)], 1u);
            asm volatile("s_waitcnt vmcnt(0)" ::: "memory");
        } else {
            XB_SPIN(xb_ld(&bar[XB_XGEN(b.x)]) == gen, bar);
            __builtin_amdgcn_fence(__ATOMIC_ACQUIRE, "agent");
            asm volatile("s_waitcnt vmcnt(0)" ::: "memory");
        }
    }
    __syncthreads();
}


typedef __bf16 bf16x2_t __attribute__((ext_vector_type(2)));
typedef float f32x2_t __attribute__((ext_vector_type(2)));
using bf16x8 = __attribute__((ext_vector_type(8))) short;
using f32x16 = __attribute__((ext_vector_type(16))) float;
using u32x4 = __attribute__((ext_vector_type(4))) unsigned;
using u32x2 = __attribute__((ext_vector_type(2))) unsigned;
using f32x4v = __attribute__((ext_vector_type(4))) float;
using f32x2v = __attribute__((ext_vector_type(2))) float;
#define GAS __attribute__((address_space(1)))
typedef const GAS u32x4* gp_u32x4;
DI u32x4 gload16(const void* p) { return *(gp_u32x4)(p); }
DI bf16_t f2bf(float f) { __bf16 b = (__bf16)f; return __builtin_bit_cast(unsigned short, b); }
DI unsigned pack2(float a, float b) { f32x2_t v = {a, b}; bf16x2_t r = __builtin_convertvector(v, bf16x2_t); return __builtin_bit_cast(unsigned, r); }
DI float bf2f(bf16_t u) { return __uint_as_float(((unsigned)u) << 16); }
DI float bflo(unsigned u) { return __uint_as_float(u << 16); }
DI float bfhi(unsigned u) { return __uint_as_float(u & 0xffff0000u); }
DI f32x4v bf4_to_f(const u32x2 v) { const unsigned a = v[0], b = v[1]; f32x4v r; r[0] = bflo(a); r[1] = bfhi(a); r[2] = bflo(b); r[3] = bfhi(b); return r; }
DI int ltid(int wq) { int t; asm volatile("v_mbcnt_lo_u32_b32 %0, -1, 0\n\tv_mbcnt_hi_u32_b32 %0, -1, %0" : "=v"(t)); return (wq << 6) | t; }
DI int lbid() { int b = blockIdx.x; asm volatile("" : "+s"(b)); return b; }
#define DPP_F(v, ctrl, rmask, bctl) __int_as_float(__builtin_amdgcn_update_dpp(0, __float_as_int(v), (ctrl), (rmask), 0xF, (bctl)))
DI float wave_sum(float v) {
  v += DPP_F(v, 0xB1, 0xF, true);
  v += DPP_F(v, 0x4E, 0xF, true);
  v += DPP_F(v, 0x141, 0xF, true);
  v += DPP_F(v, 0x140, 0xF, true);
  v += DPP_F(v, 0x142, 0xA, false);
  v += DPP_F(v, 0x143, 0xC, false);
  return __int_as_float(__builtin_amdgcn_readlane(__float_as_int(v), 63));
}
#define DPP_I(v, ctrl, rmask, bctl) __builtin_amdgcn_update_dpp(0, (v), (ctrl), (rmask), 0xF, (bctl))
DI int wave_sum_i(int v) {
  v += DPP_I(v, 0xB1, 0xF, true); v += DPP_I(v, 0x4E, 0xF, true); v += DPP_I(v, 0x141, 0xF, true); v += DPP_I(v, 0x140, 0xF, true);
  v += DPP_I(v, 0x142, 0xA, false); v += DPP_I(v, 0x143, 0xC, false);
  return __builtin_amdgcn_readlane(v, 63);
}
DI float wave_max(float v) {
  v = fmaxf(v, DPP_F(v, 0xB1, 0xF, true));
  v = fmaxf(v, DPP_F(v, 0x4E, 0xF, true));
  v = fmaxf(v, DPP_F(v, 0x141, 0xF, true));
  v = fmaxf(v, DPP_F(v, 0x140, 0xF, true));
  { const float t = __int_as_float(__builtin_amdgcn_update_dpp(__float_as_int(v), __float_as_int(v), 0x142, 0xA, 0xF, false)); v = fmaxf(v, t); }
  { const float t = __int_as_float(__builtin_amdgcn_update_dpp(__float_as_int(v), __float_as_int(v), 0x143, 0xC, 0xF, false)); v = fmaxf(v, t); }
  return __int_as_float(__builtin_amdgcn_readlane(__float_as_int(v), 63));
}
DI float rowsum16(float v) { v += DPP_F(v, 0x128, 0xF, true); v += DPP_F(v, 0x124, 0xF, true); v += DPP_F(v, 0x122, 0xF, true); v += DPP_F(v, 0x121, 0xF, true); return v; }
DI float rowmax16(float v) { v = fmaxf(v, DPP_F(v, 0x128, 0xF, true)); v = fmaxf(v, DPP_F(v, 0x124, 0xF, true)); v = fmaxf(v, DPP_F(v, 0x122, 0xF, true)); v = fmaxf(v, DPP_F(v, 0x121, 0xF, true)); return v; }
DI float shx(float v, int mask, int lane) { return __int_as_float(__builtin_amdgcn_ds_bpermute((lane ^ mask) << 2, __float_as_int(v))); }
DI int shxi(int v, int mask, int lane) { return __builtin_amdgcn_ds_bpermute((lane ^ mask) << 2, v); }
DI float gelu_tanh(float x) {
  const float k0 = 0.7978845608028654f, k1 = 0.044715f;
  return 0.5f * x * (1.f + tanhf(k0 * (x + k1 * x * x * x)));
}
DI float sigmoidf(float x) { return 1.f / (1.f + expf(-x)); }

DI float rstd_of(const float* __restrict__ rss, int row) {
  const float* q = rss + (size_t)row * 16;
  const f32x4v a = *(const f32x4v*)q, b = *(const f32x4v*)(q + 4), c = *(const f32x4v*)(q + 8), d = *(const f32x4v*)(q + 12);
  const float s0 = (a[0] + a[1]) + (a[2] + a[3]), s1 = (b[0] + b[1]) + (b[2] + b[3]), s2 = (c[0] + c[1]) + (c[2] + c[3]), s3 = (d[0] + d[1]) + (d[2] + d[3]);
  return rsqrtf(((s0 + s1) + (s2 + s3)) * (1.f / 1024.f) + 1e-6f);
}
DI void phase_init_h(const int wq, const float* __restrict__ x, float* __restrict__ h, bf16_t* __restrict__ hb, float* __restrict__ rss) {
  const int tid = ltid(wq); const int bid = lbid();
  const int lane = tid & 63, wv = tid >> 6;
  for (int r = bid * 4 + wv; r < T; r += gridDim.x * 4) {
    float ss = 0.f;
#pragma unroll
    for (int i = 0; i < 4; ++i) {
      const u32x4 v = gload16(x + (size_t)r * D + i * 256 + lane * 4);
      const unsigned v0 = v[0], v1 = v[1], v2 = v[2], v3 = v[3];
      const float a = __uint_as_float(v0), b = __uint_as_float(v1), c = __uint_as_float(v2), d = __uint_as_float(v3);
      ss += a * a + b * b + c * c + d * d;
      *(GAS u32x4*)(h + (size_t)r * D + i * 256 + lane * 4) = v;
      u32x2 o; o[0] = pack2(a, b); o[1] = pack2(c, d);
      *(GAS u32x2*)(hb + (size_t)r * D + i * 256 + lane * 4) = o;
    }
    ss = wave_sum(ss);
    if (lane < 16) rss[(size_t)r * 16 + lane] = lane == 0 ? ss : 0.f;
  }
}

DI void phase_rmsnorm_bf(const int wq, const float* __restrict__ in, int ldi, const float* __restrict__ g, bf16_t* __restrict__ out, int ldo, int rows, int W) {
  const int tid_ = ltid(wq); const int bid_ = lbid();
  const int lane = tid_ & 63, wv = tid_ >> 6;
  f32x4v gv[4];
#pragma unroll
  for (int i = 0; i < 4; ++i) gv[i] = *(const f32x4v*)(g + i * 256 + lane * 4);
  for (int r = bid_ * 4 + wv; r < rows; r += gridDim.x * 4) {
    const float* p = in + (size_t)r * ldi;
    u32x4 v[4];
#pragma unroll
    for (int i = 0; i < 4; ++i) v[i] = gload16(p + i * 256 + lane * 4);
    float ss = 0.f;
#pragma unroll
    for (int i = 0; i < 4; ++i) {
      const float a = __uint_as_float(v[i][0]), b = __uint_as_float(v[i][1]), c = __uint_as_float(v[i][2]), d = __uint_as_float(v[i][3]);
      ss += a * a + b * b + c * c + d * d;
    }
    ss = wave_sum(ss);
    const float rs = rsqrtf(ss / (float)W + 1e-6f);
    bf16_t* o = out + (size_t)r * ldo;
#pragma unroll
    for (int i = 0; i < 4; ++i) {
      u32x2 ov;
      ov[0] = pack2(__uint_as_float(v[i][0]) * rs * gv[i][0], __uint_as_float(v[i][1]) * rs * gv[i][1]);
      ov[1] = pack2(__uint_as_float(v[i][2]) * rs * gv[i][2], __uint_as_float(v[i][3]) * rs * gv[i][3]);
      *(GAS u32x2*)(o + i * 256 + lane * 4) = ov;
    }
  }
}

DI void phase_convert(const int wq, const float* __restrict__ W0, int K, int N, int ldw, bf16_t* __restrict__ Bt0, int Npad, const float* __restrict__ cs0,
                      int nbatch, size_t sW, size_t sBt, size_t sCS, float* smem, const float* __restrict__ rs0 = nullptr, size_t sRS = 0) {
  const int tid = ltid(wq); const int bid = lbid();
  float (*tl)[65] = (float (*)[65])smem;
  const int tk = K / 64, tn = Npad / 64;
  for (int tile0 = bid; tile0 < tk * tn * nbatch; tile0 += gridDim.x) {
    const int bt = tile0 / (tk * tn), tile = tile0 % (tk * tn);
    const int k0 = (tile / tn) * 64, n0 = (tile % tn) * 64;
    const float* W = W0 + (size_t)bt * sW;
    bf16_t* Bt = Bt0 + (size_t)bt * sBt;
    __syncthreads();
#pragma unroll 4
    for (int i = 0; i < 16; ++i) {
      const int k = i * 4 + (tid >> 6), n = tid & 63;
      float v = 0.f;
      if (n0 + n < N) { v = W[(size_t)(k0 + k) * ldw + n0 + n]; if (cs0) v *= cs0[(size_t)bt * sCS + n0 + n]; if (rs0) v *= rs0[(size_t)bt * sRS + k0 + k]; }
      tl[k][n] = v;
    }
    __syncthreads();
#pragma unroll 4
    for (int i = 0; i < 16; ++i) {
      const int n = i * 4 + (tid >> 6), k = tid & 63;
      Bt[(size_t)(n0 + n) * K + k0 + k] = f2bf(tl[k][n]);
    }
  }
}

constexpr int G_LDS_ROW = 144;
constexpr int G_TILE_B = 128 * G_LDS_ROW;
template <int MODE, int RS = 0>
DI void phase_gemm_bf16(const int wq, const bf16_t* __restrict__ A0, int lda, const bf16_t* __restrict__ B0, void* __restrict__ C0, int ldc,
                        int M, int N, int K, char* smem, int dry, int nbatch = 1, size_t sA = 0, size_t sB = 0, size_t sC = 0,
                        int inner = 1, size_t sA2 = 0, size_t sC2 = 0, const float* __restrict__ rss_in = nullptr, bf16_t* __restrict__ hb_out = nullptr, float* __restrict__ rss_out = nullptr) {
  const int tid = ltid(wq); const int bid = lbid();
  const int lane = tid & 63, wv = tid >> 6, wm = wv >> 1, wn = wv & 1;
  const int r = lane & 31, hh = lane >> 5;
  const int tm = M / 128, tn = (N + 127) / 128;
  const int nk = K / 64;
  const int srow = tid >> 3, skc = tid & 7;
  const int ntile_all = tm * tn * nbatch;
  const int per_x = (ntile_all + 7) >> 3;
  const int t_beg = (bid & 7) * per_x, t_end = (t_beg + per_x < ntile_all) ? t_beg + per_x : ntile_all;
  for (int tile0 = t_beg + (bid >> 3); tile0 < t_end; tile0 += (int)(gridDim.x >> 3)) {
    const int bt = tile0 / (tm * tn), tile = tile0 % (tm * tn);
    const int m0 = (tile / tn) * 128, n0 = (tile % tn) * 128;
    const int bhi = bt / inner, blo = bt % inner;
    const bf16_t* Ag = A0 + (size_t)bhi * sA + (size_t)blo * sA2 + (size_t)(m0 + srow) * lda + skc * 8;
    const bf16_t* Bg = B0 + (size_t)bt * sB + (size_t)(n0 + srow) * K + skc * 8;
    f32x16 acc[2][2];
#pragma unroll
    for (int i = 0; i < 2; ++i)
#pragma unroll
      for (int j = 0; j < 2; ++j)
#pragma unroll
        for (int e = 0; e < 16; ++e) acc[i][j][e] = 0.f;
    u32x4 ra[4], rb[4];
#pragma unroll
    for (int i = 0; i < 4; ++i) {
      ra[i] = gload16(Ag + (size_t)(32 * i) * lda);
      rb[i] = gload16(Bg + (size_t)(32 * i) * K);
    }
    __syncthreads();
#pragma unroll
    for (int i = 0; i < 4; ++i) {
      *(u32x4*)(smem + (srow + 32 * i) * G_LDS_ROW + skc * 16) = ra[i];
      *(u32x4*)(smem + 2 * G_TILE_B + (srow + 32 * i) * G_LDS_ROW + skc * 16) = rb[i];
    }
    __syncthreads();
#pragma unroll 1
    for (int kt = 0; kt < nk; ++kt) {
      const int cur = kt & 1;
      if (kt + 1 < nk) {
#pragma unroll
        for (int i = 0; i < 4; ++i) {
          ra[i] = gload16(Ag + (size_t)(32 * i) * lda + (kt + 1) * 64);
          rb[i] = gload16(Bg + (size_t)(32 * i) * K + (kt + 1) * 64);
        }
      }
      const char* As = smem + cur * G_TILE_B + (wm * 64 + r) * G_LDS_ROW + hh * 16;
      const char* Bs = smem + 2 * G_TILE_B + cur * G_TILE_B + (wn * 64 + r) * G_LDS_ROW + hh * 16;
#pragma unroll
      for (int ks = 0; ks < 4; ++ks) {
        bf16x8 a0 = *(const bf16x8*)(As + ks * 32);
        bf16x8 a1 = *(const bf16x8*)(As + 32 * G_LDS_ROW + ks * 32);
        bf16x8 b0 = *(const bf16x8*)(Bs + ks * 32);
        bf16x8 b1 = *(const bf16x8*)(Bs + 32 * G_LDS_ROW + ks * 32);
        acc[0][0] = __builtin_amdgcn_mfma_f32_32x32x16_bf16(a0, b0, acc[0][0], 0, 0, 0);
        acc[0][1] = __builtin_amdgcn_mfma_f32_32x32x16_bf16(a0, b1, acc[0][1], 0, 0, 0);
        acc[1][0] = __builtin_amdgcn_mfma_f32_32x32x16_bf16(a1, b0, acc[1][0], 0, 0, 0);
        acc[1][1] = __builtin_amdgcn_mfma_f32_32x32x16_bf16(a1, b1, acc[1][1], 0, 0, 0);
      }
      if (kt + 1 < nk) {
        const int nxt = cur ^ 1;
#pragma unroll
        for (int i = 0; i < 4; ++i) {
          *(u32x4*)(smem + nxt * G_TILE_B + (srow + 32 * i) * G_LDS_ROW + skc * 16) = ra[i];
          *(u32x4*)(smem + 2 * G_TILE_B + nxt * G_TILE_B + (srow + 32 * i) * G_LDS_ROW + skc * 16) = rb[i];
        }
      }
      __syncthreads();
    }
    if (RS) {
      if (tid < 128) ((float*)smem)[tid] = rstd_of(rss_in, m0 + tid);
      __syncthreads();
    }
#pragma unroll
    for (int i = 0; i < 2; ++i)
#pragma unroll
      for (int j = 0; j < 2; ++j) {
        const int col = n0 + wn * 64 + j * 32 + r;
        if (col < N && !dry) {
          const size_t base = (size_t)bhi * sC + (size_t)blo * sC2 + (size_t)(m0 + wm * 64 + i * 32 + 4 * hh) * ldc + col;
          if (RS) {
            const float* rp = (const float*)smem + wm * 64 + i * 32 + 4 * hh;
#pragma unroll
            for (int e = 0; e < 16; ++e) acc[i][j][e] *= rp[(e & 3) + 8 * (e >> 2)];
          }
          if (MODE == 1) {
            GAS float* cp = (GAS float*)C0 + base;
            float old[16];
#pragma unroll
            for (int e = 0; e < 16; ++e) old[e] = cp[(size_t)((e & 3) + 8 * (e >> 2)) * ldc];
#pragma unroll
            for (int e = 0; e < 16; ++e) { old[e] += acc[i][j][e]; acc[i][j][e] = old[e]; cp[(size_t)((e & 3) + 8 * (e >> 2)) * ldc] = old[e]; }
            if (hb_out) {
              GAS bf16_t* hp = (GAS bf16_t*)hb_out + base;
#pragma unroll
              for (int e = 0; e < 16; ++e) hp[(size_t)((e & 3) + 8 * (e >> 2)) * ldc] = f2bf(old[e]);
            }
          } else if (MODE == 0) {
            GAS float* cp = (GAS float*)C0 + base;
#pragma unroll
            for (int e = 0; e < 16; ++e) cp[(size_t)((e & 3) + 8 * (e >> 2)) * ldc] = acc[i][j][e];
          } else if (MODE == 2) {
            GAS bf16_t* cp = (GAS bf16_t*)C0 + base;
#pragma unroll
            for (int e = 0; e < 16; ++e) cp[(size_t)((e & 3) + 8 * (e >> 2)) * ldc] = f2bf(acc[i][j][e]);
          } else if (MODE == 4) {
            GAS bf16_t* cp = (GAS bf16_t*)C0 + base;
#pragma unroll
            for (int e = 0; e < 16; ++e) cp[(size_t)((e & 3) + 8 * (e >> 2)) * ldc] = f2bf(acc[i][j][e] * 0.0625f);
          } else {
            const int rowb = m0 + wm * 64 + i * 32 + 4 * hh;
            const int b_ = rowb >> 8, mm = rowb & 255;
            const int cc = col & 1023, hd_ = cc >> 8, dd = cc & 255;
            GAS bf16_t* kb = (GAS bf16_t*)C0;
            if (col < 1024) {
#pragma unroll
              for (int e = 0; e < 16; ++e) kb[((size_t)(b_ * 4 + hd_) * 256 + mm + (e & 3) + 8 * (e >> 2)) * 256 + dd] = f2bf(acc[i][j][e]);
            } else {
#pragma unroll
              for (int e = 0; e < 16; ++e) kb[(size_t)2048 * 1024 + ((size_t)(b_ * 4 + hd_) * 256 + dd) * 256 + mm + (e & 3) + 8 * (e >> 2)] = f2bf(acc[i][j][e]);
            }
          }
        }
      }
    if (MODE == 1 && rss_out && !dry) {
#pragma unroll
      for (int i = 0; i < 2; ++i) {
        float myv = 0.f;
#pragma unroll
        for (int e = 0; e < 16; ++e) {
          float v = acc[i][0][e] * acc[i][0][e] + acc[i][1][e] * acc[i][1][e];
          v = rowsum16(v);
          v += shx(v, 16, lane);
          if ((lane & 15) == e) myv = v;
        }
        if ((lane & 16) == 0) rss_out[(size_t)(m0 + wm * 64 + i * 32 + (lane & 3) + 8 * ((lane & 15) >> 2) + 4 * hh) * 16 + (n0 >> 7) * 2 + wn] = myv;
      }
    }
  }
}

template <int W>
DI void evenmix_run(const bf16_t* __restrict__ P, const float* __restrict__ cw, bf16_t* __restrict__ Y, bf16_t* __restrict__ pool, int t0, int c) {
  const int s0 = t0 & (S - 1);
  f32x4v w0 = *(const f32x4v*)(cw + c), w1 = *(const f32x4v*)(cw + 512 + c), w2 = *(const f32x4v*)(cw + 1024 + c);
  const f32x4v zero = {0.f, 0.f, 0.f, 0.f};
  auto ld = [&](int t, int off) { const u32x2 v = *(const GAS u32x2*)(P + (size_t)t * EVEN_IN + off + c); return bf4_to_f(v); };
  f32x4v xm2 = zero, xm1 = zero;
  if (s0 >= 2) xm2 = ld(t0 - 2, 512) * ld(t0 - 2, 0);
  if (s0 >= 1) xm1 = ld(t0 - 1, 512) * ld(t0 - 1, 0);
  f32x4v ring[W];
  f32x4v sum = zero;
#pragma unroll
  for (int i = 0; i < W; ++i) { ring[i] = (s0 + i - W >= 0) ? ld(t0 + i - W, 1536) : zero; sum += ring[i]; }
#pragma unroll
  for (int tt = 0; tt < 32; ++tt) {
    const int t = t0 + tt;
    const f32x4v x0 = ld(t, 512) * ld(t, 0);
    const f32x4v z = w0 * xm2 + w1 * xm1 + w2 * x0;
    xm2 = xm1; xm1 = x0;
    const f32x4v ya = ld(t, 1024) * z;
    const f32x4v pv = ld(t, 1536);
    sum += pv - ring[tt % W]; ring[tt % W] = pv;
    const int cnt = (s0 + tt + 1 < W) ? (s0 + tt + 1) : W;
    const float ic = 1.f / (float)cnt;
    const f32x4v pl = sum * ic - pv;
    u32x2 oa, ob;
    oa[0] = pack2(ya[0], ya[1]); oa[1] = pack2(ya[2], ya[3]);
    ob[0] = pack2(pl[0], pl[1]); ob[1] = pack2(pl[2], pl[3]);
    *(GAS u32x2*)(Y + (size_t)t * D + c) = oa;
    *(GAS u32x2*)(pool + (size_t)t * 512 + c) = ob;
  }
}
DI void phase_evenmix(const int wq, PRef p, int j) {
  const int tid = ltid(wq); const int bid = lbid();
  const int lane = tid & 63, wv = tid >> 6;
  const float* cw = p.even_conv_w + (size_t)j * 3 * 512;
  for (int Wg = bid * 4 + wv; Wg < 1024; Wg += gridDim.x * 4) {
    const int g = Wg & 3, cp = Wg >> 2;
    const int t0 = (cp * 2 + (lane >> 5)) * 32;
    const int c = g * 128 + (lane & 31) * 4;
    if (g == 0) evenmix_run<2>(p.P16, cw, p.Y, p.pool, t0, c);
    else if (g == 1) evenmix_run<4>(p.P16, cw, p.Y, p.pool, t0, c);
    else if (g == 2) evenmix_run<8>(p.P16, cw, p.Y, p.pool, t0, c);
    else evenmix_run<16>(p.P16, cw, p.Y, p.pool, t0, c);
  }
}

DI void phase_lb(const int wq, PRef p) {
  const int tid_ = ltid(wq); const int bid_ = lbid(); (void)tid_; (void)bid_;
  for (int c = bid_ * NT + tid_; c < 512; c += gridDim.x * NT) {
    float g[DEPTH], m = -INFINITY;
#pragma unroll
    for (int l = 0; l < DEPTH; ++l) { g[l] = p.hgrn_gamma[l * 512 + c]; m = fmaxf(m, g[l]); }
    float sum = 0.f;
#pragma unroll
    for (int l = 0; l < DEPTH; ++l) { g[l] = expf(g[l] - m); sum += g[l]; }
    float cum = 0.f;
#pragma unroll
    for (int l = 0; l < DEPTH; ++l) { p.lb[l * 512 + c] = cum; cum += g[l] / sum; }
  }
}

DI int t5_bucket(int dist) {
  const int d = dist < 0 ? 0 : dist;
  if (d < 16) return d;
  const float lr = logf((float)d / 16.f) / 2.0794415416798357f;
  int large = 16 + (int)(lr * 16.f);
  return large < 31 ? large : 31;
}

DI unsigned fkey(float f) { unsigned u = __float_as_uint(f); return (u & 0x80000000u) ? ~u : (u | 0x80000000u); }

DI void phase_hgrn_post(const int wq, PRef p, int j) {
  const int tid_ = ltid(wq); const int bid_ = lbid(); (void)tid_; (void)bid_;
  const int lane = tid_ & 63, wv = tid_ >> 6;
  for (int r = bid_ * 4 + wv; r < T * 4; r += gridDim.x * 4) {
    const int t = r >> 2, hd = r & 3;
    const float* o = p.oraw + (size_t)t * 512 + hd * 128;
    const float a = o[lane], bq = o[lane + 64];
    const float ss = wave_sum(a * a + bq * bq);
    const float rs = rsqrtf(ss / 128.f + 1e-6f);
    const bf16_t* gate = p.P16 + (size_t)t * ODD_IN + 3272 + hd * 128;
    const float* gn = p.odd_hg_norm + j * 512 + hd * 128;
    const float g0 = bf2f(gate[lane]), g1 = bf2f(gate[lane + 64]);
    p.Y[(size_t)t * D + 512 + hd * 128 + lane] = f2bf(a * rs * gn[lane] * (g0 * sigmoidf(g0)));
    p.Y[(size_t)t * D + 512 + hd * 128 + lane + 64] = f2bf(bq * rs * gn[lane + 64] * (g1 * sigmoidf(g1)));
  }
}

DI void phase_dsa_prep(const int wq, PRef p, int j) {
  const int tid = ltid(wq); const int bid = lbid();
  const int lane = tid & 63, wv = tid >> 6;
  for (int t = bid * 4 + wv; t < T; t += gridDim.x * 4) {
    const bf16_t* row = p.P16 + (size_t)t * ODD_IN;
#pragma unroll
    for (int c = 0; c < 2; ++c) *(GAS u32x4*)(p.qlat16 + (size_t)t * 1024 + c * 512 + lane * 8) = gload16(row + c * 512 + lane * 8);
    {
      const unsigned cv = *(const GAS unsigned*)(row + 1024 + 2 * lane);
      const float c0 = bflo(cv), c1 = bfhi(cv);
      const float ss = wave_sum(c0 * c0 + c1 * c1);
      const float rs = rsqrtf(ss / 128.f + 1e-6f);
      const float* g = p.odd_kv_norm + j * 128;
      *(GAS unsigned*)(p.ckv16 + (size_t)t * 128 + 2 * lane) = pack2(c0 * rs * g[2 * lane], c1 * rs * g[2 * lane + 1]);
    }
    *(GAS u32x4*)(p.iq16 + (size_t)t * 512 + lane * 8) = gload16(row + 1152 + lane * 8);
    p.ik16[(size_t)t * 64 + lane] = row[1664 + lane];
  }
}

DI void phase_dsa_scores(const int wq, PRef p, char* smem) {
  const int tid = ltid(wq); const int bid = lbid();
  const int lane = tid & 63, wv = tid >> 6, wm = wv >> 1, wn = wv & 1;
  const int r = lane & 31, hh = lane >> 5;
  const int srow = tid >> 3, skc = tid & 7;
  char* Ks = smem;
  char* Qs = smem + G_TILE_B;
  float* Ws = (float*)(smem + 3 * G_TILE_B);
  for (int tile = bid; tile < NB * 136; tile += gridDim.x) {
    const int b = tile / 136, u = tile % 136;
    int qb = 0;
    while ((qb + 1) * (qb + 2) / 2 <= u) ++qb;
    const int kb = u - qb * (qb + 1) / 2;
    const int q0 = b * S + qb * 128, k0 = b * S + kb * 128;
    const bf16_t* Kg = p.ik16 + (size_t)(k0 + srow) * 64 + skc * 8;
    const bf16_t* Qg = p.iq16 + (size_t)(q0 + srow) * 512 + skc * 8;
    u32x4 rk[4], rq[4];
#pragma unroll
    for (int i = 0; i < 4; ++i) { rk[i] = gload16(Kg + (size_t)(32 * i) * 64); rq[i] = gload16(Qg + (size_t)(32 * i) * 512); }
    u32x4 wv4 = {0u, 0u, 0u, 0u};
    if (tid < 128) wv4 = gload16(p.P16 + (size_t)(q0 + tid) * ODD_IN + 1728);
    __syncthreads();
#pragma unroll
    for (int i = 0; i < 4; ++i) {
      *(u32x4*)(Ks + (srow + 32 * i) * G_LDS_ROW + skc * 16) = rk[i];
      *(u32x4*)(Qs + (srow + 32 * i) * G_LDS_ROW + skc * 16) = rq[i];
    }
    if (tid < 128) {
      const unsigned w0 = wv4[0], w1 = wv4[1], w2 = wv4[2], w3 = wv4[3];
      f32x4v a4, b4;
      a4[0] = bflo(w0) * 0.35355339059327373f; a4[1] = bfhi(w0) * 0.35355339059327373f; a4[2] = bflo(w1) * 0.35355339059327373f; a4[3] = bfhi(w1) * 0.35355339059327373f;
      b4[0] = bflo(w2) * 0.35355339059327373f; b4[1] = bfhi(w2) * 0.35355339059327373f; b4[2] = bflo(w3) * 0.35355339059327373f; b4[3] = bfhi(w3) * 0.35355339059327373f;
      *(f32x4v*)(Ws + tid * 8) = a4; *(f32x4v*)(Ws + tid * 8 + 4) = b4;
    }
    __syncthreads();
    f32x16 sc[2][2];
#pragma unroll
    for (int i = 0; i < 2; ++i)
#pragma unroll
      for (int jx = 0; jx < 2; ++jx)
#pragma unroll
        for (int e = 0; e < 16; ++e) sc[i][jx][e] = 0.f;
#pragma unroll 1
    for (int hd = 0; hd < 8; ++hd) {
      const int cur = hd & 1;
      if (hd + 1 < 8) {
#pragma unroll
        for (int i = 0; i < 4; ++i) rq[i] = gload16(Qg + (size_t)(32 * i) * 512 + (hd + 1) * 64);
      }
      f32x16 acc[2][2];
#pragma unroll
      for (int i = 0; i < 2; ++i)
#pragma unroll
        for (int jx = 0; jx < 2; ++jx)
#pragma unroll
          for (int e = 0; e < 16; ++e) acc[i][jx][e] = 0.f;
      const char* As = Qs + cur * G_TILE_B + (wm * 64 + r) * G_LDS_ROW + hh * 16;
      const char* Bs = Ks + (wn * 64 + r) * G_LDS_ROW + hh * 16;
#pragma unroll
      for (int ks = 0; ks < 4; ++ks) {
        const bf16x8 a0 = *(const bf16x8*)(As + ks * 32), a1 = *(const bf16x8*)(As + 32 * G_LDS_ROW + ks * 32);
        const bf16x8 b0 = *(const bf16x8*)(Bs + ks * 32), b1 = *(const bf16x8*)(Bs + 32 * G_LDS_ROW + ks * 32);
        acc[0][0] = __builtin_amdgcn_mfma_f32_32x32x16_bf16(a0, b0, acc[0][0], 0, 0, 0);
        acc[0][1] = __builtin_amdgcn_mfma_f32_32x32x16_bf16(a0, b1, acc[0][1], 0, 0, 0);
        acc[1][0] = __builtin_amdgcn_mfma_f32_32x32x16_bf16(a1, b0, acc[1][0], 0, 0, 0);
        acc[1][1] = __builtin_amdgcn_mfma_f32_32x32x16_bf16(a1, b1, acc[1][1], 0, 0, 0);
      }
#pragma unroll
      for (int i = 0; i < 2; ++i)
#pragma unroll
        for (int e = 0; e < 16; ++e) {
          const float w = Ws[(wm * 64 + i * 32 + (e & 3) + 8 * (e >> 2) + 4 * hh) * 8 + hd];
          sc[i][0][e] = fmaf(w, fmaxf(acc[i][0][e] * 0.125f, 0.f), sc[i][0][e]);
          sc[i][1][e] = fmaf(w, fmaxf(acc[i][1][e] * 0.125f, 0.f), sc[i][1][e]);
        }
      if (hd + 1 < 8) {
#pragma unroll
        for (int i = 0; i < 4; ++i) *(u32x4*)(Qs + (cur ^ 1) * G_TILE_B + (srow + 32 * i) * G_LDS_ROW + skc * 16) = rq[i];
      }
      __syncthreads();
    }
#pragma unroll
    for (int i = 0; i < 2; ++i)
#pragma unroll
      for (int jx = 0; jx < 2; ++jx) {
        GAS float* cp = (GAS float*)p.sc + (size_t)(q0 + wm * 64 + i * 32 + 4 * hh) * 2048 + kb * 128 + wn * 64 + jx * 32 + r;
#pragma unroll
        for (int e = 0; e < 16; ++e) cp[(size_t)((e & 3) + 8 * (e >> 2)) * 2048] = sc[i][jx][e];
      }
  }
}

DI void phase_hgrn_scan(const int wq, PRef p, int l, char* smem) {
  const int tid = ltid(wq); const int bid = lbid();
  const int lane = tid & 63, wv = tid >> 6;
  const int kq = wv * 4 + (lane & 3), v = lane >> 2;
  constexpr int BUF = (2048 + 2048 + 256);
  float* bufs = (float*)smem;
  float* opart0 = bufs + 2 * BUF;
  for (int unit = bid; unit < 256; unit += gridDim.x) {
    const int b = unit >> 5, hd = (unit >> 3) & 3, vs = unit & 7;
    const int ltok = tid >> 4, lc = (tid & 15) * 8;
    const bf16_t* Pb = p.P16 + (size_t)(b * S) * ODD_IN;
    f32x4v lbv0, lbv1;
    { const float* lbp = p.lb + l * 512 + hd * 128 + lc; lbv0 = *(const f32x4v*)lbp; lbv1 = *(const f32x4v*)(lbp + 4); }
    f32x2v st[4];
#pragma unroll
    for (int i = 0; i < 4; ++i) { st[i][0] = 0.f; st[i][1] = 0.f; }
    u32x4 rq, rf; float riv;
    auto gl = [&](int bt) {
      const bf16_t* row = Pb + (size_t)(bt * 16 + ltok) * ODD_IN;
      rq = gload16(row + 1736 + hd * 128 + lc);
      rf = gload16(row + 2248 + hd * 128 + lc);
      riv = bf2f(row[2760 + hd * 128 + vs * 16 + (tid & 15)]);
    };
    auto st_lds = [&](int which) {
      float* bq = bufs + which * BUF; float* bf = bq + 2048; float* bi = bf + 2048;
      const unsigned q0_ = rq[0], q1_ = rq[1], q2_ = rq[2], q3_ = rq[3], f0_ = rf[0], f1_ = rf[1], f2_ = rf[2], f3_ = rf[3];
      f32x4v qa, qb, fa, fb;
      qa[0] = bflo(q0_); qa[1] = bfhi(q0_); qa[2] = bflo(q1_); qa[3] = bfhi(q1_); qb[0] = bflo(q2_); qb[1] = bfhi(q2_); qb[2] = bflo(q3_); qb[3] = bfhi(q3_);
      fa[0] = bflo(f0_); fa[1] = bfhi(f0_); fa[2] = bflo(f1_); fa[3] = bfhi(f1_); fb[0] = bflo(f2_); fb[1] = bfhi(f2_); fb[2] = bflo(f3_); fb[3] = bfhi(f3_);
      *(f32x4v*)(bq + ltok * 128 + lc) = qa; *(f32x4v*)(bq + ltok * 128 + lc + 4) = qb;
      f32x4v f0, f1;
#pragma unroll
      for (int i = 0; i < 4; ++i) {
        f0[i] = lbv0[i] + (1.f - lbv0[i]) * __builtin_amdgcn_rcpf(1.f + __expf(-fa[i]));
        f1[i] = lbv1[i] + (1.f - lbv1[i]) * __builtin_amdgcn_rcpf(1.f + __expf(-fb[i]));
      }
      *(f32x4v*)(bf + ltok * 128 + lc) = f0; *(f32x4v*)(bf + ltok * 128 + lc + 4) = f1;
      bi[ltok * 16 + (tid & 15)] = riv;
    };
    gl(0);
    __syncthreads();
    st_lds(0);
    __syncthreads();
#pragma unroll 1
    for (int bt = 0; bt < S / 16; ++bt) {
      const int cur = bt & 1;
      if (bt + 1 < S / 16) gl(bt + 1);
      const float* bq = bufs + cur * BUF; const float* bf = bq + 2048; const float* bi = bf + 2048;
      float* opart = opart0 + cur * 1024;
      f32x4v F0, F1, Q0, Q1; float IV;
      auto ldstep = [&](int tt) {
        IV = bi[tt * 16 + v];
        F0 = *(const f32x4v*)(bf + tt * 128 + kq * 8); F1 = *(const f32x4v*)(bf + tt * 128 + kq * 8 + 4);
        Q0 = *(const f32x4v*)(bq + tt * 128 + kq * 8); Q1 = *(const f32x4v*)(bq + tt * 128 + kq * 8 + 4);
      };
      ldstep(0);
#pragma unroll
      for (int tt = 0; tt < 16; ++tt) {
        const float iv = IV;
        const f32x4v f0 = F0, f1 = F1, q0 = Q0, q1 = Q1;
        if (tt + 1 < 16) ldstep(tt + 1);
        f32x2v iv2; iv2[0] = iv; iv2[1] = iv;
        f32x2v fa, fb, fc, fd, qa, qb, qc, qd;
        fa[0] = f0[0]; fa[1] = f0[1]; fb[0] = f0[2]; fb[1] = f0[3]; fc[0] = f1[0]; fc[1] = f1[1]; fd[0] = f1[2]; fd[1] = f1[3];
        qa[0] = q0[0]; qa[1] = q0[1]; qb[0] = q0[2]; qb[1] = q0[3]; qc[0] = q1[0]; qc[1] = q1[1]; qd[0] = q1[2]; qd[1] = q1[3];
        st[0] = __builtin_elementwise_fma(fa, st[0] - iv2, iv2);
        st[1] = __builtin_elementwise_fma(fb, st[1] - iv2, iv2);
        st[2] = __builtin_elementwise_fma(fc, st[2] - iv2, iv2);
        st[3] = __builtin_elementwise_fma(fd, st[3] - iv2, iv2);
        f32x2v o2 = qa * st[0];
        o2 = __builtin_elementwise_fma(qb, st[1], o2);
        o2 = __builtin_elementwise_fma(qc, st[2], o2);
        o2 = __builtin_elementwise_fma(qd, st[3], o2);
        float o = o2[0] + o2[1];
        o += __int_as_float(__builtin_amdgcn_update_dpp(0, __float_as_int(o), 0xB1, 0xF, 0xF, true));
        o += __int_as_float(__builtin_amdgcn_update_dpp(0, __float_as_int(o), 0x4E, 0xF, 0xF, true));
        opart[(tt * 4 + wv) * 16 + v] = o;
      }
      if (bt + 1 < S / 16) st_lds(cur ^ 1);
      __syncthreads();
      {
        const int tt = tid >> 4, vo = tid & 15;
        const float o = opart[(tt * 4 + 0) * 16 + vo] + opart[(tt * 4 + 1) * 16 + vo] + opart[(tt * 4 + 2) * 16 + vo] + opart[(tt * 4 + 3) * 16 + vo];
        p.oraw[(size_t)(b * S + bt * 16 + tt) * 512 + hd * 128 + vs * 16 + vo] = o;
      }
    }
    __syncthreads();
  }
}

DI float dot2bf(unsigned a, unsigned b, float acc) { return __builtin_amdgcn_fdot2_f32_bf16(__builtin_bit_cast(bf16x2_t, a), __builtin_bit_cast(bf16x2_t, b), acc, false); }
DI unsigned fkey_u(float f) { const unsigned u = __float_as_uint(f); return (u & 0x80000000u) ? ~u : (u | 0x80000000u); }
DI void phase_dsa_attend(const int wq, PRef p, int j, char* smem, int qoff) {
  const int tid = ltid(wq); const int bid = lbid(); (void)bid;
  const int lane = tid & 63, wv = tid >> 6;
  int* selL = (int*)smem;
  int* nselL = selL + 1024;
  float* bias = (float*)(smem + 4096 + 64);
  float* part = (float*)(smem + 4096 + 64 + 1024);
  float* msb = part + 2 * 4 * 8 * 128;
  float* plw = msb + 2 * 4 * 16 + wv * 64 * 8;
  int* sel = selL + wv * 256;
  __syncthreads();
  bias[tid] = p.rel_bias[tid];
  const int n16 = lane & 15, kg = lane >> 4;
  const unsigned long long ltmask = (1ull << lane) - 1ull;
  for (;;) {
    __syncthreads();
    if (tid == 0) nselL[4] = (int)atomicAdd(p.qctr + qoff, 4u);
    __syncthreads();
    const int base = nselL[4];
    if (base >= T) break;
    {
      const int q = base + wv;
      const int t = q % S;
      const float* row = p.sc + (size_t)q * 2048;
      int nsel;
      if (t < 256) {
        nsel = t + 1;
#pragma unroll
        for (int i = 0; i < 4; ++i) sel[i * 64 + lane] = i * 64 + lane;
      } else {
        nsel = 256;
        const int ni = (t >> 6) + 1;
        unsigned keys[32];
#pragma unroll
        for (int i = 0; i < 32; ++i) {
          keys[i] = 0u;
          if (i < ni) { const int s_ = i * 64 + lane; if (s_ <= t) keys[i] = fkey_u(row[s_]); }
        }
        unsigned thr = 0u;
#pragma unroll 1
        for (int bit = 31; bit >= 0; --bit) {
          const unsigned cand = thr | (1u << bit);
          int cl = 0;
#pragma unroll
          for (int g = 0; g < 4; ++g) if (g * 8 < ni) {
#pragma unroll
            for (int i = g * 8; i < g * 8 + 8; ++i) cl += (keys[i] >= cand) ? 1 : 0;
          }
          const int cnt = wave_sum_i(cl);
          if (cnt >= 256) thr = cand;
        }
        int ngt = 0;
#pragma unroll
        for (int i = 0; i < 32; ++i) if (i < ni) ngt += __builtin_popcountll(__ballot(keys[i] > thr));
        const int need = 256 - ngt;
        int pg = 0, pe = 0;
#pragma unroll
        for (int i = 0; i < 32; ++i) if (i < ni) {
          const unsigned long long mg = __ballot(keys[i] > thr), me = __ballot(keys[i] == thr);
          const int myg = pg + __builtin_popcountll(mg & ltmask), mye = pe + __builtin_popcountll(me & ltmask);
          if (keys[i] > thr) sel[myg] = i * 64 + lane;
          else if (keys[i] == thr && mye < need) sel[ngt + mye] = i * 64 + lane;
          pg += __builtin_popcountll(mg); pe += __builtin_popcountll(me);
        }
      }
      if (lane == 0) nselL[wv] = nsel;
    }
    __syncthreads();
#pragma unroll 1
    for (int qi = 0; qi < 4; ++qi) {
      const int tid = ltid(wq);
      const int lane = tid & 63;
      const int n16 = lane & 15, kg = lane >> 4;
      const int q = base + qi;
      const int b = q / S, t = q % S;
      const int nsel = nselL[qi];
      const int* qsel = selL + qi * 256 + wv * 64;
      const int slot0 = wv * 64;
      float* pw = part + ((qi & 1) * 4 + wv) * 8 * 128;
      float* mw = msb + ((qi & 1) * 4 + wv) * 16;
      bf16x8 aq[4];
#pragma unroll
      for (int ks = 0; ks < 4; ++ks) {
        u32x4 z = {0u, 0u, 0u, 0u};
        if (n16 < 8) z = gload16(p.qlat16 + (size_t)q * 1024 + n16 * 128 + ks * 32 + kg * 8);
        aq[ks] = __builtin_bit_cast(bf16x8, z);
      }
      u32x4 bv[4][4];
#pragma unroll
      for (int bb = 0; bb < 4; ++bb) {
        const int sl = bb * 16 + n16;
        const int sxv = (slot0 + sl < nsel) ? qsel[sl] : 0;
        const bf16_t* crow = p.ckv16 + (size_t)(b * S + sxv) * 128 + kg * 8;
#pragma unroll
        for (int ks = 0; ks < 4; ++ks) bv[bb][ks] = gload16(crow + ks * 32);
      }
      const bf16_t* cb = p.ckv16 + (size_t)(b * S) * 128 + 2 * lane;
      unsigned cbuf[64];
#pragma unroll
      for (int i4 = 0; i4 < 8; ++i4) {
        const u32x4 s4 = *(const u32x4*)(qsel + i4 * 4);
#pragma unroll
        for (int e = 0; e < 4; ++e) {
          const int k = i4 * 4 + e;
          const int sk = (slot0 + k < nsel) ? __builtin_amdgcn_readfirstlane((int)s4[e]) : 0;
          cbuf[k] = *(const GAS unsigned*)(cb + (size_t)sk * 128);
        }
      }
      asm volatile("" ::: "memory");
      f32x4v lg[4];
#pragma unroll
      for (int bb = 0; bb < 4; ++bb) {
        f32x4v acc = {0.f, 0.f, 0.f, 0.f};
#pragma unroll
        for (int ks = 0; ks < 4; ++ks) acc = __builtin_amdgcn_mfma_f32_16x16x32_bf16(aq[ks], __builtin_bit_cast(bf16x8, bv[bb][ks]), acc, 0, 0, 0);
        lg[bb] = acc;
      }
      asm volatile("" ::: "memory");
#pragma unroll
      for (int i4 = 8; i4 < 16; ++i4) {
        const u32x4 s4 = *(const u32x4*)(qsel + i4 * 4);
#pragma unroll
        for (int e = 0; e < 4; ++e) {
          const int k = i4 * 4 + e;
          const int sk = (slot0 + k < nsel) ? __builtin_amdgcn_readfirstlane((int)s4[e]) : 0;
          cbuf[k] = *(const GAS unsigned*)(cb + (size_t)sk * 128);
        }
      }
      float mx[4] = {-INFINITY, -INFINITY, -INFINITY, -INFINITY};
#pragma unroll
      for (int bb = 0; bb < 4; ++bb) {
        const bool ok = slot0 + bb * 16 + n16 < nsel;
        const int bk = t5_bucket(t - (ok ? qsel[bb * 16 + n16] : 0));
#pragma unroll
        for (int i = 0; i < 4; ++i) {
          const float lv = ok ? lg[bb][i] * 0.08838834764831845f + bias[bk * 8 + ((4 * kg + i) & 7)] : -INFINITY;
          lg[bb][i] = lv; mx[i] = fmaxf(mx[i], lv);
        }
      }
#pragma unroll
      for (int i = 0; i < 4; ++i) mx[i] = rowmax16(mx[i]);
      float sm[4] = {0.f, 0.f, 0.f, 0.f};
#pragma unroll
      for (int bb = 0; bb < 4; ++bb)
#pragma unroll
        for (int i = 0; i < 4; ++i) {
          const float e_ = (mx[i] == -INFINITY) ? 0.f : __expf(lg[bb][i] - mx[i]);
          lg[bb][i] = e_; sm[i] += e_;
        }
#pragma unroll
      for (int i = 0; i < 4; ++i) sm[i] = rowsum16(sm[i]);
#pragma unroll
      for (int bb = 0; bb < 4; ++bb) {
        u32x4 pr;
#pragma unroll
        for (int i = 0; i < 4; ++i) {
          const float other = DPP_F(lg[bb][i], 0xB1, 0xF, true);
          pr[i] = pack2(lg[bb][i], other);
        }
        if (kg < 2 && (n16 & 1) == 0) *(u32x4*)((unsigned*)plw + ((bb * 16 + n16) >> 1) * 8 + 4 * kg) = pr;
      }
      if (kg < 2) {
        if (n16 == 0) {
#pragma unroll
          for (int i = 0; i < 4; ++i) { mw[4 * kg + i] = mx[i]; mw[8 + 4 * kg + i] = sm[i]; }
        }
      }
      asm volatile("s_waitcnt lgkmcnt(0)" ::: "memory");
      float o[16];
#pragma unroll
      for (int i = 0; i < 16; ++i) o[i] = 0.f;
#pragma unroll
      for (int kp = 0; kp < 32; ++kp) {
        if ((kp & 1) == 0) asm volatile("" ::: "memory");
        const unsigned ca = cbuf[2 * kp], cbx = cbuf[2 * kp + 1];
        const unsigned x0 = __builtin_amdgcn_perm(cbx, ca, 0x05040100u);
        const unsigned x1 = __builtin_amdgcn_perm(cbx, ca, 0x07060302u);
        const u32x4 pa4 = *(const u32x4*)((const unsigned*)plw + kp * 8), pb4 = *(const u32x4*)((const unsigned*)plw + kp * 8 + 4);
        const unsigned q0 = pa4[0], q1 = pa4[1], q2 = pa4[2], q3 = pa4[3], q4 = pb4[0], q5 = pb4[1], q6 = pb4[2], q7 = pb4[3];
        o[0] = dot2bf(q0, x0, o[0]); o[1] = dot2bf(q0, x1, o[1]); o[2] = dot2bf(q1, x0, o[2]); o[3] = dot2bf(q1, x1, o[3]);
        o[4] = dot2bf(q2, x0, o[4]); o[5] = dot2bf(q2, x1, o[5]); o[6] = dot2bf(q3, x0, o[6]); o[7] = dot2bf(q3, x1, o[7]);
        o[8] = dot2bf(q4, x0, o[8]); o[9] = dot2bf(q4, x1, o[9]); o[10] = dot2bf(q5, x0, o[10]); o[11] = dot2bf(q5, x1, o[11]);
        o[12] = dot2bf(q6, x0, o[12]); o[13] = dot2bf(q6, x1, o[13]); o[14] = dot2bf(q7, x0, o[14]); o[15] = dot2bf(q7, x1, o[15]);
      }
#pragma unroll
      for (int hd = 0; hd < 8; ++hd) { float2 ov; ov.x = o[2 * hd]; ov.y = o[2 * hd + 1]; *(float2*)(pw + hd * 128 + 2 * lane) = ov; }
      __syncthreads();
      {
        const int hd = tid >> 5, ch = (tid & 31) * 4;
        const float* pq = part + (qi & 1) * 4 * 8 * 128;
        const float* mq = msb + (qi & 1) * 4 * 16;
        float m0 = mq[hd], m1 = mq[16 + hd], m2 = mq[32 + hd], m3 = mq[48 + hd];
        const float M = fmaxf(fmaxf(m0, m1), fmaxf(m2, m3));
        const float f0 = __expf(m0 - M), f1 = __expf(m1 - M), f2 = __expf(m2 - M), f3 = __expf(m3 - M);
        const float den = f0 * mq[8 + hd] + f1 * mq[24 + hd] + f2 * mq[40 + hd] + f3 * mq[56 + hd];
        const f32x4v a0 = *(const f32x4v*)(pq + (0 * 8 + hd) * 128 + ch), a1 = *(const f32x4v*)(pq + (1 * 8 + hd) * 128 + ch);
        const f32x4v a2 = *(const f32x4v*)(pq + (2 * 8 + hd) * 128 + ch), a3 = *(const f32x4v*)(pq + (3 * 8 + hd) * 128 + ch);
        const float inv = 1.f / den;
        const f32x4v r = (a0 * f0 + a1 * f1 + a2 * f2 + a3 * f3) * inv;
        u32x2 ov; ov[0] = pack2(r[0], r[1]); ov[1] = pack2(r[2], r[3]);
        *(GAS u32x2*)(p.lat + (size_t)q * D + hd * 128 + ch) = ov;
      }
    }
  }
}

DI void phase_softmax256(const int wq, const bf16_t* __restrict__ S, bf16_t* __restrict__ Pm, int rows) {
  const int tid = ltid(wq); const int bid = lbid();
  const int lane = tid & 63, wv = tid >> 6;
  for (int r = bid * 4 + wv; r < rows; r += gridDim.x * 4) {
    const f32x4v v = bf4_to_f(*(const GAS u32x2*)(S + (size_t)r * 256 + lane * 4));
    const float a = v[0], b = v[1], c = v[2], d = v[3];
    const float m = wave_max(fmaxf(fmaxf(a, b), fmaxf(c, d)));
    const float ea = __expf(a - m), eb = __expf(b - m), ec = __expf(c - m), ed = __expf(d - m);
    const float inv = 1.f / wave_sum(ea + eb + ec + ed);
    u32x2 o; o[0] = pack2(ea * inv, eb * inv); o[1] = pack2(ec * inv, ed * inv);
    *(GAS u32x2*)(Pm + (size_t)r * 256 + lane * 4) = o;
  }
}

DI int fkey_s(int b) { return b ^ ((b >> 31) & 0x7fffffff); }

template <int N, int KMAX>
DI void bitonic_blocks(int (&v)[N]) {
#pragma unroll
  for (int k = 2; k <= KMAX; k <<= 1)
#pragma unroll
    for (int j = k >> 1; j > 0; j >>= 1)
#pragma unroll
      for (int i = 0; i < N; ++i) {
        const int l = i ^ j;
        if (l > i) {
          const bool desc = ((i & k) == 0);
          const int a = v[i], b = v[l];
          const int hi = a > b ? a : b, lo = a > b ? b : a;
          v[i] = desc ? hi : lo;
          v[l] = desc ? lo : hi;
        }
      }
}
template <bool DESC>
DI void bitonic_merge16(int (&v)[16]) {
#pragma unroll
  for (int j = 8; j > 0; j >>= 1)
#pragma unroll
    for (int i = 0; i < 16; ++i) {
      const int l = i ^ j;
      if (l > i) {
        const int a = v[i], b = v[l];
        const int hi = a > b ? a : b, lo = a > b ? b : a;
        v[i] = DESC ? hi : lo;
        v[l] = DESC ? lo : hi;
      }
    }
}

DI void phase_cvt_rows(const int wq, const float* __restrict__ src, bf16_t* __restrict__ dst, size_t n8) {
  const int tid = ltid(wq); const int bid = lbid();
  for (size_t i = (size_t)bid * NT + tid; i < n8; i += (size_t)gridDim.x * NT) {
    const u32x4 a = gload16(src + i * 8), b = gload16(src + i * 8 + 4);
    u32x4 o;
    o[0] = pack2(__uint_as_float(a[0]), __uint_as_float(a[1])); o[1] = pack2(__uint_as_float(a[2]), __uint_as_float(a[3]));
    o[2] = pack2(__uint_as_float(b[0]), __uint_as_float(b[1])); o[3] = pack2(__uint_as_float(b[2]), __uint_as_float(b[3]));
    *(GAS u32x4*)(dst + i * 8) = o;
  }
}

constexpr int KEY_ROW = 264;
DI void phase_peer_qs(const int wq, const bf16_t* __restrict__ X0, const bf16_t* __restrict__ W0, const bf16_t* __restrict__ keys0, int* __restrict__ tops, char* smem, const float* __restrict__ rss_in) {
  const int tid = ltid(wq); const int bid = lbid();
  const int lane = tid & 63, wv = tid >> 6;
  const int r = lane & 31, hh = lane >> 5;
  const int srow = tid >> 3, skc = tid & 7;
  constexpr int nk = D / 64;
  for (int tile = bid; tile < (T / 128) * 16; tile += gridDim.x) {
    const int mt = tile >> 4, hp = tile & 15;
    const bf16_t* Wg = W0 + (size_t)(hp * 128 + srow) * D + skc * 8;
    const bf16_t* Xg = X0 + (size_t)(mt * 128 + srow) * D + skc * 8;
    f32x16 acc[4];
#pragma unroll
    for (int i = 0; i < 4; ++i)
#pragma unroll
      for (int e = 0; e < 16; ++e) acc[i][e] = 0.f;
    u32x4 ra[4], rb[4];
#pragma unroll
    for (int i = 0; i < 4; ++i) { ra[i] = gload16(Wg + (size_t)(32 * i) * D); rb[i] = gload16(Xg + (size_t)(32 * i) * D); }
    __syncthreads();
#pragma unroll
    for (int i = 0; i < 4; ++i) {
      *(u32x4*)(smem + (srow + 32 * i) * G_LDS_ROW + skc * 16) = ra[i];
      *(u32x4*)(smem + 2 * G_TILE_B + (srow + 32 * i) * G_LDS_ROW + skc * 16) = rb[i];
    }
    __syncthreads();
#pragma unroll 1
    for (int kt = 0; kt < nk; ++kt) {
      const int cur = kt & 1;
      if (kt + 1 < nk) {
#pragma unroll
        for (int i = 0; i < 4; ++i) { ra[i] = gload16(Wg + (size_t)(32 * i) * D + (kt + 1) * 64); rb[i] = gload16(Xg + (size_t)(32 * i) * D + (kt + 1) * 64); }
      }
      const char* As = smem + cur * G_TILE_B + r * G_LDS_ROW + hh * 16;
      const char* Bs = smem + 2 * G_TILE_B + cur * G_TILE_B + (wv * 32 + r) * G_LDS_ROW + hh * 16;
#pragma unroll
      for (int ks = 0; ks < 4; ++ks) {
        const bf16x8 b = *(const bf16x8*)(Bs + ks * 32);
#pragma unroll
        for (int mb = 0; mb < 4; ++mb) {
          const bf16x8 a = *(const bf16x8*)(As + mb * 32 * G_LDS_ROW + ks * 32);
          acc[mb] = __builtin_amdgcn_mfma_f32_32x32x16_bf16(a, b, acc[mb], 0, 0, 0);
        }
      }
      if (kt + 1 < nk) {
        const int nxt = cur ^ 1;
#pragma unroll
        for (int i = 0; i < 4; ++i) {
          *(u32x4*)(smem + nxt * G_TILE_B + (srow + 32 * i) * G_LDS_ROW + skc * 16) = ra[i];
          *(u32x4*)(smem + 2 * G_TILE_B + nxt * G_TILE_B + (srow + 32 * i) * G_LDS_ROW + skc * 16) = rb[i];
        }
      }
      __syncthreads();
    }
    {
      const bf16_t* kg = keys0 + (size_t)hp * 128 * 128;
#pragma unroll
      for (int i = 0; i < 8; ++i) {
        const int c = tid + NT * i, row = c >> 4, c16 = c & 15;
        const u32x4 v = gload16(kg + row * 128 + c16 * 8);
        uint2 lo, hi2; lo.x = v[0]; lo.y = v[1]; hi2.x = v[2]; hi2.y = v[3];
        *(uint2*)(smem + row * KEY_ROW + c16 * 16) = lo;
        *(uint2*)(smem + row * KEY_ROW + c16 * 16 + 8) = hi2;
      }
    }
    __syncthreads();
    u32x4 qf[8];
    const float rstd_t = rstd_of(rss_in, mt * 128 + wv * 32 + r);
#pragma unroll
    for (int mb = 0; mb < 4; ++mb)
#pragma unroll
      for (int s2 = 0; s2 < 2; ++s2) {
        u32x4 f;
#pragma unroll
        for (int jj = 0; jj < 4; ++jj) f[jj] = pack2(acc[mb][8 * s2 + 2 * jj] * rstd_t, acc[mb][8 * s2 + 2 * jj + 1] * rstd_t);
        qf[mb * 2 + s2] = f;
      }
    int v[64];
#pragma unroll
    for (int kb = 0; kb < 4; ++kb) {
      f32x16 sa;
#pragma unroll
      for (int e = 0; e < 16; ++e) sa[e] = 0.f;
      const char* kr = smem + (kb * 32 + r) * KEY_ROW + hh * 8;
#pragma unroll
      for (int ksi = 0; ksi < 8; ++ksi) {
        const uint2 lo = *(const uint2*)(kr + ksi * 32);
        const uint2 hi2 = *(const uint2*)(kr + ksi * 32 + 16);
        u32x4 a; a[0] = lo.x; a[1] = lo.y; a[2] = hi2.x; a[3] = hi2.y;
        sa = __builtin_amdgcn_mfma_f32_32x32x16_bf16(__builtin_bit_cast(bf16x8, a), __builtin_bit_cast(bf16x8, qf[ksi]), sa, 0, 0, 0);
      }
#pragma unroll
      for (int e = 0; e < 16; ++e) {
        const int kidx = kb * 32 + (e & 3) + 8 * (e >> 2) + 4 * hh;
        v[kb * 16 + e] = (fkey_s(__float_as_int(sa[e])) & ~127) | kidx;
      }
    }
    bitonic_blocks<64, 16>(v);
    int c01[16], c23[16];
#pragma unroll
    for (int i = 0; i < 16; ++i) { c01[i] = v[i] > v[16 + i] ? v[i] : v[16 + i]; c23[i] = v[32 + i] > v[48 + i] ? v[32 + i] : v[48 + i]; }
    bitonic_merge16<true>(c01);
    bitonic_merge16<false>(c23);
    int d[16];
#pragma unroll
    for (int i = 0; i < 16; ++i) d[i] = c01[i] > c23[i] ? c01[i] : c23[i];
    bitonic_merge16<true>(d);
    int f[16];
#pragma unroll
    for (int i = 0; i < 16; ++i) { const int o = shxi(d[15 - i], 32, lane); f[i] = d[i] > o ? d[i] : o; }
    bitonic_merge16<true>(f);
    {
      const int token = mt * 128 + wv * 32 + r;
      GAS int* op = (GAS int*)tops + ((size_t)token * 16 + hp) * 16 + hh * 8;
      u32x4 o0, o1;
      if (hh) {
#pragma unroll
        for (int i = 0; i < 4; ++i) { o0[i] = f[8 + i]; o1[i] = f[12 + i]; }
        asm volatile("" : "+v"(o0), "+v"(o1));
      } else {
#pragma unroll
        for (int i = 0; i < 4; ++i) { o0[i] = f[i]; o1[i] = f[4 + i]; }
        asm volatile("" : "+v"(o0), "+v"(o1));
      }
      *(GAS u32x4*)op = o0; *(GAS u32x4*)(op + 4) = o1;
    }
  }
}

DI float dot8(const u32x4 a, const u32x4 b, float acc) {
  const unsigned a0 = a[0], a1 = a[1], a2 = a[2], a3 = a[3], b0 = b[0], b1 = b[1], b2 = b[2], b3 = b[3];
  acc = dot2bf(a0, b0, acc); acc = dot2bf(a1, b1, acc); acc = dot2bf(a2, b2, acc); acc = dot2bf(a3, b3, acc);
  return acc;
}
typedef signed char i8_t;
using i32x2 = __attribute__((ext_vector_type(2))) int;
DI void phase_quant_u(const int wq, const float* __restrict__ src, i8_t* __restrict__ dst, float* __restrict__ su, int nrows, const float* __restrict__ gain) {
  const int tid = ltid(wq); const int bid = lbid();
  const int lane = tid & 63, wv = tid >> 6;
  for (int row = bid * 4 + wv; row < nrows; row += gridDim.x * 4) {
    const float* r = src + (size_t)row * 1024 + 16 * lane;
    u32x4 a[4];
    {
      const float* gp = gain + (size_t)(row >> 14) * 1024 + 16 * lane;
#pragma unroll
      for (int i = 0; i < 4; ++i) {
        const u32x4 t = gload16(r + 4 * i);
        const f32x4v g4 = *(const f32x4v*)(gp + 4 * i);
        const unsigned t0 = t[0], t1 = t[1], t2 = t[2], t3 = t[3];
        a[i][0] = __float_as_uint(__uint_as_float(t0) * g4[0]); a[i][1] = __float_as_uint(__uint_as_float(t1) * g4[1]);
        a[i][2] = __float_as_uint(__uint_as_float(t2) * g4[2]); a[i][3] = __float_as_uint(__uint_as_float(t3) * g4[3]);
      }
    }
    float am = 0.f;
#pragma unroll
    for (int i = 0; i < 4; ++i) {
      const unsigned x0 = a[i][0], x1 = a[i][1], x2 = a[i][2], x3 = a[i][3];
      am = fmaxf(am, fmaxf(fmaxf(fabsf(__uint_as_float(x0)), fabsf(__uint_as_float(x1))), fmaxf(fabsf(__uint_as_float(x2)), fabsf(__uint_as_float(x3)))));
    }
    am = wave_max(am);
    const float inv = am > 0.f ? 127.f / am : 0.f;
    u32x4 o;
#pragma unroll
    for (int i = 0; i < 4; ++i) {
      const unsigned x0 = a[i][0], x1 = a[i][1], x2 = a[i][2], x3 = a[i][3];
      const int q0 = (int)rintf(__uint_as_float(x0) * inv), q1 = (int)rintf(__uint_as_float(x1) * inv);
      const int q2 = (int)rintf(__uint_as_float(x2) * inv), q3 = (int)rintf(__uint_as_float(x3) * inv);
      o[i] = (unsigned)(q0 & 255) | ((unsigned)(q1 & 255) << 8) | ((unsigned)(q2 & 255) << 16) | ((unsigned)(q3 & 255) << 24);
    }
    const size_t lyr = (size_t)row >> 14, e = (size_t)row & 16383;
    *(GAS u32x4*)(dst + (((lyr * 8 + (lane >> 3)) * 16384 + e) * 128 + (lane & 7) * 16)) = o;
    if (lane == 0) su[row] = am * (1.f / 127.f);
  }
}
DI void phase_cvt_v8(const int wq, const float* __restrict__ src, i8_t* __restrict__ dst, size_t n16) {
  const int tid = ltid(wq); const int bid = lbid();
  for (size_t i = (size_t)bid * NT + tid; i < n16; i += (size_t)gridDim.x * NT) {
    u32x4 o;
#pragma unroll
    for (int k = 0; k < 4; ++k) {
      const u32x4 a = gload16(src + i * 16 + 4 * k);
      const unsigned x0 = a[0], x1 = a[1], x2 = a[2], x3 = a[3];
      int pk = 0;
      pk = __builtin_amdgcn_cvt_pk_fp8_f32(__uint_as_float(x0) * 16.f, __uint_as_float(x1) * 16.f, pk, false);
      pk = __builtin_amdgcn_cvt_pk_fp8_f32(__uint_as_float(x2) * 16.f, __uint_as_float(x3) * 16.f, pk, true);
      o[k] = (unsigned)pk;
    }
    const size_t row = i >> 6; const int j = (int)(i & 63);
    const size_t lyr = row >> 14, e = row & 16383;
    *(GAS u32x4*)(dst + (((lyr * 8 + (j >> 3)) * 16384 + e) * 128 + (j & 7) * 16)) = o;
  }
}

DI void phase_peer_combine8(const int wq, PRef p, int l, char* smem, const float* __restrict__ rss_in) {
  const int tid = ltid(wq); const int bid = lbid();
  const int lane = tid & 63, wv = tid >> 6;
  int* wtops = (int*)(smem + wv * 1024);
  int ci, cj;
  if (lane < 16) { ci = 0; cj = lane; } else if (lane < 24) { ci = 1; cj = lane - 16; } else if (lane < 29) { ci = 2; cj = lane - 24; }
  else if (lane < 33) { ci = 3; cj = lane - 29; } else if (lane < 36) { ci = 4; cj = lane - 33; } else if (lane < 38) { ci = 5; cj = lane - 36; }
  else if (lane < 40) { ci = 6; cj = lane - 38; } else if (lane < 42) { ci = 7; cj = lane - 40; } else { ci = lane - 42 + 8; cj = 0; }
  const bool cvalid = lane < 50;
  if (!cvalid) { ci = 0; cj = 0; }
  const float* sul = p.su + (size_t)l * 16384;
  for (int token = bid * 4 + wv; token < T; token += gridDim.x * 4) {
    {
      const u32x4 tv = gload16(p.tops + (size_t)token * 256 + lane * 4);
      *(u32x4*)(wtops + lane * 4) = tv;
    }
    {
      const u32x4 a = gload16(p.hn + (size_t)token * D + 16 * lane), b2 = gload16(p.hn + (size_t)token * D + 16 * lane + 8);
      float xv[16];
      { const unsigned a0 = a[0], a1 = a[1], a2 = a[2], a3 = a[3], c0 = b2[0], c1 = b2[1], c2 = b2[2], c3 = b2[3];
        xv[0] = bflo(a0); xv[1] = bfhi(a0); xv[2] = bflo(a1); xv[3] = bfhi(a1); xv[4] = bflo(a2); xv[5] = bfhi(a2); xv[6] = bflo(a3); xv[7] = bfhi(a3);
        xv[8] = bflo(c0); xv[9] = bfhi(c0); xv[10] = bflo(c1); xv[11] = bfhi(c1); xv[12] = bflo(c2); xv[13] = bfhi(c2); xv[14] = bflo(c3); xv[15] = bfhi(c3); }
      float am = 0.f;
#pragma unroll
      for (int i = 0; i < 16; ++i) am = fmaxf(am, fabsf(xv[i]));
      am = wave_max(am);
      const float inv = am > 0.f ? 127.f / am : 0.f;
      u32x4 o;
#pragma unroll
      for (int i = 0; i < 4; ++i) {
        const int q0 = (int)rintf(xv[4 * i] * inv), q1 = (int)rintf(xv[4 * i + 1] * inv), q2 = (int)rintf(xv[4 * i + 2] * inv), q3 = (int)rintf(xv[4 * i + 3] * inv);
        o[i] = (unsigned)(q0 & 255) | ((unsigned)(q1 & 255) << 8) | ((unsigned)(q2 & 255) << 16) | ((unsigned)(q3 & 255) << 24);
      }
      *(GAS u32x4*)(p.x8 + (size_t)token * 1024 + 16 * lane) = o;
      if (lane == 0) p.sxq[token] = am * (1.f / 127.f) * rstd_of(rss_in, token);
    }
    asm volatile("s_waitcnt lgkmcnt(0)" ::: "memory");
#pragma unroll 1
    for (int hd = 0; hd < 8; ++hd) {
      const int k1 = wtops[(2 * hd) * 16 + ci], k2 = wtops[(2 * hd + 1) * 16 + cj];
      const float s1 = __int_as_float(fkey_s(k1 & ~127)), s2 = __int_as_float(fkey_s(k2 & ~127));
      const float val = s1 + s2;
      const int vk = cvalid ? ((fkey_s(__float_as_int(val)) & ~63) | (63 - lane)) : (int)0x80000000;
      int rank = 0;
#pragma unroll
      for (int c = 0; c < 50; ++c) rank += (__builtin_amdgcn_readlane(vk, c) > vk) ? 1 : 0;
      const float m = __int_as_float(__builtin_amdgcn_readlane(__float_as_int(val), 0));
      const bool sel = cvalid && rank < 16;
      const float ev = sel ? __expf(val - m) : 0.f;
      const float sum = wave_sum(ev);
      if (sel) {
        const int eid = (k1 & 127) * 128 + (k2 & 127);
        p.sel_id[(size_t)token * 128 + hd * 16 + rank] = eid;
        p.sel_g[(size_t)token * 128 + hd * 16 + rank] = ev / sum;
        p.sel_su[(size_t)token * 128 + hd * 16 + rank] = sul[eid];
      }
    }
    asm volatile("s_waitcnt lgkmcnt(0)" ::: "memory");
  }
}

DI void phase_peer_udot8(const int wq, PRef p, int l, char* smem, int coff) {
  const int tid = ltid(wq);
  const int lane = tid & 63, wv = tid >> 6;
  const int grp = lane >> 3, li = lane & 7;
  int* wid = (int*)(smem + wv * 4096);
  const bool b2 = li & 4, b1 = li & 2, b0 = li & 1;
  const int myx = (int)(xb_xcc_id() & 7u);
  for (int cs = 0; cs < 8; ++cs) {
    const int c = (myx + cs) & 7;
    const i8_t* U8 = p.u8 + ((size_t)l * 8 + c) * 16384 * 128 + li * 16;
    int* pb = (int*)p.pbuf + (size_t)c * T * 128;
    for (;;) {
      unsigned tb = 0;
      if (lane == 0) tb = atomicAdd(p.qctr + coff + c * 16, 8u);
      tb = __builtin_amdgcn_readfirstlane(tb);
      if (tb >= (unsigned)T) break;
      u32x4 xs[8];
      {
        int idl[16];
#pragma unroll
        for (int k = 0; k < 8; ++k) {
          idl[2 * k] = __builtin_nontemporal_load((const GAS int*)p.sel_id + (size_t)(tb + k) * 128 + lane);
          idl[2 * k + 1] = __builtin_nontemporal_load((const GAS int*)p.sel_id + (size_t)(tb + k) * 128 + 64 + lane);
          xs[k] = __builtin_nontemporal_load((gp_u32x4)(p.x8 + (size_t)(tb + k) * 1024 + c * 128 + li * 16));
        }
#pragma unroll
        for (int k = 0; k < 8; ++k) { wid[k * 128 + lane] = idl[2 * k]; wid[k * 128 + 64 + lane] = idl[2 * k + 1]; }
      }
      asm volatile("s_waitcnt lgkmcnt(0)" ::: "memory");
      auto issue = [&](int k, u32x4 (&g)[16]) {
        int ids[16];
#pragma unroll
        for (int i = 0; i < 4; ++i) {
          const u32x4 t4 = *(const u32x4*)(wid + k * 128 + grp * 16 + i * 4);
          ids[4 * i] = t4[0]; ids[4 * i + 1] = t4[1]; ids[4 * i + 2] = t4[2]; ids[4 * i + 3] = t4[3];
        }
#pragma unroll
        for (int i = 0; i < 16; ++i) g[i] = gload16(U8 + (size_t)ids[i] * 128);
      };
      auto consume = [&](int k, const u32x4 (&g)[16], const u32x4 cx) {
        const int x0 = (int)cx[0], x1 = (int)cx[1], x2 = (int)cx[2], x3 = (int)cx[3];
        int pp[16];
#pragma unroll
        for (int i = 0; i < 16; ++i) {
          const u32x4 u8 = g[i];
          const int u0 = (int)u8[0], u1 = (int)u8[1], u2 = (int)u8[2], u3 = (int)u8[3];
          int acc = __builtin_amdgcn_sdot4(x0, u0, 0, false);
          acc = __builtin_amdgcn_sdot4(x1, u1, acc, false);
          acc = __builtin_amdgcn_sdot4(x2, u2, acc, false);
          pp[i] = __builtin_amdgcn_sdot4(x3, u3, acc, false);
        }
        int q8[8], q4[4], q2[2];
#pragma unroll
        for (int i = 0; i < 8; ++i) { const int mine = b2 ? pp[i + 8] : pp[i], oth = b2 ? pp[i] : pp[i + 8]; q8[i] = mine + shxi(oth, 4, lane); }
#pragma unroll
        for (int i = 0; i < 4; ++i) { const int mine = b1 ? q8[i + 4] : q8[i], oth = b1 ? q8[i] : q8[i + 4]; q4[i] = mine + shxi(oth, 2, lane); }
#pragma unroll
        for (int i = 0; i < 2; ++i) { const int mine = b0 ? q4[i + 2] : q4[i], oth = b0 ? q4[i] : q4[i + 2]; q2[i] = mine + shxi(oth, 1, lane); }
        i32x2 ov; ov[0] = q2[0]; ov[1] = q2[1];
        __builtin_nontemporal_store(ov, (GAS i32x2*)(pb + (size_t)(tb + k) * 128 + 2 * lane));
      };
      u32x4 ga[16], gb[16];
      issue(0, ga);
#pragma unroll
      for (int k2 = 0; k2 < 4; ++k2) {
        issue(2 * k2 + 1, gb);
        consume(2 * k2, ga, xs[2 * k2]);
        if (k2 < 3) issue(2 * k2 + 2, ga);
        consume(2 * k2 + 1, gb, xs[2 * k2 + 1]);
      }
      asm volatile("s_waitcnt lgkmcnt(0)" ::: "memory");
    }
  }
}

DI void phase_peer_w(const int wq, PRef p) {
  const int tid = ltid(wq); const int bid = lbid();
  const int lane = tid & 63, wv = tid >> 6;
  for (int token = bid * 4 + wv; token < T; token += gridDim.x * 4) {
    i32x2 pp8[8];
#pragma unroll
    for (int cc = 0; cc < 8; ++cc) pp8[cc] = __builtin_nontemporal_load((const GAS i32x2*)((const int*)p.pbuf + ((size_t)cc * T + token) * 128 + 2 * lane));
    const u32x2 gg = __builtin_nontemporal_load((const GAS u32x2*)(p.sel_g + (size_t)token * 128 + 2 * lane));
    const u32x2 su2 = __builtin_nontemporal_load((const GAS u32x2*)(p.sel_su + (size_t)token * 128 + 2 * lane));
    const float sxv = p.sxq[token];
    int d0 = 0, d1 = 0;
#pragma unroll
    for (int cc = 0; cc < 8; ++cc) { d0 += pp8[cc][0]; d1 += pp8[cc][1]; }
    const float f0 = (float)d0 * (sxv * __uint_as_float(su2[0])), f1 = (float)d1 * (sxv * __uint_as_float(su2[1]));
    u32x2 w2; w2[0] = __float_as_uint(__uint_as_float(gg[0]) * gelu_tanh(f0) * 0.0625f); w2[1] = __float_as_uint(__uint_as_float(gg[1]) * gelu_tanh(f1) * 0.0625f);
    *(GAS u32x2*)(p.sel_g + (size_t)token * 128 + 2 * lane) = w2;
  }
}

DI void phase_peer_vacc8(const int wq, PRef p, int l, char* smem, int coff, int dry, int rss_idx) {
  const int myx = (int)(xb_xcc_id() & 7u);
  for (int cs = 0; cs < 8; ++cs) {
    const int c = (myx + cs) & 7;
    for (;;) {
      const int tid = ltid(wq);
      const int lane = tid & 63, wv = tid >> 6;
      int* wid = (int*)(smem + wv * 8192);
      float* ww = (float*)(smem + wv * 8192 + 4096);
      const int grp = lane >> 3, li = lane & 7;
      const bool g2 = grp & 4, g1 = grp & 2, g0 = grp & 1;
      const i8_t* V8 = p.v8 + ((size_t)l * 8 + c) * 16384 * 128 + li * 16;
      const int chan = c * 128 + li * 16 + 2 * grp;
      unsigned tb = 0;
      if (lane == 0) tb = atomicAdd(p.qctr + coff + c * 16, 8u);
      tb = __builtin_amdgcn_readfirstlane(tb);
      if (tb >= (unsigned)T) break;
      {
        u32x4 iv[4], wv4[4];
#pragma unroll
        for (int j4 = 0; j4 < 4; ++j4) {
          iv[j4] = __builtin_nontemporal_load((gp_u32x4)(p.sel_id + (size_t)tb * 128 + j4 * 256 + lane * 4));
          wv4[j4] = __builtin_nontemporal_load((gp_u32x4)(p.sel_g + (size_t)tb * 128 + j4 * 256 + lane * 4));
        }
#pragma unroll
        for (int j4 = 0; j4 < 4; ++j4) { *(u32x4*)(wid + j4 * 256 + lane * 4) = iv[j4]; *(u32x4*)(ww + j4 * 256 + lane * 4) = wv4[j4]; }
      }
      asm volatile("s_waitcnt lgkmcnt(0)" ::: "memory");
      auto issue = [&](int hh_, u32x4 (&g)[8]) {
        const int k = hh_ >> 1, hf = hh_ & 1;
        int ids[8];
#pragma unroll
        for (int i = 0; i < 2; ++i) {
          const u32x4 t4 = *(const u32x4*)(wid + k * 128 + grp * 16 + hf * 8 + i * 4);
          ids[4 * i] = t4[0]; ids[4 * i + 1] = t4[1]; ids[4 * i + 2] = t4[2]; ids[4 * i + 3] = t4[3];
        }
#pragma unroll
        for (int i = 0; i < 8; ++i) g[i] = gload16(V8 + (size_t)ids[i] * 128);
      };
      float o[16];
      u32x2 hcur;
      auto accum = [&](int hh_, const u32x4 (&g)[8]) {
        const int k = hh_ >> 1, hf = hh_ & 1;
        if (hf == 0) {
#pragma unroll
          for (int i = 0; i < 16; ++i) o[i] = 0.f;
          hcur = __builtin_nontemporal_load((GAS u32x2*)((GAS float*)p.h + ((size_t)tb + k) * D + chan));
        }
#pragma unroll
        for (int i = 0; i < 8; ++i) {
          const u32x4 v8 = g[i];
          const float w = ww[k * 128 + grp * 16 + hf * 8 + i];
          const int v0 = (int)v8[0], v1 = (int)v8[1], v2 = (int)v8[2], v3 = (int)v8[3];
          f32x2v t2;
          t2 = __builtin_amdgcn_cvt_pk_f32_fp8(v0, false); o[0] = fmaf(w, t2[0], o[0]); o[1] = fmaf(w, t2[1], o[1]);
          t2 = __builtin_amdgcn_cvt_pk_f32_fp8(v0, true);  o[2] = fmaf(w, t2[0], o[2]); o[3] = fmaf(w, t2[1], o[3]);
          t2 = __builtin_amdgcn_cvt_pk_f32_fp8(v1, false); o[4] = fmaf(w, t2[0], o[4]); o[5] = fmaf(w, t2[1], o[5]);
          t2 = __builtin_amdgcn_cvt_pk_f32_fp8(v1, true);  o[6] = fmaf(w, t2[0], o[6]); o[7] = fmaf(w, t2[1], o[7]);
          t2 = __builtin_amdgcn_cvt_pk_f32_fp8(v2, false); o[8] = fmaf(w, t2[0], o[8]); o[9] = fmaf(w, t2[1], o[9]);
          t2 = __builtin_amdgcn_cvt_pk_f32_fp8(v2, true);  o[10] = fmaf(w, t2[0], o[10]); o[11] = fmaf(w, t2[1], o[11]);
          t2 = __builtin_amdgcn_cvt_pk_f32_fp8(v3, false); o[12] = fmaf(w, t2[0], o[12]); o[13] = fmaf(w, t2[1], o[13]);
          t2 = __builtin_amdgcn_cvt_pk_f32_fp8(v3, true);  o[14] = fmaf(w, t2[0], o[14]); o[15] = fmaf(w, t2[1], o[15]);
        }
        if (hf == 1) {
          float r8[8], r4[4], r2[2];
#pragma unroll
          for (int i = 0; i < 8; ++i) { const float mine = g2 ? o[i + 8] : o[i], oth = g2 ? o[i] : o[i + 8]; r8[i] = mine + shx(oth, 32, lane); }
#pragma unroll
          for (int i = 0; i < 4; ++i) { const float mine = g1 ? r8[i + 4] : r8[i], oth = g1 ? r8[i] : r8[i + 4]; r4[i] = mine + shx(oth, 16, lane); }
#pragma unroll
          for (int i = 0; i < 2; ++i) { const float mine = g0 ? r4[i + 2] : r4[i], oth = g0 ? r4[i] : r4[i + 2]; r2[i] = mine + shx(oth, 8, lane); }
          if (!dry) {
            const size_t token = (size_t)tb + k;
            GAS float* hp = (GAS float*)p.h + token * D + chan;
            const u32x2 ch = hcur;
            const float h0 = __uint_as_float(ch[0]) + r2[0], h1 = __uint_as_float(ch[1]) + r2[1];
            u32x2 sv; sv[0] = __float_as_uint(h0); sv[1] = __float_as_uint(h1);
            __builtin_nontemporal_store(sv, (GAS u32x2*)hp);
            *(GAS unsigned*)(p.hn + token * D + chan) = pack2(h0, h1);
            if (rss_idx >= 0) {
              const float ss = wave_sum(h0 * h0 + h1 * h1);
              if (lane < 2) p.rss[((size_t)rss_idx * T + token) * 16 + 2 * c + lane] = lane == 0 ? ss : 0.f;
            }
          }
        }
      };
      u32x4 gA[8], gB[8], gC[8];
      issue(0, gA); issue(1, gB);
#pragma unroll
      for (int h3 = 0; h3 < 15; h3 += 3) {
        asm volatile("" ::: "memory");
        issue(h3 + 2, gC); accum(h3, gA);
        asm volatile("" ::: "memory");
        issue(h3 + 3, gA); accum(h3 + 1, gB);
        asm volatile("" ::: "memory");
        if (h3 + 4 < 16) issue(h3 + 4, gB);
        accum(h3 + 2, gC);
      }
      accum(15, gA);
      asm volatile("s_waitcnt lgkmcnt(0)" ::: "memory");
    }
  }
}

DI void phase_final_norm(const int wq, const float* __restrict__ in, const float* __restrict__ g, float* __restrict__ out, int rows) {
  const int tid = ltid(wq); const int bid = lbid();
  const int lane = tid & 63, wv = tid >> 6;
  f32x4v gv[4];
#pragma unroll
  for (int i = 0; i < 4; ++i) gv[i] = *(const f32x4v*)(g + i * 256 + lane * 4);
  for (int r = bid * 4 + wv; r < rows; r += gridDim.x * 4) {
    const float* pr = in + (size_t)r * D;
    u32x4 v[4];
#pragma unroll
    for (int i = 0; i < 4; ++i) v[i] = gload16(pr + i * 256 + lane * 4);
    float ss = 0.f;
#pragma unroll
    for (int i = 0; i < 4; ++i) {
      const float a = __uint_as_float(v[i][0]), b = __uint_as_float(v[i][1]), c = __uint_as_float(v[i][2]), d = __uint_as_float(v[i][3]);
      ss += a * a + b * b + c * c + d * d;
    }
    ss = wave_sum(ss);
    const float rs = rsqrtf(ss / (float)D + 1e-6f);
#pragma unroll
    for (int i = 0; i < 4; ++i) {
      u32x4 ov;
#pragma unroll
      for (int e = 0; e < 4; ++e) ov[e] = __float_as_uint(__uint_as_float(v[i][e]) * rs * gv[i][e]);
      *(GAS u32x4*)(out + (size_t)r * D + i * 256 + lane * 4) = ov;
    }
  }
}

#define PROBE 0
constexpr int SMEM_BYTES = 73728;
__global__ void __launch_bounds__(NT, 2) mega(Params pk) {
  __shared__ __attribute__((aligned(16))) char smem_c[SMEM_BYTES];
  __shared__ uint4 xb_words;
  __shared__ Params sp;
  {
    const unsigned long long* src = (const unsigned long long*)&pk;
    unsigned long long* dst = (unsigned long long*)&sp;
    if (threadIdx.x < sizeof(Params) / 8) dst[threadIdx.x] = src[threadIdx.x];
  }
  if (threadIdx.x == 0) xb_words = make_uint4(0u, 0u, 0u, 0u);
  __syncthreads();
#define p (*lp((const __attribute__((address_space(3))) Params*)&sp))
  float* smem = (float*)smem_c;
  const int wq = __builtin_amdgcn_readfirstlane((int)(threadIdx.x >> 6));
  (void)xcd_barrier_post(p.bar, (volatile LAS unsigned*)&xb_words);
#define GRID_BARRIER() do { XcdBarrier bb_; bb_.bar = p.bar; bb_.x = xb_xcc_id(); bb_.st = (volatile LAS unsigned*)&xb_words; xcd_barrier(bb_); } while (0)

  phase_convert(wq, p.even_w_in, D, EVEN_IN, EVEN_IN, p.w_even_in, EVEN_IN, nullptr, 2, (size_t)D * EVEN_IN, (size_t)EVEN_IN * D, 0, smem, p.mix_norm, 2 * D);
  phase_convert(wq, p.even_pool_w, 128, 128, 128, p.w_even_pool, 128, p.even_pool_scale, 8, 128 * 128, 128 * 128, 128, smem);
  phase_convert(wq, p.even_w_out, D, D, D, p.w_even_out, D, nullptr, 2, (size_t)D * D, (size_t)D * D, 0, smem);
  phase_convert(wq, p.odd_w_in, D, ODD_IN, ODD_IN, p.w_odd_in, 3840, nullptr, 2, (size_t)D * ODD_IN, (size_t)3840 * D, 0, smem, p.mix_norm + D, 2 * D);
  phase_convert(wq, p.odd_w_uv, 128, 64, 64, p.w_odd_uv, 128, nullptr, 16, 128 * 64, 128 * 128, 0, smem);
  phase_convert(wq, p.odd_w_out, D, D, D, p.w_odd_out, D, nullptr, 2, (size_t)D * D, (size_t)D * D, 0, smem);
  phase_convert(wq, p.xattn_wq, D, D, D, p.w_xq, D, nullptr, 4, (size_t)D * D, (size_t)D * D, 0, smem, p.xattn_norm, D);
  phase_convert(wq, p.xattn_wkv, D, 2048, 2048, p.w_xkv, 2048, nullptr, 4, (size_t)D * 2048, (size_t)2048 * D, 0, smem);
  phase_convert(wq, p.xattn_wo, D, D, D, p.w_xo, D, nullptr, 4, (size_t)D * D, (size_t)D * D, 0, smem);
  phase_convert(wq, p.peer_wq, D, 2048, 2048, p.w_pq, 2048, nullptr, 4, (size_t)D * 2048, (size_t)2048 * D, 0, smem, p.peer_norm, D);
  phase_quant_u(wq, p.peer_u, p.u8, p.su, DEPTH * 16384, p.peer_norm);
  phase_cvt_v8(wq, p.peer_v, p.v8, (size_t)DEPTH * 16384 * 1024 / 16);
  phase_cvt_rows(wq, p.peer_keys, p.keys16, (size_t)DEPTH * 16 * 128 * 128 / 8);
  phase_init_h(wq, p.x, p.h, p.hn, p.rss);
  phase_lb(wq, p);
  phase_rmsnorm_bf(wq, p.mem, D, p.mem_norm, p.memn, D, NB * NMEM, D);
  GRID_BARRIER();
  for (int l = 0; l < DEPTH; ++l)
    phase_gemm_bf16<3>(wq, p.memn, D, p.w_xkv + (size_t)l * 2048 * D, p.kvh + (size_t)l * 2 * 2048 * 1024, 2048, NB * NMEM, 2048, D, smem_c, 0);
  GRID_BARRIER();
  for (int l = 0; l < DEPTH; ++l) {
    const int j = l >> 1;
    if ((l & 1) == 0) {
      phase_gemm_bf16<2, 1>(wq, p.hn, D, p.w_even_in + (size_t)j * EVEN_IN * D, p.P16, EVEN_IN, T, EVEN_IN, D, smem_c, 0, 1, 0, 0, 0, 1, 0, 0, p.rss + (size_t)(3 * l) * T * 16);
      GRID_BARRIER();
      phase_evenmix(wq, p, j);
      GRID_BARRIER();
      phase_gemm_bf16<2>(wq, p.pool, 512, p.w_even_pool + (size_t)j * 4 * 128 * 128, p.Y + 512, D, T, 128, 128, smem_c, 0, 4, 128, 128 * 128, 128);
      GRID_BARRIER();
      phase_gemm_bf16<1>(wq, p.Y, D, p.w_even_out + (size_t)j * D * D, p.h, D, T, D, D, smem_c, 0, 1, 0, 0, 0, 1, 0, 0, nullptr, p.hn, p.rss + (size_t)(3 * l + 1) * T * 16);
      GRID_BARRIER();
    } else {
      phase_gemm_bf16<2, 1>(wq, p.hn, D, p.w_odd_in + (size_t)j * 3840 * D, p.P16, ODD_IN, T, ODD_IN, D, smem_c, 0, 1, 0, 0, 0, 1, 0, 0, p.rss + (size_t)(3 * l) * T * 16);
      GRID_BARRIER();
      phase_dsa_prep(wq, p, j);
      GRID_BARRIER();
      phase_dsa_scores(wq, p, smem_c);
      GRID_BARRIER();
      phase_hgrn_scan(wq, p, l, smem_c);
      phase_dsa_attend(wq, p, j, smem_c, 64 * j);
      GRID_BARRIER();
      phase_gemm_bf16<2>(wq, p.lat, D, p.w_odd_uv + (size_t)j * 8 * 128 * 128, p.Y, D, T, 64, 128, smem_c, 0, 8, 128, 128 * 128, 64);
      phase_hgrn_post(wq, p, j);
      GRID_BARRIER();
      phase_gemm_bf16<1>(wq, p.Y, D, p.w_odd_out + (size_t)j * D * D, p.h, D, T, D, D, smem_c, 0, 1, 0, 0, 0, 1, 0, 0, nullptr, p.hn, p.rss + (size_t)(3 * l + 1) * T * 16);
      GRID_BARRIER();
    }
    phase_gemm_bf16<2, 1>(wq, p.hn, D, p.w_xq + (size_t)l * D * D, p.q16, D, T, D, D, smem_c, 0, 1, 0, 0, 0, 1, 0, 0, p.rss + (size_t)(3 * l + 1) * T * 16);
    GRID_BARRIER();
    phase_gemm_bf16<4>(wq, p.q16, D, p.kvh + (size_t)l * 2 * 2048 * 1024, p.sx, 256, S, 256, 256, smem_c, 0, 32, (size_t)S * D, 256 * 256, (size_t)S * 1024, 4, 256, (size_t)S * 256);
    GRID_BARRIER();
    phase_softmax256(wq, (const bf16_t*)p.sx, p.p16, T * 4);
    GRID_BARRIER();
    phase_gemm_bf16<2>(wq, p.p16, 256, p.kvh + (size_t)l * 2 * 2048 * 1024 + (size_t)2048 * 1024, p.Y, D, S, 256, 256, smem_c, 0, 32, (size_t)S * 1024, 256 * 256, (size_t)S * D, 4, (size_t)S * 256, 256);
    GRID_BARRIER();
    phase_gemm_bf16<1>(wq, p.Y, D, p.w_xo + (size_t)l * D * D, p.h, D, T, D, D, smem_c, 0, 1, 0, 0, 0, 1, 0, 0, nullptr, p.hn, p.rss + (size_t)(3 * l + 2) * T * 16);
    GRID_BARRIER();
    phase_peer_qs(wq, p.hn, p.w_pq + (size_t)l * 2048 * D, p.keys16 + (size_t)l * 16 * 128 * 128, p.tops, smem_c, p.rss + (size_t)(3 * l + 2) * T * 16);
    GRID_BARRIER();
    phase_peer_combine8(wq, p, l, smem_c, p.rss + (size_t)(3 * l + 2) * T * 16);
    GRID_BARRIER();
    phase_peer_udot8(wq, p, l, smem_c, 256 + (l * 2 + 0) * 128);
    GRID_BARRIER();
    phase_peer_w(wq, p);
    GRID_BARRIER();
    phase_peer_vacc8(wq, p, l, smem_c, 256 + (l * 2 + 1) * 128, 0, l + 1 < DEPTH ? 3 * l + 3 : -1);
    GRID_BARRIER();
  }
  phase_final_norm(wq, p.h, p.final_norm, p.out, T);
}

#undef p
extern "C" void kernel_launch(void* const* d_in, const int* in_sizes, int n_in, void* d_out, int out_size, void* d_ws, size_t ws_size,
                              hipStream_t stream) {
  Params p; memset(&p, 0, sizeof(p));
  const float* const* in = (const float* const*)d_in;
  p.x = in[0]; p.mem = in[1]; p.mix_norm = in[2]; p.even_w_in = in[3]; p.even_conv_w = in[4]; p.even_pool_w = in[5];
  p.even_pool_scale = in[6]; p.even_w_out = in[7]; p.odd_w_in = in[8]; p.odd_kv_norm = in[9]; p.odd_w_uv = in[10];
  p.odd_hg_norm = in[11]; p.odd_w_out = in[12]; p.hgrn_gamma = in[13]; p.rel_bias = in[14]; p.mem_norm = in[15];
  p.xattn_norm = in[16]; p.xattn_wq = in[17]; p.xattn_wkv = in[18]; p.xattn_wo = in[19]; p.peer_norm = in[20];
  p.peer_wq = in[21]; p.peer_keys = in[22]; p.peer_u = in[23]; p.peer_v = in[24]; p.final_norm = in[25];
  p.out = (float*)d_out;
  char* w = (char*)d_ws;
  auto take = [&](size_t bytes) { char* r = w; w += (bytes + 255) / 256 * 256; return r; };
  p.bar = (unsigned*)take((XCD_BAR_WORDS + 2048) * 4); p.qctr = p.bar + XCD_BAR_WORDS;
  p.h = (float*)take((size_t)T * D * 4); p.P = (float*)take((size_t)T * ODD_IN * 4); p.P16 = (bf16_t*)p.P;
  p.oraw = (float*)take((size_t)T * 512 * 4); p.lb = (float*)take(DEPTH * 512 * 4);
  p.hn = (bf16_t*)take((size_t)T * D * 2); p.Y = (bf16_t*)take((size_t)T * D * 2); p.pool = (bf16_t*)take((size_t)T * 512 * 2);
  p.memn = (bf16_t*)take((size_t)NB * NMEM * D * 2); p.lat = (bf16_t*)take((size_t)T * D * 2);
  p.w_even_in = (bf16_t*)take((size_t)2 * EVEN_IN * D * 2); p.w_even_pool = (bf16_t*)take((size_t)8 * 128 * 128 * 2);
  p.w_even_out = (bf16_t*)take((size_t)2 * D * D * 2); p.w_odd_in = (bf16_t*)take((size_t)2 * 3840 * D * 2);
  p.w_odd_uv = (bf16_t*)take((size_t)16 * 128 * 128 * 2); p.w_odd_out = (bf16_t*)take((size_t)2 * D * D * 2);
  p.w_xq = (bf16_t*)take((size_t)4 * D * D * 2); p.w_xkv = (bf16_t*)take((size_t)4 * 2048 * D * 2); p.w_xo = (bf16_t*)take((size_t)4 * D * D * 2);
  p.w_pq = (bf16_t*)take((size_t)4 * 2048 * D * 2);
  p.u8 = (signed char*)take((size_t)DEPTH * 16384 * 1024); p.v8 = (signed char*)take((size_t)DEPTH * 16384 * 1024); p.x8 = (signed char*)take((size_t)T * 1024);
  p.su = (float*)take((size_t)DEPTH * 16384 * 4); p.sxq = (float*)take((size_t)T * 4); p.sel_su = (float*)take((size_t)T * 128 * 4);
  p.keys16 = (bf16_t*)take((size_t)DEPTH * 16 * 128 * 128 * 2); p.kvh = (bf16_t*)take((size_t)DEPTH * 2 * 2048 * 1024 * 2); p.rss = (float*)take((size_t)12 * T * 16 * 4);
  {
    char* a = (char*)p.P;
    p.sx = (float*)a; a += (size_t)T * 4 * 256 * 4;
    p.p16 = (bf16_t*)a; a += (size_t)T * 4 * 256 * 2;
    p.q16 = (bf16_t*)a; a += (size_t)T * D * 2;
    p.tops = (int*)a; a += (size_t)T * 256 * 4;
    p.sel_id = (int*)a; a += (size_t)T * 128 * 4;
    p.sel_g = (float*)a; a += (size_t)T * 128 * 4;
    p.pbuf = (float*)a;
  }
  p.qlat16 = (bf16_t*)take((size_t)T * 1024 * 2); p.ckv16 = (bf16_t*)take((size_t)T * 128 * 2); p.iq16 = (bf16_t*)take((size_t)T * 512 * 2);
  p.ik16 = (bf16_t*)take((size_t)T * 64 * 2); p.sc = (float*)take((size_t)T * 2048 * 4);

  p.probe = 1;
  static int grid = 0;
  if (!grid) {
    int dev = 0, cus = 0, per_cu = 0;
    (void)hipGetDevice(&dev);
    (void)hipDeviceGetAttribute(&cus, hipDeviceAttributeMultiprocessorCount, dev);
    (void)hipOccupancyMaxActiveBlocksPerMultiprocessor(&per_cu, mega, NT, 0);
    if (per_cu > 2) per_cu = 2;
    if (per_cu < 1) per_cu = 1;
    grid = cus * per_cu;
  }
  (void)hipMemsetAsync(p.bar, 0, (XCD_BAR_WORDS + 2048) * sizeof(unsigned), stream);
  mega<<<grid, NT, 0, stream>>>(p);
}
```

```cpp
#include <hip/hip_runtime.h>
#include <hip/hip_bf16.h>
#include <stdint.h>
#include <math.h>
#include <string.h>

#define DI __device__ __forceinline__

constexpr int D = 1024, NB = 8, S = 2048, T = NB * S, DEPTH = 4, NMEM = 256;
constexpr int EVEN_IN = 2048, ODD_IN = 3784;
constexpr int NT = 256;

typedef unsigned short bf16_t;
struct Params {
  const float *x, *mem, *mix_norm, *even_w_in, *even_conv_w, *even_pool_w, *even_pool_scale, *even_w_out;
  const float *odd_w_in, *odd_kv_norm, *odd_w_uv, *odd_hg_norm, *odd_w_out, *hgrn_gamma, *rel_bias, *mem_norm;
  const float *xattn_norm, *xattn_wq, *xattn_wkv, *xattn_wo, *peer_norm, *peer_wq, *peer_keys, *peer_u, *peer_v, *final_norm;
  float* out;
  float *h, *P, *kv, *ckv, *oraw, *lb; bf16_t* P16;
  bf16_t *hn, *Y, *pool, *memn, *lat;
  bf16_t *u16, *v16, *keys16; int* tops; signed char *u8, *v8, *x8; float *su, *sxq, *sel_su;
  float* rss;
  bf16_t *q16, *kvh, *p16; float* sx; int* sel_id; float* sel_g; float* pbuf;
  bf16_t *qlat16, *ckv16, *iq16, *ik16; float* sc; unsigned* qctr;
  bf16_t *w_even_in, *w_even_pool, *w_even_out, *w_odd_in, *w_odd_uv, *w_odd_out, *w_xq, *w_xkv, *w_xo, *w_pq;
  unsigned* bar;
  int probe, pad_;
};

#define XB_TMO      128
#define XB_XCNT(j)  (256  + 64 * (j))
#define XB_XSUB(j)  (1280 + 64 * (j))
#define XB_XGEN(j)  (2304 + 64 * (j))
#define XB_TOP      3328
#define XB_TOPGEN   3392
#define XCD_BAR_WORDS 3456
#define XB_SPIN_CAP (1u << 18)
#define LAS __attribute__((address_space(3)))

__device__ __forceinline__ unsigned xb_ld(unsigned* p)              { return __hip_atomic_load(p, __ATOMIC_RELAXED, __HIP_MEMORY_SCOPE_AGENT); }
__device__ __forceinline__ unsigned xb_add(unsigned* p, unsigned v) { return __hip_atomic_fetch_add(p, v, __ATOMIC_RELAXED, __HIP_MEMORY_SCOPE_AGENT); }
__device__ __forceinline__ unsigned xb_xcc_id() { return (unsigned)__builtin_amdgcn_s_getreg((3 << 11) | 20) & 0xFu; }
#define XB_SPIN(cond, bar) do { unsigned _sp = 0; while (cond) { __builtin_amdgcn_s_sleep(1); \
    if ((++_sp & 255u) == 0u) { if (xb_ld(&(bar)[XB_TMO])) break; if (_sp > XB_SPIN_CAP) { atomicAdd(&(bar)[XB_TMO], 1u); break; } } } } while (0)

typedef const __attribute__((address_space(3))) Params& PRef;
DI const __attribute__((address_space(3))) Params* lp(const __attribute__((address_space(3))) Params* q) { asm volatile("" : "+v"(q)); return q; }
struct XcdBarrier {
    unsigned* bar; unsigned x;
    volatile LAS unsigned* st;
};

__device__ __forceinline__ XcdBarrier xcd_barrier_post(unsigned* bar, volatile LAS unsigned* st) {
    XcdBarrier b; b.bar = bar; b.x = xb_xcc_id(); b.st = st;
    if (threadIdx.x == 0) (void)xb_add(&bar[XB_XCNT(b.x)], 1u);
    return b;
}
__device__ __forceinline__ void xcd_barrier_complete(unsigned* bar, unsigned x, unsigned& nloc, unsigned& nx) {
    const unsigned G = gridDim.x * gridDim.y * gridDim.z;
    unsigned sum, cnt, mine, sp = 0u;
    for (;;) {
        sum = 0u; cnt = 0u; mine = 0u;
#pragma unroll
        for (unsigned j = 0; j < 16; ++j) { const unsigned c = xb_ld(&bar[XB_XCNT(j)]); sum += c; cnt += (c > 0u) ? 1u : 0u; mine = (j == x) ? c : mine; }
        if (sum == G) break;
        __builtin_amdgcn_s_sleep(1);
        if ((++sp & 255u) == 0u) { if (xb_ld(&bar[XB_TMO])) break; if (sp > XB_SPIN_CAP) { atomicAdd(&bar[XB_TMO], 1u); break; } }
    }
    nloc = mine > 0u ? mine : 1u; nx = cnt > 0u ? cnt : 1u;
}

__device__ __forceinline__ void xcd_barrier(const XcdBarrier& b) {
    asm volatile("s_waitcnt vmcnt(0)" ::: "memory");
    __syncthreads();
    if (threadIdx.x == 0) {
        unsigned* bar = b.bar;
        __builtin_amdgcn_s_waitcnt(0);
        unsigned nloc = b.st[0], nx = b.st[1];
        if (nloc == 0u) { xcd_barrier_complete(bar, b.x, nloc, nx); b.st[0] = nloc; b.st[1] = nx; }
        const unsigned old = xb_add(&bar[XB_XSUB(b.x)], 1u);
        const unsigned gen = old / nloc;
        if (old + 1u == (gen + 1u) * nloc) {
            __builtin_amdgcn_fence(__ATOMIC_RELEASE, "agent");
            asm volatile("s_waitcnt vmcnt(0)" ::: "memory");
            const unsigned og = xb_add(&bar[XB_TOP], 1u);
            const unsigned tg = og / nx;
            if (og + 1u == (tg + 1u) * nx) xb_add(&bar[XB_TOPGEN], 1u);
            else XB_SPIN(xb_ld(&bar[XB_TOPGEN]) == tg, bar);
            __builtin_amdgcn_fence(__ATOMIC_ACQUIRE, "agent");
            xb_add(&bar[XB_XGEN(b.x)], 1u);
            asm volatile("s_waitcnt vmcnt(0)" ::: "memory");
        } else {
            XB_SPIN(xb_ld(&bar[XB_XGEN(b.x)]) == gen, bar);
            __builtin_amdgcn_fence(__ATOMIC_ACQUIRE, "agent");
            asm volatile("s_waitcnt vmcnt(0)" ::: "memory");
        }
    }
    __syncthreads();
}


typedef __bf16 bf16x2_t __attribute__((ext_vector_type(2)));
typedef float f32x2_t __attribute__((ext_vector_type(2)));
using bf16x8 = __attribute__((ext_vector_type(8))) short;
using f32x16 = __attribute__((ext_vector_type(16))) float;
using u32x4 = __attribute__((ext_vector_type(4))) unsigned;
using u32x2 = __attribute__((ext_vector_type(2))) unsigned;
using f32x4v = __attribute__((ext_vector_type(4))) float;
using f32x2v = __attribute__((ext_vector_type(2))) float;
#define GAS __attribute__((address_space(1)))
typedef const GAS u32x4* gp_u32x4;
DI u32x4 gload16(const void* p) { return *(gp_u32x4)(p); }
DI bf16_t f2bf(float f) { __bf16 b = (__bf16)f; return __builtin_bit_cast(unsigned short, b); }
DI unsigned pack2(float a, float b) { f32x2_t v = {a, b}; bf16x2_t r = __builtin_convertvector(v, bf16x2_t); return __builtin_bit_cast(unsigned, r); }
DI float bf2f(bf16_t u) { return __uint_as_float(((unsigned)u) << 16); }
DI float bflo(unsigned u) { return __uint_as_float(u << 16); }
DI float bfhi(unsigned u) { return __uint_as_float(u & 0xffff0000u); }
DI f32x4v bf4_to_f(const u32x2 v) { const unsigned a = v[0], b = v[1]; f32x4v r; r[0] = bflo(a); r[1] = bfhi(a); r[2] = bflo(b); r[3] = bfhi(b); return r; }
DI int ltid(int wq) { int t; asm volatile("v_mbcnt_lo_u32_b32 %0, -1, 0\n\tv_mbcnt_hi_u32_b32 %0, -1, %0" : "=v"(t)); return (wq << 6) | t; }
DI int lbid() { int b = blockIdx.x; asm volatile("" : "+s"(b)); return b; }
#define DPP_F(v, ctrl, rmask, bctl) __int_as_float(__builtin_amdgcn_update_dpp(0, __float_as_int(v), (ctrl), (rmask), 0xF, (bctl)))
DI float wave_sum(float v) {
  v += DPP_F(v, 0xB1, 0xF, true);
  v += DPP_F(v, 0x4E, 0xF, true);
  v += DPP_F(v, 0x141, 0xF, true);
  v += DPP_F(v, 0x140, 0xF, true);
  v += DPP_F(v, 0x142, 0xA, false);
  v += DPP_F(v, 0x143, 0xC, false);
  return __int_as_float(__builtin_amdgcn_readlane(__float_as_int(v), 63));
}
#define DPP_I(v, ctrl, rmask, bctl) __builtin_amdgcn_update_dpp(0, (v), (ctrl), (rmask), 0xF, (bctl))
DI int wave_sum_i(int v) {
  v += DPP_I(v, 0xB1, 0xF, true); v += DPP_I(v, 0x4E, 0xF, true); v += DPP_I(v, 0x141, 0xF, true); v += DPP_I(v, 0x140, 0xF, true);
  v += DPP_I(v, 0x142, 0xA, false); v += DPP_I(v, 0x143, 0xC, false);
  return __builtin_amdgcn_readlane(v, 63);
}
DI float wave_max(float v) {
  v = fmaxf(v, DPP_F(v, 0xB1, 0xF, true));
  v = fmaxf(v, DPP_F(v, 0x4E, 0xF, true));
  v = fmaxf(v, DPP_F(v, 0x141, 0xF, true));
  v = fmaxf(v, DPP_F(v, 0x140, 0xF, true));
  { const float t = __int_as_float(__builtin_amdgcn_update_dpp(__float_as_int(v), __float_as_int(v), 0x142, 0xA, 0xF, false)); v = fmaxf(v, t); }
  { const float t = __int_as_float(__builtin_amdgcn_update_dpp(__float_as_int(v), __float_as_int(v), 0x143, 0xC, 0xF, false)); v = fmaxf(v, t); }
  return __int_as_float(__builtin_amdgcn_readlane(__float_as_int(v), 63));
}
DI float rowsum16(float v) { v += DPP_F(v, 0x128, 0xF, true); v += DPP_F(v, 0x124, 0xF, true); v += DPP_F(v, 0x122, 0xF, true); v += DPP_F(v, 0x121, 0xF, true); return v; }
DI float rowmax16(float v) { v = fmaxf(v, DPP_F(v, 0x128, 0xF, true)); v = fmaxf(v, DPP_F(v, 0x124, 0xF, true)); v = fmaxf(v, DPP_F(v, 0x122, 0xF, true)); v = fmaxf(v, DPP_F(v, 0x121, 0xF, true)); return v; }
DI float shx(float v, int mask, int lane) { return __int_as_float(__builtin_amdgcn_ds_bpermute((lane ^ mask) << 2, __float_as_int(v))); }
DI int shxi(int v, int mask, int lane) { return __builtin_amdgcn_ds_bpermute((lane ^ mask) << 2, v); }
DI float gelu_tanh(float x) {
  const float k0 = 0.7978845608028654f, k1 = 0.044715f;
  return 0.5f * x * (1.f + tanhf(k0 * (x + k1 * x * x * x)));
}
DI float sigmoidf(float x) { return 1.f / (1.f + expf(-x)); }

DI float rstd_of(const float* __restrict__ rss, int row) {
  const float* q = rss + (size_t)row * 16;
  const f32x4v a = *(const f32x4v*)q, b = *(const f32x4v*)(q + 4), c = *(const f32x4v*)(q + 8), d = *(const f32x4v*)(q + 12);
  const float s0 = (a[0] + a[1]) + (a[2] + a[3]), s1 = (b[0] + b[1]) + (b[2] + b[3]), s2 = (c[0] + c[1]) + (c[2] + c[3]), s3 = (d[0] + d[1]) + (d[2] + d[3]);
  return rsqrtf(((s0 + s1) + (s2 + s3)) * (1.f / 1024.f) + 1e-6f);
}
DI void phase_init_h(const int wq, const float* __restrict__ x, float* __restrict__ h, bf16_t* __restrict__ hb, float* __restrict__ rss) {
  const int tid = ltid(wq); const int bid = lbid();
  const int lane = tid & 63, wv = tid >> 6;
  for (int r = bid * 4 + wv; r < T; r += gridDim.x * 4) {
    float ss = 0.f;
#pragma unroll
    for (int i = 0; i < 4; ++i) {
      const u32x4 v = gload16(x + (size_t)r * D + i * 256 + lane * 4);
      const unsigned v0 = v[0], v1 = v[1], v2 = v[2], v3 = v[3];
      const float a = __uint_as_float(v0), b = __uint_as_float(v1), c = __uint_as_float(v2), d = __uint_as_float(v3);
      ss += a * a + b * b + c * c + d * d;
      *(GAS u32x4*)(h + (size_t)r * D + i * 256 + lane * 4) = v;
      u32x2 o; o[0] = pack2(a, b); o[1] = pack2(c, d);
      *(GAS u32x2*)(hb + (size_t)r * D + i * 256 + lane * 4) = o;
    }
    ss = wave_sum(ss);
    if (lane < 16) rss[(size_t)r * 16 + lane] = lane == 0 ? ss : 0.f;
  }
}

DI void phase_rmsnorm_bf(const int wq, const float* __restrict__ in, int ldi, const float* __restrict__ g, bf16_t* __restrict__ out, int ldo, int rows, int W) {
  const int tid_ = ltid(wq); const int bid_ = lbid();
  const int lane = tid_ & 63, wv = tid_ >> 6;
  f32x4v gv[4];
#pragma unroll
  for (int i = 0; i < 4; ++i) gv[i] = *(const f32x4v*)(g + i * 256 + lane * 4);
  for (int r = bid_ * 4 + wv; r < rows; r += gridDim.x * 4) {
    const float* p = in + (size_t)r * ldi;
    u32x4 v[4];
#pragma unroll
    for (int i = 0; i < 4; ++i) v[i] = gload16(p + i * 256 + lane * 4);
    float ss = 0.f;
#pragma unroll
    for (int i = 0; i < 4; ++i) {
      const float a = __uint_as_float(v[i][0]), b = __uint_as_float(v[i][1]), c = __uint_as_float(v[i][2]), d = __uint_as_float(v[i][3]);
      ss += a * a + b * b + c * c + d * d;
    }
    ss = wave_sum(ss);
    const float rs = rsqrtf(ss / (float)W + 1e-6f);
    bf16_t* o = out + (size_t)r * ldo;
#pragma unroll
    for (int i = 0; i < 4; ++i) {
      u32x2 ov;
      ov[0] = pack2(__uint_as_float(v[i][0]) * rs * gv[i][0], __uint_as_float(v[i][1]) * rs * gv[i][1]);
      ov[1] = pack2(__uint_as_float(v[i][2]) * rs * gv[i][2], __uint_as_float(v[i][3]) * rs * gv[i][3]);
      *(GAS u32x2*)(o + i * 256 + lane * 4) = ov;
    }
  }
}

DI void phase_convert(const int wq, const float* __restrict__ W0, int K, int N, int ldw, bf16_t* __restrict__ Bt0, int Npad, const float* __restrict__ cs0,
                      int nbatch, size_t sW, size_t sBt, size_t sCS, float* smem, const float* __restrict__ rs0 = nullptr, size_t sRS = 0) {
  const int tid = ltid(wq); const int bid = lbid();
  float (*tl)[65] = (float (*)[65])smem;
  const int tk = K / 64, tn = Npad / 64;
  for (int tile0 = bid; tile0 < tk * tn * nbatch; tile0 += gridDim.x) {
    const int bt = tile0 / (tk * tn), tile = tile0 % (tk * tn);
    const int k0 = (tile / tn) * 64, n0 = (tile % tn) * 64;
    const float* W = W0 + (size_t)bt * sW;
    bf16_t* Bt = Bt0 + (size_t)bt * sBt;
    __syncthreads();
    {
      const int n = tid & 63, kb = tid >> 6;
      const bool inb = n0 + n < N;
      float vv[16];
#pragma unroll
      for (int i = 0; i < 16; ++i) vv[i] = inb ? W[(size_t)(k0 + i * 4 + kb) * ldw + n0 + n] : 0.f;
      const float csv = (inb && cs0) ? cs0[(size_t)bt * sCS + n0 + n] : 1.f;
#pragma unroll
      for (int i = 0; i < 16; ++i) {
        float v = vv[i] * csv;
        if (rs0) v *= rs0[(size_t)bt * sRS + k0 + i * 4 + kb];
        tl[i * 4 + kb][n] = v;
      }
    }
    __syncthreads();
    {
      const int k8 = (tid & 7) * 8;
#pragma unroll
      for (int i = 0; i < 2; ++i) {
        const int n = (tid >> 3) + 32 * i;
        u32x4 o;
#pragma unroll
        for (int q = 0; q < 4; ++q) o[q] = pack2(tl[k8 + 2 * q][n], tl[k8 + 2 * q + 1][n]);
        *(GAS u32x4*)(Bt + (size_t)(n0 + n) * K + k0 + k8) = o;
      }
    }
  }
}

constexpr int G_LDS_ROW = 144;
constexpr int G_TILE_B = 128 * G_LDS_ROW;
template <int MODE, int RS = 0>
DI void phase_gemm_bf16(const int wq, const bf16_t* __restrict__ A0, int lda, const bf16_t* __restrict__ B0, void* __restrict__ C0, int ldc,
                        int M, int N, int K, char* smem, int dry, int nbatch = 1, size_t sA = 0, size_t sB = 0, size_t sC = 0,
                        int inner = 1, size_t sA2 = 0, size_t sC2 = 0, const float* __restrict__ rss_in = nullptr, bf16_t* __restrict__ hb_out = nullptr, float* __restrict__ rss_out = nullptr) {
  const int tid = ltid(wq); const int bid = lbid();
  const int lane = tid & 63, wv = tid >> 6, wm = wv >> 1, wn = wv & 1;
  const int r = lane & 31, hh = lane >> 5;
  const int tm = M / 128, tn = (N + 127) / 128;
  const int nk = K / 64;
  const int srow = tid >> 3, skc = tid & 7;
  const int ntile_all = tm * tn * nbatch;
  const int per_x = (ntile_all + 7) >> 3;
  const int t_beg = (bid & 7) * per_x, t_end = (t_beg + per_x < ntile_all) ? t_beg + per_x : ntile_all;
  for (int tile0 = t_beg + (bid >> 3); tile0 < t_end; tile0 += (int)(gridDim.x >> 3)) {
    const int bt = tile0 / (tm * tn), tile = tile0 % (tm * tn);
    const int m0 = (tile / tn) * 128, n0 = (tile % tn) * 128;
    const int bhi = bt / inner, blo = bt % inner;
    const bf16_t* Ag = A0 + (size_t)bhi * sA + (size_t)blo * sA2 + (size_t)(m0 + srow) * lda + skc * 8;
    const bf16_t* Bg = B0 + (size_t)bt * sB + (size_t)(n0 + srow) * K + skc * 8;
    f32x16 acc[2][2];
#pragma unroll
    for (int i = 0; i < 2; ++i)
#pragma unroll
      for (int j = 0; j < 2; ++j)
#pragma unroll
        for (int e = 0; e < 16; ++e) acc[i][j][e] = 0.f;
    u32x4 ra[4], rb[4];
#pragma unroll
    for (int i = 0; i < 4; ++i) {
      ra[i] = gload16(Ag + (size_t)(32 * i) * lda);
      rb[i] = gload16(Bg + (size_t)(32 * i) * K);
    }
    __syncthreads();
#pragma unroll
    for (int i = 0; i < 4; ++i) {
      *(u32x4*)(smem + (srow + 32 * i) * G_LDS_ROW + skc * 16) = ra[i];
      *(u32x4*)(smem + 2 * G_TILE_B + (srow + 32 * i) * G_LDS_ROW + skc * 16) = rb[i];
    }
    __syncthreads();
#pragma unroll 1
    for (int kt = 0; kt < nk; ++kt) {
      const int cur = kt & 1;
      if (kt + 1 < nk) {
#pragma unroll
        for (int i = 0; i < 4; ++i) {
          ra[i] = gload16(Ag + (size_t)(32 * i) * lda + (kt + 1) * 64);
          rb[i] = gload16(Bg + (size_t)(32 * i) * K + (kt + 1) * 64);
        }
      }
      const char* As = smem + cur * G_TILE_B + (wm * 64 + r) * G_LDS_ROW + hh * 16;
      const char* Bs = smem + 2 * G_TILE_B + cur * G_TILE_B + (wn * 64 + r) * G_LDS_ROW + hh * 16;
#pragma unroll
      for (int ks = 0; ks < 4; ++ks) {
        bf16x8 a0 = *(const bf16x8*)(As + ks * 32);
        bf16x8 a1 = *(const bf16x8*)(As + 32 * G_LDS_ROW + ks * 32);
        bf16x8 b0 = *(const bf16x8*)(Bs + ks * 32);
        bf16x8 b1 = *(const bf16x8*)(Bs + 32 * G_LDS_ROW + ks * 32);
        acc[0][0] = __builtin_amdgcn_mfma_f32_32x32x16_bf16(a0, b0, acc[0][0], 0, 0, 0);
        acc[0][1] = __builtin_amdgcn_mfma_f32_32x32x16_bf16(a0, b1, acc[0][1], 0, 0, 0);
        acc[1][0] = __builtin_amdgcn_mfma_f32_32x32x16_bf16(a1, b0, acc[1][0], 0, 0, 0);
        acc[1][1] = __builtin_amdgcn_mfma_f32_32x32x16_bf16(a1, b1, acc[1][1], 0, 0, 0);
      }
      if (kt + 1 < nk) {
        const int nxt = cur ^ 1;
#pragma unroll
        for (int i = 0; i < 4; ++i) {
          *(u32x4*)(smem + nxt * G_TILE_B + (srow + 32 * i) * G_LDS_ROW + skc * 16) = ra[i];
          *(u32x4*)(smem + 2 * G_TILE_B + nxt * G_TILE_B + (srow + 32 * i) * G_LDS_ROW + skc * 16) = rb[i];
        }
      }
      __syncthreads();
    }
    if (RS) {
      if (tid < 128) ((float*)smem)[tid] = rstd_of(rss_in, m0 + tid);
      __syncthreads();
    }
#pragma unroll
    for (int i = 0; i < 2; ++i)
#pragma unroll
      for (int j = 0; j < 2; ++j) {
        const int col = n0 + wn * 64 + j * 32 + r;
        if (col < N && !dry) {
          const size_t base = (size_t)bhi * sC + (size_t)blo * sC2 + (size_t)(m0 + wm * 64 + i * 32 + 4 * hh) * ldc + col;
          if (RS) {
            const float* rp = (const float*)smem + wm * 64 + i * 32 + 4 * hh;
#pragma unroll
            for (int e = 0; e < 16; ++e) acc[i][j][e] *= rp[(e & 3) + 8 * (e >> 2)];
          }
          if (MODE == 1) {
            GAS float* cp = (GAS float*)C0 + base;
            float old[16];
#pragma unroll
            for (int e = 0; e < 16; ++e) old[e] = cp[(size_t)((e & 3) + 8 * (e >> 2)) * ldc];
#pragma unroll
            for (int e = 0; e < 16; ++e) { old[e] += acc[i][j][e]; acc[i][j][e] = old[e]; cp[(size_t)((e & 3) + 8 * (e >> 2)) * ldc] = old[e]; }
            if (hb_out) {
              GAS bf16_t* hp = (GAS bf16_t*)hb_out + base;
#pragma unroll
              for (int e = 0; e < 16; ++e) hp[(size_t)((e & 3) + 8 * (e >> 2)) * ldc] = f2bf(old[e]);
            }
          } else if (MODE == 0) {
            GAS float* cp = (GAS float*)C0 + base;
#pragma unroll
            for (int e = 0; e < 16; ++e) cp[(size_t)((e & 3) + 8 * (e >> 2)) * ldc] = acc[i][j][e];
          } else if (MODE == 2) {
            GAS bf16_t* cp = (GAS bf16_t*)C0 + base;
#pragma unroll
            for (int e = 0; e < 16; ++e) cp[(size_t)((e & 3) + 8 * (e >> 2)) * ldc] = f2bf(acc[i][j][e]);
          } else if (MODE == 4) {
            GAS bf16_t* cp = (GAS bf16_t*)C0 + base;
#pragma unroll
            for (int e = 0; e < 16; ++e) cp[(size_t)((e & 3) + 8 * (e >> 2)) * ldc] = f2bf(acc[i][j][e] * 0.0625f);
          } else {
            const int rowb = m0 + wm * 64 + i * 32 + 4 * hh;
            const int b_ = rowb >> 8, mm = rowb & 255;
            const int cc = col & 1023, hd_ = cc >> 8, dd = cc & 255;
            GAS bf16_t* kb = (GAS bf16_t*)C0;
            if (col < 1024) {
#pragma unroll
              for (int e = 0; e < 16; ++e) kb[((size_t)(b_ * 4 + hd_) * 256 + mm + (e & 3) + 8 * (e >> 2)) * 256 + dd] = f2bf(acc[i][j][e]);
            } else {
#pragma unroll
              for (int e = 0; e < 16; ++e) kb[(size_t)2048 * 1024 + ((size_t)(b_ * 4 + hd_) * 256 + dd) * 256 + mm + (e & 3) + 8 * (e >> 2)] = f2bf(acc[i][j][e]);
            }
          }
        }
      }
    if (MODE == 1 && rss_out && !dry) {
#pragma unroll
      for (int i = 0; i < 2; ++i) {
        float myv = 0.f;
#pragma unroll
        for (int e = 0; e < 16; ++e) {
          float v = acc[i][0][e] * acc[i][0][e] + acc[i][1][e] * acc[i][1][e];
          v = rowsum16(v);
          v += shx(v, 16, lane);
          if ((lane & 15) == e) myv = v;
        }
        if ((lane & 16) == 0) rss_out[(size_t)(m0 + wm * 64 + i * 32 + (lane & 3) + 8 * ((lane & 15) >> 2) + 4 * hh) * 16 + (n0 >> 7) * 2 + wn] = myv;
      }
    }
  }
}

template <int W>
DI void evenmix_run(const bf16_t* __restrict__ P, const float* __restrict__ cw, bf16_t* __restrict__ Y, bf16_t* __restrict__ pool, int t0, int c) {
  const int s0 = t0 & (S - 1);
  f32x4v w0 = *(const f32x4v*)(cw + c), w1 = *(const f32x4v*)(cw + 512 + c), w2 = *(const f32x4v*)(cw + 1024 + c);
  const f32x4v zero = {0.f, 0.f, 0.f, 0.f};
  auto ld = [&](int t, int off) { const u32x2 v = *(const GAS u32x2*)(P + (size_t)t * EVEN_IN + off + c); return bf4_to_f(v); };
  f32x4v xm2 = zero, xm1 = zero;
  if (s0 >= 2) xm2 = ld(t0 - 2, 512) * ld(t0 - 2, 0);
  if (s0 >= 1) xm1 = ld(t0 - 1, 512) * ld(t0 - 1, 0);
  f32x4v ring[W];
  f32x4v sum = zero;
#pragma unroll
  for (int i = 0; i < W; ++i) { ring[i] = (s0 + i - W >= 0) ? ld(t0 + i - W, 1536) : zero; sum += ring[i]; }
#pragma unroll
  for (int tt = 0; tt < 32; ++tt) {
    const int t = t0 + tt;
    const f32x4v x0 = ld(t, 512) * ld(t, 0);
    const f32x4v z = w0 * xm2 + w1 * xm1 + w2 * x0;
    xm2 = xm1; xm1 = x0;
    const f32x4v ya = ld(t, 1024) * z;
    const f32x4v pv = ld(t, 1536);
    sum += pv - ring[tt % W]; ring[tt % W] = pv;
    const int cnt = (s0 + tt + 1 < W) ? (s0 + tt + 1) : W;
    const float ic = 1.f / (float)cnt;
    const f32x4v pl = sum * ic - pv;
    u32x2 oa, ob;
    oa[0] = pack2(ya[0], ya[1]); oa[1] = pack2(ya[2], ya[3]);
    ob[0] = pack2(pl[0], pl[1]); ob[1] = pack2(pl[2], pl[3]);
    *(GAS u32x2*)(Y + (size_t)t * D + c) = oa;
    *(GAS u32x2*)(pool + (size_t)t * 512 + c) = ob;
  }
}
DI void phase_evenmix(const int wq, PRef p, int j) {
  const int tid = ltid(wq); const int bid = lbid();
  const int lane = tid & 63, wv = tid >> 6;
  const float* cw = p.even_conv_w + (size_t)j * 3 * 512;
  for (int Wg = bid * 4 + wv; Wg < 1024; Wg += gridDim.x * 4) {
    const int g = Wg & 3, cp = Wg >> 2;
    const int t0 = (cp * 2 + (lane >> 5)) * 32;
    const int c = g * 128 + (lane & 31) * 4;
    if (g == 0) evenmix_run<2>(p.P16, cw, p.Y, p.pool, t0, c);
    else if (g == 1) evenmix_run<4>(p.P16, cw, p.Y, p.pool, t0, c);
    else if (g == 2) evenmix_run<8>(p.P16, cw, p.Y, p.pool, t0, c);
    else evenmix_run<16>(p.P16, cw, p.Y, p.pool, t0, c);
  }
}

DI void phase_lb(const int wq, PRef p) {
  const int tid_ = ltid(wq); const int bid_ = lbid(); (void)tid_; (void)bid_;
  for (int c = bid_ * NT + tid_; c < 512; c += gridDim.x * NT) {
    float g[DEPTH], m = -INFINITY;
#pragma unroll
    for (int l = 0; l < DEPTH; ++l) { g[l] = p.hgrn_gamma[l * 512 + c]; m = fmaxf(m, g[l]); }
    float sum = 0.f;
#pragma unroll
    for (int l = 0; l < DEPTH; ++l) { g[l] = expf(g[l] - m); sum += g[l]; }
    float cum = 0.f;
#pragma unroll
    for (int l = 0; l < DEPTH; ++l) { p.lb[l * 512 + c] = cum; cum += g[l] / sum; }
  }
}

DI int t5_bucket(int dist) {
  const int d = dist < 0 ? 0 : dist;
  if (d < 16) return d;
  const float lr = logf((float)d / 16.f) / 2.0794415416798357f;
  int large = 16 + (int)(lr * 16.f);
  return large < 31 ? large : 31;
}

DI unsigned fkey(float f) { unsigned u = __float_as_uint(f); return (u & 0x80000000u) ? ~u : (u | 0x80000000u); }

DI void phase_hgrn_post(const int wq, PRef p, int j) {
  const int tid_ = ltid(wq); const int bid_ = lbid(); (void)tid_; (void)bid_;
  const int lane = tid_ & 63, wv = tid_ >> 6;
  for (int r = bid_ * 4 + wv; r < T * 4; r += gridDim.x * 4) {
    const int t = r >> 2, hd = r & 3;
    const float* o = p.oraw + (size_t)t * 512 + hd * 128;
    const float a = o[lane], bq = o[lane + 64];
    const float ss = wave_sum(a * a + bq * bq);
    const float rs = rsqrtf(ss / 128.f + 1e-6f);
    const bf16_t* gate = p.P16 + (size_t)t * ODD_IN + 3272 + hd * 128;
    const float* gn = p.odd_hg_norm + j * 512 + hd * 128;
    const float g0 = bf2f(gate[lane]), g1 = bf2f(gate[lane + 64]);
    p.Y[(size_t)t * D + 512 + hd * 128 + lane] = f2bf(a * rs * gn[lane] * (g0 * sigmoidf(g0)));
    p.Y[(size_t)t * D + 512 + hd * 128 + lane + 64] = f2bf(bq * rs * gn[lane + 64] * (g1 * sigmoidf(g1)));
  }
}

DI void phase_dsa_prep(const int wq, PRef p, int j) {
  const int tid = ltid(wq); const int bid = lbid();
  const int lane = tid & 63, wv = tid >> 6;
  for (int t = bid * 4 + wv; t < T; t += gridDim.x * 4) {
    const bf16_t* row = p.P16 + (size_t)t * ODD_IN;
#pragma unroll
    for (int c = 0; c < 2; ++c) *(GAS u32x4*)(p.qlat16 + (size_t)t * 1024 + c * 512 + lane * 8) = gload16(row + c * 512 + lane * 8);
    {
      const unsigned cv = *(const GAS unsigned*)(row + 1024 + 2 * lane);
      const float c0 = bflo(cv), c1 = bfhi(cv);
      const float ss = wave_sum(c0 * c0 + c1 * c1);
      const float rs = rsqrtf(ss / 128.f + 1e-6f);
      const float* g = p.odd_kv_norm + j * 128;
      *(GAS unsigned*)(p.ckv16 + (size_t)t * 128 + 2 * lane) = pack2(c0 * rs * g[2 * lane], c1 * rs * g[2 * lane + 1]);
    }
    *(GAS u32x4*)(p.iq16 + (size_t)t * 512 + lane * 8) = gload16(row + 1152 + lane * 8);
    p.ik16[(size_t)t * 64 + lane] = row[1664 + lane];
  }
}

DI void phase_dsa_scores(const int wq, PRef p, char* smem) {
  const int tid = ltid(wq); const int bid = lbid();
  const int lane = tid & 63, wv = tid >> 6, wm = wv >> 1, wn = wv & 1;
  const int r = lane & 31, hh = lane >> 5;
  const int srow = tid >> 3, skc = tid & 7;
  char* Ks = smem;
  char* Qs = smem + G_TILE_B;
  float* Ws = (float*)(smem + 3 * G_TILE_B);
  for (int tile = bid; tile < NB * 136; tile += gridDim.x) {
    const int b = tile / 136, u = tile % 136;
    int qb = 0;
    while ((qb + 1) * (qb + 2) / 2 <= u) ++qb;
    const int kb = u - qb * (qb + 1) / 2;
    const int q0 = b * S + qb * 128, k0 = b * S + kb * 128;
    const bf16_t* Kg = p.ik16 + (size_t)(k0 + srow) * 64 + skc * 8;
    const bf16_t* Qg = p.iq16 + (size_t)(q0 + srow) * 512 + skc * 8;
    u32x4 rk[4], rq[4];
#pragma unroll
    for (int i = 0; i < 4; ++i) { rk[i] = gload16(Kg + (size_t)(32 * i) * 64); rq[i] = gload16(Qg + (size_t)(32 * i) * 512); }
    u32x4 wv4 = {0u, 0u, 0u, 0u};
    if (tid < 128) wv4 = gload16(p.P16 + (size_t)(q0 + tid) * ODD_IN + 1728);
    __syncthreads();
#pragma unroll
    for (int i = 0; i < 4; ++i) {
      *(u32x4*)(Ks + (srow + 32 * i) * G_LDS_ROW + skc * 16) = rk[i];
      *(u32x4*)(Qs + (srow + 32 * i) * G_LDS_ROW + skc * 16) = rq[i];
    }
    if (tid < 128) {
      const unsigned w0 = wv4[0], w1 = wv4[1], w2 = wv4[2], w3 = wv4[3];
      f32x4v a4, b4;
      a4[0] = bflo(w0) * 0.35355339059327373f; a4[1] = bfhi(w0) * 0.35355339059327373f; a4[2] = bflo(w1) * 0.35355339059327373f; a4[3] = bfhi(w1) * 0.35355339059327373f;
      b4[0] = bflo(w2) * 0.35355339059327373f; b4[1] = bfhi(w2) * 0.35355339059327373f; b4[2] = bflo(w3) * 0.35355339059327373f; b4[3] = bfhi(w3) * 0.35355339059327373f;
      *(f32x4v*)(Ws + tid * 8) = a4; *(f32x4v*)(Ws + tid * 8 + 4) = b4;
    }
    __syncthreads();
    f32x16 sc[2][2];
#pragma unroll
    for (int i = 0; i < 2; ++i)
#pragma unroll
      for (int jx = 0; jx < 2; ++jx)
#pragma unroll
        for (int e = 0; e < 16; ++e) sc[i][jx][e] = 0.f;
#pragma unroll 1
    for (int hd = 0; hd < 8; ++hd) {
      const int cur = hd & 1;
      if (hd + 1 < 8) {
#pragma unroll
        for (int i = 0; i < 4; ++i) rq[i] = gload16(Qg + (size_t)(32 * i) * 512 + (hd + 1) * 64);
      }
      f32x16 acc[2][2];
#pragma unroll
      for (int i = 0; i < 2; ++i)
#pragma unroll
        for (int jx = 0; jx < 2; ++jx)
#pragma unroll
          for (int e = 0; e < 16; ++e) acc[i][jx][e] = 0.f;
      const char* As = Qs + cur * G_TILE_B + (wm * 64 + r) * G_LDS_ROW + hh * 16;
      const char* Bs = Ks + (wn * 64 + r) * G_LDS_ROW + hh * 16;
#pragma unroll
      for (int ks = 0; ks < 4; ++ks) {
        const bf16x8 a0 = *(const bf16x8*)(As + ks * 32), a1 = *(const bf16x8*)(As + 32 * G_LDS_ROW + ks * 32);
        const bf16x8 b0 = *(const bf16x8*)(Bs + ks * 32), b1 = *(const bf16x8*)(Bs + 32 * G_LDS_ROW + ks * 32);
        acc[0][0] = __builtin_amdgcn_mfma_f32_32x32x16_bf16(a0, b0, acc[0][0], 0, 0, 0);
        acc[0][1] = __builtin_amdgcn_mfma_f32_32x32x16_bf16(a0, b1, acc[0][1], 0, 0, 0);
        acc[1][0] = __builtin_amdgcn_mfma_f32_32x32x16_bf16(a1, b0, acc[1][0], 0, 0, 0);
        acc[1][1] = __builtin_amdgcn_mfma_f32_32x32x16_bf16(a1, b1, acc[1][1], 0, 0, 0);
      }
#pragma unroll
      for (int i = 0; i < 2; ++i)
#pragma unroll
        for (int e = 0; e < 16; ++e) {
          const float w = Ws[(wm * 64 + i * 32 + (e & 3) + 8 * (e >> 2) + 4 * hh) * 8 + hd];
          sc[i][0][e] = fmaf(w, fmaxf(acc[i][0][e] * 0.125f, 0.f), sc[i][0][e]);
          sc[i][1][e] = fmaf(w, fmaxf(acc[i][1][e] * 0.125f, 0.f), sc[i][1][e]);
        }
      if (hd + 1 < 8) {
#pragma unroll
        for (int i = 0; i < 4; ++i) *(u32x4*)(Qs + (cur ^ 1) * G_TILE_B + (srow + 32 * i) * G_LDS_ROW + skc * 16) = rq[i];
      }
      __syncthreads();
    }
#pragma unroll
    for (int i = 0; i < 2; ++i)
#pragma unroll
      for (int jx = 0; jx < 2; ++jx) {
        GAS float* cp = (GAS float*)p.sc + (size_t)(q0 + wm * 64 + i * 32 + 4 * hh) * 2048 + kb * 128 + wn * 64 + jx * 32 + r;
#pragma unroll
        for (int e = 0; e < 16; ++e) cp[(size_t)((e & 3) + 8 * (e >> 2)) * 2048] = sc[i][jx][e];
      }
  }
}

DI void phase_hgrn_scan(const int wq, PRef p, int l, char* smem) {
  const int tid = ltid(wq); const int bid = lbid();
  const int lane = tid & 63, wv = tid >> 6;
  const int kq = wv * 4 + (lane & 3), v = lane >> 2;
  constexpr int BUF = (2048 + 2048 + 256);
  float* bufs = (float*)smem;
  float* opart = bufs + 2 * BUF;
  for (int unit = bid; unit < 256; unit += gridDim.x) {
    const int b = unit >> 5, hd = (unit >> 3) & 3, vs = unit & 7;
    const int ltok = tid >> 4, lc = (tid & 15) * 8;
    const bf16_t* Pb = p.P16 + (size_t)(b * S) * ODD_IN;
    f32x4v lbv0, lbv1;
    { const float* lbp = p.lb + l * 512 + hd * 128 + lc; lbv0 = *(const f32x4v*)lbp; lbv1 = *(const f32x4v*)(lbp + 4); }
    f32x2v st[4];
#pragma unroll
    for (int i = 0; i < 4; ++i) { st[i][0] = 0.f; st[i][1] = 0.f; }
    u32x4 rq, rf; float riv;
    auto gl = [&](int bt) {
      const bf16_t* row = Pb + (size_t)(bt * 16 + ltok) * ODD_IN;
      rq = gload16(row + 1736 + hd * 128 + lc);
      rf = gload16(row + 2248 + hd * 128 + lc);
      riv = bf2f(row[2760 + hd * 128 + vs * 16 + (tid & 15)]);
    };
    auto st_lds = [&](int which) {
      float* bq = bufs + which * BUF; float* bf = bq + 2048; float* bi = bf + 2048;
      const unsigned q0_ = rq[0], q1_ = rq[1], q2_ = rq[2], q3_ = rq[3], f0_ = rf[0], f1_ = rf[1], f2_ = rf[2], f3_ = rf[3];
      f32x4v qa, qb, fa, fb;
      qa[0] = bflo(q0_); qa[1] = bfhi(q0_); qa[2] = bflo(q1_); qa[3] = bfhi(q1_); qb[0] = bflo(q2_); qb[1] = bfhi(q2_); qb[2] = bflo(q3_); qb[3] = bfhi(q3_);
      fa[0] = bflo(f0_); fa[1] = bfhi(f0_); fa[2] = bflo(f1_); fa[3] = bfhi(f1_); fb[0] = bflo(f2_); fb[1] = bfhi(f2_); fb[2] = bflo(f3_); fb[3] = bfhi(f3_);
      *(f32x4v*)(bq + ltok * 128 + lc) = qa; *(f32x4v*)(bq + ltok * 128 + lc + 4) = qb;
      f32x4v f0, f1;
#pragma unroll
      for (int i = 0; i < 4; ++i) {
        f0[i] = lbv0[i] + (1.f - lbv0[i]) * __builtin_amdgcn_rcpf(1.f + __expf(-fa[i]));
        f1[i] = lbv1[i] + (1.f - lbv1[i]) * __builtin_amdgcn_rcpf(1.f + __expf(-fb[i]));
      }
      *(f32x4v*)(bf + ltok * 128 + lc) = f0; *(f32x4v*)(bf + ltok * 128 + lc + 4) = f1;
      bi[ltok * 16 + (tid & 15)] = riv;
    };
    gl(0);
    __syncthreads();
    st_lds(0);
    __syncthreads();
#pragma unroll 1
    for (int bt = 0; bt < S / 16; ++bt) {
      const int cur = bt & 1;
      if (bt + 1 < S / 16) gl(bt + 1);
      const float* bq = bufs + cur * BUF; const float* bf = bq + 2048; const float* bi = bf + 2048;
      f32x4v F0, F1, Q0, Q1; float IV;
      auto ldstep = [&](int tt) {
        IV = bi[tt * 16 + v];
        F0 = *(const f32x4v*)(bf + tt * 128 + kq * 8); F1 = *(const f32x4v*)(bf + tt * 128 + kq * 8 + 4);
        Q0 = *(const f32x4v*)(bq + tt * 128 + kq * 8); Q1 = *(const f32x4v*)(bq + tt * 128 + kq * 8 + 4);
      };
      ldstep(0);
#pragma unroll
      for (int tt = 0; tt < 16; ++tt) {
        const float iv = IV;
        const f32x4v f0 = F0, f1 = F1, q0 = Q0, q1 = Q1;
        if (tt + 1 < 16) ldstep(tt + 1);
        f32x2v iv2; iv2[0] = iv; iv2[1] = iv;
        f32x2v fa, fb, fc, fd, qa, qb, qc, qd;
        fa[0] = f0[0]; fa[1] = f0[1]; fb[0] = f0[2]; fb[1] = f0[3]; fc[0] = f1[0]; fc[1] = f1[1]; fd[0] = f1[2]; fd[1] = f1[3];
        qa[0] = q0[0]; qa[1] = q0[1]; qb[0] = q0[2]; qb[1] = q0[3]; qc[0] = q1[0]; qc[1] = q1[1]; qd[0] = q1[2]; qd[1] = q1[3];
        st[0] = __builtin_elementwise_fma(fa, st[0] - iv2, iv2);
        st[1] = __builtin_elementwise_fma(fb, st[1] - iv2, iv2);
        st[2] = __builtin_elementwise_fma(fc, st[2] - iv2, iv2);
        st[3] = __builtin_elementwise_fma(fd, st[3] - iv2, iv2);
        f32x2v o2 = qa * st[0];
        o2 = __builtin_elementwise_fma(qb, st[1], o2);
        o2 = __builtin_elementwise_fma(qc, st[2], o2);
        o2 = __builtin_elementwise_fma(qd, st[3], o2);
        float o = o2[0] + o2[1];
        o += __int_as_float(__builtin_amdgcn_update_dpp(0, __float_as_int(o), 0xB1, 0xF, 0xF, true));
        o += __int_as_float(__builtin_amdgcn_update_dpp(0, __float_as_int(o), 0x4E, 0xF, 0xF, true));
        opart[(tt * 4 + wv) * 16 + v] = o;
      }
      __syncthreads();
      {
        const int tt = tid >> 4, vo = tid & 15;
        const float o = opart[(tt * 4 + 0) * 16 + vo] + opart[(tt * 4 + 1) * 16 + vo] + opart[(tt * 4 + 2) * 16 + vo] + opart[(tt * 4 + 3) * 16 + vo];
        p.oraw[(size_t)(b * S + bt * 16 + tt) * 512 + hd * 128 + vs * 16 + vo] = o;
      }
      if (bt + 1 < S / 16) st_lds(cur ^ 1);
      __syncthreads();
    }
  }
}

DI float dot2bf(unsigned a, unsigned b, float acc) { return __builtin_amdgcn_fdot2_f32_bf16(__builtin_bit_cast(bf16x2_t, a), __builtin_bit_cast(bf16x2_t, b), acc, false); }
DI unsigned fkey_u(float f) { const unsigned u = __float_as_uint(f); return (u & 0x80000000u) ? ~u : (u | 0x80000000u); }
DI void phase_dsa_attend(const int wq, PRef p, int j, char* smem, int qoff) {
  const int tid = ltid(wq); const int bid = lbid(); (void)bid;
  const int lane = tid & 63, wv = tid >> 6;
  int* selL = (int*)smem;
  int* nselL = selL + 1024;
  float* bias = (float*)(smem + 4096 + 64);
  float* part = (float*)(smem + 4096 + 64 + 1024);
  float* msb = part + 2 * 4 * 8 * 128;
  float* plw = msb + 2 * 4 * 16 + wv * 64 * 8;
  int* sel = selL + wv * 256;
  __syncthreads();
  bias[tid] = p.rel_bias[tid];
  const int n16 = lane & 15, kg = lane >> 4;
  const unsigned long long ltmask = (1ull << lane) - 1ull;
  for (;;) {
    __syncthreads();
    if (tid == 0) nselL[4] = (int)atomicAdd(p.qctr + qoff, 4u);
    __syncthreads();
    const int base = nselL[4];
    if (base >= T) break;
    {
      const int q = base + wv;
      const int t = q % S;
      const float* row = p.sc + (size_t)q * 2048;
      int nsel;
      if (t < 256) {
        nsel = t + 1;
#pragma unroll
        for (int i = 0; i < 4; ++i) sel[i * 64 + lane] = i * 64 + lane;
      } else {
        nsel = 256;
        const int ni = (t >> 6) + 1;
        unsigned keys[32];
#pragma unroll
        for (int i = 0; i < 32; ++i) {
          keys[i] = 0u;
          if (i < ni) { const int s_ = i * 64 + lane; if (s_ <= t) keys[i] = fkey_u(row[s_]); }
        }
        unsigned thr = 0u;
#pragma unroll 1
        for (int bit = 31; bit >= 0; --bit) {
          const unsigned cand = thr | (1u << bit);
          int cl = 0;
#pragma unroll
          for (int g = 0; g < 4; ++g) if (g * 8 < ni) {
#pragma unroll
            for (int i = g * 8; i < g * 8 + 8; ++i) cl += (keys[i] >= cand) ? 1 : 0;
          }
          const int cnt = wave_sum_i(cl);
          if (cnt >= 256) thr = cand;
        }
        int ngt = 0;
#pragma unroll
        for (int i = 0; i < 32; ++i) if (i < ni) ngt += __builtin_popcountll(__ballot(keys[i] > thr));
        const int need = 256 - ngt;
        int pg = 0, pe = 0;
#pragma unroll
        for (int i = 0; i < 32; ++i) if (i < ni) {
          const unsigned long long mg = __ballot(keys[i] > thr), me = __ballot(keys[i] == thr);
          const int myg = pg + __builtin_popcountll(mg & ltmask), mye = pe + __builtin_popcountll(me & ltmask);
          if (keys[i] > thr) sel[myg] = i * 64 + lane;
          else if (keys[i] == thr && mye < need) sel[ngt + mye] = i * 64 + lane;
          pg += __builtin_popcountll(mg); pe += __builtin_popcountll(me);
        }
      }
      if (lane == 0) nselL[wv] = nsel;
    }
    __syncthreads();
#pragma unroll 1
    for (int qi = 0; qi < 4; ++qi) {
      const int tid = ltid(wq);
      const int lane = tid & 63;
      const int n16 = lane & 15, kg = lane >> 4;
      const int q = base + qi;
      const int b = q / S, t = q % S;
      const int nsel = nselL[qi];
      const int* qsel = selL + qi * 256 + wv * 64;
      const int slot0 = wv * 64;
      float* pw = part + ((qi & 1) * 4 + wv) * 8 * 128;
      float* mw = msb + ((qi & 1) * 4 + wv) * 16;
      bf16x8 aq[4];
#pragma unroll
      for (int ks = 0; ks < 4; ++ks) {
        u32x4 z = {0u, 0u, 0u, 0u};
        if (n16 < 8) z = gload16(p.qlat16 + (size_t)q * 1024 + n16 * 128 + ks * 32 + kg * 8);
        aq[ks] = __builtin_bit_cast(bf16x8, z);
      }
      u32x4 bv[4][4];
#pragma unroll
      for (int bb = 0; bb < 4; ++bb) {
        const int sl = bb * 16 + n16;
        const int sxv = (slot0 + sl < nsel) ? qsel[sl] : 0;
        const bf16_t* crow = p.ckv16 + (size_t)(b * S + sxv) * 128 + kg * 8;
#pragma unroll
        for (int ks = 0; ks < 4; ++ks) bv[bb][ks] = gload16(crow + ks * 32);
      }
      const bf16_t* cb = p.ckv16 + (size_t)(b * S) * 128 + 2 * lane;
      unsigned cbuf[64];
#pragma unroll
      for (int i4 = 0; i4 < 8; ++i4) {
        const u32x4 s4 = *(const u32x4*)(qsel + i4 * 4);
#pragma unroll
        for (int e = 0; e < 4; ++e) {
          const int k = i4 * 4 + e;
          const int sk = (slot0 + k < nsel) ? __builtin_amdgcn_readfirstlane((int)s4[e]) : 0;
          cbuf[k] = *(const GAS unsigned*)(cb + (size_t)sk * 128);
        }
      }
      asm volatile("" ::: "memory");
      f32x4v lg[4];
#pragma unroll
      for (int bb = 0; bb < 4; ++bb) {
        f32x4v acc = {0.f, 0.f, 0.f, 0.f};
#pragma unroll
        for (int ks = 0; ks < 4; ++ks) acc = __builtin_amdgcn_mfma_f32_16x16x32_bf16(aq[ks], __builtin_bit_cast(bf16x8, bv[bb][ks]), acc, 0, 0, 0);
        lg[bb] = acc;
      }
      asm volatile("" ::: "memory");
#pragma unroll
      for (int i4 = 8; i4 < 16; ++i4) {
        const u32x4 s4 = *(const u32x4*)(qsel + i4 * 4);
#pragma unroll
        for (int e = 0; e < 4; ++e) {
          const int k = i4 * 4 + e;
          const int sk = (slot0 + k < nsel) ? __builtin_amdgcn_readfirstlane((int)s4[e]) : 0;
          cbuf[k] = *(const GAS unsigned*)(cb + (size_t)sk * 128);
        }
      }
      float mx[4] = {-INFINITY, -INFINITY, -INFINITY, -INFINITY};
#pragma unroll
      for (int bb = 0; bb < 4; ++bb) {
        const bool ok = slot0 + bb * 16 + n16 < nsel;
        const int bk = t5_bucket(t - (ok ? qsel[bb * 16 + n16] : 0));
#pragma unroll
        for (int i = 0; i < 4; ++i) {
          const float lv = ok ? lg[bb][i] * 0.08838834764831845f + bias[bk * 8 + ((4 * kg + i) & 7)] : -INFINITY;
          lg[bb][i] = lv; mx[i] = fmaxf(mx[i], lv);
        }
      }
#pragma unroll
      for (int i = 0; i < 4; ++i) mx[i] = rowmax16(mx[i]);
      float sm[4] = {0.f, 0.f, 0.f, 0.f};
#pragma unroll
      for (int bb = 0; bb < 4; ++bb)
#pragma unroll
        for (int i = 0; i < 4; ++i) {
          const float e_ = (mx[i] == -INFINITY) ? 0.f : __expf(lg[bb][i] - mx[i]);
          lg[bb][i] = e_; sm[i] += e_;
        }
#pragma unroll
      for (int i = 0; i < 4; ++i) sm[i] = rowsum16(sm[i]);
#pragma unroll
      for (int bb = 0; bb < 4; ++bb) {
        u32x4 pr;
#pragma unroll
        for (int i = 0; i < 4; ++i) {
          const float other = DPP_F(lg[bb][i], 0xB1, 0xF, true);
          pr[i] = pack2(lg[bb][i], other);
        }
        if (kg < 2 && (n16 & 1) == 0) *(u32x4*)((unsigned*)plw + ((bb * 16 + n16) >> 1) * 8 + 4 * kg) = pr;
      }
      if (kg < 2) {
        if (n16 == 0) {
#pragma unroll
          for (int i = 0; i < 4; ++i) { mw[4 * kg + i] = mx[i]; mw[8 + 4 * kg + i] = sm[i]; }
        }
      }
      asm volatile("s_waitcnt lgkmcnt(0)" ::: "memory");
      float o[16];
#pragma unroll
      for (int i = 0; i < 16; ++i) o[i] = 0.f;
#pragma unroll
      for (int kp = 0; kp < 32; ++kp) {
        if ((kp & 1) == 0) asm volatile("" ::: "memory");
        const unsigned ca = cbuf[2 * kp], cbx = cbuf[2 * kp + 1];
        const unsigned x0 = __builtin_amdgcn_perm(cbx, ca, 0x05040100u);
        const unsigned x1 = __builtin_amdgcn_perm(cbx, ca, 0x07060302u);
        const u32x4 pa4 = *(const u32x4*)((const unsigned*)plw + kp * 8), pb4 = *(const u32x4*)((const unsigned*)plw + kp * 8 + 4);
        const unsigned q0 = pa4[0], q1 = pa4[1], q2 = pa4[2], q3 = pa4[3], q4 = pb4[0], q5 = pb4[1], q6 = pb4[2], q7 = pb4[3];
        o[0] = dot2bf(q0, x0, o[0]); o[1] = dot2bf(q0, x1, o[1]); o[2] = dot2bf(q1, x0, o[2]); o[3] = dot2bf(q1, x1, o[3]);
        o[4] = dot2bf(q2, x0, o[4]); o[5] = dot2bf(q2, x1, o[5]); o[6] = dot2bf(q3, x0, o[6]); o[7] = dot2bf(q3, x1, o[7]);
        o[8] = dot2bf(q4, x0, o[8]); o[9] = dot2bf(q4, x1, o[9]); o[10] = dot2bf(q5, x0, o[10]); o[11] = dot2bf(q5, x1, o[11]);
        o[12] = dot2bf(q6, x0, o[12]); o[13] = dot2bf(q6, x1, o[13]); o[14] = dot2bf(q7, x0, o[14]); o[15] = dot2bf(q7, x1, o[15]);
      }
#pragma unroll
      for (int hd = 0; hd < 8; ++hd) { float2 ov; ov.x = o[2 * hd]; ov.y = o[2 * hd + 1]; *(float2*)(pw + hd * 128 + 2 * lane) = ov; }
      __syncthreads();
      {
        const int hd = tid >> 5, ch = (tid & 31) * 4;
        const float* pq = part + (qi & 1) * 4 * 8 * 128;
        const float* mq = msb + (qi & 1) * 4 * 16;
        float m0 = mq[hd], m1 = mq[16 + hd], m2 = mq[32 + hd], m3 = mq[48 + hd];
        const float M = fmaxf(fmaxf(m0, m1), fmaxf(m2, m3));
        const float f0 = __expf(m0 - M), f1 = __expf(m1 - M), f2 = __expf(m2 - M), f3 = __expf(m3 - M);
        const float den = f0 * mq[8 + hd] + f1 * mq[24 + hd] + f2 * mq[40 + hd] + f3 * mq[56 + hd];
        const f32x4v a0 = *(const f32x4v*)(pq + (0 * 8 + hd) * 128 + ch), a1 = *(const f32x4v*)(pq + (1 * 8 + hd) * 128 + ch);
        const f32x4v a2 = *(const f32x4v*)(pq + (2 * 8 + hd) * 128 + ch), a3 = *(const f32x4v*)(pq + (3 * 8 + hd) * 128 + ch);
        const float inv = 1.f / den;
        const f32x4v r = (a0 * f0 + a1 * f1 + a2 * f2 + a3 * f3) * inv;
        u32x2 ov; ov[0] = pack2(r[0], r[1]); ov[1] = pack2(r[2], r[3]);
        *(GAS u32x2*)(p.lat + (size_t)q * D + hd * 128 + ch) = ov;
      }
    }
  }
}

DI void phase_softmax256(const int wq, const bf16_t* __restrict__ S, bf16_t* __restrict__ Pm, int rows) {
  const int tid = ltid(wq); const int bid = lbid();
  const int lane = tid & 63, wv = tid >> 6;
  for (int r = bid * 4 + wv; r < rows; r += gridDim.x * 4) {
    const f32x4v v = bf4_to_f(*(const GAS u32x2*)(S + (size_t)r * 256 + lane * 4));
    const float a = v[0], b = v[1], c = v[2], d = v[3];
    const float m = wave_max(fmaxf(fmaxf(a, b), fmaxf(c, d)));
    const float ea = __expf(a - m), eb = __expf(b - m), ec = __expf(c - m), ed = __expf(d - m);
    const float inv = 1.f / wave_sum(ea + eb + ec + ed);
    u32x2 o; o[0] = pack2(ea * inv, eb * inv); o[1] = pack2(ec * inv, ed * inv);
    *(GAS u32x2*)(Pm + (size_t)r * 256 + lane * 4) = o;
  }
}

DI int fkey_s(int b) { return b ^ ((b >> 31) & 0x7fffffff); }

template <int N, int KMAX>
DI void bitonic_blocks(int (&v)[N]) {
#pragma unroll
  for (int k = 2; k <= KMAX; k <<= 1)
#pragma unroll
    for (int j = k >> 1; j > 0; j >>= 1)
#pragma unroll
      for (int i = 0; i < N; ++i) {
        const int l = i ^ j;
        if (l > i) {
          const bool desc = ((i & k) == 0);
          const int a = v[i], b = v[l];
          const int hi = a > b ? a : b, lo = a > b ? b : a;
          v[i] = desc ? hi : lo;
          v[l] = desc ? lo : hi;
        }
      }
}
template <bool DESC>
DI void bitonic_merge16(int (&v)[16]) {
#pragma unroll
  for (int j = 8; j > 0; j >>= 1)
#pragma unroll
    for (int i = 0; i < 16; ++i) {
      const int l = i ^ j;
      if (l > i) {
        const int a = v[i], b = v[l];
        const int hi = a > b ? a : b, lo = a > b ? b : a;
        v[i] = DESC ? hi : lo;
        v[l] = DESC ? lo : hi;
      }
    }
}

DI void phase_cvt_rows(const int wq, const float* __restrict__ src, bf16_t* __restrict__ dst, size_t n8) {
  const int tid = ltid(wq); const int bid = lbid();
  for (size_t i = (size_t)bid * NT + tid; i < n8; i += (size_t)gridDim.x * NT) {
    const u32x4 a = gload16(src + i * 8), b = gload16(src + i * 8 + 4);
    u32x4 o;
    o[0] = pack2(__uint_as_float(a[0]), __uint_as_float(a[1])); o[1] = pack2(__uint_as_float(a[2]), __uint_as_float(a[3]));
    o[2] = pack2(__uint_as_float(b[0]), __uint_as_float(b[1])); o[3] = pack2(__uint_as_float(b[2]), __uint_as_float(b[3]));
    *(GAS u32x4*)(dst + i * 8) = o;
  }
}

constexpr int KEY_ROW = 264;
DI void phase_peer_qs(const int wq, const bf16_t* __restrict__ X0, const bf16_t* __restrict__ W0, const bf16_t* __restrict__ keys0, int* __restrict__ tops, char* smem, const float* __restrict__ rss_in) {
  const int tid = ltid(wq); const int bid = lbid();
  const int lane = tid & 63, wv = tid >> 6;
  const int r = lane & 31, hh = lane >> 5;
  const int srow = tid >> 3, skc = tid & 7;
  constexpr int nk = D / 64;
  for (int tile = bid; tile < (T / 128) * 16; tile += gridDim.x) {
    const int mt = tile >> 4, hp = tile & 15;
    const bf16_t* Wg = W0 + (size_t)(hp * 128 + srow) * D + skc * 8;
    const bf16_t* Xg = X0 + (size_t)(mt * 128 + srow) * D + skc * 8;
    f32x16 acc[4];
#pragma unroll
    for (int i = 0; i < 4; ++i)
#pragma unroll
      for (int e = 0; e < 16; ++e) acc[i][e] = 0.f;
    u32x4 ra[4], rb[4];
#pragma unroll
    for (int i = 0; i < 4; ++i) { ra[i] = gload16(Wg + (size_t)(32 * i) * D); rb[i] = gload16(Xg + (size_t)(32 * i) * D); }
    __syncthreads();
#pragma unroll
    for (int i = 0; i < 4; ++i) {
      *(u32x4*)(smem + (srow + 32 * i) * G_LDS_ROW + skc * 16) = ra[i];
      *(u32x4*)(smem + 2 * G_TILE_B + (srow + 32 * i) * G_LDS_ROW + skc * 16) = rb[i];
    }
    __syncthreads();
#pragma unroll 1
    for (int kt = 0; kt < nk; ++kt) {
      const int cur = kt & 1;
      if (kt + 1 < nk) {
#pragma unroll
        for (int i = 0; i < 4; ++i) { ra[i] = gload16(Wg + (size_t)(32 * i) * D + (kt + 1) * 64); rb[i] = gload16(Xg + (size_t)(32 * i) * D + (kt + 1) * 64); }
      }
      const char* As = smem + cur * G_TILE_B + r * G_LDS_ROW + hh * 16;
      const char* Bs = smem + 2 * G_TILE_B + cur * G_TILE_B + (wv * 32 + r) * G_LDS_ROW + hh * 16;
#pragma unroll
      for (int ks = 0; ks < 4; ++ks) {
        const bf16x8 b = *(const bf16x8*)(Bs + ks * 32);
#pragma unroll
        for (int mb = 0; mb < 4; ++mb) {
          const bf16x8 a = *(const bf16x8*)(As + mb * 32 * G_LDS_ROW + ks * 32);
          acc[mb] = __builtin_amdgcn_mfma_f32_32x32x16_bf16(a, b, acc[mb], 0, 0, 0);
        }
      }
      if (kt + 1 < nk) {
        const int nxt = cur ^ 1;
#pragma unroll
        for (int i = 0; i < 4; ++i) {
          *(u32x4*)(smem + nxt * G_TILE_B + (srow + 32 * i) * G_LDS_ROW + skc * 16) = ra[i];
          *(u32x4*)(smem + 2 * G_TILE_B + nxt * G_TILE_B + (srow + 32 * i) * G_LDS_ROW + skc * 16) = rb[i];
        }
      }
      __syncthreads();
    }
    {
      const bf16_t* kg = keys0 + (size_t)hp * 128 * 128;
#pragma unroll
      for (int i = 0; i < 8; ++i) {
        const int c = tid + NT * i, row = c >> 4, c16 = c & 15;
        const u32x4 v = gload16(kg + row * 128 + c16 * 8);
        uint2 lo, hi2; lo.x = v[0]; lo.y = v[1]; hi2.x = v[2]; hi2.y = v[3];
        *(uint2*)(smem + row * KEY_ROW + c16 * 16) = lo;
        *(uint2*)(smem + row * KEY_ROW + c16 * 16 + 8) = hi2;
      }
    }
    __syncthreads();
    u32x4 qf[8];
    const float rstd_t = rstd_of(rss_in, mt * 128 + wv * 32 + r);
#pragma unroll
    for (int mb = 0; mb < 4; ++mb)
#pragma unroll
      for (int s2 = 0; s2 < 2; ++s2) {
        u32x4 f;
#pragma unroll
        for (int jj = 0; jj < 4; ++jj) f[jj] = pack2(acc[mb][8 * s2 + 2 * jj] * rstd_t, acc[mb][8 * s2 + 2 * jj + 1] * rstd_t);
        qf[mb * 2 + s2] = f;
      }
    int v[64];
#pragma unroll
    for (int kb = 0; kb < 4; ++kb) {
      f32x16 sa;
#pragma unroll
      for (int e = 0; e < 16; ++e) sa[e] = 0.f;
      const char* kr = smem + (kb * 32 + r) * KEY_ROW + hh * 8;
#pragma unroll
      for (int ksi = 0; ksi < 8; ++ksi) {
        const uint2 lo = *(const uint2*)(kr + ksi * 32);
        const uint2 hi2 = *(const uint2*)(kr + ksi * 32 + 16);
        u32x4 a; a[0] = lo.x; a[1] = lo.y; a[2] = hi2.x; a[3] = hi2.y;
        sa = __builtin_amdgcn_mfma_f32_32x32x16_bf16(__builtin_bit_cast(bf16x8, a), __builtin_bit_cast(bf16x8, qf[ksi]), sa, 0, 0, 0);
      }
#pragma unroll
      for (int e = 0; e < 16; ++e) {
        const int kidx = kb * 32 + (e & 3) + 8 * (e >> 2) + 4 * hh;
        v[kb * 16 + e] = (fkey_s(__float_as_int(sa[e])) & ~127) | kidx;
      }
    }
    bitonic_blocks<64, 16>(v);
    int c01[16], c23[16];
#pragma unroll
    for (int i = 0; i < 16; ++i) { c01[i] = v[i] > v[16 + i] ? v[i] : v[16 + i]; c23[i] = v[32 + i] > v[48 + i] ? v[32 + i] : v[48 + i]; }
    bitonic_merge16<true>(c01);
    bitonic_merge16<false>(c23);
    int d[16];
#pragma unroll
    for (int i = 0; i < 16; ++i) d[i] = c01[i] > c23[i] ? c01[i] : c23[i];
    bitonic_merge16<true>(d);
    int f[16];
#pragma unroll
    for (int i = 0; i < 16; ++i) { const int o = shxi(d[15 - i], 32, lane); f[i] = d[i] > o ? d[i] : o; }
    bitonic_merge16<true>(f);
    {
      const int token = mt * 128 + wv * 32 + r;
      GAS int* op = (GAS int*)tops + ((size_t)token * 16 + hp) * 16 + hh * 8;
      u32x4 o0, o1;
      if (hh) {
#pragma unroll
        for (int i = 0; i < 4; ++i) { o0[i] = f[8 + i]; o1[i] = f[12 + i]; }
        asm volatile("" : "+v"(o0), "+v"(o1));
      } else {
#pragma unroll
        for (int i = 0; i < 4; ++i) { o0[i] = f[i]; o1[i] = f[4 + i]; }
        asm volatile("" : "+v"(o0), "+v"(o1));
      }
      *(GAS u32x4*)op = o0; *(GAS u32x4*)(op + 4) = o1;
    }
  }
}

DI float dot8(const u32x4 a, const u32x4 b, float acc) {
  const unsigned a0 = a[0], a1 = a[1], a2 = a[2], a3 = a[3], b0 = b[0], b1 = b[1], b2 = b[2], b3 = b[3];
  acc = dot2bf(a0, b0, acc); acc = dot2bf(a1, b1, acc); acc = dot2bf(a2, b2, acc); acc = dot2bf(a3, b3, acc);
  return acc;
}
typedef signed char i8_t;
using i32x2 = __attribute__((ext_vector_type(2))) int;
DI void phase_quant_u(const int wq, const float* __restrict__ src, i8_t* __restrict__ dst, float* __restrict__ su, int nrows, const float* __restrict__ gain, int nblk) {
  const int tid = ltid(wq); const int bid = lbid();
  const int lane = tid & 63, wv = tid >> 6;
  const int stride = nblk * 4;
  for (int row0 = bid * 4 + wv; row0 < nrows; row0 += 2 * stride) {
  u32x4 raw[8];
#pragma unroll
  for (int i = 0; i < 4; ++i) { raw[i] = gload16(src + (size_t)row0 * 1024 + 16 * lane + 4 * i); raw[4 + i] = gload16(src + (size_t)(row0 + stride) * 1024 + 16 * lane + 4 * i); }
#pragma unroll
  for (int u = 0; u < 2; ++u) {
    const int row = row0 + u * stride;
    u32x4 a[4];
    {
      const float* gp = gain + (size_t)(row >> 14) * 1024 + 16 * lane;
#pragma unroll
      for (int i = 0; i < 4; ++i) {
        const u32x4 t = raw[u * 4 + i];
        const f32x4v g4 = *(const f32x4v*)(gp + 4 * i);
        const unsigned t0 = t[0], t1 = t[1], t2 = t[2], t3 = t[3];
        a[i][0] = __float_as_uint(__uint_as_float(t0) * g4[0]); a[i][1] = __float_as_uint(__uint_as_float(t1) * g4[1]);
        a[i][2] = __float_as_uint(__uint_as_float(t2) * g4[2]); a[i][3] = __float_as_uint(__uint_as_float(t3) * g4[3]);
      }
    }
    float am = 0.f;
#pragma unroll
    for (int i = 0; i < 4; ++i) {
      const unsigned x0 = a[i][0], x1 = a[i][1], x2 = a[i][2], x3 = a[i][3];
      am = fmaxf(am, fmaxf(fmaxf(fabsf(__uint_as_float(x0)), fabsf(__uint_as_float(x1))), fmaxf(fabsf(__uint_as_float(x2)), fabsf(__uint_as_float(x3)))));
    }
    am = wave_max(am);
    const float inv = am > 0.f ? 127.f / am : 0.f;
    u32x4 o;
#pragma unroll
    for (int i = 0; i < 4; ++i) {
      const unsigned x0 = a[i][0], x1 = a[i][1], x2 = a[i][2], x3 = a[i][3];
      const int q0 = (int)rintf(__uint_as_float(x0) * inv), q1 = (int)rintf(__uint_as_float(x1) * inv);
      const int q2 = (int)rintf(__uint_as_float(x2) * inv), q3 = (int)rintf(__uint_as_float(x3) * inv);
      o[i] = (unsigned)(q0 & 255) | ((unsigned)(q1 & 255) << 8) | ((unsigned)(q2 & 255) << 16) | ((unsigned)(q3 & 255) << 24);
    }
    const size_t lyr = (size_t)row >> 14, e = (size_t)row & 16383;
    *(GAS u32x4*)(dst + (((lyr * 8 + (lane >> 3)) * 16384 + e) * 128 + (lane & 7) * 16)) = o;
    if (lane == 0) su[row] = am * (1.f / 127.f);
  }
  }
}
DI void phase_cvt_v8(const int wq, const float* __restrict__ src, i8_t* __restrict__ dst, size_t n16, int nblk) {
  const int tid = ltid(wq); const int bid = lbid();
  const unsigned step = (unsigned)nblk * NT;
  for (unsigned i0 = (unsigned)bid * NT + tid; i0 < (unsigned)n16; i0 += 2 * step) {
    u32x4 a[8];
#pragma unroll
    for (int k = 0; k < 4; ++k) { a[k] = gload16(src + (size_t)i0 * 16 + 4 * k); a[4 + k] = gload16(src + (size_t)(i0 + step) * 16 + 4 * k); }
#pragma unroll
    for (int u = 0; u < 2; ++u) {
      const unsigned i = i0 + u * step;
      u32x4 o;
#pragma unroll
      for (int k = 0; k < 4; ++k) {
        const u32x4 av = a[u * 4 + k];
        const unsigned x0 = av[0], x1 = av[1], x2 = av[2], x3 = av[3];
        int pk = 0;
        pk = __builtin_amdgcn_cvt_pk_fp8_f32(__uint_as_float(x0) * 16.f, __uint_as_float(x1) * 16.f, pk, false);
        pk = __builtin_amdgcn_cvt_pk_fp8_f32(__uint_as_float(x2) * 16.f, __uint_as_float(x3) * 16.f, pk, true);
        o[k] = (unsigned)pk;
      }
      const unsigned row = i >> 6; const int j = (int)(i & 63);
      const unsigned lyr = row >> 14, e = row & 16383;
      *(GAS u32x4*)(dst + (((size_t)(lyr * 8 + (j >> 3)) * 16384 + e) * 128 + (j & 7) * 16)) = o;
    }
  }
}

DI void phase_peer_combine8(const int wq, PRef p, int l, char* smem, const float* __restrict__ rss_in) {
  const int tid = ltid(wq); const int bid = lbid();
  const int lane = tid & 63, wv = tid >> 6;
  int* wtops = (int*)(smem + wv * 1024);
  int ci, cj;
  if (lane < 16) { ci = 0; cj = lane; } else if (lane < 24) { ci = 1; cj = lane - 16; } else if (lane < 29) { ci = 2; cj = lane - 24; }
  else if (lane < 33) { ci = 3; cj = lane - 29; } else if (lane < 36) { ci = 4; cj = lane - 33; } else if (lane < 38) { ci = 5; cj = lane - 36; }
  else if (lane < 40) { ci = 6; cj = lane - 38; } else if (lane < 42) { ci = 7; cj = lane - 40; } else { ci = lane - 42 + 8; cj = 0; }
  const bool cvalid = lane < 50;
  if (!cvalid) { ci = 0; cj = 0; }
  const float* sul = p.su + (size_t)l * 16384;
  for (int token = bid * 4 + wv; token < T; token += gridDim.x * 4) {
    {
      const u32x4 tv = gload16(p.tops + (size_t)token * 256 + lane * 4);
      *(u32x4*)(wtops + lane * 4) = tv;
    }
    {
      const u32x4 a = gload16(p.hn + (size_t)token * D + 16 * lane), b2 = gload16(p.hn + (size_t)token * D + 16 * lane + 8);
      float xv[16];
      { const unsigned a0 = a[0], a1 = a[1], a2 = a[2], a3 = a[3], c0 = b2[0], c1 = b2[1], c2 = b2[2], c3 = b2[3];
        xv[0] = bflo(a0); xv[1] = bfhi(a0); xv[2] = bflo(a1); xv[3] = bfhi(a1); xv[4] = bflo(a2); xv[5] = bfhi(a2); xv[6] = bflo(a3); xv[7] = bfhi(a3);
        xv[8] = bflo(c0); xv[9] = bfhi(c0); xv[10] = bflo(c1); xv[11] = bfhi(c1); xv[12] = bflo(c2); xv[13] = bfhi(c2); xv[14] = bflo(c3); xv[15] = bfhi(c3); }
      float am = 0.f;
#pragma unroll
      for (int i = 0; i < 16; ++i) am = fmaxf(am, fabsf(xv[i]));
      am = wave_max(am);
      const float inv = am > 0.f ? 127.f / am : 0.f;
      u32x4 o;
#pragma unroll
      for (int i = 0; i < 4; ++i) {
        const int q0 = (int)rintf(xv[4 * i] * inv), q1 = (int)rintf(xv[4 * i + 1] * inv), q2 = (int)rintf(xv[4 * i + 2] * inv), q3 = (int)rintf(xv[4 * i + 3] * inv);
        o[i] = (unsigned)(q0 & 255) | ((unsigned)(q1 & 255) << 8) | ((unsigned)(q2 & 255) << 16) | ((unsigned)(q3 & 255) << 24);
      }
      *(GAS u32x4*)(p.x8 + (size_t)token * 1024 + 16 * lane) = o;
      if (lane == 0) p.sxq[token] = am * (1.f / 127.f) * rstd_of(rss_in, token);
    }
    asm volatile("s_waitcnt lgkmcnt(0)" ::: "memory");
#pragma unroll 1
    for (int hd = 0; hd < 8; ++hd) {
      const int k1 = wtops[(2 * hd) * 16 + ci], k2 = wtops[(2 * hd + 1) * 16 + cj];
      const float s1 = __int_as_float(fkey_s(k1 & ~127)), s2 = __int_as_float(fkey_s(k2 & ~127));
      const float val = s1 + s2;
      const int vk = cvalid ? ((fkey_s(__float_as_int(val)) & ~63) | (63 - lane)) : (int)0x80000000;
      int rank = 0;
#pragma unroll
      for (int c = 0; c < 50; ++c) rank += (__builtin_amdgcn_readlane(vk, c) > vk) ? 1 : 0;
      const float m = __int_as_float(__builtin_amdgcn_readlane(__float_as_int(val), 0));
      const bool sel = cvalid && rank < 16;
      const float ev = sel ? __expf(val - m) : 0.f;
      const float sum = wave_sum(ev);
      if (sel) {
        const int eid = (k1 & 127) * 128 + (k2 & 127);
        p.sel_id[(size_t)token * 128 + hd * 16 + rank] = eid;
        p.sel_g[(size_t)token * 128 + hd * 16 + rank] = ev / sum;
        p.sel_su[(size_t)token * 128 + hd * 16 + rank] = sul[eid];
      }
    }
    asm volatile("s_waitcnt lgkmcnt(0)" ::: "memory");
  }
}

DI void phase_peer_udot8(const int wq, PRef p, int l, char* smem, int coff) {
  const int tid = ltid(wq);
  const int lane = tid & 63, wv = tid >> 6;
  const int grp = lane >> 3, li = lane & 7;
  int* wid = (int*)(smem + wv * 4096);
  const bool b2 = li & 4, b1 = li & 2, b0 = li & 1;
  const int myx = (int)(xb_xcc_id() & 7u);
  for (int cs = 0; cs < 8; ++cs) {
    const int c = (myx + cs) & 7;
    const i8_t* U8 = p.u8 + ((size_t)l * 8 + c) * 16384 * 128 + li * 16;
    int* pb = (int*)p.pbuf + (size_t)c * T * 128;
    for (;;) {
      unsigned tb = 0;
      if (lane == 0) tb = atomicAdd(p.qctr + coff + c * 16, 8u);
      tb = __builtin_amdgcn_readfirstlane(tb);
      if (tb >= (unsigned)T) break;
      u32x4 xs[8];
      {
        int idl[16];
#pragma unroll
        for (int k = 0; k < 8; ++k) {
          idl[2 * k] = __builtin_nontemporal_load((const GAS int*)p.sel_id + (size_t)(tb + k) * 128 + lane);
          idl[2 * k + 1] = __builtin_nontemporal_load((const GAS int*)p.sel_id + (size_t)(tb + k) * 128 + 64 + lane);
          xs[k] = __builtin_nontemporal_load((gp_u32x4)(p.x8 + (size_t)(tb + k) * 1024 + c * 128 + li * 16));
        }
#pragma unroll
        for (int k = 0; k < 8; ++k) { wid[k * 128 + lane] = idl[2 * k]; wid[k * 128 + 64 + lane] = idl[2 * k + 1]; }
      }
      asm volatile("s_waitcnt lgkmcnt(0)" ::: "memory");
      auto issue = [&](int k, u32x4 (&g)[16]) {
        int ids[16];
#pragma unroll
        for (int i = 0; i < 4; ++i) {
          const u32x4 t4 = *(const u32x4*)(wid + k * 128 + grp * 16 + i * 4);
          ids[4 * i] = t4[0]; ids[4 * i + 1] = t4[1]; ids[4 * i + 2] = t4[2]; ids[4 * i + 3] = t4[3];
        }
#pragma unroll
        for (int i = 0; i < 16; ++i) g[i] = gload16(U8 + (size_t)ids[i] * 128);
      };
      auto consume = [&](int k, const u32x4 (&g)[16], const u32x4 cx) {
        const int x0 = (int)cx[0], x1 = (int)cx[1], x2 = (int)cx[2], x3 = (int)cx[3];
        int pp[16];
#pragma unroll
        for (int i = 0; i < 16; ++i) {
          const u32x4 u8 = g[i];
          const int u0 = (int)u8[0], u1 = (int)u8[1], u2 = (int)u8[2], u3 = (int)u8[3];
          int acc = __builtin_amdgcn_sdot4(x0, u0, 0, false);
          acc = __builtin_amdgcn_sdot4(x1, u1, acc, false);
          acc = __builtin_amdgcn_sdot4(x2, u2, acc, false);
          pp[i] = __builtin_amdgcn_sdot4(x3, u3, acc, false);
        }
        int q8[8], q4[4], q2[2];
#pragma unroll
        for (int i = 0; i < 8; ++i) { const int mine = b2 ? pp[i + 8] : pp[i], oth = b2 ? pp[i] : pp[i + 8]; q8[i] = mine + shxi(oth, 4, lane); }
#pragma unroll
        for (int i = 0; i < 4; ++i) { const int mine = b1 ? q8[i + 4] : q8[i], oth = b1 ? q8[i] : q8[i + 4]; q4[i] = mine + shxi(oth, 2, lane); }
#pragma unroll
        for (int i = 0; i < 2; ++i) { const int mine = b0 ? q4[i + 2] : q4[i], oth = b0 ? q4[i] : q4[i + 2]; q2[i] = mine + shxi(oth, 1, lane); }
        i32x2 ov; ov[0] = q2[0]; ov[1] = q2[1];
        __builtin_nontemporal_store(ov, (GAS i32x2*)(pb + (size_t)(tb + k) * 128 + 2 * lane));
      };
      u32x4 ga[16], gb[16];
      issue(0, ga);
#pragma unroll
      for (int k2 = 0; k2 < 4; ++k2) {
        issue(2 * k2 + 1, gb);
        consume(2 * k2, ga, xs[2 * k2]);
        if (k2 < 3) issue(2 * k2 + 2, ga);
        consume(2 * k2 + 1, gb, xs[2 * k2 + 1]);
      }
      asm volatile("s_waitcnt lgkmcnt(0)" ::: "memory");
    }
  }
}

DI void phase_peer_w(const int wq, PRef p) {
  const int tid = ltid(wq); const int bid = lbid();
  const int lane = tid & 63, wv = tid >> 6;
  for (int token = bid * 4 + wv; token < T; token += gridDim.x * 4) {
    i32x2 pp8[8];
#pragma unroll
    for (int cc = 0; cc < 8; ++cc) pp8[cc] = __builtin_nontemporal_load((const GAS i32x2*)((const int*)p.pbuf + ((size_t)cc * T + token) * 128 + 2 * lane));
    const u32x2 gg = __builtin_nontemporal_load((const GAS u32x2*)(p.sel_g + (size_t)token * 128 + 2 * lane));
    const u32x2 su2 = __builtin_nontemporal_load((const GAS u32x2*)(p.sel_su + (size_t)token * 128 + 2 * lane));
    const float sxv = p.sxq[token];
    int d0 = 0, d1 = 0;
#pragma unroll
    for (int cc = 0; cc < 8; ++cc) { d0 += pp8[cc][0]; d1 += pp8[cc][1]; }
    const float f0 = (float)d0 * (sxv * __uint_as_float(su2[0])), f1 = (float)d1 * (sxv * __uint_as_float(su2[1]));
    u32x2 w2; w2[0] = __float_as_uint(__uint_as_float(gg[0]) * gelu_tanh(f0) * 0.0625f); w2[1] = __float_as_uint(__uint_as_float(gg[1]) * gelu_tanh(f1) * 0.0625f);
    *(GAS u32x2*)(p.sel_g + (size_t)token * 128 + 2 * lane) = w2;
  }
}

DI void phase_peer_vacc8(const int wq, PRef p, int l, char* smem, int coff, int dry, int rss_idx) {
  const int myx = (int)(xb_xcc_id() & 7u);
  for (int cs = 0; cs < 8; ++cs) {
    const int c = (myx + cs) & 7;
    for (;;) {
      const int tid = ltid(wq);
      const int lane = tid & 63, wv = tid >> 6;
      int* wid = (int*)(smem + wv * 8192);
      float* ww = (float*)(smem + wv * 8192 + 4096);
      const int grp = lane >> 3, li = lane & 7;
      const bool g2 = grp & 4, g1 = grp & 2, g0 = grp & 1;
      const i8_t* V8 = p.v8 + ((size_t)l * 8 + c) * 16384 * 128 + li * 16;
      const int chan = c * 128 + li * 16 + 2 * grp;
      unsigned tb = 0;
      if (lane == 0) tb = atomicAdd(p.qctr + coff + c * 16, 8u);
      tb = __builtin_amdgcn_readfirstlane(tb);
      if (tb >= (unsigned)T) break;
      {
        u32x4 iv[4], wv4[4];
#pragma unroll
        for (int j4 = 0; j4 < 4; ++j4) {
          iv[j4] = __builtin_nontemporal_load((gp_u32x4)(p.sel_id + (size_t)tb * 128 + j4 * 256 + lane * 4));
          wv4[j4] = __builtin_nontemporal_load((gp_u32x4)(p.sel_g + (size_t)tb * 128 + j4 * 256 + lane * 4));
        }
#pragma unroll
        for (int j4 = 0; j4 < 4; ++j4) { *(u32x4*)(wid + j4 * 256 + lane * 4) = iv[j4]; *(u32x4*)(ww + j4 * 256 + lane * 4) = wv4[j4]; }
      }
      asm volatile("s_waitcnt lgkmcnt(0)" ::: "memory");
      auto issue = [&](int hh_, u32x4 (&g)[8]) {
        const int k = hh_ >> 1, hf = hh_ & 1;
        int ids[8];
#pragma unroll
        for (int i = 0; i < 2; ++i) {
          const u32x4 t4 = *(const u32x4*)(wid + k * 128 + grp * 16 + hf * 8 + i * 4);
          ids[4 * i] = t4[0]; ids[4 * i + 1] = t4[1]; ids[4 * i + 2] = t4[2]; ids[4 * i + 3] = t4[3];
        }
#pragma unroll
        for (int i = 0; i < 8; ++i) g[i] = gload16(V8 + (size_t)ids[i] * 128);
      };
      float o[16];
      u32x2 hcur;
      auto accum = [&](int hh_, const u32x4 (&g)[8]) {
        const int k = hh_ >> 1, hf = hh_ & 1;
        if (hf == 0) {
#pragma unroll
          for (int i = 0; i < 16; ++i) o[i] = 0.f;
          hcur = __builtin_nontemporal_load((GAS u32x2*)((GAS float*)p.h + ((size_t)tb + k) * D + chan));
        }
#pragma unroll
        for (int i = 0; i < 8; ++i) {
          const u32x4 v8 = g[i];
          const float w = ww[k * 128 + grp * 16 + hf * 8 + i];
          const int v0 = (int)v8[0], v1 = (int)v8[1], v2 = (int)v8[2], v3 = (int)v8[3];
          f32x2v t2;
          t2 = __builtin_amdgcn_cvt_pk_f32_fp8(v0, false); o[0] = fmaf(w, t2[0], o[0]); o[1] = fmaf(w, t2[1], o[1]);
          t2 = __builtin_amdgcn_cvt_pk_f32_fp8(v0, true);  o[2] = fmaf(w, t2[0], o[2]); o[3] = fmaf(w, t2[1], o[3]);
          t2 = __builtin_amdgcn_cvt_pk_f32_fp8(v1, false); o[4] = fmaf(w, t2[0], o[4]); o[5] = fmaf(w, t2[1], o[5]);
          t2 = __builtin_amdgcn_cvt_pk_f32_fp8(v1, true);  o[6] = fmaf(w, t2[0], o[6]); o[7] = fmaf(w, t2[1], o[7]);
          t2 = __builtin_amdgcn_cvt_pk_f32_fp8(v2, false); o[8] = fmaf(w, t2[0], o[8]); o[9] = fmaf(w, t2[1], o[9]);
          t2 = __builtin_amdgcn_cvt_pk_f32_fp8(v2, true);  o[10] = fmaf(w, t2[0], o[10]); o[11] = fmaf(w, t2[1], o[11]);
          t2 = __builtin_amdgcn_cvt_pk_f32_fp8(v3, false); o[12] = fmaf(w, t2[0], o[12]); o[13] = fmaf(w, t2[1], o[13]);
          t2 = __builtin_amdgcn_cvt_pk_f32_fp8(v3, true);  o[14] = fmaf(w, t2[0], o[14]); o[15] = fmaf(w, t2[1], o[15]);
        }
        if (hf == 1) {
          float r8[8], r4[4], r2[2];
#pragma unroll
          for (int i = 0; i < 8; ++i) { const float mine = g2 ? o[i + 8] : o[i], oth = g2 ? o[i] : o[i + 8]; r8[i] = mine + shx(oth, 32, lane); }
#pragma unroll
          for (int i = 0; i < 4; ++i) { const float mine = g1 ? r8[i + 4] : r8[i], oth = g1 ? r8[i] : r8[i + 4]; r4[i] = mine + shx(oth, 16, lane); }
#pragma unroll
          for (int i = 0; i < 2; ++i) { const float mine = g0 ? r4[i + 2] : r4[i], oth = g0 ? r4[i] : r4[i + 2]; r2[i] = mine + shx(oth, 8, lane); }
          if (!dry) {
            const size_t token = (size_t)tb + k;
            GAS float* hp = (GAS float*)p.h + token * D + chan;
            const u32x2 ch = hcur;
            const float h0 = __uint_as_float(ch[0]) + r2[0], h1 = __uint_as_float(ch[1]) + r2[1];
            u32x2 sv; sv[0] = __float_as_uint(h0); sv[1] = __float_as_uint(h1);
            __builtin_nontemporal_store(sv, (GAS u32x2*)hp);
            *(GAS unsigned*)(p.hn + token * D + chan) = pack2(h0, h1);
            if (rss_idx >= 0) {
              const float ss = wave_sum(h0 * h0 + h1 * h1);
              if (lane < 2) p.rss[((size_t)rss_idx * T + token) * 16 + 2 * c + lane] = lane == 0 ? ss : 0.f;
            }
          }
        }
      };
      u32x4 gA[8], gB[8], gC[8];
      issue(0, gA); issue(1, gB);
#pragma unroll
      for (int h3 = 0; h3 < 15; h3 += 3) {
        asm volatile("" ::: "memory");
        issue(h3 + 2, gC); accum(h3, gA);
        asm volatile("" ::: "memory");
        issue(h3 + 3, gA); accum(h3 + 1, gB);
        asm volatile("" ::: "memory");
        if (h3 + 4 < 16) issue(h3 + 4, gB);
        accum(h3 + 2, gC);
      }
      accum(15, gA);
      asm volatile("s_waitcnt lgkmcnt(0)" ::: "memory");
    }
  }
}

DI void phase_final_norm(const int wq, const float* __restrict__ in, const float* __restrict__ g, float* __restrict__ out, int rows) {
  const int tid = ltid(wq); const int bid = lbid();
  const int lane = tid & 63, wv = tid >> 6;
  f32x4v gv[4];
#pragma unroll
  for (int i = 0; i < 4; ++i) gv[i] = *(const f32x4v*)(g + i * 256 + lane * 4);
  for (int r = bid * 4 + wv; r < rows; r += gridDim.x * 4) {
    const float* pr = in + (size_t)r * D;
    u32x4 v[4];
#pragma unroll
    for (int i = 0; i < 4; ++i) v[i] = gload16(pr + i * 256 + lane * 4);
    float ss = 0.f;
#pragma unroll
    for (int i = 0; i < 4; ++i) {
      const float a = __uint_as_float(v[i][0]), b = __uint_as_float(v[i][1]), c = __uint_as_float(v[i][2]), d = __uint_as_float(v[i][3]);
      ss += a * a + b * b + c * c + d * d;
    }
    ss = wave_sum(ss);
    const float rs = rsqrtf(ss / (float)D + 1e-6f);
#pragma unroll
    for (int i = 0; i < 4; ++i) {
      u32x4 ov;
#pragma unroll
      for (int e = 0; e < 4; ++e) ov[e] = __float_as_uint(__uint_as_float(v[i][e]) * rs * gv[i][e]);
      *(GAS u32x4*)(out + (size_t)r * D + i * 256 + lane * 4) = ov;
    }
  }
}

#define PROBE 0
constexpr int SMEM_BYTES = 73728;
__global__ void __launch_bounds__(NT, 2) mega(Params pk) {
  __shared__ __attribute__((aligned(16))) char smem_c[SMEM_BYTES];
  __shared__ uint4 xb_words;
  __shared__ Params sp;
  {
    const unsigned long long* src = (const unsigned long long*)&pk;
    unsigned long long* dst = (unsigned long long*)&sp;
    if (threadIdx.x < sizeof(Params) / 8) dst[threadIdx.x] = src[threadIdx.x];
  }
  if (threadIdx.x == 0) xb_words = make_uint4(0u, 0u, 0u, 0u);
  __syncthreads();
#define p (*lp((const __attribute__((address_space(3))) Params*)&sp))
  float* smem = (float*)smem_c;
  const int wq = __builtin_amdgcn_readfirstlane((int)(threadIdx.x >> 6));
  (void)xcd_barrier_post(p.bar, (volatile LAS unsigned*)&xb_words);
#define GRID_BARRIER() do { XcdBarrier bb_; bb_.bar = p.bar; bb_.x = xb_xcc_id(); bb_.st = (volatile LAS unsigned*)&xb_words; xcd_barrier(bb_); } while (0)

  phase_convert(wq, p.even_w_in, D, EVEN_IN, EVEN_IN, p.w_even_in, EVEN_IN, nullptr, 2, (size_t)D * EVEN_IN, (size_t)EVEN_IN * D, 0, smem, p.mix_norm, 2 * D);
  phase_convert(wq, p.even_pool_w, 128, 128, 128, p.w_even_pool, 128, p.even_pool_scale, 8, 128 * 128, 128 * 128, 128, smem);
  phase_convert(wq, p.even_w_out, D, D, D, p.w_even_out, D, nullptr, 2, (size_t)D * D, (size_t)D * D, 0, smem);
  phase_convert(wq, p.odd_w_in, D, ODD_IN, ODD_IN, p.w_odd_in, 3840, nullptr, 2, (size_t)D * ODD_IN, (size_t)3840 * D, 0, smem, p.mix_norm + D, 2 * D);
  phase_convert(wq, p.odd_w_uv, 128, 64, 64, p.w_odd_uv, 128, nullptr, 16, 128 * 64, 128 * 128, 0, smem);
  phase_convert(wq, p.odd_w_out, D, D, D, p.w_odd_out, D, nullptr, 2, (size_t)D * D, (size_t)D * D, 0, smem);
  phase_convert(wq, p.xattn_wq, D, D, D, p.w_xq, D, nullptr, 4, (size_t)D * D, (size_t)D * D, 0, smem, p.xattn_norm, D);
  phase_convert(wq, p.xattn_wkv, D, 2048, 2048, p.w_xkv, 2048, nullptr, 4, (size_t)D * 2048, (size_t)2048 * D, 0, smem);
  phase_convert(wq, p.xattn_wo, D, D, D, p.w_xo, D, nullptr, 4, (size_t)D * D, (size_t)D * D, 0, smem);
  phase_convert(wq, p.peer_wq, D, 2048, 2048, p.w_pq, 2048, nullptr, 4, (size_t)D * 2048, (size_t)2048 * D, 0, smem, p.peer_norm, D);
  phase_quant_u(wq, p.peer_u, p.u8, p.su, DEPTH * 16384, p.peer_norm, p.probe);
  phase_cvt_v8(wq, p.peer_v, p.v8, (size_t)DEPTH * 16384 * 1024 / 16, p.probe);
  phase_cvt_rows(wq, p.peer_keys, p.keys16, (size_t)DEPTH * 16 * 128 * 128 / 8);
  phase_init_h(wq, p.x, p.h, p.hn, p.rss);
  phase_lb(wq, p);
  phase_rmsnorm_bf(wq, p.mem, D, p.mem_norm, p.memn, D, NB * NMEM, D);
  GRID_BARRIER();
  for (int l = 0; l < DEPTH; ++l)
    phase_gemm_bf16<3>(wq, p.memn, D, p.w_xkv + (size_t)l * 2048 * D, p.kvh + (size_t)l * 2 * 2048 * 1024, 2048, NB * NMEM, 2048, D, smem_c, 0);
  GRID_BARRIER();
  for (int l = 0; l < DEPTH; ++l) {
    const int j = l >> 1;
    if ((l & 1) == 0) {
      phase_gemm_bf16<2, 1>(wq, p.hn, D, p.w_even_in + (size_t)j * EVEN_IN * D, p.P16, EVEN_IN, T, EVEN_IN, D, smem_c, 0, 1, 0, 0, 0, 1, 0, 0, p.rss + (size_t)(3 * l) * T * 16);
      GRID_BARRIER();
      phase_evenmix(wq, p, j);
      GRID_BARRIER();
      phase_gemm_bf16<2>(wq, p.pool, 512, p.w_even_pool + (size_t)j * 4 * 128 * 128, p.Y + 512, D, T, 128, 128, smem_c, 0, 4, 128, 128 * 128, 128);
      GRID_BARRIER();
      phase_gemm_bf16<1>(wq, p.Y, D, p.w_even_out + (size_t)j * D * D, p.h, D, T, D, D, smem_c, 0, 1, 0, 0, 0, 1, 0, 0, nullptr, p.hn, p.rss + (size_t)(3 * l + 1) * T * 16);
      GRID_BARRIER();
    } else {
      phase_gemm_bf16<2, 1>(wq, p.hn, D, p.w_odd_in + (size_t)j * 3840 * D, p.P16, ODD_IN, T, ODD_IN, D, smem_c, 0, 1, 0, 0, 0, 1, 0, 0, p.rss + (size_t)(3 * l) * T * 16);
      GRID_BARRIER();
      phase_dsa_prep(wq, p, j);
      GRID_BARRIER();
      phase_dsa_scores(wq, p, smem_c);
      GRID_BARRIER();
      phase_hgrn_scan(wq, p, l, smem_c);
      phase_dsa_attend(wq, p, j, smem_c, 64 * j);
      GRID_BARRIER();
      phase_gemm_bf16<2>(wq, p.lat, D, p.w_odd_uv + (size_t)j * 8 * 128 * 128, p.Y, D, T, 64, 128, smem_c, 0, 8, 128, 128 * 128, 64);
      phase_hgrn_post(wq, p, j);
      GRID_BARRIER();
      phase_gemm_bf16<1>(wq, p.Y, D, p.w_odd_out + (size_t)j * D * D, p.h, D, T, D, D, smem_c, 0, 1, 0, 0, 0, 1, 0, 0, nullptr, p.hn, p.rss + (size_t)(3 * l + 1) * T * 16);
      GRID_BARRIER();
    }
    phase_gemm_bf16<2, 1>(wq, p.hn, D, p.w_xq + (size_t)l * D * D, p.q16, D, T, D, D, smem_c, 0, 1, 0, 0, 0, 1, 0, 0, p.rss + (size_t)(3 * l + 1) * T * 16);
    GRID_BARRIER();
    phase_gemm_bf16<4>(wq, p.q16, D, p.kvh + (size_t)l * 2 * 2048 * 1024, p.sx, 256, S, 256, 256, smem_c, 0, 32, (size_t)S * D, 256 * 256, (size_t)S * 1024, 4, 256, (size_t)S * 256);
    GRID_BARRIER();
    phase_softmax256(wq, (const bf16_t*)p.sx, p.p16, T * 4);
    GRID_BARRIER();
    phase_gemm_bf16<2>(wq, p.p16, 256, p.kvh + (size_t)l * 2 * 2048 * 1024 + (size_t)2048 * 1024, p.Y, D, S, 256, 256, smem_c, 0, 32, (size_t)S * 1024, 256 * 256, (size_t)S * D, 4, (size_t)S * 256, 256);
    GRID_BARRIER();
    phase_gemm_bf16<1>(wq, p.Y, D, p.w_xo + (size_t)l * D * D, p.h, D, T, D, D, smem_c, 0, 1, 0, 0, 0, 1, 0, 0, nullptr, p.hn, p.rss + (size_t)(3 * l + 2) * T * 16);
    GRID_BARRIER();
    phase_peer_qs(wq, p.hn, p.w_pq + (size_t)l * 2048 * D, p.keys16 + (size_t)l * 16 * 128 * 128, p.tops, smem_c, p.rss + (size_t)(3 * l + 2) * T * 16);
    GRID_BARRIER();
    phase_peer_combine8(wq, p, l, smem_c, p.rss + (size_t)(3 * l + 2) * T * 16);
    GRID_BARRIER();
    phase_peer_udot8(wq, p, l, smem_c, 256 + (l * 2 + 0) * 128);
    GRID_BARRIER();
    phase_peer_w(wq, p);
    GRID_BARRIER();
    phase_peer_vacc8(wq, p, l, smem_c, 256 + (l * 2 + 1) * 128, 0, l + 1 < DEPTH ? 3 * l + 3 : -1);
    GRID_BARRIER();
  }
  phase_final_norm(wq, p.h, p.final_norm, p.out, T);
}

#undef p
extern "C" void kernel_launch(void* const* d_in, const int* in_sizes, int n_in, void* d_out, int out_size, void* d_ws, size_t ws_size,
                              hipStream_t stream) {
  Params p; memset(&p, 0, sizeof(p));
  const float* const* in = (const float* const*)d_in;
  p.x = in[0]; p.mem = in[1]; p.mix_norm = in[2]; p.even_w_in = in[3]; p.even_conv_w = in[4]; p.even_pool_w = in[5];
  p.even_pool_scale = in[6]; p.even_w_out = in[7]; p.odd_w_in = in[8]; p.odd_kv_norm = in[9]; p.odd_w_uv = in[10];
  p.odd_hg_norm = in[11]; p.odd_w_out = in[12]; p.hgrn_gamma = in[13]; p.rel_bias = in[14]; p.mem_norm = in[15];
  p.xattn_norm = in[16]; p.xattn_wq = in[17]; p.xattn_wkv = in[18]; p.xattn_wo = in[19]; p.peer_norm = in[20];
  p.peer_wq = in[21]; p.peer_keys = in[22]; p.peer_u = in[23]; p.peer_v = in[24]; p.final_norm = in[25];
  p.out = (float*)d_out;
  char* w = (char*)d_ws;
  auto take = [&](size_t bytes) { char* r = w; w += (bytes + 255) / 256 * 256; return r; };
  p.bar = (unsigned*)take((XCD_BAR_WORDS + 2048) * 4); p.qctr = p.bar + XCD_BAR_WORDS;
  p.h = (float*)take((size_t)T * D * 4); p.P = (float*)take((size_t)T * ODD_IN * 4); p.P16 = (bf16_t*)p.P;
  p.oraw = (float*)take((size_t)T * 512 * 4); p.lb = (float*)take(DEPTH * 512 * 4);
  p.hn = (bf16_t*)take((size_t)T * D * 2); p.Y = (bf16_t*)take((size_t)T * D * 2); p.pool = (bf16_t*)take((size_t)T * 512 * 2);
  p.memn = (bf16_t*)take((size_t)NB * NMEM * D * 2); p.lat = (bf16_t*)take((size_t)T * D * 2);
  p.w_even_in = (bf16_t*)take((size_t)2 * EVEN_IN * D * 2); p.w_even_pool = (bf16_t*)take((size_t)8 * 128 * 128 * 2);
  p.w_even_out = (bf16_t*)take((size_t)2 * D * D * 2); p.w_odd_in = (bf16_t*)take((size_t)2 * 3840 * D * 2);
  p.w_odd_uv = (bf16_t*)take((size_t)16 * 128 * 128 * 2); p.w_odd_out = (bf16_t*)take((size_t)2 * D * D * 2);
  p.w_xq = (bf16_t*)take((size_t)4 * D * D * 2); p.w_xkv = (bf16_t*)take((size_t)4 * 2048 * D * 2); p.w_xo = (bf16_t*)take((size_t)4 * D * D * 2);
  p.w_pq = (bf16_t*)take((size_t)4 * 2048 * D * 2);
  p.u8 = (signed char*)take((size_t)DEPTH * 16384 * 1024); p.v8 = (signed char*)take((size_t)DEPTH * 16384 * 1024); p.x8 = (signed char*)take((size_t)T * 1024);
  p.su = (float*)take((size_t)DEPTH * 16384 * 4); p.sxq = (float*)take((size_t)T * 4); p.sel_su = (float*)take((size_t)T * 128 * 4);
  p.keys16 = (bf16_t*)take((size_t)DEPTH * 16 * 128 * 128 * 2); p.kvh = (bf16_t*)take((size_t)DEPTH * 2 * 2048 * 1024 * 2); p.rss = (float*)take((size_t)12 * T * 16 * 4);
  {
    char* a = (char*)p.P;
    p.sx = (float*)a; a += (size_t)T * 4 * 256 * 4;
    p.p16 = (bf16_t*)a; a += (size_t)T * 4 * 256 * 2;
    p.q16 = (bf16_t*)a; a += (size_t)T * D * 2;
    p.tops = (int*)a; a += (size_t)T * 256 * 4;
    p.sel_id = (int*)a; a += (size_t)T * 128 * 4;
    p.sel_g = (float*)a; a += (size_t)T * 128 * 4;
    p.pbuf = (float*)a;
  }
  p.qlat16 = (bf16_t*)take((size_t)T * 1024 * 2); p.ckv16 = (bf16_t*)take((size_t)T * 128 * 2); p.iq16 = (bf16_t*)take((size_t)T * 512 * 2);
  p.ik16 = (bf16_t*)take((size_t)T * 64 * 2); p.sc = (float*)take((size_t)T * 2048 * 4);

  static int grid = 0;
  if (!grid) {
    int dev = 0, cus = 0, per_cu = 0;
    (void)hipGetDevice(&dev);
    (void)hipDeviceGetAttribute(&cus, hipDeviceAttributeMultiprocessorCount, dev);
    (void)hipOccupancyMaxActiveBlocksPerMultiprocessor(&per_cu, mega, NT, 0);
    if (per_cu > 2) per_cu = 2;
    if (per_cu < 1) per_cu = 1;
    grid = cus * per_cu;
  }
  p.probe = grid;
  (void)hipMemsetAsync(p.bar, 0, (XCD_BAR_WORDS + 2048) * sizeof(unsigned), stream);
  mega<<<grid, NT, 0, stream>>>(p);
}
```

```cpp
#include <hip/hip_runtime.h>
#include <hip/hip_bf16.h>
#include <stdint.h>
#include <math.h>
#include <string.h>

#define DI __device__ __forceinline__

constexpr int D = 1024, NB = 8, S = 2048, T = NB * S, DEPTH = 4, NMEM = 256;
constexpr int EVEN_IN = 2048, ODD_IN = 3784;
constexpr int NT = 256;

typedef unsigned short bf16_t;
struct Params {
  const float *x, *mem, *mix_norm, *even_w_in, *even_conv_w, *even_pool_w, *even_pool_scale, *even_w_out;
  const float *odd_w_in, *odd_kv_norm, *odd_w_uv, *odd_hg_norm, *odd_w_out, *hgrn_gamma, *rel_bias, *mem_norm;
  const float *xattn_norm, *xattn_wq, *xattn_wkv, *xattn_wo, *peer_norm, *peer_wq, *peer_keys, *peer_u, *peer_v, *final_norm;
  float* out;
  float *h, *P, *kv, *ckv, *oraw, *lb; bf16_t* P16;
  bf16_t *hn, *Y, *pool, *memn, *lat;
  bf16_t *u16, *v16, *keys16; int* tops; signed char *u8, *v8, *x8; float *su, *sxq, *sel_su;
  float* rss;
  bf16_t *q16, *kvh, *p16; float* sx; int* sel_id; float* sel_g; float* pbuf;
  bf16_t *qlat16, *ckv16, *iq16, *ik16; float* sc; unsigned* qctr;
  bf16_t *w_even_in, *w_even_pool, *w_even_out, *w_odd_in, *w_odd_uv, *w_odd_out, *w_xq, *w_xkv, *w_xo, *w_pq;
  unsigned* bar;
  int probe, pad_;
};

#define XB_TMO      128
#define XB_XCNT(j)  (256  + 64 * (j))
#define XB_XSUB(j)  (1280 + 64 * (j))
#define XB_XGEN(j)  (2304 + 64 * (j))
#define XB_TOP      3328
#define XB_TOPGEN   3392
#define XCD_BAR_WORDS 3456
#define XB_SPIN_CAP (1u << 18)
#define LAS __attribute__((address_space(3)))

__device__ __forceinline__ unsigned xb_ld(unsigned* p)              { return __hip_atomic_load(p, __ATOMIC_RELAXED, __HIP_MEMORY_SCOPE_AGENT); }
__device__ __forceinline__ unsigned xb_add(unsigned* p, unsigned v) { return __hip_atomic_fetch_add(p, v, __ATOMIC_RELAXED, __HIP_MEMORY_SCOPE_AGENT); }
__device__ __forceinline__ unsigned xb_xcc_id() { return (unsigned)__builtin_amdgcn_s_getreg((3 << 11) | 20) & 0xFu; }
#define XB_SPIN(cond, bar) do { unsigned _sp = 0; while (cond) { __builtin_amdgcn_s_sleep(1); \
    if ((++_sp & 255u) == 0u) { if (xb_ld(&(bar)[XB_TMO])) break; if (_sp > XB_SPIN_CAP) { atomicAdd(&(bar)[XB_TMO], 1u); break; } } } } while (0)

typedef const __attribute__((address_space(3))) Params& PRef;
DI const __attribute__((address_space(3))) Params* lp(const __attribute__((address_space(3))) Params* q) { asm volatile("" : "+v"(q)); return q; }
struct XcdBarrier {
    unsigned* bar; unsigned x;
    volatile LAS unsigned* st;
};

__device__ __forceinline__ XcdBarrier xcd_barrier_post(unsigned* bar, volatile LAS unsigned* st) {
    XcdBarrier b; b.bar = bar; b.x = xb_xcc_id(); b.st = st;
    if (threadIdx.x == 0) (void)xb_add(&bar[XB_XCNT(b.x)], 1u);
    return b;
}
__device__ __forceinline__ void xcd_barrier_complete(unsigned* bar, unsigned x, unsigned& nloc, unsigned& nx) {
    const unsigned G = gridDim.x * gridDim.y * gridDim.z;
    unsigned sum, cnt, mine, sp = 0u;
    for (;;) {
        sum = 0u; cnt = 0u; mine = 0u;
#pragma unroll
        for (unsigned j = 0; j < 16; ++j) { const unsigned c = xb_ld(&bar[XB_XCNT(j)]); sum += c; cnt += (c > 0u) ? 1u : 0u; mine = (j == x) ? c : mine; }
        if (sum == G) break;
        __builtin_amdgcn_s_sleep(1);
        if ((++sp & 255u) == 0u) { if (xb_ld(&bar[XB_TMO])) break; if (sp > XB_SPIN_CAP) { atomicAdd(&bar[XB_TMO], 1u); break; } }
    }
    nloc = mine > 0u ? mine : 1u; nx = cnt > 0u ? cnt : 1u;
}

__device__ __forceinline__ void xcd_barrier(const XcdBarrier& b) {
    asm volatile("s_waitcnt vmcnt(0)" ::: "memory");
    __syncthreads();
    if (threadIdx.x == 0) {
        unsigned* bar = b.bar;
        __builtin_amdgcn_s_waitcnt(0);
        unsigned nloc = b.st[0], nx = b.st[1];
        if (nloc == 0u) { xcd_barrier_complete(bar, b.x, nloc, nx); b.st[0] = nloc; b.st[1] = nx; }
        const unsigned old = xb_add(&bar[XB_XSUB(b.x)], 1u);
        const unsigned gen = old / nloc;
        if (old + 1u == (gen + 1u) * nloc) {
            __builtin_amdgcn_fence(__ATOMIC_RELEASE, "agent");
            asm volatile("s_waitcnt vmcnt(0)" ::: "memory");
            const unsigned og = xb_add(&bar[XB_TOP], 1u);
            const unsigned tg = og / nx;
            if (og + 1u == (tg + 1u) * nx) xb_add(&bar[XB_TOPGEN], 1u);
            else XB_SPIN(xb_ld(&bar[XB_TOPGEN]) == tg, bar);
            __builtin_amdgcn_fence(__ATOMIC_ACQUIRE, "agent");
            xb_add(&bar[XB_XGEN(b.x)], 1u);
            asm volatile("s_waitcnt vmcnt(0)" ::: "memory");
        } else {
            XB_SPIN(xb_ld(&bar[XB_XGEN(b.x)]) == gen, bar);
            __builtin_amdgcn_fence(__ATOMIC_ACQUIRE, "agent");
            asm volatile("s_waitcnt vmcnt(0)" ::: "memory");
        }
    }
    __syncthreads();
}


typedef __bf16 bf16x2_t __attribute__((ext_vector_type(2)));
typedef float f32x2_t __attribute__((ext_vector_type(2)));
using bf16x8 = __attribute__((ext_vector_type(8))) short;
using f32x16 = __attribute__((ext_vector_type(16))) float;
using u32x4 = __attribute__((ext_vector_type(4))) unsigned;
using u32x2 = __attribute__((ext_vector_type(2))) unsigned;
using f32x4v = __attribute__((ext_vector_type(4))) float;
using f32x2v = __attribute__((ext_vector_type(2))) float;
#define GAS __attribute__((address_space(1)))
typedef const GAS u32x4* gp_u32x4;
DI u32x4 gload16(const void* p) { return *(gp_u32x4)(p); }
DI bf16_t f2bf(float f) { __bf16 b = (__bf16)f; return __builtin_bit_cast(unsigned short, b); }
DI unsigned pack2(float a, float b) { f32x2_t v = {a, b}; bf16x2_t r = __builtin_convertvector(v, bf16x2_t); return __builtin_bit_cast(unsigned, r); }
DI float bf2f(bf16_t u) { return __uint_as_float(((unsigned)u) << 16); }
DI float bflo(unsigned u) { return __uint_as_float(u << 16); }
DI float bfhi(unsigned u) { return __uint_as_float(u & 0xffff0000u); }
DI f32x4v bf4_to_f(const u32x2 v) { const unsigned a = v[0], b = v[1]; f32x4v r; r[0] = bflo(a); r[1] = bfhi(a); r[2] = bflo(b); r[3] = bfhi(b); return r; }
DI int ltid(int wq) { int t; asm volatile("v_mbcnt_lo_u32_b32 %0, -1, 0\n\tv_mbcnt_hi_u32_b32 %0, -1, %0" : "=v"(t)); return (wq << 6) | t; }
DI int lbid() { int b = blockIdx.x; asm volatile("" : "+s"(b)); return b; }
#define DPP_F(v, ctrl, rmask, bctl) __int_as_float(__builtin_amdgcn_update_dpp(0, __float_as_int(v), (ctrl), (rmask), 0xF, (bctl)))
DI float wave_sum(float v) {
  v += DPP_F(v, 0xB1, 0xF, true);
  v += DPP_F(v, 0x4E, 0xF, true);
  v += DPP_F(v, 0x141, 0xF, true);
  v += DPP_F(v, 0x140, 0xF, true);
  v += DPP_F(v, 0x142, 0xA, false);
  v += DPP_F(v, 0x143, 0xC, false);
  return __int_as_float(__builtin_amdgcn_readlane(__float_as_int(v), 63));
}
#define DPP_I(v, ctrl, rmask, bctl) __builtin_amdgcn_update_dpp(0, (v), (ctrl), (rmask), 0xF, (bctl))
DI int wave_sum_i(int v) {
  v += DPP_I(v, 0xB1, 0xF, true); v += DPP_I(v, 0x4E, 0xF, true); v += DPP_I(v, 0x141, 0xF, true); v += DPP_I(v, 0x140, 0xF, true);
  v += DPP_I(v, 0x142, 0xA, false); v += DPP_I(v, 0x143, 0xC, false);
  return __builtin_amdgcn_readlane(v, 63);
}
DI float wave_max(float v) {
  v = fmaxf(v, DPP_F(v, 0xB1, 0xF, true));
  v = fmaxf(v, DPP_F(v, 0x4E, 0xF, true));
  v = fmaxf(v, DPP_F(v, 0x141, 0xF, true));
  v = fmaxf(v, DPP_F(v, 0x140, 0xF, true));
  { const float t = __int_as_float(__builtin_amdgcn_update_dpp(__float_as_int(v), __float_as_int(v), 0x142, 0xA, 0xF, false)); v = fmaxf(v, t); }
  { const float t = __int_as_float(__builtin_amdgcn_update_dpp(__float_as_int(v), __float_as_int(v), 0x143, 0xC, 0xF, false)); v = fmaxf(v, t); }
  return __int_as_float(__builtin_amdgcn_readlane(__float_as_int(v), 63));
}
DI float rowsum16(float v) { v += DPP_F(v, 0x128, 0xF, true); v += DPP_F(v, 0x124, 0xF, true); v += DPP_F(v, 0x122, 0xF, true); v += DPP_F(v, 0x121, 0xF, true); return v; }
DI float rowmax16(float v) { v = fmaxf(v, DPP_F(v, 0x128, 0xF, true)); v = fmaxf(v, DPP_F(v, 0x124, 0xF, true)); v = fmaxf(v, DPP_F(v, 0x122, 0xF, true)); v = fmaxf(v, DPP_F(v, 0x121, 0xF, true)); return v; }
DI float shx(float v, int mask, int lane) { return __int_as_float(__builtin_amdgcn_ds_bpermute((lane ^ mask) << 2, __float_as_int(v))); }
DI int shxi(int v, int mask, int lane) { return __builtin_amdgcn_ds_bpermute((lane ^ mask) << 2, v); }
DI float gelu_tanh(float x) {
  const float k0 = 0.7978845608028654f, k1 = 0.044715f;
  return 0.5f * x * (1.f + tanhf(k0 * (x + k1 * x * x * x)));
}
DI float sigmoidf(float x) { return 1.f / (1.f + expf(-x)); }

constexpr int HLD = 1088;
constexpr int WK = 1088;
DI float rstd_of(const float* __restrict__ rss, int row) {
  const float* q = rss + (size_t)row * 16;
  const f32x4v a = *(const f32x4v*)q, b = *(const f32x4v*)(q + 4), c = *(const f32x4v*)(q + 8), d = *(const f32x4v*)(q + 12);
  const float s0 = (a[0] + a[1]) + (a[2] + a[3]), s1 = (b[0] + b[1]) + (b[2] + b[3]), s2 = (c[0] + c[1]) + (c[2] + c[3]), s3 = (d[0] + d[1]) + (d[2] + d[3]);
  return rsqrtf(((s0 + s1) + (s2 + s3)) * (1.f / 1024.f) + 1e-6f);
}
DI void phase_init_h(const int wq, const float* __restrict__ x, float* __restrict__ h, bf16_t* __restrict__ hb, float* __restrict__ rss, int nblk) {
  const int tid = ltid(wq); const int bid = lbid();
  const int lane = tid & 63, wv = tid >> 6;
  const int stride = nblk * 4;
  for (int r0 = bid * 4 + wv; r0 < T; r0 += 2 * stride) {
    u32x4 vv[8];
#pragma unroll
    for (int u = 0; u < 2; ++u)
#pragma unroll
      for (int i = 0; i < 4; ++i) vv[u * 4 + i] = gload16(x + (size_t)(r0 + u * stride) * D + i * 256 + lane * 4);
#pragma unroll
    for (int u = 0; u < 2; ++u) {
      const int r = r0 + u * stride;
      float ss = 0.f;
#pragma unroll
      for (int i = 0; i < 4; ++i) {
        const u32x4 v = vv[u * 4 + i];
        const unsigned v0 = v[0], v1 = v[1], v2 = v[2], v3 = v[3];
        const float a = __uint_as_float(v0), b = __uint_as_float(v1), c = __uint_as_float(v2), d = __uint_as_float(v3);
        ss += a * a + b * b + c * c + d * d;
        *(GAS u32x4*)(h + (size_t)r * D + i * 256 + lane * 4) = v;
        u32x2 o; o[0] = pack2(a, b); o[1] = pack2(c, d);
        *(GAS u32x2*)(hb + (size_t)r * HLD + i * 256 + lane * 4) = o;
      }
      ss = wave_sum(ss);
      if (lane < 16) rss[(size_t)r * 16 + lane] = lane == 0 ? ss : 0.f;
    }
  }
}

DI void phase_rmsnorm_bf(const int wq, const float* __restrict__ in, int ldi, const float* __restrict__ g, bf16_t* __restrict__ out, int ldo, int rows, int W) {
  const int tid_ = ltid(wq); const int bid_ = lbid();
  const int lane = tid_ & 63, wv = tid_ >> 6;
  f32x4v gv[4];
#pragma unroll
  for (int i = 0; i < 4; ++i) gv[i] = *(const f32x4v*)(g + i * 256 + lane * 4);
  for (int r = bid_ * 4 + wv; r < rows; r += gridDim.x * 4) {
    const float* p = in + (size_t)r * ldi;
    u32x4 v[4];
#pragma unroll
    for (int i = 0; i < 4; ++i) v[i] = gload16(p + i * 256 + lane * 4);
    float ss = 0.f;
#pragma unroll
    for (int i = 0; i < 4; ++i) {
      const float a = __uint_as_float(v[i][0]), b = __uint_as_float(v[i][1]), c = __uint_as_float(v[i][2]), d = __uint_as_float(v[i][3]);
      ss += a * a + b * b + c * c + d * d;
    }
    ss = wave_sum(ss);
    const float rs = rsqrtf(ss / (float)W + 1e-6f);
    bf16_t* o = out + (size_t)r * ldo;
#pragma unroll
    for (int i = 0; i < 4; ++i) {
      u32x2 ov;
      ov[0] = pack2(__uint_as_float(v[i][0]) * rs * gv[i][0], __uint_as_float(v[i][1]) * rs * gv[i][1]);
      ov[1] = pack2(__uint_as_float(v[i][2]) * rs * gv[i][2], __uint_as_float(v[i][3]) * rs * gv[i][3]);
      *(GAS u32x2*)(o + i * 256 + lane * 4) = ov;
    }
  }
}

DI void phase_convert(const int wq, const float* __restrict__ W0, int K, int N, int ldw, bf16_t* __restrict__ Bt0, int Npad, const float* __restrict__ cs0,
                      int nbatch, size_t sW, size_t sBt, size_t sCS, float* smem, const float* __restrict__ rs0 = nullptr, size_t sRS = 0) {
  const int tid = ltid(wq); const int bid = lbid();
  float (*tl)[65] = (float (*)[65])smem;
  const int tk = K / 64, tn = Npad / 64;
  for (int tile0 = bid; tile0 < tk * tn * nbatch; tile0 += gridDim.x) {
    const int bt = tile0 / (tk * tn), tile = tile0 % (tk * tn);
    const int k0 = (tile / tn) * 64, n0 = (tile % tn) * 64;
    const float* W = W0 + (size_t)bt * sW;
    bf16_t* Bt = Bt0 + (size_t)bt * sBt;
    __syncthreads();
    {
      const int n = tid & 63, kb = tid >> 6;
      const bool inb = n0 + n < N;
      float vv[16];
#pragma unroll
      for (int i = 0; i < 16; ++i) vv[i] = inb ? W[(size_t)(k0 + i * 4 + kb) * ldw + n0 + n] : 0.f;
      const float csv = (inb && cs0) ? cs0[(size_t)bt * sCS + n0 + n] : 1.f;
#pragma unroll
      for (int i = 0; i < 16; ++i) {
        float v = vv[i] * csv;
        if (rs0) v *= rs0[(size_t)bt * sRS + k0 + i * 4 + kb];
        tl[i * 4 + kb][n] = v;
      }
    }
    __syncthreads();
    {
      const int k8 = (tid & 7) * 8;
#pragma unroll
      for (int i = 0; i < 2; ++i) {
        const int n = (tid >> 3) + 32 * i;
        u32x4 o;
#pragma unroll
        for (int q = 0; q < 4; ++q) o[q] = pack2(tl[k8 + 2 * q][n], tl[k8 + 2 * q + 1][n]);
        *(GAS u32x4*)(Bt + (size_t)(n0 + n) * (K == 1024 ? WK : K) + k0 + k8) = o;
      }
    }
  }
}

constexpr int G_LDS_ROW = 144;
constexpr int G_TILE_B = 128 * G_LDS_ROW;
template <int MODE, int RS = 0>
DI void phase_gemm_bf16(const int wq, const bf16_t* __restrict__ A0, int lda, const bf16_t* __restrict__ B0, void* __restrict__ C0, int ldc,
                        int M, int N, int K, char* smem, int dry, int nbatch = 1, size_t sA = 0, size_t sB = 0, size_t sC = 0,
                        int inner = 1, size_t sA2 = 0, size_t sC2 = 0, const float* __restrict__ rss_in = nullptr, bf16_t* __restrict__ hb_out = nullptr, float* __restrict__ rss_out = nullptr) {
  const int tid = ltid(wq); const int bid = lbid();
  const int lane = tid & 63, wv = tid >> 6, wm = wv >> 1, wn = wv & 1;
  const int r = lane & 31, hh = lane >> 5;
  const int tm = M / 128, tn = (N + 127) / 128;
  const int nk = K / 64;
  const int srow = tid >> 3, skc = tid & 7;
  const int ntile_all = tm * tn * nbatch;
  const int per_x = (ntile_all + 7) >> 3;
  const int t_beg = (bid & 7) * per_x, t_end = (t_beg + per_x < ntile_all) ? t_beg + per_x : ntile_all;
  for (int tile0 = t_beg + (bid >> 3); tile0 < t_end; tile0 += (int)(gridDim.x >> 3)) {
    const int bt = tile0 / (tm * tn), tile = tile0 % (tm * tn);
    const int m0 = (tile / tn) * 128, n0 = (tile % tn) * 128;
    const int bhi = bt / inner, blo = bt % inner;
    const bf16_t* Ag = A0 + (size_t)bhi * sA + (size_t)blo * sA2 + (size_t)(m0 + srow) * lda + skc * 8;
    const int ldb = (K == 1024) ? WK : K;
    const bf16_t* Bg = B0 + (size_t)bt * sB + (size_t)(n0 + srow) * ldb + skc * 8;
    f32x16 acc[2][2];
#pragma unroll
    for (int i = 0; i < 2; ++i)
#pragma unroll
      for (int j = 0; j < 2; ++j)
#pragma unroll
        for (int e = 0; e < 16; ++e) acc[i][j][e] = 0.f;
    u32x4 ra[4], rb[4];
#pragma unroll
    for (int i = 0; i < 4; ++i) {
      ra[i] = gload16(Ag + (size_t)(32 * i) * lda);
      rb[i] = gload16(Bg + (size_t)(32 * i) * ldb);
    }
    __syncthreads();
#pragma unroll
    for (int i = 0; i < 4; ++i) {
      *(u32x4*)(smem + (srow + 32 * i) * G_LDS_ROW + skc * 16) = ra[i];
      *(u32x4*)(smem + 2 * G_TILE_B + (srow + 32 * i) * G_LDS_ROW + skc * 16) = rb[i];
    }
    __syncthreads();
#pragma unroll 1
    for (int kt = 0; kt < nk; ++kt) {
      const int cur = kt & 1;
      if (kt + 1 < nk) {
#pragma unroll
        for (int i = 0; i < 4; ++i) {
          ra[i] = gload16(Ag + (size_t)(32 * i) * lda + (kt + 1) * 64);
          rb[i] = gload16(Bg + (size_t)(32 * i) * ldb + (kt + 1) * 64);
        }
      }
      const char* As = smem + cur * G_TILE_B + (wm * 64 + r) * G_LDS_ROW + hh * 16;
      const char* Bs = smem + 2 * G_TILE_B + cur * G_TILE_B + (wn * 64 + r) * G_LDS_ROW + hh * 16;
      bf16x8 a0 = *(const bf16x8*)(As), a1 = *(const bf16x8*)(As + 32 * G_LDS_ROW), b0 = *(const bf16x8*)(Bs), b1 = *(const bf16x8*)(Bs + 32 * G_LDS_ROW);
#pragma unroll
      for (int ks = 0; ks < 4; ++ks) {
        bf16x8 na0 = a0, na1 = a1, nb0 = b0, nb1 = b1;
        if (ks < 3) {
          na0 = *(const bf16x8*)(As + (ks + 1) * 32); na1 = *(const bf16x8*)(As + 32 * G_LDS_ROW + (ks + 1) * 32);
          nb0 = *(const bf16x8*)(Bs + (ks + 1) * 32); nb1 = *(const bf16x8*)(Bs + 32 * G_LDS_ROW + (ks + 1) * 32);
        }
        acc[0][0] = __builtin_amdgcn_mfma_f32_32x32x16_bf16(a0, b0, acc[0][0], 0, 0, 0);
        acc[0][1] = __builtin_amdgcn_mfma_f32_32x32x16_bf16(a0, b1, acc[0][1], 0, 0, 0);
        acc[1][0] = __builtin_amdgcn_mfma_f32_32x32x16_bf16(a1, b0, acc[1][0], 0, 0, 0);
        acc[1][1] = __builtin_amdgcn_mfma_f32_32x32x16_bf16(a1, b1, acc[1][1], 0, 0, 0);
        a0 = na0; a1 = na1; b0 = nb0; b1 = nb1;
      }
      __builtin_amdgcn_sched_group_barrier(0x100, 8, 0);
      __builtin_amdgcn_sched_group_barrier(0x008, 4, 0);
      __builtin_amdgcn_sched_group_barrier(0x100, 4, 0);
      __builtin_amdgcn_sched_group_barrier(0x008, 4, 0);
      __builtin_amdgcn_sched_group_barrier(0x100, 4, 0);
      __builtin_amdgcn_sched_group_barrier(0x008, 8, 0);
      if (kt + 1 < nk) {
        const int nxt = cur ^ 1;
#pragma unroll
        for (int i = 0; i < 4; ++i) {
          *(u32x4*)(smem + nxt * G_TILE_B + (srow + 32 * i) * G_LDS_ROW + skc * 16) = ra[i];
          *(u32x4*)(smem + 2 * G_TILE_B + nxt * G_TILE_B + (srow + 32 * i) * G_LDS_ROW + skc * 16) = rb[i];
        }
      }
      __syncthreads();
    }
    if (RS) {
      if (tid < 128) ((float*)smem)[tid] = rstd_of(rss_in, m0 + tid);
      __syncthreads();
    }
#pragma unroll
    for (int i = 0; i < 2; ++i)
#pragma unroll
      for (int j = 0; j < 2; ++j) {
        const int col = n0 + wn * 64 + j * 32 + r;
        if (col < N && !dry) {
          const size_t base = (size_t)bhi * sC + (size_t)blo * sC2 + (size_t)(m0 + wm * 64 + i * 32 + 4 * hh) * ldc + col;
          if (RS) {
            const float* rp = (const float*)smem + wm * 64 + i * 32 + 4 * hh;
#pragma unroll
            for (int e = 0; e < 16; ++e) acc[i][j][e] *= rp[(e & 3) + 8 * (e >> 2)];
          }
          if (MODE == 1) {
            GAS float* cp = (GAS float*)C0 + base;
            float old[16];
#pragma unroll
            for (int e = 0; e < 16; ++e) old[e] = cp[(size_t)((e & 3) + 8 * (e >> 2)) * ldc];
#pragma unroll
            for (int e = 0; e < 16; ++e) { old[e] += acc[i][j][e]; acc[i][j][e] = old[e]; cp[(size_t)((e & 3) + 8 * (e >> 2)) * ldc] = old[e]; }
            if (hb_out) {
              GAS bf16_t* hp = (GAS bf16_t*)hb_out + (size_t)(m0 + wm * 64 + i * 32 + 4 * hh) * HLD + col;
#pragma unroll
              for (int e = 0; e < 16; ++e) hp[(size_t)((e & 3) + 8 * (e >> 2)) * HLD] = f2bf(old[e]);
            }
          } else if (MODE == 0) {
            GAS float* cp = (GAS float*)C0 + base;
#pragma unroll
            for (int e = 0; e < 16; ++e) cp[(size_t)((e & 3) + 8 * (e >> 2)) * ldc] = acc[i][j][e];
          } else if (MODE == 2) {
            GAS bf16_t* cp = (GAS bf16_t*)C0 + base;
#pragma unroll
            for (int e = 0; e < 16; ++e) cp[(size_t)((e & 3) + 8 * (e >> 2)) * ldc] = f2bf(acc[i][j][e]);
          } else if (MODE == 4) {
            GAS bf16_t* cp = (GAS bf16_t*)C0 + base;
#pragma unroll
            for (int e = 0; e < 16; ++e) cp[(size_t)((e & 3) + 8 * (e >> 2)) * ldc] = f2bf(acc[i][j][e] * 0.0625f);
          } else {
            const int rowb = m0 + wm * 64 + i * 32 + 4 * hh;
            const int b_ = rowb >> 8, mm = rowb & 255;
            const int cc = col & 1023, hd_ = cc >> 8, dd = cc & 255;
            GAS bf16_t* kb = (GAS bf16_t*)C0 + (size_t)bhi * sC + (size_t)blo * sC2;
            if (col < 1024) {
#pragma unroll
              for (int e = 0; e < 16; ++e) kb[((size_t)(b_ * 4 + hd_) * 256 + mm + (e & 3) + 8 * (e >> 2)) * 256 + dd] = f2bf(acc[i][j][e]);
            } else {
#pragma unroll
              for (int e = 0; e < 16; ++e) kb[(size_t)2048 * 1024 + ((size_t)(b_ * 4 + hd_) * 256 + dd) * 256 + mm + (e & 3) + 8 * (e >> 2)] = f2bf(acc[i][j][e]);
            }
          }
        }
      }
    if (MODE == 1 && rss_out && !dry) {
#pragma unroll
      for (int i = 0; i < 2; ++i) {
        float myv = 0.f;
#pragma unroll
        for (int e = 0; e < 16; ++e) {
          float v = acc[i][0][e] * acc[i][0][e] + acc[i][1][e] * acc[i][1][e];
          v = rowsum16(v);
          v += shx(v, 16, lane);
          if ((lane & 15) == e) myv = v;
        }
        if ((lane & 16) == 0) rss_out[(size_t)(m0 + wm * 64 + i * 32 + (lane & 3) + 8 * ((lane & 15) >> 2) + 4 * hh) * 16 + (n0 >> 7) * 2 + wn] = myv;
      }
    }
  }
}

constexpr int W_LROW = 144;
constexpr int W_ASZ = 128 * W_LROW, W_BSZ = 256 * W_LROW, W_STAGE = W_ASZ + W_BSZ;
template <int MODE, int RS = 0>
DI void phase_gemm_wide(const int wq, const bf16_t* __restrict__ A0, int lda, const bf16_t* __restrict__ B0, void* __restrict__ C0, int ldc,
                        int M, int N, int K, char* smem, int dry, int nbatch = 1, size_t sA = 0, size_t sB = 0, size_t sC = 0,
                        int inner = 1, size_t sA2 = 0, size_t sC2 = 0, const float* __restrict__ rss_in = nullptr, bf16_t* __restrict__ hb_out = nullptr, float* __restrict__ rss_out = nullptr) {
  if (MODE == 6 || MODE == 1) {
    auto to_sgpr = [](const void* q_) { const unsigned long long v = (unsigned long long)q_;
      const unsigned lo = __builtin_amdgcn_readfirstlane((unsigned)v), hi2 = __builtin_amdgcn_readfirstlane((unsigned)(v >> 32));
      return (void*)(((unsigned long long)hi2 << 32) | lo); };
    C0 = to_sgpr(C0); hb_out = (bf16_t*)to_sgpr(hb_out); rss_in = (const float*)to_sgpr(rss_in);
    A0 = (const bf16_t*)to_sgpr(A0); B0 = (const bf16_t*)to_sgpr(B0);
    rss_out = (float*)to_sgpr(rss_out);
  }
  const int tid = ltid(wq); const int bid = lbid();
  const int lane = tid & 63, wv = tid >> 6, wm = wv >> 1, wn = wv & 1;
  const int r = lane & 31, hh = lane >> 5;
  const int tm = M / 128, tn = (N + 255) / 256;
  const int nk = K / 64;
  const int srow0 = tid >> 3, skc0 = tid & 7;
  const int ntile_all = tm * tn * nbatch;
  const int per_x = (ntile_all + 7) >> 3;
  const int t_beg = (bid & 7) * per_x, t_end = (t_beg + per_x < ntile_all) ? t_beg + per_x : ntile_all;
  for (int tile0 = t_beg + (bid >> 3); tile0 < t_end; tile0 += (int)(gridDim.x >> 3)) {
    const int bt = tile0 / (tm * tn), tile = tile0 % (tm * tn);
    const int m0 = (tile / tn) * 128, n0 = (tile % tn) * 256;
    const int bhi = bt / inner, blo = bt % inner;
    int srow = srow0, skc = skc0;
    asm volatile("" : "+v"(srow), "+v"(skc));
    const bf16_t* Ag = A0 + (size_t)bhi * sA + (size_t)blo * sA2 + (size_t)(m0 + srow) * lda + skc * 8;
    const int ldb = (K == 1024) ? WK : K;
    const bf16_t* Bg = B0 + (size_t)bt * sB + (size_t)(n0 + srow) * ldb + skc * 8;
    f32x16 acc[2][4];
#pragma unroll
    for (int i = 0; i < 2; ++i)
#pragma unroll
      for (int j = 0; j < 4; ++j)
#pragma unroll
        for (int e = 0; e < 16; ++e) acc[i][j][e] = 0.f;
    u32x4 ra[4], rb[8];
#pragma unroll
    for (int i = 0; i < 4; ++i) ra[i] = gload16(Ag + (size_t)(32 * i) * lda);
#pragma unroll
    for (int i = 0; i < 8; ++i) rb[i] = gload16(Bg + (size_t)(32 * i) * ldb);
    __syncthreads();
#pragma unroll
    for (int i = 0; i < 4; ++i) *(u32x4*)(smem + (srow + 32 * i) * W_LROW + skc * 16) = ra[i];
#pragma unroll
    for (int i = 0; i < 8; ++i) *(u32x4*)(smem + W_ASZ + (srow + 32 * i) * W_LROW + skc * 16) = rb[i];
    __syncthreads();
#pragma unroll 1
    for (int kt = 0; kt < nk; ++kt) {
      if (kt + 1 < nk) {
#pragma unroll
        for (int i = 0; i < 4; ++i) ra[i] = gload16(Ag + (size_t)(32 * i) * lda + (kt + 1) * 64);
#pragma unroll
        for (int i = 0; i < 8; ++i) rb[i] = gload16(Bg + (size_t)(32 * i) * ldb + (kt + 1) * 64);
      }
      const char* As = smem + (wm * 64 + r) * W_LROW + hh * 16;
      const char* Bs = smem + W_ASZ + (wn * 128 + r) * W_LROW + hh * 16;
#pragma unroll
      for (int ks = 0; ks < 4; ++ks) {
        const bf16x8 a0 = *(const bf16x8*)(As + ks * 32), a1 = *(const bf16x8*)(As + 32 * W_LROW + ks * 32);
        bf16x8 b[4];
#pragma unroll
        for (int j = 0; j < 4; ++j) b[j] = *(const bf16x8*)(Bs + j * 32 * W_LROW + ks * 32);
#pragma unroll
        for (int j = 0; j < 4; ++j) {
          acc[0][j] = __builtin_amdgcn_mfma_f32_32x32x16_bf16(a0, b[j], acc[0][j], 0, 0, 0);
          acc[1][j] = __builtin_amdgcn_mfma_f32_32x32x16_bf16(a1, b[j], acc[1][j], 0, 0, 0);
        }
      }
      __builtin_amdgcn_sched_group_barrier(0x100, 6, 0);
      __builtin_amdgcn_sched_group_barrier(0x100, 6, 0);
      __builtin_amdgcn_sched_group_barrier(0x008, 8, 0);
      __builtin_amdgcn_sched_group_barrier(0x100, 6, 0);
      __builtin_amdgcn_sched_group_barrier(0x008, 8, 0);
      __builtin_amdgcn_sched_group_barrier(0x100, 6, 0);
      __builtin_amdgcn_sched_group_barrier(0x008, 8, 0);
      __builtin_amdgcn_sched_group_barrier(0x008, 8, 0);
      __syncthreads();
      if (kt + 1 < nk) {
#pragma unroll
        for (int i = 0; i < 4; ++i) *(u32x4*)(smem + (srow + 32 * i) * W_LROW + skc * 16) = ra[i];
#pragma unroll
        for (int i = 0; i < 8; ++i) *(u32x4*)(smem + W_ASZ + (srow + 32 * i) * W_LROW + skc * 16) = rb[i];
      }
      __syncthreads();
    }
    if (RS) {
      if (tid < 128) ((float*)smem)[tid] = rstd_of(rss_in, m0 + tid);
      __syncthreads();
    }
    if (MODE == 6) {
      constexpr int PROW = 528;
      const int kb = (m0 >> 11) * 4 + (n0 >> 8);
      const bf16_t* Ktile = (const bf16_t*)hb_out + (size_t)kb * 256 * 256;
      const bf16_t* Vtile = Ktile + (size_t)2048 * 1024;
      auto acc_to_lds = [&](const float (&sc)[2][16]) {
#pragma unroll
        for (int i = 0; i < 2; ++i)
#pragma unroll
          for (int j = 0; j < 4; ++j)
#pragma unroll
            for (int e = 0; e < 16; ++e)
              *(bf16_t*)(smem + (wm * 64 + i * 32 + (e & 3) + 8 * (e >> 2) + 4 * hh) * PROW + (wn * 128 + j * 32 + r) * 2) = f2bf(acc[i][j][e] * sc[i][e]);
      };
      auto lds_gemm = [&](const bf16_t* Bt) {
        const bf16_t* Bg = Bt + (size_t)(wn * 128 + r) * 256 + hh * 8;
        u32x4 vq[4][4];
#pragma unroll
        for (int sl = 0; sl < 4; ++sl)
#pragma unroll
          for (int j = 0; j < 4; ++j) vq[sl][j] = gload16(Bg + (size_t)(j * 32) * 256 + sl * 16);
        __syncthreads();
#pragma unroll
        for (int i = 0; i < 2; ++i)
#pragma unroll
          for (int j = 0; j < 4; ++j)
#pragma unroll
            for (int e = 0; e < 16; ++e) acc[i][j][e] = 0.f;
        const char* Pa = smem + (wm * 64 + r) * PROW + hh * 16;
#pragma unroll
        for (int ks = 0; ks < 16; ++ks) {
          const int sl = ks & 3;
          const bf16x8 a0 = *(const bf16x8*)(Pa + ks * 32), a1 = *(const bf16x8*)(Pa + 32 * PROW + ks * 32);
#pragma unroll
          for (int j = 0; j < 4; ++j) {
            const bf16x8 bj = __builtin_bit_cast(bf16x8, vq[sl][j]);
            acc[0][j] = __builtin_amdgcn_mfma_f32_32x32x16_bf16(a0, bj, acc[0][j], 0, 0, 0);
            acc[1][j] = __builtin_amdgcn_mfma_f32_32x32x16_bf16(a1, bj, acc[1][j], 0, 0, 0);
          }
          if (ks + 4 < 16) {
#pragma unroll
            for (int j = 0; j < 4; ++j) vq[sl][j] = gload16(Bg + (size_t)(j * 32) * 256 + (ks + 4) * 16);
          }
        }
      };
      {
        float sc[2][16];
#pragma unroll
        for (int i = 0; i < 2; ++i)
#pragma unroll
          for (int e = 0; e < 16; ++e) sc[i][e] = ((const float*)smem)[wm * 64 + i * 32 + (e & 3) + 8 * (e >> 2) + 4 * hh];
        __syncthreads();
        acc_to_lds(sc);
      }
      lds_gemm(Ktile);
      __syncthreads();
      float* smax = (float*)smem;
      float* ssum = (float*)smem + 256;
      const int rowl = (lane & 3) + 8 * ((lane & 15) >> 2) + 4 * hh;
#pragma unroll
      for (int i = 0; i < 2; ++i) {
        float myv = 0.f;
#pragma unroll
        for (int e = 0; e < 16; ++e) {
#pragma unroll
          for (int j = 0; j < 4; ++j) acc[i][j][e] *= 0.0625f;
          float m = fmaxf(fmaxf(acc[i][0][e], acc[i][1][e]), fmaxf(acc[i][2][e], acc[i][3][e]));
          m = rowmax16(m);
          m = fmaxf(m, shx(m, 16, lane));
          if ((lane & 15) == e) myv = m;
        }
        if ((lane & 16) == 0) smax[wn * 128 + wm * 64 + i * 32 + rowl] = myv;
      }
      __syncthreads();
#pragma unroll
      for (int i = 0; i < 2; ++i) {
        float myv = 0.f;
#pragma unroll
        for (int e = 0; e < 16; ++e) {
          const int row = wm * 64 + i * 32 + (e & 3) + 8 * (e >> 2) + 4 * hh;
          const float m = fmaxf(smax[row], smax[128 + row]);
          float sm = 0.f;
#pragma unroll
          for (int j = 0; j < 4; ++j) { const float pe = __expf(acc[i][j][e] - m); acc[i][j][e] = pe; sm += pe; }
          sm = rowsum16(sm);
          sm += shx(sm, 16, lane);
          if ((lane & 15) == e) myv = sm;
        }
        if ((lane & 16) == 0) ssum[wn * 128 + wm * 64 + i * 32 + rowl] = myv;
      }
      __syncthreads();
      {
        float inv[2][16];
#pragma unroll
        for (int i = 0; i < 2; ++i)
#pragma unroll
          for (int e = 0; e < 16; ++e) { const int row = wm * 64 + i * 32 + (e & 3) + 8 * (e >> 2) + 4 * hh; inv[i][e] = 1.f / (ssum[row] + ssum[128 + row]); }
        __syncthreads();
        acc_to_lds(inv);
      }
      lds_gemm(Vtile);
      if (!dry) {
#pragma unroll
        for (int i = 0; i < 2; ++i)
#pragma unroll
          for (int j = 0; j < 4; ++j) {
            GAS bf16_t* cp = (GAS bf16_t*)C0 + (size_t)(m0 + wm * 64 + i * 32 + 4 * hh) * ldc + n0 + wn * 128 + j * 32 + r;
#pragma unroll
            for (int e = 0; e < 16; ++e) cp[(size_t)((e & 3) + 8 * (e >> 2)) * ldc] = f2bf(acc[i][j][e]);
          }
      }
    }
    if (MODE == 1) {
      float* wt = (float*)(smem + wv * 16896);
      if (!dry) {
#pragma unroll
        for (int i = 0; i < 2; ++i) {
          const size_t rowbase = (size_t)(m0 + wm * 64 + i * 32);
          const int colbase = n0 + wn * 128;
#pragma unroll
          for (int j = 0; j < 4; ++j)
#pragma unroll
            for (int e = 0; e < 16; ++e) wt[((e & 3) + 8 * (e >> 2) + 4 * hh) * 132 + j * 32 + r] = acc[i][j][e];
#pragma unroll
          for (int qh = 0; qh < 2; ++qh) {
          u32x4 oldq[8];
#pragma unroll
          for (int q8 = 0; q8 < 8; ++q8) {
            const int c = lane + 64 * (qh * 8 + q8), row = c >> 5, c4 = c & 31;
            oldq[q8] = gload16((const float*)C0 + (rowbase + row) * ldc + colbase + c4 * 4);
          }
#pragma unroll
          for (int q8 = 0; q8 < 8; ++q8) {
            const int q = qh * 8 + q8;
            const int c = lane + 64 * q, row = c >> 5, c4 = c & 31;
            const f32x4v v = *(const f32x4v*)(wt + row * 132 + c4 * 4);
            const u32x4 oq = oldq[q8];
            const unsigned o0 = oq[0], o1 = oq[1], o2 = oq[2], o3 = oq[3];
            const float h0 = __uint_as_float(o0) + v[0], h1 = __uint_as_float(o1) + v[1], h2 = __uint_as_float(o2) + v[2], h3 = __uint_as_float(o3) + v[3];
            u32x4 hv; hv[0] = __float_as_uint(h0); hv[1] = __float_as_uint(h1); hv[2] = __float_as_uint(h2); hv[3] = __float_as_uint(h3);
            *(GAS u32x4*)((float*)C0 + (rowbase + row) * ldc + colbase + c4 * 4) = hv;
            if (hb_out) { u32x2 hb2; hb2[0] = pack2(h0, h1); hb2[1] = pack2(h2, h3); *(GAS u32x2*)(hb_out + (rowbase + row) * HLD + colbase + c4 * 4) = hb2; }
            if (rss_out) {
              float ss = h0 * h0 + h1 * h1 + h2 * h2 + h3 * h3;
              ss = rowsum16(ss);
              if ((lane & 15) == 0) rss_out[(rowbase + row) * 16 + (n0 >> 6) + wn * 2 + (c4 >> 4)] = ss;
            }
          }
          }
        }
      }
    }
    if (MODE != 6 && MODE != 1)
#pragma unroll
    for (int i = 0; i < 2; ++i) {
      float oldv[4][16];
      if (MODE == 1) {
#pragma unroll
        for (int j = 0; j < 4; ++j) {
          const int col = n0 + wn * 128 + j * 32 + r;
          const GAS float* cq = (const GAS float*)C0 + (size_t)bhi * sC + (size_t)blo * sC2 + (size_t)(m0 + wm * 64 + i * 32 + 4 * hh) * ldc + col;
#pragma unroll
          for (int e = 0; e < 16; ++e) oldv[j][e] = (col < N && !dry) ? cq[(size_t)((e & 3) + 8 * (e >> 2)) * ldc] : 0.f;
        }
      }
#pragma unroll
      for (int j = 0; j < 4; ++j) {
        const int col = n0 + wn * 128 + j * 32 + r;
        if (col < N && !dry) {
          const size_t base = (size_t)bhi * sC + (size_t)blo * sC2 + (size_t)(m0 + wm * 64 + i * 32 + 4 * hh) * ldc + col;
          if (RS) {
            const float* rp = (const float*)smem + wm * 64 + i * 32 + 4 * hh;
#pragma unroll
            for (int e = 0; e < 16; ++e) acc[i][j][e] *= rp[(e & 3) + 8 * (e >> 2)];
          }
          if (MODE == 1) {
            GAS float* cp = (GAS float*)C0 + base;
            float old[16];
#pragma unroll
            for (int e = 0; e < 16; ++e) old[e] = oldv[j][e];
#pragma unroll
            for (int e = 0; e < 16; ++e) { old[e] += acc[i][j][e]; acc[i][j][e] = old[e]; cp[(size_t)((e & 3) + 8 * (e >> 2)) * ldc] = old[e]; }
            if (hb_out) {
              GAS bf16_t* hp = (GAS bf16_t*)hb_out + (size_t)(m0 + wm * 64 + i * 32 + 4 * hh) * HLD + col;
#pragma unroll
              for (int e = 0; e < 16; ++e) hp[(size_t)((e & 3) + 8 * (e >> 2)) * HLD] = f2bf(old[e]);
            }
          } else if (MODE == 0) {
            GAS float* cp = (GAS float*)C0 + base;
#pragma unroll
            for (int e = 0; e < 16; ++e) cp[(size_t)((e & 3) + 8 * (e >> 2)) * ldc] = acc[i][j][e];
          } else if (MODE == 2) {
            GAS bf16_t* cp = (GAS bf16_t*)C0 + base;
#pragma unroll
            for (int e = 0; e < 16; ++e) cp[(size_t)((e & 3) + 8 * (e >> 2)) * ldc] = f2bf(acc[i][j][e]);
          } else if (MODE == 4) {
            GAS bf16_t* cp = (GAS bf16_t*)C0 + base;
#pragma unroll
            for (int e = 0; e < 16; ++e) cp[(size_t)((e & 3) + 8 * (e >> 2)) * ldc] = f2bf(acc[i][j][e] * 0.0625f);
          } else if (MODE == 7) {
            const int cb = n0 + wn * 128 + j * 32;
            if (cb < 1024 || cb >= 1152) {
              GAS bf16_t* dst; size_t ldd; int cofs;
              if (cb < 1024) { dst = (GAS bf16_t*)hb_out; ldd = 1024; cofs = col; }
              else if (cb < 1664) { dst = (GAS bf16_t*)hb_out + (size_t)T * (1024 + 128); ldd = 512; cofs = col - 1152; }
              else if (cb < 1728) { dst = (GAS bf16_t*)hb_out + (size_t)T * (1024 + 128 + 512); ldd = 64; cofs = col - 1664; }
              else { dst = (GAS bf16_t*)C0; ldd = (size_t)ldc; cofs = col; }
              GAS bf16_t* cp = dst + (size_t)(m0 + wm * 64 + i * 32 + 4 * hh) * ldd + cofs;
#pragma unroll
              for (int e = 0; e < 16; ++e) cp[(size_t)((e & 3) + 8 * (e >> 2)) * ldd] = f2bf(acc[i][j][e]);
            }
          } else {
            const int rowb = m0 + wm * 64 + i * 32 + 4 * hh;
            const int b_ = rowb >> 8, mm = rowb & 255;
            const int cc = col & 1023, hd_ = cc >> 8, dd = cc & 255;
            GAS bf16_t* kb = (GAS bf16_t*)C0 + (size_t)bhi * sC + (size_t)blo * sC2;
            if (col < 1024) {
#pragma unroll
              for (int e = 0; e < 16; ++e) kb[((size_t)(b_ * 4 + hd_) * 256 + mm + (e & 3) + 8 * (e >> 2)) * 256 + dd] = f2bf(acc[i][j][e]);
            } else {
#pragma unroll
              for (int g4 = 0; g4 < 4; ++g4) {
                u32x2 o2; o2[0] = pack2(acc[i][j][4 * g4], acc[i][j][4 * g4 + 1]); o2[1] = pack2(acc[i][j][4 * g4 + 2], acc[i][j][4 * g4 + 3]);
                *(GAS u32x2*)(kb + (size_t)2048 * 1024 + ((size_t)(b_ * 4 + hd_) * 256 + dd) * 256 + mm + 8 * g4) = o2;
              }
            }
          }
        }
      }
    }
    if (MODE == 7 && n0 == 1024 && wn == 0 && !dry) {
      const float* g = (const float*)rss_out;
      GAS bf16_t* ck = (GAS bf16_t*)hb_out + (size_t)T * 1024;
#pragma unroll
      for (int i = 0; i < 2; ++i)
#pragma unroll
        for (int e = 0; e < 16; ++e) {
          float ss = acc[i][0][e] * acc[i][0][e] + acc[i][1][e] * acc[i][1][e] + acc[i][2][e] * acc[i][2][e] + acc[i][3][e] * acc[i][3][e];
          ss = rowsum16(ss);
          ss += shx(ss, 16, lane);
          const float rs = rsqrtf(ss * (1.f / 128.f) + 1e-6f);
          const size_t row = (size_t)(m0 + wm * 64 + i * 32 + (e & 3) + 8 * (e >> 2) + 4 * hh);
#pragma unroll
          for (int j = 0; j < 4; ++j) ck[row * 128 + j * 32 + r] = f2bf(acc[i][j][e] * rs * g[j * 32 + r]);
        }
    }
  }
}

template <int W>
DI void evenmix_run(const bf16_t* __restrict__ P, const float* __restrict__ cw, bf16_t* __restrict__ Y, bf16_t* __restrict__ pool, int t0, int c) {
  const int s0 = t0 & (S - 1);
  f32x4v w0 = *(const f32x4v*)(cw + c), w1 = *(const f32x4v*)(cw + 512 + c), w2 = *(const f32x4v*)(cw + 1024 + c);
  const f32x4v zero = {0.f, 0.f, 0.f, 0.f};
  auto ld = [&](int t, int off) { const u32x2 v = *(const GAS u32x2*)(P + (size_t)t * EVEN_IN + off + c); return bf4_to_f(v); };
  f32x4v xm2 = zero, xm1 = zero;
  if (s0 >= 2) xm2 = ld(t0 - 2, 512) * ld(t0 - 2, 0);
  if (s0 >= 1) xm1 = ld(t0 - 1, 512) * ld(t0 - 1, 0);
  f32x4v ring[W];
  f32x4v sum = zero;
#pragma unroll
  for (int i = 0; i < W; ++i) { ring[i] = (s0 + i - W >= 0) ? ld(t0 + i - W, 1536) : zero; sum += ring[i]; }
#pragma unroll
  for (int tt = 0; tt < 32; ++tt) {
    const int t = t0 + tt;
    const f32x4v x0 = ld(t, 512) * ld(t, 0);
    const f32x4v z = w0 * xm2 + w1 * xm1 + w2 * x0;
    xm2 = xm1; xm1 = x0;
    const f32x4v ya = ld(t, 1024) * z;
    const f32x4v pv = ld(t, 1536);
    sum += pv - ring[tt % W]; ring[tt % W] = pv;
    const int cnt = (s0 + tt + 1 < W) ? (s0 + tt + 1) : W;
    const float ic = 1.f / (float)cnt;
    const f32x4v pl = sum * ic - pv;
    u32x2 oa, ob;
    oa[0] = pack2(ya[0], ya[1]); oa[1] = pack2(ya[2], ya[3]);
    ob[0] = pack2(pl[0], pl[1]); ob[1] = pack2(pl[2], pl[3]);
    *(GAS u32x2*)(Y + (size_t)t * D + c) = oa;
    *(GAS u32x2*)(pool + (size_t)t * 512 + c) = ob;
  }
}
DI void phase_evenmix(const int wq, PRef p, int j) {
  const int tid = ltid(wq); const int bid = lbid();
  const int lane = tid & 63, wv = tid >> 6;
  const float* cw = p.even_conv_w + (size_t)j * 3 * 512;
  for (int Wg = bid * 4 + wv; Wg < 1024; Wg += gridDim.x * 4) {
    const int g = Wg & 3, cp = Wg >> 2;
    const int t0 = (cp * 2 + (lane >> 5)) * 32;
    const int c = g * 128 + (lane & 31) * 4;
    if (g == 0) evenmix_run<2>(p.P16, cw, p.Y, p.pool, t0, c);
    else if (g == 1) evenmix_run<4>(p.P16, cw, p.Y, p.pool, t0, c);
    else if (g == 2) evenmix_run<8>(p.P16, cw, p.Y, p.pool, t0, c);
    else evenmix_run<16>(p.P16, cw, p.Y, p.pool, t0, c);
  }
}

DI void phase_lb(const int wq, PRef p) {
  const int tid_ = ltid(wq); const int bid_ = lbid(); (void)tid_; (void)bid_;
  for (int c = bid_ * NT + tid_; c < 512; c += gridDim.x * NT) {
    float g[DEPTH], m = -INFINITY;
#pragma unroll
    for (int l = 0; l < DEPTH; ++l) { g[l] = p.hgrn_gamma[l * 512 + c]; m = fmaxf(m, g[l]); }
    float sum = 0.f;
#pragma unroll
    for (int l = 0; l < DEPTH; ++l) { g[l] = expf(g[l] - m); sum += g[l]; }
    float cum = 0.f;
#pragma unroll
    for (int l = 0; l < DEPTH; ++l) { p.lb[l * 512 + c] = cum; cum += g[l] / sum; }
  }
}

DI int t5_bucket(int dist) {
  const int d = dist < 0 ? 0 : dist;
  if (d < 16) return d;
  const float lr = logf((float)d / 16.f) / 2.0794415416798357f;
  int large = 16 + (int)(lr * 16.f);
  return large < 31 ? large : 31;
}

DI unsigned fkey(float f) { unsigned u = __float_as_uint(f); return (u & 0x80000000u) ? ~u : (u | 0x80000000u); }

DI void phase_hgrn_post(const int wq, PRef p, int j) {
  const int tid_ = ltid(wq); const int bid_ = lbid(); (void)tid_; (void)bid_;
  const int lane = tid_ & 63, wv = tid_ >> 6;
  const int stride = p.probe * 4;
  for (int r0 = bid_ * 4 + wv; r0 < T * 4; r0 += 2 * stride) {
    float a[2], bq[2], g0[2], g1[2];
#pragma unroll
    for (int u = 0; u < 2; ++u) {
      const int r = r0 + u * stride;
      const int t = r >> 2, hd = r & 3;
      const float* o = p.oraw + (size_t)t * 512 + hd * 128;
      a[u] = o[lane]; bq[u] = o[lane + 64];
      const bf16_t* gate = p.P16 + (size_t)t * ODD_IN + 3272 + hd * 128;
      g0[u] = bf2f(gate[lane]); g1[u] = bf2f(gate[lane + 64]);
    }
#pragma unroll
    for (int u = 0; u < 2; ++u) {
      const int r = r0 + u * stride;
      const int t = r >> 2, hd = r & 3;
      const float ss = wave_sum(a[u] * a[u] + bq[u] * bq[u]);
      const float rs = rsqrtf(ss / 128.f + 1e-6f);
      const float* gn = p.odd_hg_norm + j * 512 + hd * 128;
      p.Y[(size_t)t * D + 512 + hd * 128 + lane] = f2bf(a[u] * rs * gn[lane] * (g0[u] * sigmoidf(g0[u])));
      p.Y[(size_t)t * D + 512 + hd * 128 + lane + 64] = f2bf(bq[u] * rs * gn[lane + 64] * (g1[u] * sigmoidf(g1[u])));
    }
  }
}

DI void phase_dsa_prep(const int wq, PRef p, int j) {
  const int tid = ltid(wq); const int bid = lbid();
  const int lane = tid & 63, wv = tid >> 6;
  for (int t = bid * 4 + wv; t < T; t += gridDim.x * 4) {
    const bf16_t* row = p.P16 + (size_t)t * ODD_IN;
#pragma unroll
    for (int c = 0; c < 2; ++c) *(GAS u32x4*)(p.qlat16 + (size_t)t * 1024 + c * 512 + lane * 8) = gload16(row + c * 512 + lane * 8);
    {
      const unsigned cv = *(const GAS unsigned*)(row + 1024 + 2 * lane);
      const float c0 = bflo(cv), c1 = bfhi(cv);
      const float ss = wave_sum(c0 * c0 + c1 * c1);
      const float rs = rsqrtf(ss / 128.f + 1e-6f);
      const float* g = p.odd_kv_norm + j * 128;
      *(GAS unsigned*)(p.ckv16 + (size_t)t * 128 + 2 * lane) = pack2(c0 * rs * g[2 * lane], c1 * rs * g[2 * lane + 1]);
    }
    *(GAS u32x4*)(p.iq16 + (size_t)t * 512 + lane * 8) = gload16(row + 1152 + lane * 8);
    p.ik16[(size_t)t * 64 + lane] = row[1664 + lane];
  }
}

DI void phase_dsa_scores(const int wq, PRef p, char* smem) {
  const int tid = ltid(wq); const int bid = lbid();
  const int lane = tid & 63, wv = tid >> 6, wm = wv >> 1, wn = wv & 1;
  const int r = lane & 31, hh = lane >> 5;
  const int srow = tid >> 3, skc = tid & 7;
  char* Ks = smem;
  char* Qs = smem + G_TILE_B;
  float* Ws = (float*)(smem + 3 * G_TILE_B);
  for (int tile = bid; tile < NB * 136; tile += gridDim.x) {
    const int b = tile / 136, u = tile % 136;
    int qb = 0;
    while ((qb + 1) * (qb + 2) / 2 <= u) ++qb;
    const int kb = u - qb * (qb + 1) / 2;
    const int q0 = b * S + qb * 128, k0 = b * S + kb * 128;
    const bf16_t* Kg = p.ik16 + (size_t)(k0 + srow) * 64 + skc * 8;
    const bf16_t* Qg = p.iq16 + (size_t)(q0 + srow) * 512 + skc * 8;
    u32x4 rk[4], rq[4];
#pragma unroll
    for (int i = 0; i < 4; ++i) { rk[i] = gload16(Kg + (size_t)(32 * i) * 64); rq[i] = gload16(Qg + (size_t)(32 * i) * 512); }
    u32x4 wv4 = {0u, 0u, 0u, 0u};
    if (tid < 128) wv4 = gload16(p.P16 + (size_t)(q0 + tid) * ODD_IN + 1728);
    __syncthreads();
#pragma unroll
    for (int i = 0; i < 4; ++i) {
      *(u32x4*)(Ks + (srow + 32 * i) * G_LDS_ROW + skc * 16) = rk[i];
      *(u32x4*)(Qs + (srow + 32 * i) * G_LDS_ROW + skc * 16) = rq[i];
    }
    if (tid < 128) {
      const unsigned w0 = wv4[0], w1 = wv4[1], w2 = wv4[2], w3 = wv4[3];
      f32x4v a4, b4;
      a4[0] = bflo(w0) * 0.35355339059327373f; a4[1] = bfhi(w0) * 0.35355339059327373f; a4[2] = bflo(w1) * 0.35355339059327373f; a4[3] = bfhi(w1) * 0.35355339059327373f;
      b4[0] = bflo(w2) * 0.35355339059327373f; b4[1] = bfhi(w2) * 0.35355339059327373f; b4[2] = bflo(w3) * 0.35355339059327373f; b4[3] = bfhi(w3) * 0.35355339059327373f;
      *(f32x4v*)(Ws + tid * 8) = a4; *(f32x4v*)(Ws + tid * 8 + 4) = b4;
    }
    __syncthreads();
    f32x16 sc[2][2];
#pragma unroll
    for (int i = 0; i < 2; ++i)
#pragma unroll
      for (int jx = 0; jx < 2; ++jx)
#pragma unroll
        for (int e = 0; e < 16; ++e) sc[i][jx][e] = 0.f;
#pragma unroll 1
    for (int hd = 0; hd < 8; ++hd) {
      const int cur = hd & 1;
      if (hd + 1 < 8) {
#pragma unroll
        for (int i = 0; i < 4; ++i) rq[i] = gload16(Qg + (size_t)(32 * i) * 512 + (hd + 1) * 64);
      }
      f32x16 acc[2][2];
#pragma unroll
      for (int i = 0; i < 2; ++i)
#pragma unroll
        for (int jx = 0; jx < 2; ++jx)
#pragma unroll
          for (int e = 0; e < 16; ++e) acc[i][jx][e] = 0.f;
      const char* As = Qs + cur * G_TILE_B + (wm * 64 + r) * G_LDS_ROW + hh * 16;
      const char* Bs = Ks + (wn * 64 + r) * G_LDS_ROW + hh * 16;
#pragma unroll
      for (int ks = 0; ks < 4; ++ks) {
        const bf16x8 a0 = *(const bf16x8*)(As + ks * 32), a1 = *(const bf16x8*)(As + 32 * G_LDS_ROW + ks * 32);
        const bf16x8 b0 = *(const bf16x8*)(Bs + ks * 32), b1 = *(const bf16x8*)(Bs + 32 * G_LDS_ROW + ks * 32);
        acc[0][0] = __builtin_amdgcn_mfma_f32_32x32x16_bf16(a0, b0, acc[0][0], 0, 0, 0);
        acc[0][1] = __builtin_amdgcn_mfma_f32_32x32x16_bf16(a0, b1, acc[0][1], 0, 0, 0);
        acc[1][0] = __builtin_amdgcn_mfma_f32_32x32x16_bf16(a1, b0, acc[1][0], 0, 0, 0);
        acc[1][1] = __builtin_amdgcn_mfma_f32_32x32x16_bf16(a1, b1, acc[1][1], 0, 0, 0);
      }
#pragma unroll
      for (int i = 0; i < 2; ++i)
#pragma unroll
        for (int e = 0; e < 16; ++e) {
          const float w = Ws[(wm * 64 + i * 32 + (e & 3) + 8 * (e >> 2) + 4 * hh) * 8 + hd];
          sc[i][0][e] = fmaf(w, fmaxf(acc[i][0][e] * 0.125f, 0.f), sc[i][0][e]);
          sc[i][1][e] = fmaf(w, fmaxf(acc[i][1][e] * 0.125f, 0.f), sc[i][1][e]);
        }
      if (hd + 1 < 8) {
#pragma unroll
        for (int i = 0; i < 4; ++i) *(u32x4*)(Qs + (cur ^ 1) * G_TILE_B + (srow + 32 * i) * G_LDS_ROW + skc * 16) = rq[i];
      }
      __syncthreads();
    }
#pragma unroll
    for (int i = 0; i < 2; ++i)
#pragma unroll
      for (int jx = 0; jx < 2; ++jx) {
        GAS float* cp = (GAS float*)p.sc + (size_t)(q0 + wm * 64 + i * 32 + 4 * hh) * 2048 + kb * 128 + wn * 64 + jx * 32 + r;
#pragma unroll
        for (int e = 0; e < 16; ++e) cp[(size_t)((e & 3) + 8 * (e >> 2)) * 2048] = sc[i][jx][e];
      }
  }
}

DI void phase_hgrn_scan(const int wq, PRef p, int l, char* smem) {
  const int tid = ltid(wq); const int bid = lbid();
  const int lane = tid & 63, wv = tid >> 6;
  const int kq = wv * 4 + (lane & 3), v = lane >> 2;
  constexpr int BUF = (2048 + 2048 + 256);
  float* bufs = (float*)smem;
  float* opart = bufs + 2 * BUF;
  for (int unit = bid; unit < 256; unit += gridDim.x) {
    const int b = unit >> 5, hd = (unit >> 3) & 3, vs = unit & 7;
    const int ltok = tid >> 4, lc = (tid & 15) * 8;
    const bf16_t* Pb = p.P16 + (size_t)(b * S) * ODD_IN;
    f32x4v lbv0, lbv1;
    { const float* lbp = p.lb + l * 512 + hd * 128 + lc; lbv0 = *(const f32x4v*)lbp; lbv1 = *(const f32x4v*)(lbp + 4); }
    f32x2v st[4];
#pragma unroll
    for (int i = 0; i < 4; ++i) { st[i][0] = 0.f; st[i][1] = 0.f; }
    u32x4 rq[4], rf[4]; unsigned short riv[4];
    auto gl = [&](int bt, int sl) {
      const bf16_t* row = Pb + (size_t)(bt * 16 + ltok) * ODD_IN;
      rq[sl] = gload16(row + 1736 + hd * 128 + lc);
      rf[sl] = gload16(row + 2248 + hd * 128 + lc);
      riv[sl] = *(const GAS bf16_t*)(row + 2760 + hd * 128 + vs * 16 + (tid & 15));
    };
    auto st_lds = [&](int which, int sl) {
      float* bq = bufs + which * BUF; float* bf = bq + 2048; float* bi = bf + 2048;
      const u32x4 rqv = rq[sl], rfv = rf[sl];
      const unsigned q0_ = rqv[0], q1_ = rqv[1], q2_ = rqv[2], q3_ = rqv[3], f0_ = rfv[0], f1_ = rfv[1], f2_ = rfv[2], f3_ = rfv[3];
      f32x4v qa, qb, fa, fb;
      qa[0] = bflo(q0_); qa[1] = bfhi(q0_); qa[2] = bflo(q1_); qa[3] = bfhi(q1_); qb[0] = bflo(q2_); qb[1] = bfhi(q2_); qb[2] = bflo(q3_); qb[3] = bfhi(q3_);
      fa[0] = bflo(f0_); fa[1] = bfhi(f0_); fa[2] = bflo(f1_); fa[3] = bfhi(f1_); fb[0] = bflo(f2_); fb[1] = bfhi(f2_); fb[2] = bflo(f3_); fb[3] = bfhi(f3_);
      *(f32x4v*)(bq + ltok * 128 + lc) = qa; *(f32x4v*)(bq + ltok * 128 + lc + 4) = qb;
      f32x4v f0, f1;
#pragma unroll
      for (int i = 0; i < 4; ++i) {
        f0[i] = lbv0[i] + (1.f - lbv0[i]) * __builtin_amdgcn_rcpf(1.f + __expf(-fa[i]));
        f1[i] = lbv1[i] + (1.f - lbv1[i]) * __builtin_amdgcn_rcpf(1.f + __expf(-fb[i]));
      }
      *(f32x4v*)(bf + ltok * 128 + lc) = f0; *(f32x4v*)(bf + ltok * 128 + lc + 4) = f1;
      bi[ltok * 16 + (tid & 15)] = bf2f(riv[sl]);
    };
    gl(0, 0); gl(1, 1); gl(2, 2); gl(3, 3);
    __syncthreads();
    st_lds(0, 0);
    __syncthreads();
#pragma unroll 1
    for (int bt4 = 0; bt4 < S / 16; bt4 += 4) {
#pragma unroll
    for (int u4 = 0; u4 < 4; ++u4) {
      const int bt = bt4 + u4;
      const int cur = u4 & 1;
      gl(bt + 4 < S / 16 ? bt + 4 : S / 16 - 1, u4);
      const float* bq = bufs + cur * BUF; const float* bf = bq + 2048; const float* bi = bf + 2048;
      f32x4v F0, F1, Q0, Q1; float IV;
      auto ldstep = [&](int tt) {
        IV = bi[tt * 16 + v];
        F0 = *(const f32x4v*)(bf + tt * 128 + kq * 8); F1 = *(const f32x4v*)(bf + tt * 128 + kq * 8 + 4);
        Q0 = *(const f32x4v*)(bq + tt * 128 + kq * 8); Q1 = *(const f32x4v*)(bq + tt * 128 + kq * 8 + 4);
      };
      ldstep(0);
#pragma unroll
      for (int tt = 0; tt < 16; ++tt) {
        const float iv = IV;
        const f32x4v f0 = F0, f1 = F1, q0 = Q0, q1 = Q1;
        if (tt + 1 < 16) ldstep(tt + 1);
        f32x2v iv2; iv2[0] = iv; iv2[1] = iv;
        f32x2v fa, fb, fc, fd, qa, qb, qc, qd;
        fa[0] = f0[0]; fa[1] = f0[1]; fb[0] = f0[2]; fb[1] = f0[3]; fc[0] = f1[0]; fc[1] = f1[1]; fd[0] = f1[2]; fd[1] = f1[3];
        qa[0] = q0[0]; qa[1] = q0[1]; qb[0] = q0[2]; qb[1] = q0[3]; qc[0] = q1[0]; qc[1] = q1[1]; qd[0] = q1[2]; qd[1] = q1[3];
        st[0] = __builtin_elementwise_fma(fa, st[0] - iv2, iv2);
        st[1] = __builtin_elementwise_fma(fb, st[1] - iv2, iv2);
        st[2] = __builtin_elementwise_fma(fc, st[2] - iv2, iv2);
        st[3] = __builtin_elementwise_fma(fd, st[3] - iv2, iv2);
        f32x2v o2 = qa * st[0];
        o2 = __builtin_elementwise_fma(qb, st[1], o2);
        o2 = __builtin_elementwise_fma(qc, st[2], o2);
        o2 = __builtin_elementwise_fma(qd, st[3], o2);
        float o = o2[0] + o2[1];
        o += __int_as_float(__builtin_amdgcn_update_dpp(0, __float_as_int(o), 0xB1, 0xF, 0xF, true));
        o += __int_as_float(__builtin_amdgcn_update_dpp(0, __float_as_int(o), 0x4E, 0xF, 0xF, true));
        opart[(tt * 4 + wv) * 16 + v] = o;
      }
      __syncthreads();
      {
        const int tt = tid >> 4, vo = tid & 15;
        const float o = opart[(tt * 4 + 0) * 16 + vo] + opart[(tt * 4 + 1) * 16 + vo] + opart[(tt * 4 + 2) * 16 + vo] + opart[(tt * 4 + 3) * 16 + vo];
        p.oraw[(size_t)(b * S + bt * 16 + tt) * 512 + hd * 128 + vs * 16 + vo] = o;
      }
      st_lds(cur ^ 1, (u4 + 1) & 3);
      __syncthreads();
    }
    }
  }
}

DI float dot2bf(unsigned a, unsigned b, float acc) { return __builtin_amdgcn_fdot2_f32_bf16(__builtin_bit_cast(bf16x2_t, a), __builtin_bit_cast(bf16x2_t, b), acc, false); }
DI unsigned fkey_u(float f) { const unsigned u = __float_as_uint(f); return (u & 0x80000000u) ? ~u : (u | 0x80000000u); }
DI void phase_dsa_attend(const int wq, PRef p, int j, char* smem, int qoff) {
  const int tid = ltid(wq); const int bid = lbid(); (void)bid;
  const int lane = tid & 63, wv = tid >> 6;
  int* selL = (int*)smem;
  int* nselL = selL + 1024;
  float* bias = (float*)(smem + 4096 + 64);
  float* part = (float*)(smem + 4096 + 64 + 1024);
  float* msb = part + 2 * 4 * 8 * 128;
  float* plw = msb + 2 * 4 * 16 + wv * 64 * 8;
  int* sel = selL + wv * 256;
  __syncthreads();
  bias[tid] = p.rel_bias[tid];
  const int n16 = lane & 15, kg = lane >> 4;
  const unsigned long long ltmask = (1ull << lane) - 1ull;
  for (;;) {
    __syncthreads();
    if (tid == 0) nselL[4] = (int)atomicAdd(p.qctr + qoff, 4u);
    __syncthreads();
    const int claimed = nselL[4];
    if (claimed >= T) break;
    const int base = T - 4 - claimed;
    {
      const int q = base + wv;
      const int t = q % S;
      const float* row = p.sc + (size_t)q * 2048;
      int nsel;
      if (t < 256) {
        nsel = t + 1;
#pragma unroll
        for (int i = 0; i < 4; ++i) sel[i * 64 + lane] = i * 64 + lane;
      } else {
        nsel = 256;
        const int ni = (t >> 6) + 1;
        unsigned keys[32];
#pragma unroll
        for (int i = 0; i < 32; ++i) {
          keys[i] = 0u;
          if (i < ni) { const int s_ = i * 64 + lane; if (s_ <= t) keys[i] = fkey_u(__builtin_nontemporal_load((const GAS float*)row + s_)); }
        }
        unsigned* hist = (unsigned*)(smem + 49152) + wv * 256;
        unsigned thr = 0u; int need = 256;
#pragma unroll 1
        for (int pass = 0; pass < 4; ++pass) {
          const int sh = 24 - 8 * pass;
          { unsigned zz = 0u; asm volatile("" : "+v"(zz)); u32x4 z4 = {zz, zz, zz, zz}; *(u32x4*)(hist + lane * 4) = z4; }
#pragma unroll
          for (int i = 0; i < 32; ++i) if (i < ni) {
            const unsigned k_ = keys[i];
            const bool m_ = (pass == 0) || (((k_ ^ thr) >> ((sh + 8) & 31)) == 0u);
            if (m_) atomicAdd(hist + ((k_ >> sh) & 255u), 1u);
          }
          const u32x4 hb = *(const u32x4*)(hist + lane * 4);
          const int b0 = (int)hb[0], b1 = (int)hb[1], b2 = (int)hb[2], b3 = (int)hb[3];
          int P = b0 + b1 + b2 + b3;
          P += DPP_I(P, 0x111, 0xF, true); P += DPP_I(P, 0x112, 0xF, true); P += DPP_I(P, 0x114, 0xF, true); P += DPP_I(P, 0x118, 0xF, true);
          P += DPP_I(P, 0x142, 0xA, false); P += DPP_I(P, 0x143, 0xC, false);
          const int total = __builtin_amdgcn_readlane(P, 63);
          const int sab = total - P;
          const int c3 = sab + b3, c2 = c3 + b2, c1 = c2 + b1, c0 = c1 + b0;
          const unsigned long long mk = __ballot(c0 >= need);
          const int ls = 63 - __builtin_clzll(mk);
          int dl, ab;
          if (c3 >= need) { dl = 3; ab = sab; } else if (c2 >= need) { dl = 2; ab = c3; } else if (c1 >= need) { dl = 1; ab = c2; } else { dl = 0; ab = c1; }
          const int dsel = 4 * ls + __builtin_amdgcn_readlane(dl, ls);
          need -= __builtin_amdgcn_readlane(ab, ls);
          thr |= (unsigned)dsel << sh;
        }
        const int ngt = 256 - need;
        int pg = 0, pe = 0;
#pragma unroll
        for (int i = 0; i < 32; ++i) if (i < ni) {
          const unsigned long long mg = __ballot(keys[i] > thr), me = __ballot(keys[i] == thr);
          const int myg = pg + __builtin_popcountll(mg & ltmask), mye = pe + __builtin_popcountll(me & ltmask);
          if (keys[i] > thr) sel[myg] = i * 64 + lane;
          else if (keys[i] == thr && mye < need) sel[ngt + mye] = i * 64 + lane;
          pg += __builtin_popcountll(mg); pe += __builtin_popcountll(me);
        }
      }
      if (lane == 0) nselL[wv] = nsel;
    }
    __syncthreads();
#pragma unroll 1
    for (int qi = 0; qi < 4; ++qi) {
      const int tid = ltid(wq);
      const int lane = tid & 63;
      const int n16 = lane & 15, kg = lane >> 4;
      const int q = base + qi;
      const int b = q / S, t = q % S;
      const int nsel = nselL[qi];
      const int* qsel = selL + qi * 256 + wv * 64;
      const int slot0 = wv * 64;
      float* pw = part + ((qi & 1) * 4 + wv) * 8 * 128;
      float* mw = msb + ((qi & 1) * 4 + wv) * 16;
      bf16x8 aq[4];
#pragma unroll
      for (int ks = 0; ks < 4; ++ks) {
        u32x4 z = {0u, 0u, 0u, 0u};
        if (n16 < 8) z = __builtin_nontemporal_load((gp_u32x4)(p.qlat16 + (size_t)q * 1024 + n16 * 128 + ks * 32 + kg * 8));
        aq[ks] = __builtin_bit_cast(bf16x8, z);
      }
      u32x4 bv[4][4];
#pragma unroll
      for (int bb = 0; bb < 4; ++bb) {
        const int sl = bb * 16 + n16;
        const int sxv = (slot0 + sl < nsel) ? qsel[sl] : 0;
        const bf16_t* crow = p.ckv16 + (size_t)(b * S + sxv) * 128 + kg * 8;
#pragma unroll
        for (int ks = 0; ks < 4; ++ks) bv[bb][ks] = gload16(crow + ks * 32);
      }
      const bf16_t* cb = p.ckv16 + (size_t)(b * S) * 128 + 2 * lane;
      unsigned cbuf[64];
#pragma unroll
      for (int i4 = 0; i4 < 8; ++i4) {
        const u32x4 s4 = *(const u32x4*)(qsel + i4 * 4);
#pragma unroll
        for (int e = 0; e < 4; ++e) {
          const int k = i4 * 4 + e;
          const int sk = (slot0 + k < nsel) ? __builtin_amdgcn_readfirstlane((int)s4[e]) : 0;
          cbuf[k] = *(const GAS unsigned*)(cb + (size_t)sk * 128);
        }
      }
      asm volatile("" ::: "memory");
      f32x4v lg[4];
#pragma unroll
      for (int bb = 0; bb < 4; ++bb) {
        f32x4v acc = {0.f, 0.f, 0.f, 0.f};
#pragma unroll
        for (int ks = 0; ks < 4; ++ks) acc = __builtin_amdgcn_mfma_f32_16x16x32_bf16(aq[ks], __builtin_bit_cast(bf16x8, bv[bb][ks]), acc, 0, 0, 0);
        lg[bb] = acc;
      }
      asm volatile("" ::: "memory");
#pragma unroll
      for (int i4 = 8; i4 < 16; ++i4) {
        const u32x4 s4 = *(const u32x4*)(qsel + i4 * 4);
#pragma unroll
        for (int e = 0; e < 4; ++e) {
          const int k = i4 * 4 + e;
          const int sk = (slot0 + k < nsel) ? __builtin_amdgcn_readfirstlane((int)s4[e]) : 0;
          cbuf[k] = *(const GAS unsigned*)(cb + (size_t)sk * 128);
        }
      }
      float mx[4] = {-INFINITY, -INFINITY, -INFINITY, -INFINITY};
#pragma unroll
      for (int bb = 0; bb < 4; ++bb) {
        const bool ok = slot0 + bb * 16 + n16 < nsel;
        const int bk = t5_bucket(t - (ok ? qsel[bb * 16 + n16] : 0));
#pragma unroll
        for (int i = 0; i < 4; ++i) {
          const float lv = ok ? lg[bb][i] * 0.08838834764831845f + bias[bk * 8 + ((4 * kg + i) & 7)] : -INFINITY;
          lg[bb][i] = lv; mx[i] = fmaxf(mx[i], lv);
        }
      }
#pragma unroll
      for (int i = 0; i < 4; ++i) mx[i] = rowmax16(mx[i]);
      float sm[4] = {0.f, 0.f, 0.f, 0.f};
#pragma unroll
      for (int bb = 0; bb < 4; ++bb)
#pragma unroll
        for (int i = 0; i < 4; ++i) {
          const float e_ = (mx[i] == -INFINITY) ? 0.f : __expf(lg[bb][i] - mx[i]);
          lg[bb][i] = e_; sm[i] += e_;
        }
#pragma unroll
      for (int i = 0; i < 4; ++i) sm[i] = rowsum16(sm[i]);
#pragma unroll
      for (int bb = 0; bb < 4; ++bb) {
        u32x4 pr;
#pragma unroll
        for (int i = 0; i < 4; ++i) {
          const float other = DPP_F(lg[bb][i], 0xB1, 0xF, true);
          pr[i] = pack2(lg[bb][i], other);
        }
        if (kg < 2 && (n16 & 1) == 0) *(u32x4*)((unsigned*)plw + ((bb * 16 + n16) >> 1) * 8 + 4 * kg) = pr;
      }
      if (kg < 2) {
        if (n16 == 0) {
#pragma unroll
          for (int i = 0; i < 4; ++i) { mw[4 * kg + i] = mx[i]; mw[8 + 4 * kg + i] = sm[i]; }
        }
      }
      asm volatile("s_waitcnt lgkmcnt(0)" ::: "memory");
      float o[16];
#pragma unroll
      for (int i = 0; i < 16; ++i) o[i] = 0.f;
#pragma unroll
      for (int kp = 0; kp < 32; ++kp) {
        if ((kp & 1) == 0) asm volatile("" ::: "memory");
        const unsigned ca = cbuf[2 * kp], cbx = cbuf[2 * kp + 1];
        const unsigned x0 = __builtin_amdgcn_perm(cbx, ca, 0x05040100u);
        const unsigned x1 = __builtin_amdgcn_perm(cbx, ca, 0x07060302u);
        const u32x4 pa4 = *(const u32x4*)((const unsigned*)plw + kp * 8), pb4 = *(const u32x4*)((const unsigned*)plw + kp * 8 + 4);
        const unsigned q0 = pa4[0], q1 = pa4[1], q2 = pa4[2], q3 = pa4[3], q4 = pb4[0], q5 = pb4[1], q6 = pb4[2], q7 = pb4[3];
        o[0] = dot2bf(q0, x0, o[0]); o[1] = dot2bf(q0, x1, o[1]); o[2] = dot2bf(q1, x0, o[2]); o[3] = dot2bf(q1, x1, o[3]);
        o[4] = dot2bf(q2, x0, o[4]); o[5] = dot2bf(q2, x1, o[5]); o[6] = dot2bf(q3, x0, o[6]); o[7] = dot2bf(q3, x1, o[7]);
        o[8] = dot2bf(q4, x0, o[8]); o[9] = dot2bf(q4, x1, o[9]); o[10] = dot2bf(q5, x0, o[10]); o[11] = dot2bf(q5, x1, o[11]);
        o[12] = dot2bf(q6, x0, o[12]); o[13] = dot2bf(q6, x1, o[13]); o[14] = dot2bf(q7, x0, o[14]); o[15] = dot2bf(q7, x1, o[15]);
      }
#pragma unroll
      for (int hd = 0; hd < 8; ++hd) { float2 ov; ov.x = o[2 * hd]; ov.y = o[2 * hd + 1]; *(float2*)(pw + hd * 128 + 2 * lane) = ov; }
      __syncthreads();
      {
        const int hd = tid >> 5, ch = (tid & 31) * 4;
        const float* pq = part + (qi & 1) * 4 * 8 * 128;
        const float* mq = msb + (qi & 1) * 4 * 16;
        float m0 = mq[hd], m1 = mq[16 + hd], m2 = mq[32 + hd], m3 = mq[48 + hd];
        const float M = fmaxf(fmaxf(m0, m1), fmaxf(m2, m3));
        const float f0 = __expf(m0 - M), f1 = __expf(m1 - M), f2 = __expf(m2 - M), f3 = __expf(m3 - M);
        const float den = f0 * mq[8 + hd] + f1 * mq[24 + hd] + f2 * mq[40 + hd] + f3 * mq[56 + hd];
        const f32x4v a0 = *(const f32x4v*)(pq + (0 * 8 + hd) * 128 + ch), a1 = *(const f32x4v*)(pq + (1 * 8 + hd) * 128 + ch);
        const f32x4v a2 = *(const f32x4v*)(pq + (2 * 8 + hd) * 128 + ch), a3 = *(const f32x4v*)(pq + (3 * 8 + hd) * 128 + ch);
        const float inv = 1.f / den;
        const f32x4v r = (a0 * f0 + a1 * f1 + a2 * f2 + a3 * f3) * inv;
        u32x2 ov; ov[0] = pack2(r[0], r[1]); ov[1] = pack2(r[2], r[3]);
        *(GAS u32x2*)(p.lat + (size_t)q * D + hd * 128 + ch) = ov;
      }
    }
  }
}

DI void phase_softmax256(const int wq, const bf16_t* __restrict__ S, bf16_t* __restrict__ Pm, int rows) {
  const int tid = ltid(wq); const int bid = lbid();
  const int lane = tid & 63, wv = tid >> 6;
  for (int r = bid * 4 + wv; r < rows; r += gridDim.x * 4) {
    const f32x4v v = bf4_to_f(*(const GAS u32x2*)(S + (size_t)r * 256 + lane * 4));
    const float a = v[0], b = v[1], c = v[2], d = v[3];
    const float m = wave_max(fmaxf(fmaxf(a, b), fmaxf(c, d)));
    const float ea = __expf(a - m), eb = __expf(b - m), ec = __expf(c - m), ed = __expf(d - m);
    const float inv = 1.f / wave_sum(ea + eb + ec + ed);
    u32x2 o; o[0] = pack2(ea * inv, eb * inv); o[1] = pack2(ec * inv, ed * inv);
    *(GAS u32x2*)(Pm + (size_t)r * 256 + lane * 4) = o;
  }
}

DI int fkey_s(int b) { return b ^ ((b >> 31) & 0x7fffffff); }

template <int N, int KMAX>
DI void bitonic_blocks(int (&v)[N]) {
#pragma unroll
  for (int k = 2; k <= KMAX; k <<= 1)
#pragma unroll
    for (int j = k >> 1; j > 0; j >>= 1)
#pragma unroll
      for (int i = 0; i < N; ++i) {
        const int l = i ^ j;
        if (l > i) {
          const bool desc = ((i & k) == 0);
          const int a = v[i], b = v[l];
          const int hi = a > b ? a : b, lo = a > b ? b : a;
          v[i] = desc ? hi : lo;
          v[l] = desc ? lo : hi;
        }
      }
}
template <bool DESC>
DI void bitonic_merge16(int (&v)[16]) {
#pragma unroll
  for (int j = 8; j > 0; j >>= 1)
#pragma unroll
    for (int i = 0; i < 16; ++i) {
      const int l = i ^ j;
      if (l > i) {
        const int a = v[i], b = v[l];
        const int hi = a > b ? a : b, lo = a > b ? b : a;
        v[i] = DESC ? hi : lo;
        v[l] = DESC ? lo : hi;
      }
    }
}

DI void phase_cvt_rows(const int wq, const float* __restrict__ src, bf16_t* __restrict__ dst, size_t n8) {
  const int tid = ltid(wq); const int bid = lbid();
  for (size_t i = (size_t)bid * NT + tid; i < n8; i += (size_t)gridDim.x * NT) {
    const u32x4 a = gload16(src + i * 8), b = gload16(src + i * 8 + 4);
    u32x4 o;
    o[0] = pack2(__uint_as_float(a[0]), __uint_as_float(a[1])); o[1] = pack2(__uint_as_float(a[2]), __uint_as_float(a[3]));
    o[2] = pack2(__uint_as_float(b[0]), __uint_as_float(b[1])); o[3] = pack2(__uint_as_float(b[2]), __uint_as_float(b[3]));
    *(GAS u32x4*)(dst + i * 8) = o;
  }
}

constexpr int KEY_ROW = 264;
DI void phase_peer_qs(const int wq, const bf16_t* __restrict__ X0, const bf16_t* __restrict__ W0, const bf16_t* __restrict__ keys0, int* __restrict__ tops, char* smem, const float* __restrict__ rss_in) {
  const int tid = ltid(wq); const int bid = lbid();
  const int lane = tid & 63, wv = tid >> 6;
  const int r = lane & 31, hh = lane >> 5;
  const int srow = tid >> 3, skc = tid & 7;
  constexpr int nk = D / 64;
  for (int tile = bid; tile < (T / 128) * 16; tile += gridDim.x) {
    const int mt = tile >> 4, hp = tile & 15;
    const bf16_t* Wg = W0 + (size_t)(hp * 128 + srow) * WK + skc * 8;
    const bf16_t* Xg = X0 + (size_t)(mt * 128 + srow) * HLD + skc * 8;
    f32x16 acc[4];
#pragma unroll
    for (int i = 0; i < 4; ++i)
#pragma unroll
      for (int e = 0; e < 16; ++e) acc[i][e] = 0.f;
    u32x4 ra[4], rb[4];
#pragma unroll
    for (int i = 0; i < 4; ++i) { ra[i] = gload16(Wg + (size_t)(32 * i) * WK); rb[i] = gload16(Xg + (size_t)(32 * i) * HLD); }
    __syncthreads();
#pragma unroll
    for (int i = 0; i < 4; ++i) {
      *(u32x4*)(smem + (srow + 32 * i) * G_LDS_ROW + skc * 16) = ra[i];
      *(u32x4*)(smem + 2 * G_TILE_B + (srow + 32 * i) * G_LDS_ROW + skc * 16) = rb[i];
    }
    __syncthreads();
#pragma unroll 1
    for (int kt = 0; kt < nk; ++kt) {
      const int cur = kt & 1;
      if (kt + 1 < nk) {
#pragma unroll
        for (int i = 0; i < 4; ++i) { ra[i] = gload16(Wg + (size_t)(32 * i) * WK + (kt + 1) * 64); rb[i] = gload16(Xg + (size_t)(32 * i) * HLD + (kt + 1) * 64); }
      }
      const char* As = smem + cur * G_TILE_B + r * G_LDS_ROW + hh * 16;
      const char* Bs = smem + 2 * G_TILE_B + cur * G_TILE_B + (wv * 32 + r) * G_LDS_ROW + hh * 16;
#pragma unroll
      for (int ks = 0; ks < 4; ++ks) {
        const bf16x8 b = *(const bf16x8*)(Bs + ks * 32);
#pragma unroll
        for (int mb = 0; mb < 4; ++mb) {
          const bf16x8 a = *(const bf16x8*)(As + mb * 32 * G_LDS_ROW + ks * 32);
          acc[mb] = __builtin_amdgcn_mfma_f32_32x32x16_bf16(a, b, acc[mb], 0, 0, 0);
        }
      }
      __builtin_amdgcn_sched_group_barrier(0x100, 5, 0);
      __builtin_amdgcn_sched_group_barrier(0x100, 5, 0);
      __builtin_amdgcn_sched_group_barrier(0x008, 4, 0);
      __builtin_amdgcn_sched_group_barrier(0x100, 5, 0);
      __builtin_amdgcn_sched_group_barrier(0x008, 4, 0);
      __builtin_amdgcn_sched_group_barrier(0x100, 5, 0);
      __builtin_amdgcn_sched_group_barrier(0x008, 4, 0);
      __builtin_amdgcn_sched_group_barrier(0x008, 4, 0);
      if (kt + 1 < nk) {
        const int nxt = cur ^ 1;
#pragma unroll
        for (int i = 0; i < 4; ++i) {
          *(u32x4*)(smem + nxt * G_TILE_B + (srow + 32 * i) * G_LDS_ROW + skc * 16) = ra[i];
          *(u32x4*)(smem + 2 * G_TILE_B + nxt * G_TILE_B + (srow + 32 * i) * G_LDS_ROW + skc * 16) = rb[i];
        }
      }
      __syncthreads();
    }
    {
      const bf16_t* kg = keys0 + (size_t)hp * 128 * 128;
#pragma unroll
      for (int i = 0; i < 8; ++i) {
        const int c = tid + NT * i, row = c >> 4, c16 = c & 15;
        const u32x4 v = gload16(kg + row * 128 + c16 * 8);
        uint2 lo, hi2; lo.x = v[0]; lo.y = v[1]; hi2.x = v[2]; hi2.y = v[3];
        *(uint2*)(smem + row * KEY_ROW + c16 * 16) = lo;
        *(uint2*)(smem + row * KEY_ROW + c16 * 16 + 8) = hi2;
      }
    }
    __syncthreads();
    u32x4 qf[8];
    const float rstd_t = rstd_of(rss_in, mt * 128 + wv * 32 + r);
#pragma unroll
    for (int mb = 0; mb < 4; ++mb)
#pragma unroll
      for (int s2 = 0; s2 < 2; ++s2) {
        u32x4 f;
#pragma unroll
        for (int jj = 0; jj < 4; ++jj) f[jj] = pack2(acc[mb][8 * s2 + 2 * jj] * rstd_t, acc[mb][8 * s2 + 2 * jj + 1] * rstd_t);
        qf[mb * 2 + s2] = f;
      }
    int v[64];
#pragma unroll
    for (int kb = 0; kb < 4; ++kb) {
      f32x16 sa;
#pragma unroll
      for (int e = 0; e < 16; ++e) sa[e] = 0.f;
      const char* kr = smem + (kb * 32 + r) * KEY_ROW + hh * 8;
#pragma unroll
      for (int ksi = 0; ksi < 8; ++ksi) {
        const uint2 lo = *(const uint2*)(kr + ksi * 32);
        const uint2 hi2 = *(const uint2*)(kr + ksi * 32 + 16);
        u32x4 a; a[0] = lo.x; a[1] = lo.y; a[2] = hi2.x; a[3] = hi2.y;
        sa = __builtin_amdgcn_mfma_f32_32x32x16_bf16(__builtin_bit_cast(bf16x8, a), __builtin_bit_cast(bf16x8, qf[ksi]), sa, 0, 0, 0);
      }
#pragma unroll
      for (int e = 0; e < 16; ++e) {
        const int kidx = kb * 32 + (e & 3) + 8 * (e >> 2) + 4 * hh;
        v[kb * 16 + e] = (fkey_s(__float_as_int(sa[e])) & ~127) | kidx;
      }
    }
    bitonic_blocks<64, 16>(v);
    int c01[16], c23[16];
#pragma unroll
    for (int i = 0; i < 16; ++i) { c01[i] = v[i] > v[16 + i] ? v[i] : v[16 + i]; c23[i] = v[32 + i] > v[48 + i] ? v[32 + i] : v[48 + i]; }
    bitonic_merge16<true>(c01);
    bitonic_merge16<false>(c23);
    int d[16];
#pragma unroll
    for (int i = 0; i < 16; ++i) d[i] = c01[i] > c23[i] ? c01[i] : c23[i];
    bitonic_merge16<true>(d);
    int f[16];
#pragma unroll
    for (int i = 0; i < 16; ++i) { const int o = shxi(d[15 - i], 32, lane); f[i] = d[i] > o ? d[i] : o; }
    bitonic_merge16<true>(f);
    {
      const int token = mt * 128 + wv * 32 + r;
      GAS int* op = (GAS int*)tops + ((size_t)token * 16 + hp) * 16 + hh * 8;
      u32x4 o0, o1;
      if (hh) {
#pragma unroll
        for (int i = 0; i < 4; ++i) { o0[i] = f[8 + i]; o1[i] = f[12 + i]; }
        asm volatile("" : "+v"(o0), "+v"(o1));
      } else {
#pragma unroll
        for (int i = 0; i < 4; ++i) { o0[i] = f[i]; o1[i] = f[4 + i]; }
        asm volatile("" : "+v"(o0), "+v"(o1));
      }
      *(GAS u32x4*)op = o0; *(GAS u32x4*)(op + 4) = o1;
    }
  }
}

DI float dot8(const u32x4 a, const u32x4 b, float acc) {
  const unsigned a0 = a[0], a1 = a[1], a2 = a[2], a3 = a[3], b0 = b[0], b1 = b[1], b2 = b[2], b3 = b[3];
  acc = dot2bf(a0, b0, acc); acc = dot2bf(a1, b1, acc); acc = dot2bf(a2, b2, acc); acc = dot2bf(a3, b3, acc);
  return acc;
}
typedef signed char i8_t;
using i32x2 = __attribute__((ext_vector_type(2))) int;
DI void phase_quant_u(const int wq, const float* __restrict__ src, i8_t* __restrict__ dst, float* __restrict__ su, int nrows, const float* __restrict__ gain, int nblk) {
  const int tid = ltid(wq); const int bid = lbid();
  const int lane = tid & 63, wv = tid >> 6;
  const int stride = nblk * 4;
  for (int row0 = bid * 4 + wv; row0 < nrows; row0 += 2 * stride) {
  u32x4 raw[8];
#pragma unroll
  for (int i = 0; i < 4; ++i) { raw[i] = gload16(src + (size_t)row0 * 1024 + 16 * lane + 4 * i); raw[4 + i] = gload16(src + (size_t)(row0 + stride) * 1024 + 16 * lane + 4 * i); }
#pragma unroll
  for (int u = 0; u < 2; ++u) {
    const int row = row0 + u * stride;
    u32x4 a[4];
    {
      const float* gp = gain + (size_t)(row >> 14) * 1024 + 16 * lane;
#pragma unroll
      for (int i = 0; i < 4; ++i) {
        const u32x4 t = raw[u * 4 + i];
        const f32x4v g4 = *(const f32x4v*)(gp + 4 * i);
        const unsigned t0 = t[0], t1 = t[1], t2 = t[2], t3 = t[3];
        a[i][0] = __float_as_uint(__uint_as_float(t0) * g4[0]); a[i][1] = __float_as_uint(__uint_as_float(t1) * g4[1]);
        a[i][2] = __float_as_uint(__uint_as_float(t2) * g4[2]); a[i][3] = __float_as_uint(__uint_as_float(t3) * g4[3]);
      }
    }
    float am = 0.f;
#pragma unroll
    for (int i = 0; i < 4; ++i) {
      const unsigned x0 = a[i][0], x1 = a[i][1], x2 = a[i][2], x3 = a[i][3];
      am = fmaxf(am, fmaxf(fmaxf(fabsf(__uint_as_float(x0)), fabsf(__uint_as_float(x1))), fmaxf(fabsf(__uint_as_float(x2)), fabsf(__uint_as_float(x3)))));
    }
    am = wave_max(am);
    const float inv = am > 0.f ? 127.f / am : 0.f;
    u32x4 o;
#pragma unroll
    for (int i = 0; i < 4; ++i) {
      const unsigned x0 = a[i][0], x1 = a[i][1], x2 = a[i][2], x3 = a[i][3];
      const int q0 = (int)rintf(__uint_as_float(x0) * inv), q1 = (int)rintf(__uint_as_float(x1) * inv);
      const int q2 = (int)rintf(__uint_as_float(x2) * inv), q3 = (int)rintf(__uint_as_float(x3) * inv);
      o[i] = (unsigned)(q0 & 255) | ((unsigned)(q1 & 255) << 8) | ((unsigned)(q2 & 255) << 16) | ((unsigned)(q3 & 255) << 24);
    }
    const size_t lyr = (size_t)row >> 14, e = (size_t)row & 16383;
    *(GAS u32x4*)(dst + (((lyr * 8 + (lane >> 3)) * 16384 + e) * 128 + (lane & 7) * 16)) = o;
    if (lane == 0) su[row] = am * (1.f / 127.f);
  }
  }
}
DI void phase_cvt_v8(const int wq, const float* __restrict__ src, i8_t* __restrict__ dst, size_t n16, int nblk) {
  const int tid = ltid(wq); const int bid = lbid();
  const unsigned step = (unsigned)nblk * NT;
  for (unsigned i0 = (unsigned)bid * NT + tid; i0 < (unsigned)n16; i0 += 2 * step) {
    u32x4 a[8];
#pragma unroll
    for (int k = 0; k < 4; ++k) { a[k] = gload16(src + (size_t)i0 * 16 + 4 * k); a[4 + k] = gload16(src + (size_t)(i0 + step) * 16 + 4 * k); }
#pragma unroll
    for (int u = 0; u < 2; ++u) {
      const unsigned i = i0 + u * step;
      u32x4 o;
#pragma unroll
      for (int k = 0; k < 4; ++k) {
        const u32x4 av = a[u * 4 + k];
        const unsigned x0 = av[0], x1 = av[1], x2 = av[2], x3 = av[3];
        int pk = 0;
        pk = __builtin_amdgcn_cvt_pk_fp8_f32(__uint_as_float(x0) * 16.f, __uint_as_float(x1) * 16.f, pk, false);
        pk = __builtin_amdgcn_cvt_pk_fp8_f32(__uint_as_float(x2) * 16.f, __uint_as_float(x3) * 16.f, pk, true);
        o[k] = (unsigned)pk;
      }
      const unsigned row = i >> 6; const int j = (int)(i & 63);
      const unsigned lyr = row >> 14, e = row & 16383;
      *(GAS u32x4*)(dst + (((size_t)(lyr * 8 + (j >> 3)) * 16384 + e) * 128 + (j & 7) * 16)) = o;
    }
  }
}

DI void phase_peer_combine8(const int wq, PRef p, int l, char* smem, const float* __restrict__ rss_in) {
  const int tid = ltid(wq); const int bid = lbid();
  const int lane = tid & 63, wv = tid >> 6;
  int* wtops = (int*)(smem + wv * 1024);
  int ci, cj;
  if (lane < 16) { ci = 0; cj = lane; } else if (lane < 24) { ci = 1; cj = lane - 16; } else if (lane < 29) { ci = 2; cj = lane - 24; }
  else if (lane < 33) { ci = 3; cj = lane - 29; } else if (lane < 36) { ci = 4; cj = lane - 33; } else if (lane < 38) { ci = 5; cj = lane - 36; }
  else if (lane < 40) { ci = 6; cj = lane - 38; } else if (lane < 42) { ci = 7; cj = lane - 40; } else { ci = lane - 42 + 8; cj = 0; }
  const bool cvalid = lane < 50;
  if (!cvalid) { ci = 0; cj = 0; }
  const float* sul = p.su + (size_t)l * 16384;
  for (int token = bid * 4 + wv; token < T; token += gridDim.x * 4) {
    {
      const u32x4 tv = __builtin_nontemporal_load((gp_u32x4)(p.tops + (size_t)token * 256 + lane * 4));
      *(u32x4*)(wtops + lane * 4) = tv;
    }
    {
      const u32x4 a = gload16(p.hn + (size_t)token * HLD + 16 * lane), b2 = gload16(p.hn + (size_t)token * HLD + 16 * lane + 8);
      float xv[16];
      { const unsigned a0 = a[0], a1 = a[1], a2 = a[2], a3 = a[3], c0 = b2[0], c1 = b2[1], c2 = b2[2], c3 = b2[3];
        xv[0] = bflo(a0); xv[1] = bfhi(a0); xv[2] = bflo(a1); xv[3] = bfhi(a1); xv[4] = bflo(a2); xv[5] = bfhi(a2); xv[6] = bflo(a3); xv[7] = bfhi(a3);
        xv[8] = bflo(c0); xv[9] = bfhi(c0); xv[10] = bflo(c1); xv[11] = bfhi(c1); xv[12] = bflo(c2); xv[13] = bfhi(c2); xv[14] = bflo(c3); xv[15] = bfhi(c3); }
      float am = 0.f;
#pragma unroll
      for (int i = 0; i < 16; ++i) am = fmaxf(am, fabsf(xv[i]));
      am = wave_max(am);
      const float inv = am > 0.f ? 127.f / am : 0.f;
      u32x4 o;
#pragma unroll
      for (int i = 0; i < 4; ++i) {
        const int q0 = (int)rintf(xv[4 * i] * inv), q1 = (int)rintf(xv[4 * i + 1] * inv), q2 = (int)rintf(xv[4 * i + 2] * inv), q3 = (int)rintf(xv[4 * i + 3] * inv);
        o[i] = (unsigned)(q0 & 255) | ((unsigned)(q1 & 255) << 8) | ((unsigned)(q2 & 255) << 16) | ((unsigned)(q3 & 255) << 24);
      }
      *(GAS u32x4*)(p.x8 + (size_t)token * 1024 + 16 * lane) = o;
      if (lane == 0) p.sxq[token] = am * (1.f / 127.f) * rstd_of(rss_in, token);
    }
    asm volatile("s_waitcnt lgkmcnt(0)" ::: "memory");
#pragma unroll 1
    for (int hd = 0; hd < 8; ++hd) {
      const int k1 = wtops[(2 * hd) * 16 + ci], k2 = wtops[(2 * hd + 1) * 16 + cj];
      const float s1 = __int_as_float(fkey_s(k1 & ~127)), s2 = __int_as_float(fkey_s(k2 & ~127));
      const float val = s1 + s2;
      const int vk = cvalid ? ((fkey_s(__float_as_int(val)) & ~63) | (63 - lane)) : (int)0x80000000;
      int rank = 0;
#pragma unroll
      for (int c = 0; c < 50; ++c) rank += (__builtin_amdgcn_readlane(vk, c) > vk) ? 1 : 0;
      const float m = __int_as_float(__builtin_amdgcn_readlane(__float_as_int(val), 0));
      const bool sel = cvalid && rank < 16;
      const float ev = sel ? __expf(val - m) : 0.f;
      const float sum = wave_sum(ev);
      if (sel) {
        const int eid = (k1 & 127) * 128 + (k2 & 127);
        p.sel_id[(size_t)token * 128 + hd * 16 + rank] = eid;
        p.sel_g[(size_t)token * 128 + hd * 16 + rank] = ev / sum;
        p.sel_su[(size_t)token * 128 + hd * 16 + rank] = sul[eid];
      }
    }
    asm volatile("s_waitcnt lgkmcnt(0)" ::: "memory");
  }
}

DI void phase_peer_udot8(const int wq, PRef p, int l, char* smem, int coff) {
  const int tid = ltid(wq);
  const int lane = tid & 63, wv = tid >> 6;
  const int grp = lane >> 3, li = lane & 7;
  int* wid = (int*)(smem + wv * 4096);
  const bool b2 = li & 4, b1 = li & 2, b0 = li & 1;
  const int myx = (int)(xb_xcc_id() & 7u);
  for (int cs = 0; cs < 8; ++cs) {
    const int c = (myx + cs) & 7;
    const i8_t* U8 = p.u8 + ((size_t)l * 8 + c) * 16384 * 128 + li * 16;
    int* pb = (int*)p.pbuf + (size_t)c * T * 128;
    for (;;) {
      unsigned tb = 0;
      if (lane == 0) tb = atomicAdd(p.qctr + coff + c * 16, 8u);
      tb = __builtin_amdgcn_readfirstlane(tb);
      if (tb >= (unsigned)T) break;
      u32x4 xs[8];
      {
        int idl[16];
#pragma unroll
        for (int k = 0; k < 8; ++k) {
          idl[2 * k] = __builtin_nontemporal_load((const GAS int*)p.sel_id + (size_t)(tb + k) * 128 + lane);
          idl[2 * k + 1] = __builtin_nontemporal_load((const GAS int*)p.sel_id + (size_t)(tb + k) * 128 + 64 + lane);
          xs[k] = __builtin_nontemporal_load((gp_u32x4)(p.x8 + (size_t)(tb + k) * 1024 + c * 128 + li * 16));
        }
#pragma unroll
        for (int k = 0; k < 8; ++k) { wid[k * 128 + lane] = idl[2 * k]; wid[k * 128 + 64 + lane] = idl[2 * k + 1]; }
      }
      asm volatile("s_waitcnt lgkmcnt(0)" ::: "memory");
      auto issue = [&](int k, u32x4 (&g)[16]) {
        int ids[16];
#pragma unroll
        for (int i = 0; i < 4; ++i) {
          const u32x4 t4 = *(const u32x4*)(wid + k * 128 + grp * 16 + i * 4);
          ids[4 * i] = t4[0]; ids[4 * i + 1] = t4[1]; ids[4 * i + 2] = t4[2]; ids[4 * i + 3] = t4[3];
        }
#pragma unroll
        for (int i = 0; i < 16; ++i) g[i] = gload16(U8 + (size_t)ids[i] * 128);
      };
      auto consume = [&](int k, const u32x4 (&g)[16], const u32x4 cx) {
        const int x0 = (int)cx[0], x1 = (int)cx[1], x2 = (int)cx[2], x3 = (int)cx[3];
        int pp[16];
#pragma unroll
        for (int i = 0; i < 16; ++i) {
          const u32x4 u8 = g[i];
          const int u0 = (int)u8[0], u1 = (int)u8[1], u2 = (int)u8[2], u3 = (int)u8[3];
          int acc = __builtin_amdgcn_sdot4(x0, u0, 0, false);
          acc = __builtin_amdgcn_sdot4(x1, u1, acc, false);
          acc = __builtin_amdgcn_sdot4(x2, u2, acc, false);
          pp[i] = __builtin_amdgcn_sdot4(x3, u3, acc, false);
        }
        int q8[8], q4[4], q2[2];
#pragma unroll
        for (int i = 0; i < 8; ++i) { const int mine = b2 ? pp[i + 8] : pp[i], oth = b2 ? pp[i] : pp[i + 8]; q8[i] = mine + shxi(oth, 4, lane); }
#pragma unroll
        for (int i = 0; i < 4; ++i) { const int mine = b1 ? q8[i + 4] : q8[i], oth = b1 ? q8[i] : q8[i + 4]; q4[i] = mine + shxi(oth, 2, lane); }
#pragma unroll
        for (int i = 0; i < 2; ++i) { const int mine = b0 ? q4[i + 2] : q4[i], oth = b0 ? q4[i] : q4[i + 2]; q2[i] = mine + shxi(oth, 1, lane); }
        i32x2 ov; ov[0] = q2[0]; ov[1] = q2[1];
        __builtin_nontemporal_store(ov, (GAS i32x2*)(pb + (size_t)(tb + k) * 128 + 2 * lane));
      };
      u32x4 ga[16], gb[16];
      issue(0, ga);
#pragma unroll
      for (int k2 = 0; k2 < 4; ++k2) {
        issue(2 * k2 + 1, gb);
        consume(2 * k2, ga, xs[2 * k2]);
        if (k2 < 3) issue(2 * k2 + 2, ga);
        consume(2 * k2 + 1, gb, xs[2 * k2 + 1]);
      }
      asm volatile("s_waitcnt lgkmcnt(0)" ::: "memory");
    }
  }
}

DI void phase_peer_w(const int wq, PRef p) {
  const int tid = ltid(wq); const int bid = lbid();
  const int lane = tid & 63, wv = tid >> 6;
  const int stride = p.probe * 4;
  for (int token0 = bid * 4 + wv; token0 < T; token0 += 2 * stride) {
    i32x2 pp8[2][8]; u32x2 gg[2], su2[2]; float sxv[2];
#pragma unroll
    for (int u = 0; u < 2; ++u) {
      const int token = token0 + u * stride;
#pragma unroll
      for (int cc = 0; cc < 8; ++cc) pp8[u][cc] = __builtin_nontemporal_load((const GAS i32x2*)((const int*)p.pbuf + ((size_t)cc * T + token) * 128 + 2 * lane));
      gg[u] = __builtin_nontemporal_load((const GAS u32x2*)(p.sel_g + (size_t)token * 128 + 2 * lane));
      su2[u] = __builtin_nontemporal_load((const GAS u32x2*)(p.sel_su + (size_t)token * 128 + 2 * lane));
      sxv[u] = p.sxq[token];
    }
#pragma unroll
    for (int u = 0; u < 2; ++u) {
      const int token = token0 + u * stride;
      int d0 = 0, d1 = 0;
#pragma unroll
      for (int cc = 0; cc < 8; ++cc) { d0 += pp8[u][cc][0]; d1 += pp8[u][cc][1]; }
      const float f0 = (float)d0 * (sxv[u] * __uint_as_float(su2[u][0])), f1 = (float)d1 * (sxv[u] * __uint_as_float(su2[u][1]));
      u32x2 w2; w2[0] = __float_as_uint(__uint_as_float(gg[u][0]) * gelu_tanh(f0) * 0.0625f); w2[1] = __float_as_uint(__uint_as_float(gg[u][1]) * gelu_tanh(f1) * 0.0625f);
      *(GAS u32x2*)(p.sel_g + (size_t)token * 128 + 2 * lane) = w2;
    }
  }
}

DI void phase_peer_vacc8(const int wq, PRef p, int l, char* smem, int coff, int dry, int rss_idx) {
  const int myx = (int)(xb_xcc_id() & 7u);
  for (int cs = 0; cs < 8; ++cs) {
    const int c = (myx + cs) & 7;
    for (;;) {
      const int tid = ltid(wq);
      const int lane = tid & 63, wv = tid >> 6;
      int* wid = (int*)(smem + wv * 8192);
      float* ww = (float*)(smem + wv * 8192 + 4096);
      const int grp = lane >> 3, li = lane & 7;
      const bool g2 = grp & 4, g1 = grp & 2, g0 = grp & 1;
      const i8_t* V8 = p.v8 + ((size_t)l * 8 + c) * 16384 * 128 + li * 16;
      const int chan = c * 128 + li * 16 + 2 * grp;
      unsigned tb = 0;
      if (lane == 0) tb = atomicAdd(p.qctr + coff + c * 16, 8u);
      tb = __builtin_amdgcn_readfirstlane(tb);
      if (tb >= (unsigned)T) break;
      {
        u32x4 iv[4], wv4[4];
#pragma unroll
        for (int j4 = 0; j4 < 4; ++j4) {
          iv[j4] = __builtin_nontemporal_load((gp_u32x4)(p.sel_id + (size_t)tb * 128 + j4 * 256 + lane * 4));
          wv4[j4] = __builtin_nontemporal_load((gp_u32x4)(p.sel_g + (size_t)tb * 128 + j4 * 256 + lane * 4));
        }
#pragma unroll
        for (int j4 = 0; j4 < 4; ++j4) { *(u32x4*)(wid + j4 * 256 + lane * 4) = iv[j4]; *(u32x4*)(ww + j4 * 256 + lane * 4) = wv4[j4]; }
      }
      asm volatile("s_waitcnt lgkmcnt(0)" ::: "memory");
      auto issue = [&](int hh_, u32x4 (&g)[8]) {
        const int k = hh_ >> 1, hf = hh_ & 1;
        int ids[8];
#pragma unroll
        for (int i = 0; i < 2; ++i) {
          const u32x4 t4 = *(const u32x4*)(wid + k * 128 + grp * 16 + hf * 8 + i * 4);
          ids[4 * i] = t4[0]; ids[4 * i + 1] = t4[1]; ids[4 * i + 2] = t4[2]; ids[4 * i + 3] = t4[3];
        }
#pragma unroll
        for (int i = 0; i < 8; ++i) g[i] = gload16(V8 + (size_t)ids[i] * 128);
      };
      float o[16];
      u32x2 hcur;
      auto accum = [&](int hh_, const u32x4 (&g)[8]) {
        const int k = hh_ >> 1, hf = hh_ & 1;
        if (hf == 0) {
#pragma unroll
          for (int i = 0; i < 16; ++i) o[i] = 0.f;
          hcur = __builtin_nontemporal_load((GAS u32x2*)((GAS float*)p.h + ((size_t)tb + k) * D + chan));
        }
#pragma unroll
        for (int i = 0; i < 8; ++i) {
          const u32x4 v8 = g[i];
          const float w = ww[k * 128 + grp * 16 + hf * 8 + i];
          const int v0 = (int)v8[0], v1 = (int)v8[1], v2 = (int)v8[2], v3 = (int)v8[3];
          f32x2v t2;
          t2 = __builtin_amdgcn_cvt_pk_f32_fp8(v0, false); o[0] = fmaf(w, t2[0], o[0]); o[1] = fmaf(w, t2[1], o[1]);
          t2 = __builtin_amdgcn_cvt_pk_f32_fp8(v0, true);  o[2] = fmaf(w, t2[0], o[2]); o[3] = fmaf(w, t2[1], o[3]);
          t2 = __builtin_amdgcn_cvt_pk_f32_fp8(v1, false); o[4] = fmaf(w, t2[0], o[4]); o[5] = fmaf(w, t2[1], o[5]);
          t2 = __builtin_amdgcn_cvt_pk_f32_fp8(v1, true);  o[6] = fmaf(w, t2[0], o[6]); o[7] = fmaf(w, t2[1], o[7]);
          t2 = __builtin_amdgcn_cvt_pk_f32_fp8(v2, false); o[8] = fmaf(w, t2[0], o[8]); o[9] = fmaf(w, t2[1], o[9]);
          t2 = __builtin_amdgcn_cvt_pk_f32_fp8(v2, true);  o[10] = fmaf(w, t2[0], o[10]); o[11] = fmaf(w, t2[1], o[11]);
          t2 = __builtin_amdgcn_cvt_pk_f32_fp8(v3, false); o[12] = fmaf(w, t2[0], o[12]); o[13] = fmaf(w, t2[1], o[13]);
          t2 = __builtin_amdgcn_cvt_pk_f32_fp8(v3, true);  o[14] = fmaf(w, t2[0], o[14]); o[15] = fmaf(w, t2[1], o[15]);
        }
        if (hf == 1) {
          float r8[8], r4[4], r2[2];
#pragma unroll
          for (int i = 0; i < 8; ++i) { const float mine = g2 ? o[i + 8] : o[i], oth = g2 ? o[i] : o[i + 8]; r8[i] = mine + shx(oth, 32, lane); }
#pragma unroll
          for (int i = 0; i < 4; ++i) { const float mine = g1 ? r8[i + 4] : r8[i], oth = g1 ? r8[i] : r8[i + 4]; r4[i] = mine + shx(oth, 16, lane); }
#pragma unroll
          for (int i = 0; i < 2; ++i) { const float mine = g0 ? r4[i + 2] : r4[i], oth = g0 ? r4[i] : r4[i + 2]; r2[i] = mine + shx(oth, 8, lane); }
          if (!dry) {
            const size_t token = (size_t)tb + k;
            GAS float* hp = (GAS float*)p.h + token * D + chan;
            const u32x2 ch = hcur;
            const float h0 = __uint_as_float(ch[0]) + r2[0], h1 = __uint_as_float(ch[1]) + r2[1];
            u32x2 sv; sv[0] = __float_as_uint(h0); sv[1] = __float_as_uint(h1);
            __builtin_nontemporal_store(sv, (GAS u32x2*)hp);
            *(GAS unsigned*)(p.hn + token * HLD + chan) = pack2(h0, h1);
            if (rss_idx >= 0) {
              const float ss = wave_sum(h0 * h0 + h1 * h1);
              if (lane < 2) p.rss[((size_t)rss_idx * T + token) * 16 + 2 * c + lane] = lane == 0 ? ss : 0.f;
            }
          }
        }
      };
      u32x4 gA[8], gB[8], gC[8];
      issue(0, gA); issue(1, gB);
#pragma unroll
      for (int h3 = 0; h3 < 15; h3 += 3) {
        asm volatile("" ::: "memory");
        issue(h3 + 2, gC); accum(h3, gA);
        asm volatile("" ::: "memory");
        issue(h3 + 3, gA); accum(h3 + 1, gB);
        asm volatile("" ::: "memory");
        if (h3 + 4 < 16) issue(h3 + 4, gB);
        accum(h3 + 2, gC);
      }
      accum(15, gA);
      asm volatile("s_waitcnt lgkmcnt(0)" ::: "memory");
    }
  }
}

DI void phase_final_norm(const int wq, const float* __restrict__ in, const float* __restrict__ g, float* __restrict__ out, int rows, int nblk) {
  const int tid = ltid(wq); const int bid = lbid();
  const int lane = tid & 63, wv = tid >> 6;
  f32x4v gv[4];
#pragma unroll
  for (int i = 0; i < 4; ++i) gv[i] = *(const f32x4v*)(g + i * 256 + lane * 4);
  const int stride = nblk * 4;
  for (int r0 = bid * 4 + wv; r0 < rows; r0 += 2 * stride) {
    u32x4 v[8];
#pragma unroll
    for (int u = 0; u < 2; ++u)
#pragma unroll
      for (int i = 0; i < 4; ++i) v[u * 4 + i] = gload16(in + (size_t)(r0 + u * stride) * D + i * 256 + lane * 4);
#pragma unroll
    for (int u = 0; u < 2; ++u) {
      const int r = r0 + u * stride;
      float ss = 0.f;
#pragma unroll
      for (int i = 0; i < 4; ++i) {
        const u32x4 w = v[u * 4 + i];
        const unsigned w0 = w[0], w1 = w[1], w2 = w[2], w3 = w[3];
        const float a = __uint_as_float(w0), b = __uint_as_float(w1), c = __uint_as_float(w2), d = __uint_as_float(w3);
        ss += a * a + b * b + c * c + d * d;
      }
      ss = wave_sum(ss);
      const float rs = rsqrtf(ss / (float)D + 1e-6f);
#pragma unroll
      for (int i = 0; i < 4; ++i) {
        const u32x4 w = v[u * 4 + i];
        const unsigned w0 = w[0], w1 = w[1], w2 = w[2], w3 = w[3];
        u32x4 ov;
        ov[0] = __float_as_uint(__uint_as_float(w0) * rs * gv[i][0]); ov[1] = __float_as_uint(__uint_as_float(w1) * rs * gv[i][1]);
        ov[2] = __float_as_uint(__uint_as_float(w2) * rs * gv[i][2]); ov[3] = __float_as_uint(__uint_as_float(w3) * rs * gv[i][3]);
        *(GAS u32x4*)(out + (size_t)r * D + i * 256 + lane * 4) = ov;
      }
    }
  }
}

#define PROBE 0
constexpr int SMEM_BYTES = 73728;
__global__ void __launch_bounds__(NT, 2) mega(Params pk) {
  __shared__ __attribute__((aligned(16))) char smem_c[SMEM_BYTES];
  __shared__ uint4 xb_words;
  __shared__ Params sp;
  {
    const unsigned long long* src = (const unsigned long long*)&pk;
    unsigned long long* dst = (unsigned long long*)&sp;
    if (threadIdx.x < sizeof(Params) / 8) dst[threadIdx.x] = src[threadIdx.x];
  }
  if (threadIdx.x == 0) xb_words = make_uint4(0u, 0u, 0u, 0u);
  __syncthreads();
#define p (*lp((const __attribute__((address_space(3))) Params*)&sp))
  float* smem = (float*)smem_c;
  const int wq = __builtin_amdgcn_readfirstlane((int)(threadIdx.x >> 6));
  (void)xcd_barrier_post(p.bar, (volatile LAS unsigned*)&xb_words);
#define GRID_BARRIER() do { XcdBarrier bb_; bb_.bar = p.bar; bb_.x = xb_xcc_id(); bb_.st = (volatile LAS unsigned*)&xb_words; xcd_barrier(bb_); } while (0)

  phase_convert(wq, p.even_w_in, D, EVEN_IN, EVEN_IN, p.w_even_in, EVEN_IN, nullptr, 2, (size_t)D * EVEN_IN, (size_t)EVEN_IN * WK, 0, smem, p.mix_norm, 2 * D);
  phase_convert(wq, p.even_pool_w, 128, 128, 128, p.w_even_pool, 128, p.even_pool_scale, 8, 128 * 128, 128 * 128, 128, smem);
  phase_convert(wq, p.even_w_out, D, D, D, p.w_even_out, D, nullptr, 2, (size_t)D * D, (size_t)D * WK, 0, smem);
  phase_convert(wq, p.odd_w_in, D, ODD_IN, ODD_IN, p.w_odd_in, 3840, nullptr, 2, (size_t)D * ODD_IN, (size_t)3840 * WK, 0, smem, p.mix_norm + D, 2 * D);
  phase_convert(wq, p.odd_w_uv, 128, 64, 64, p.w_odd_uv, 128, nullptr, 16, 128 * 64, 128 * 128, 0, smem);
  phase_convert(wq, p.odd_w_out, D, D, D, p.w_odd_out, D, nullptr, 2, (size_t)D * D, (size_t)D * WK, 0, smem);
  phase_convert(wq, p.xattn_wq, D, D, D, p.w_xq, D, nullptr, 4, (size_t)D * D, (size_t)D * WK, 0, smem, p.xattn_norm, D);
  phase_convert(wq, p.xattn_wkv, D, 2048, 2048, p.w_xkv, 2048, nullptr, 4, (size_t)D * 2048, (size_t)2048 * WK, 0, smem);
  phase_convert(wq, p.xattn_wo, D, D, D, p.w_xo, D, nullptr, 4, (size_t)D * D, (size_t)D * WK, 0, smem);
  phase_convert(wq, p.peer_wq, D, 2048, 2048, p.w_pq, 2048, nullptr, 4, (size_t)D * 2048, (size_t)2048 * WK, 0, smem, p.peer_norm, D);
  phase_quant_u(wq, p.peer_u, p.u8, p.su, DEPTH * 16384, p.peer_norm, p.probe);
  phase_cvt_v8(wq, p.peer_v, p.v8, (size_t)DEPTH * 16384 * 1024 / 16, p.probe);
  phase_cvt_rows(wq, p.peer_keys, p.keys16, (size_t)DEPTH * 16 * 128 * 128 / 8);
  phase_init_h(wq, p.x, p.h, p.hn, p.rss, p.probe);
  phase_lb(wq, p);
  phase_rmsnorm_bf(wq, p.mem, D, p.mem_norm, p.memn, D, NB * NMEM, D);
  GRID_BARRIER();
  phase_gemm_wide<3>(wq, p.memn, D, p.w_xkv, p.kvh, 2048, NB * NMEM, 2048, D, smem_c, 0, DEPTH, 0, (size_t)2048 * WK, (size_t)2 * 2048 * 1024);
  GRID_BARRIER();
  for (int l = 0; l < DEPTH; ++l) {
    const int j = l >> 1;
    if ((l & 1) == 0) {
      phase_gemm_wide<2, 1>(wq, p.hn, HLD, p.w_even_in + (size_t)j * EVEN_IN * WK, p.P16, EVEN_IN, T, EVEN_IN, D, smem_c, 0, 1, 0, 0, 0, 1, 0, 0, p.rss + (size_t)(3 * l) * T * 16);
      GRID_BARRIER();
      phase_evenmix(wq, p, j);
      GRID_BARRIER();
      phase_gemm_bf16<2>(wq, p.pool, 512, p.w_even_pool + (size_t)j * 4 * 128 * 128, p.Y + 512, D, T, 128, 128, smem_c, 0, 4, 128, 128 * 128, 128);
      GRID_BARRIER();
      phase_gemm_wide<1>(wq, p.Y, D, p.w_even_out + (size_t)j * D * WK, p.h, D, T, D, D, smem_c, 0, 1, 0, 0, 0, 1, 0, 0, nullptr, p.hn, p.rss + (size_t)(3 * l + 1) * T * 16);
      GRID_BARRIER();
    } else {
      phase_gemm_wide<7, 1>(wq, p.hn, HLD, p.w_odd_in + (size_t)j * 3840 * WK, p.P16, ODD_IN, T, ODD_IN, D, smem_c, 0, 1, 0, 0, 0, 1, 0, 0, p.rss + (size_t)(3 * l) * T * 16,
                            p.qlat16, (float*)(p.odd_kv_norm + j * 128));
      GRID_BARRIER();
      phase_dsa_scores(wq, p, smem_c);
      GRID_BARRIER();
      phase_hgrn_scan(wq, p, l, smem_c);
      phase_dsa_attend(wq, p, j, smem_c, 64 * j);
      GRID_BARRIER();
      phase_gemm_bf16<2>(wq, p.lat, D, p.w_odd_uv + (size_t)j * 8 * 128 * 128, p.Y, D, T, 64, 128, smem_c, 0, 8, 128, 128 * 128, 64);
      phase_hgrn_post(wq, p, j);
      GRID_BARRIER();
      phase_gemm_wide<1>(wq, p.Y, D, p.w_odd_out + (size_t)j * D * WK, p.h, D, T, D, D, smem_c, 0, 1, 0, 0, 0, 1, 0, 0, nullptr, p.hn, p.rss + (size_t)(3 * l + 1) * T * 16);
      GRID_BARRIER();
    }
    phase_gemm_wide<6, 1>(wq, p.hn, HLD, p.w_xq + (size_t)l * D * WK, p.Y, D, T, D, D, smem_c, 0, 1, 0, 0, 0, 1, 0, 0, p.rss + (size_t)(3 * l + 1) * T * 16,
                          p.kvh + (size_t)l * 2 * 2048 * 1024, nullptr);
    GRID_BARRIER();
    phase_gemm_wide<1>(wq, p.Y, D, p.w_xo + (size_t)l * D * WK, p.h, D, T, D, D, smem_c, 0, 1, 0, 0, 0, 1, 0, 0, nullptr, p.hn, p.rss + (size_t)(3 * l + 2) * T * 16);
    GRID_BARRIER();
    phase_peer_qs(wq, p.hn, p.w_pq + (size_t)l * 2048 * WK, p.keys16 + (size_t)l * 16 * 128 * 128, p.tops, smem_c, p.rss + (size_t)(3 * l + 2) * T * 16);
    GRID_BARRIER();
    phase_peer_combine8(wq, p, l, smem_c, p.rss + (size_t)(3 * l + 2) * T * 16);
    GRID_BARRIER();
    phase_peer_udot8(wq, p, l, smem_c, 256 + (l * 2 + 0) * 128);
    GRID_BARRIER();
    phase_peer_w(wq, p);
    GRID_BARRIER();
    phase_peer_vacc8(wq, p, l, smem_c, 256 + (l * 2 + 1) * 128, 0, l + 1 < DEPTH ? 3 * l + 3 : -1);
    GRID_BARRIER();
  }
  phase_final_norm(wq, p.h, p.final_norm, p.out, T, p.probe);
}

#undef p
extern "C" void kernel_launch(void* const* d_in, const int* in_sizes, int n_in, void* d_out, int out_size, void* d_ws, size_t ws_size,
                              hipStream_t stream) {
  Params p; memset(&p, 0, sizeof(p));
  const float* const* in = (const float* const*)d_in;
  p.x = in[0]; p.mem = in[1]; p.mix_norm = in[2]; p.even_w_in = in[3]; p.even_conv_w = in[4]; p.even_pool_w = in[5];
  p.even_pool_scale = in[6]; p.even_w_out = in[7]; p.odd_w_in = in[8]; p.odd_kv_norm = in[9]; p.odd_w_uv = in[10];
  p.odd_hg_norm = in[11]; p.odd_w_out = in[12]; p.hgrn_gamma = in[13]; p.rel_bias = in[14]; p.mem_norm = in[15];
  p.xattn_norm = in[16]; p.xattn_wq = in[17]; p.xattn_wkv = in[18]; p.xattn_wo = in[19]; p.peer_norm = in[20];
  p.peer_wq = in[21]; p.peer_keys = in[22]; p.peer_u = in[23]; p.peer_v = in[24]; p.final_norm = in[25];
  p.out = (float*)d_out;
  char* w = (char*)d_ws;
  auto take = [&](size_t bytes) { char* r = w; w += (bytes + 255) / 256 * 256; return r; };
  p.bar = (unsigned*)take((XCD_BAR_WORDS + 2048) * 4); p.qctr = p.bar + XCD_BAR_WORDS;
  p.h = (float*)take((size_t)T * D * 4); p.P = (float*)take((size_t)T * ODD_IN * 4); p.P16 = (bf16_t*)p.P;
  p.oraw = (float*)take((size_t)T * 512 * 4); p.lb = (float*)take(DEPTH * 512 * 4);
  p.hn = (bf16_t*)take((size_t)T * HLD * 2); p.Y = (bf16_t*)take((size_t)T * D * 2); p.pool = (bf16_t*)take((size_t)T * 512 * 2);
  p.memn = (bf16_t*)take((size_t)NB * NMEM * D * 2); p.lat = (bf16_t*)take((size_t)T * D * 2);
  p.w_even_in = (bf16_t*)take((size_t)2 * EVEN_IN * WK * 2); p.w_even_pool = (bf16_t*)take((size_t)8 * 128 * 128 * 2);
  p.w_even_out = (bf16_t*)take((size_t)2 * D * WK * 2); p.w_odd_in = (bf16_t*)take((size_t)2 * 3840 * WK * 2);
  p.w_odd_uv = (bf16_t*)take((size_t)16 * 128 * 128 * 2); p.w_odd_out = (bf16_t*)take((size_t)2 * D * WK * 2);
  p.w_xq = (bf16_t*)take((size_t)4 * D * WK * 2); p.w_xkv = (bf16_t*)take((size_t)4 * 2048 * WK * 2); p.w_xo = (bf16_t*)take((size_t)4 * D * WK * 2);
  p.w_pq = (bf16_t*)take((size_t)4 * 2048 * WK * 2);
  p.u8 = (signed char*)take((size_t)DEPTH * 16384 * 1024); p.v8 = (signed char*)take((size_t)DEPTH * 16384 * 1024); p.x8 = (signed char*)take((size_t)T * 1024);
  p.su = (float*)take((size_t)DEPTH * 16384 * 4); p.sxq = (float*)take((size_t)T * 4); p.sel_su = (float*)take((size_t)T * 128 * 4);
  p.keys16 = (bf16_t*)take((size_t)DEPTH * 16 * 128 * 128 * 2); p.kvh = (bf16_t*)take((size_t)DEPTH * 2 * 2048 * 1024 * 2); p.rss = (float*)take((size_t)12 * T * 16 * 4);
  {
    char* a = (char*)p.P;
    p.sx = (float*)a; a += (size_t)T * 4 * 256 * 4;
    p.p16 = (bf16_t*)a; a += (size_t)T * 4 * 256 * 2;
    p.q16 = (bf16_t*)a; a += (size_t)T * D * 2;
    p.tops = (int*)a; a += (size_t)T * 256 * 4;
    p.sel_id = (int*)a; a += (size_t)T * 128 * 4;
    p.sel_g = (float*)a; a += (size_t)T * 128 * 4;
    p.pbuf = (float*)a;
  }
  p.qlat16 = (bf16_t*)take((size_t)T * 1024 * 2); p.ckv16 = (bf16_t*)take((size_t)T * 128 * 2); p.iq16 = (bf16_t*)take((size_t)T * 512 * 2);
  p.ik16 = (bf16_t*)take((size_t)T * 64 * 2); p.sc = (float*)take((size_t)T * 2048 * 4);

  static int grid = 0;
  if (!grid) {
    int dev = 0, cus = 0, per_cu = 0;
    (void)hipGetDevice(&dev);
    (void)hipDeviceGetAttribute(&cus, hipDeviceAttributeMultiprocessorCount, dev);
    (void)hipOccupancyMaxActiveBlocksPerMultiprocessor(&per_cu, mega, NT, 0);
    if (per_cu > 2) per_cu = 2;
    if (per_cu < 1) per_cu = 1;
    grid = cus * per_cu;
  }
  p.probe = grid;
  (void)hipMemsetAsync(p.bar, 0, (XCD_BAR_WORDS + 2048) * sizeof(unsigned), stream);
  mega<<<grid, NT, 0, stream>>>(p);
}
```
